# Optimizing an MI355X kernel written in HIP

```python
import math
import jax, jax.numpy as jnp
from jax import lax
import numpy as np

D_MODEL = 1024
BATCH = 1
SEQ = 16384
DEPTH = 2

D_MIX = D_MODEL
N_MIXERS = 4
GROUP_WIDTH = D_MIX // N_MIXERS

S5_CH = 16
S5_GROUPS = GROUP_WIDTH // S5_CH
S5_STATE = 64
S5_DT_MIN = 1e-3
S5_DT_MAX = 1e-1

RET_HEADS = 4
RET_HEAD_DIM = GROUP_WIDTH // RET_HEADS
RET_CHUNK = 128
ROPE_BASE = 10000.0

M2_HEADS = 4
M2_HEAD_DIM = GROUP_WIDTH // M2_HEADS
M2_NGROUPS = 2
M2_STATE = 128
M2_CONV = 4
M2_CHUNK = 128
M2_CONV_DIM = GROUP_WIDTH + 2 * M2_NGROUPS * M2_STATE

HG_HEADS = 4
HG_KEY_DIM = GROUP_WIDTH // HG_HEADS
HG_VAL_DIM = GROUP_WIDTH // HG_HEADS
HG_CHUNK = 16

D_IN = 10 * GROUP_WIDTH + M2_CONV_DIM + M2_HEADS

MOE_GROUPS = 4
MOE_PER_GROUP = 4
MOE_EXPERTS = MOE_GROUPS * MOE_PER_GROUP
MOE_TOPK = 2
MOE_FF = 512

NORM_EPS = 1e-6

kernel_name = 'hybrid_s5_retnet_ssd_hgrn2_hmoe'


def rms_norm(x, g):
    x32 = x.astype(jnp.float32)
    y = x32 * lax.rsqrt(jnp.mean(x32 * x32, axis=-1, keepdims=True) + NORM_EPS)
    return (y * g.astype(jnp.float32)).astype(x.dtype)


def head_layer_norm(o):
    o32 = o.astype(jnp.float32)
    c = o32 - jnp.mean(o32, axis=-1, keepdims=True)
    return (c * lax.rsqrt(jnp.mean(c * c, axis=-1, keepdims=True) + NORM_EPS)).astype(o.dtype)


def rotary(t, positions):
    half = t.shape[-1] // 2
    inv_freq = ROPE_BASE ** (-jnp.arange(half, dtype=jnp.float32) / half)
    ang = positions.astype(jnp.float32)[..., None] * inv_freq
    cos = jnp.cos(ang)[:, :, None, :].astype(t.dtype)
    sin = jnp.sin(ang)[:, :, None, :].astype(t.dtype)
    t1, t2 = t[..., :half], t[..., half:]
    return jnp.concatenate([t1 * cos - t2 * sin, t2 * cos + t1 * sin], axis=-1)


def causal_mask(n):
    i = jnp.arange(n)
    return i[:, None] >= i[None, :]


def chunk_state_scan(decay, inc):
    dtype = jnp.result_type(decay, inc)
    inc_t = jnp.moveaxis(inc.astype(dtype), 1, 0)
    dec_t = jnp.moveaxis(jnp.broadcast_to(decay, inc.shape).astype(dtype), 1, 0)

    def step(s, xs):
        d, u = xs
        return d * s + u, s

    _, prev = lax.scan(step, jnp.zeros_like(inc_t[0]), (dec_t, inc_t))
    return jnp.moveaxis(prev, 0, 1)


def causal_depthwise_conv(x, w, b):
    out = lax.conv_general_dilated(
        x, w[:, None, :], window_strides=(1,), padding=[(M2_CONV - 1, 0)],
        dimension_numbers=('NWC', 'WIO', 'NWC'), feature_group_count=x.shape[-1])
    return out + b


def _complex_affine_combine(e1, e2):
    a1r, a1i, b1r, b1i = e1
    a2r, a2i, b2r, b2i = e2
    return (a2r * a1r - a2i * a1i, a2r * a1i + a2i * a1r,
            a2r * b1r - a2i * b1i + b2r, a2r * b1i + a2i * b1r + b2i)


def s5_mixer(u, a_re, a_im, log_dt, b_re, b_im, c_re, c_im, d_skip, w_glu, b_glu):
    bsz, seqlen, _ = u.shape
    ug = u.reshape(bsz, seqlen, S5_GROUPS, S5_CH)
    a_re = jnp.minimum(a_re, -1e-4)
    dt = jnp.exp(log_dt)[:, None]
    mag = jnp.exp(a_re * dt)
    ab_re = mag * jnp.cos(a_im * dt)
    ab_im = mag * jnp.sin(a_im * dt)
    den = a_re * a_re + a_im * a_im
    k_re = ((ab_re - 1.0) * a_re + ab_im * a_im) / den
    k_im = (ab_im * a_re - (ab_re - 1.0) * a_im) / den
    bb_re = k_re[..., None] * b_re - k_im[..., None] * b_im
    bb_im = k_re[..., None] * b_im + k_im[..., None] * b_re
    bu_re = jnp.einsum('blgp,gnp->blgn', ug, bb_re)
    bu_im = jnp.einsum('blgp,gnp->blgn', ug, bb_im)
    dtype = bu_re.dtype
    elems = (jnp.broadcast_to(ab_re, bu_re.shape).astype(dtype),
             jnp.broadcast_to(ab_im, bu_re.shape).astype(dtype),
             bu_re, bu_im.astype(dtype))
    _, _, s_re, s_im = lax.associative_scan(_complex_affine_combine, elems, axis=1)
    y = (jnp.einsum('blgn,gpn->blgp', s_re, c_re)
         - jnp.einsum('blgn,gpn->blgp', s_im, c_im) + d_skip * ug)
    y = jax.nn.gelu(y.reshape(bsz, seqlen, GROUP_WIDTH))
    return y * jax.nn.sigmoid(y @ w_glu + b_glu)


def retention_mixer(q, k, v, g, positions):
    bsz, seqlen, _ = q.shape
    nc = seqlen // RET_CHUNK
    hs = (bsz, seqlen, RET_HEADS, RET_HEAD_DIM)
    cs = (bsz, nc, RET_CHUNK, RET_HEADS, RET_HEAD_DIM)
    qh = rotary(q.reshape(hs), positions).reshape(cs)
    kh = (rotary(k.reshape(hs), positions) * (RET_HEAD_DIM ** -0.5)).reshape(cs)
    vh = v.reshape(cs)
    log_gamma = jnp.log1p(-jnp.exp2(-5.0 - jnp.arange(RET_HEADS, dtype=jnp.float32)))
    idx = jnp.arange(RET_CHUNK, dtype=jnp.float32)
    mask = causal_mask(RET_CHUNK)
    rel = jnp.where(mask, idx[:, None] - idx[None, :], 0.0)
    decay = jnp.where(mask[None], jnp.exp(rel[None] * log_gamma[:, None, None]), 0.0)
    xi = jnp.exp((idx + 1.0)[None] * log_gamma[:, None])
    zeta = jnp.exp((RET_CHUNK - 1.0 - idx)[None] * log_gamma[:, None])
    scores = jnp.einsum('bnthd,bnshd->bnhts', qh, kh) * decay
    inner = jnp.einsum('bnhts,bnshe->bnthe', scores, vh)
    kv = jnp.einsum('bnshd,hs,bnshe->bnhde', kh, zeta, vh)
    r_prev = chunk_state_scan(jnp.exp(RET_CHUNK * log_gamma)[:, None, None], kv)
    cross = jnp.einsum('bnthd,ht,bnhde->bnthe', qh, xi, r_prev)
    o = head_layer_norm((inner + cross).reshape(hs))
    return o.reshape(bsz, seqlen, GROUP_WIDTH) * jax.nn.silu(g)


def mamba2_mixer(z, xbc, dt_raw, conv_w, conv_b, dt_bias, a_log, d_skip, norm_g):
    bsz, seqlen, _ = z.shape
    nc = seqlen // M2_CHUNK
    xbc = jax.nn.silu(causal_depthwise_conv(xbc, conv_w, conv_b))
    xs, bm, cm = jnp.split(xbc, [GROUP_WIDTH, GROUP_WIDTH + M2_NGROUPS * M2_STATE], axis=-1)
    xs = xs.reshape(bsz, seqlen, M2_HEADS, M2_HEAD_DIM)
    rep = M2_HEADS // M2_NGROUPS
    bm = jnp.repeat(bm.reshape(bsz, seqlen, M2_NGROUPS, M2_STATE), rep, axis=2)
    cm = jnp.repeat(cm.reshape(bsz, seqlen, M2_NGROUPS, M2_STATE), rep, axis=2)
    dt = jax.nn.softplus((dt_raw + dt_bias).astype(jnp.float32))
    da = dt * (-jnp.exp(a_log.astype(jnp.float32)))
    xc = (xs * dt[..., None]).reshape(bsz, nc, M2_CHUNK, M2_HEADS, M2_HEAD_DIM)
    bc = bm.reshape(bsz, nc, M2_CHUNK, M2_HEADS, M2_STATE)
    cc = cm.reshape(bsz, nc, M2_CHUNK, M2_HEADS, M2_STATE)
    acum = jnp.cumsum(da.reshape(bsz, nc, M2_CHUNK, M2_HEADS), axis=2)
    acum_h = jnp.moveaxis(acum, 2, 3)
    mask = causal_mask(M2_CHUNK)
    seg = jnp.where(mask, acum_h[..., :, None] - acum_h[..., None, :], 0.0)
    lmat = jnp.where(mask, jnp.exp(seg), 0.0)
    scores = jnp.einsum('bnthN,bnshN->bnhts', cc, bc) * lmat
    y_diag = jnp.einsum('bnhts,bnshp->bnthp', scores, xc)
    decay_states = jnp.exp(acum[:, :, -1:, :] - acum)
    states = jnp.einsum('bnshN,bnsh,bnshp->bnhpN', bc, decay_states, xc)
    s_prev = chunk_state_scan(jnp.exp(acum[:, :, -1, :])[..., None, None], states)
    y_off = jnp.einsum('bnthN,bnhpN,bnth->bnthp', cc, s_prev, jnp.exp(acum))
    y = (y_diag + y_off).reshape(bsz, seqlen, M2_HEADS, M2_HEAD_DIM) + d_skip[:, None] * xs
    return rms_norm(y.reshape(bsz, seqlen, GROUP_WIDTH) * jax.nn.silu(z), norm_g)


def hgrn2_mixer(q, f, i, g, lower_bound, norm_g):
    bsz, seqlen, _ = q.shape
    nc = seqlen // HG_CHUNK
    ck = (bsz, nc, HG_CHUNK, HG_HEADS, HG_KEY_DIM)
    cv = (bsz, nc, HG_CHUNK, HG_HEADS, HG_VAL_DIM)
    forget = lower_bound + (1.0 - lower_bound) * jax.nn.sigmoid(f.astype(jnp.float32))
    qc = jax.nn.silu(q).reshape(ck)
    kc = (1.0 - forget).reshape(ck)
    vc = i.reshape(cv)
    bcum = jnp.cumsum(jnp.log(forget).reshape(ck), axis=2)
    mask = causal_mask(HG_CHUNK)[:, :, None, None]
    diff = bcum[:, :, :, None] - bcum[:, :, None, :]
    wdec = jnp.where(mask, jnp.exp(jnp.where(mask, diff, 0.0)), 0.0)
    attn = jnp.einsum('bnthd,bnshd,bntshd->bnhts', qc, kc, wdec)
    intra = jnp.einsum('bnhts,bnshe->bnthe', attn, vc)
    blast = bcum[:, :, -1]
    states = jnp.einsum('bnshd,bnshe->bnhde', kc * jnp.exp(blast[:, :, None] - bcum), vc)
    s_prev = chunk_state_scan(jnp.exp(blast)[..., None], states)
    cross = jnp.einsum('bnthd,bnhde->bnthe', qc * jnp.exp(bcum), s_prev)
    o32 = (intra + cross).reshape(bsz, seqlen, HG_HEADS, HG_VAL_DIM).astype(jnp.float32)
    o32 = o32 * lax.rsqrt(jnp.mean(o32 * o32, axis=-1, keepdims=True) + NORM_EPS)
    o = (o32 * norm_g.reshape(HG_HEADS, HG_VAL_DIM).astype(jnp.float32)).astype(q.dtype)
    return o.reshape(bsz, seqlen, GROUP_WIDTH) * jax.nn.silu(g)


def hier_moe(h, w_group, b_group, w_expert, b_expert, w_gate, w_up, w_down):
    bsz, seqlen, _ = h.shape
    group_prob = jax.nn.softmax((h @ w_group + b_group).astype(jnp.float32), axis=-1)
    p_g, g_idx = lax.top_k(group_prob, 1)
    expert_logits = (h @ w_expert + b_expert).astype(jnp.float32).reshape(
        bsz, seqlen, MOE_GROUPS, MOE_PER_GROUP)
    in_group = jnp.take_along_axis(expert_logits, g_idx[..., None], axis=2)[:, :, 0]
    top_p, top_i = lax.top_k(jax.nn.softmax(in_group, axis=-1), MOE_TOPK)
    weights = p_g * top_p / jnp.sum(top_p, axis=-1, keepdims=True)
    expert_id = g_idx * MOE_PER_GROUP + top_i
    combine = jnp.einsum('blk,blke->ble', weights,
                         jax.nn.one_hot(expert_id, MOE_EXPERTS, dtype=weights.dtype))
    out = jnp.zeros_like(h)
    for e in range(MOE_EXPERTS):
        act = jax.nn.silu(h @ w_gate[e]) * (h @ w_up[e])
        out = out + combine[..., e:e + 1].astype(h.dtype) * (act @ w_down[e])
    return out


def setup_inputs(seed: int = 0) -> dict:
    key = jax.random.key(seed)
    ks = jax.random.split(key, 32)
    f32 = jnp.float32

    def nrm(k, shape, scale):
        return scale * jax.random.normal(k, shape, f32)

    def gain(k, shape):
        return 1.0 + 0.1 * jax.random.normal(k, shape, f32)

    L, G, N, P = DEPTH, S5_GROUPS, S5_STATE, S5_CH
    m2_dt = jnp.exp(jax.random.uniform(ks[17], (L, M2_HEADS), f32, math.log(1e-3), math.log(1e-1)))
    return {
        'x': jax.random.normal(ks[0], (BATCH, SEQ, D_MODEL), f32),
        'positions': jnp.broadcast_to(jnp.arange(SEQ, dtype=jnp.int32)[None, :], (BATCH, SEQ)),
        'norm1_g': gain(ks[1], (L, D_MODEL)),
        'w_in': nrm(ks[2], (L, D_MODEL, D_IN), D_MODEL ** -0.5),
        'w_out': nrm(ks[3], (L, D_MIX, D_MODEL), D_MIX ** -0.5),
        's5_a_re': -0.5 + nrm(ks[4], (L, G, N), 0.01),
        's5_a_im': math.pi * jnp.arange(N, dtype=f32) + nrm(ks[5], (L, G, N), 0.01),
        's5_log_dt': jax.random.uniform(ks[6], (L, G), f32, math.log(S5_DT_MIN), math.log(S5_DT_MAX)),
        's5_b_re': nrm(ks[7], (L, G, N, P), (2.0 * P) ** -0.5),
        's5_b_im': nrm(ks[8], (L, G, N, P), (2.0 * P) ** -0.5),
        's5_c_re': nrm(ks[9], (L, G, P, N), (2.0 * N) ** -0.5),
        's5_c_im': nrm(ks[10], (L, G, P, N), (2.0 * N) ** -0.5),
        's5_d': nrm(ks[11], (L, G, P), 1.0),
        's5_w_glu': nrm(ks[12], (L, GROUP_WIDTH, GROUP_WIDTH), GROUP_WIDTH ** -0.5),
        's5_b_glu': nrm(ks[13], (L, GROUP_WIDTH), 0.01),
        'm2_conv_w': nrm(ks[14], (L, M2_CONV, M2_CONV_DIM), M2_CONV ** -0.5),
        'm2_conv_b': nrm(ks[15], (L, M2_CONV_DIM), 0.01),
        'm2_dt_bias': m2_dt + jnp.log(-jnp.expm1(-m2_dt)),
        'm2_a_log': jnp.log(jax.random.uniform(ks[16], (L, M2_HEADS), f32, 1.0, 16.0)),
        'm2_d': gain(ks[18], (L, M2_HEADS)),
        'm2_norm_g': gain(ks[19], (L, GROUP_WIDTH)),
        'hg_lb_logits': nrm(ks[20], (L, HG_HEADS * HG_KEY_DIM), 0.1),
        'hg_norm_g': gain(ks[21], (L, GROUP_WIDTH)),
        'norm2_g': gain(ks[22], (L, D_MODEL)),
        'moe_w_group': nrm(ks[23], (L, D_MODEL, MOE_GROUPS), D_MODEL ** -0.5),
        'moe_b_group': nrm(ks[24], (L, MOE_GROUPS), 0.01),
        'moe_w_expert': nrm(ks[25], (L, D_MODEL, MOE_EXPERTS), D_MODEL ** -0.5),
        'moe_b_expert': nrm(ks[26], (L, MOE_EXPERTS), 0.01),
        'moe_w_gate': nrm(ks[27], (L, MOE_EXPERTS, D_MODEL, MOE_FF), D_MODEL ** -0.5),
        'moe_w_up': nrm(ks[28], (L, MOE_EXPERTS, D_MODEL, MOE_FF), D_MODEL ** -0.5),
        'moe_w_down': nrm(ks[29], (L, MOE_EXPERTS, MOE_FF, D_MODEL), MOE_FF ** -0.5),
        'final_norm_g': gain(ks[30], (D_MODEL,)),
    }


def reference(x, positions, norm1_g, w_in, w_out,
              s5_a_re, s5_a_im, s5_log_dt, s5_b_re, s5_b_im, s5_c_re, s5_c_im, s5_d,
              s5_w_glu, s5_b_glu,
              m2_conv_w, m2_conv_b, m2_dt_bias, m2_a_log, m2_d, m2_norm_g,
              hg_lb_logits, hg_norm_g,
              norm2_g, moe_w_group, moe_b_group, moe_w_expert, moe_b_expert,
              moe_w_gate, moe_w_up, moe_w_down,
              final_norm_g):
    lb_probs = jax.nn.softmax(hg_lb_logits.astype(jnp.float32), axis=0)
    lower_bounds = jnp.cumsum(lb_probs, axis=0) - lb_probs[0]
    sizes = (GROUP_WIDTH,) * 6 + (M2_CONV_DIM, M2_HEADS) + (GROUP_WIDTH,) * 4
    cuts = [int(c) for c in np.cumsum(sizes)[:-1]]
    for l in range(DEPTH):
        h = rms_norm(x, norm1_g[l])
        (s5_u, r_q, r_k, r_v, r_g, m_z, m_xbc, m_dt,
         g_q, g_f, g_i, g_g) = jnp.split(h @ w_in[l], cuts, axis=-1)
        y_s5 = s5_mixer(s5_u, s5_a_re[l], s5_a_im[l], s5_log_dt[l], s5_b_re[l], s5_b_im[l],
                        s5_c_re[l], s5_c_im[l], s5_d[l], s5_w_glu[l], s5_b_glu[l])
        y_ret = retention_mixer(r_q, r_k, r_v, r_g, positions)
        y_m2 = mamba2_mixer(m_z, m_xbc, m_dt, m2_conv_w[l], m2_conv_b[l], m2_dt_bias[l],
                            m2_a_log[l], m2_d[l], m2_norm_g[l])
        y_hg = hgrn2_mixer(g_q, g_f, g_i, g_g, lower_bounds[l], hg_norm_g[l])
        x = x + jnp.concatenate([y_s5, y_ret, y_m2, y_hg], axis=-1) @ w_out[l]
        x = x + hier_moe(rms_norm(x, norm2_g[l]), moe_w_group[l], moe_b_group[l],
                         moe_w_expert[l], moe_b_expert[l], moe_w_gate[l], moe_w_up[l],
                         moe_w_down[l])
    return rms_norm(x, final_norm_g)
```

```cpp
#ifndef EMU
#include <hip/hip_runtime.h>
#endif
#include <cstdio>
#include <cstdint>
#include <cmath>
#include <cstdlib>

#ifndef SEQ_LEN
#define SEQ_LEN 16384
#endif


typedef unsigned short bf16;
typedef short bf16x8 __attribute__((ext_vector_type(8)));
typedef float f32x4 __attribute__((ext_vector_type(4)));
typedef float f32x2 __attribute__((ext_vector_type(2)));
typedef unsigned u32x4 __attribute__((ext_vector_type(4)));
typedef unsigned u32x2 __attribute__((ext_vector_type(2)));
#ifdef EMU
#define LAS
#else
#define LAS __attribute__((address_space(3)))
#endif
typedef LAS bf16 lbf; typedef LAS float lf32; typedef LAS int li32; typedef LAS unsigned char lu8;

#ifdef EMU
#define WAVE_SYNC() emu::wave_barrier()
#else
#define WAVE_SYNC() do { __builtin_amdgcn_fence(__ATOMIC_RELEASE, "wavefront"); asm volatile("s_waitcnt lgkmcnt(0)" ::: "memory"); __builtin_amdgcn_wave_barrier(); } while (0)
#endif
constexpr int L = SEQ_LEN, D = 1024, NPROJ = 3328, DIN = 3332;
constexpr int C_S5U = 0, C_RQ = 256, C_RK = 512, C_RV = 768, C_RG = 1024, C_MZ = 1280, C_MX = 1536, C_MB = 1792, C_MC = 2048,
              C_GQ = 2304, C_GF = 2560, C_GI = 2816, C_GG = 3072;
constexpr int Y_S5 = 0, Y_RET = 256, Y_M2 = 512, Y_HG = 768;
constexpr int CH = 128, NCH = L / CH;
constexpr int HSC = 64, NHSC = L / HSC;
constexpr int T5 = 32, NCH5 = L / T5;
constexpr int NEXP = 16, FF = 512;
constexpr int NSLOTP = 2 * L + NEXP * 256;
constexpr float EPS = 1e-6f;
constexpr int NTHREADS = 512;
constexpr int LDS_BYTES = 147456;
constexpr int MISC_OFF = 147456 - 512;

constexpr size_t al(size_t x) { return (x + 4095) & ~(size_t)4095; }
constexpr size_t WS_CTL = 0, CTL_ZERO_BYTES = 1u << 20;
constexpr int CW_BAR = 4096;
constexpr int CW_CNT = 65536;
constexpr size_t WS_WIN = 1u << 20;
constexpr size_t WS_WOUT = WS_WIN + al((size_t)2 * NPROJ * 1024 * 2);
constexpr size_t WS_WGLU = WS_WOUT + al((size_t)2 * 1024 * 1024 * 2);
constexpr size_t WS_WGU = WS_WGLU + al((size_t)2 * 256 * 256 * 2);
constexpr size_t WS_WD = WS_WGU + al((size_t)16 * 1024 * 1024 * 2);
constexpr size_t WS_S5MT = WS_WD + al((size_t)16 * 1024 * 512 * 2);
constexpr size_t WS_S5BI = WS_S5MT + al((size_t)16 * 512 * 640 * 2);
constexpr size_t WS_S5AP = WS_S5BI + al((size_t)16 * 128 * 512 * 2);
constexpr size_t WS_S5BB = WS_S5AP + al((size_t)2 * 16 * 64 * 34 * 2 * 4);
constexpr size_t WS_S5KT = WS_S5BB + al((size_t)2 * 16 * 64 * 16 * 2 * 4);
constexpr size_t WS_ROPE = WS_S5KT + al((size_t)16 * 32 * 256 * 4);
constexpr size_t WS_DTW = WS_ROPE + al((size_t)L * 64 * 4);
constexpr size_t WS_HIST = WS_DTW;
constexpr size_t WS_LB = WS_DTW + al((size_t)2 * 1024 * 4 * 4);
constexpr size_t WS_ACT = WS_LB + al(2 * 256 * 4);
constexpr size_t WS_YPRE = WS_ACT + al((size_t)L * 1024 * 2);
constexpr size_t WS_DTRAW = WS_YPRE + al((size_t)L * 256 * 2);
constexpr size_t WS_ROUTE = WS_DTRAW + al((size_t)L * 4 * 4);
constexpr size_t WS_ST_RET = WS_ROUTE + al((size_t)2 * L * 8 * 4);
constexpr size_t WS_ST_M2 = WS_ST_RET + al((size_t)NCH * 4 * 4096 * 4);
constexpr size_t WS_DEC_M2 = WS_ST_M2 + al((size_t)NCH * 4 * 8192 * 4);
constexpr size_t WS_ST_HG = WS_DEC_M2 + al((size_t)NCH * 4 * 4);
constexpr size_t WS_DEC_HG = WS_ST_HG + al((size_t)NHSC * 4 * 4096 * 4);
constexpr size_t WS_ST_S5 = WS_DEC_HG + al((size_t)NHSC * 4 * 64 * 4);
constexpr size_t WS_SP_S5 = WS_ST_S5 + al((size_t)NCH5 * 16 * 128 * 4);
constexpr size_t WS_BIG = WS_SP_S5 + al((size_t)NCH5 * 16 * 128 * 2);
constexpr size_t BIG_BYTES = ((size_t)L * NPROJ * 2 > (size_t)NSLOTP * 1536 * 2) ? (size_t)L * NPROJ * 2 : (size_t)NSLOTP * 1536 * 2;
constexpr size_t WS_XRES = WS_ST_RET;
static_assert(WS_BIG - WS_ST_RET >= (size_t)L * 1024 * 2, "xres overlay");
#define XBC_PTR(F) ((bf16*)(F).out + (size_t)L * 1024)
static_assert((size_t)L * 768 * 2 <= (size_t)16 * 1024 * 1024 * 2, "xbc overlay");
constexpr size_t WS_H2G = WS_BIG, WS_ACTB = WS_BIG + (size_t)NSLOTP * 1024 * 2;
constexpr int NR5 = ((NCH5 + 255) / 256) * 256;
constexpr size_t WS_S5UG = WS_BIG + al(BIG_BYTES);
constexpr size_t WS_END = WS_S5UG + al((size_t)16 * NR5 * 640 * 2);

#ifdef EMU
__device__ __forceinline__ unsigned f2bf(float f) { unsigned u = __builtin_bit_cast(unsigned, f); return (u + 0x7fffu + ((u >> 16) & 1u)) >> 16; }
__device__ __forceinline__ unsigned pk2(float lo, float hi) { return f2bf(lo) | (f2bf(hi) << 16); }
#else
typedef __bf16 hw_bf16x2 __attribute__((ext_vector_type(2)));
__device__ __forceinline__ unsigned pk2(float lo, float hi) { return __builtin_bit_cast(unsigned, __builtin_convertvector((f32x2){lo, hi}, hw_bf16x2)); }
__device__ __forceinline__ unsigned f2bf(float f) { return pk2(f, 0.f) & 0xffffu; }
#endif
__device__ __forceinline__ float bf2f(unsigned short b) { return __builtin_bit_cast(float, ((unsigned)b) << 16); }
__device__ __forceinline__ float bflo(unsigned w) { return __builtin_bit_cast(float, w << 16); }
__device__ __forceinline__ float bfhi(unsigned w) { return __builtin_bit_cast(float, w & 0xffff0000u); }
#ifdef EMU
__device__ __forceinline__ float fexp(float x) { return expf(x); }
__device__ __forceinline__ float frcp(float x) { return 1.0f / x; }
__device__ __forceinline__ float frsq(float x) { return 1.0f / sqrtf(x); }
__device__ __forceinline__ float fexp2(float x) { return exp2f(x); }
__device__ __forceinline__ float flog(float x) { return logf(x); }
#else
__device__ __forceinline__ float fexp(float x) { return __builtin_amdgcn_exp2f(x * 1.4426950408889634f); }
__device__ __forceinline__ float frcp(float x) { return __builtin_amdgcn_rcpf(x); }
__device__ __forceinline__ float frsq(float x) { return __builtin_amdgcn_rsqf(x); }
__device__ __forceinline__ float fexp2(float x) { return __builtin_amdgcn_exp2f(x); }
__device__ __forceinline__ float flog(float x) { return __builtin_amdgcn_logf(x) * 0.6931471805599453f; }
#endif
__device__ __forceinline__ float sigmoidf_(float x) { return frcp(1.0f + fexp(-x)); }
__device__ __forceinline__ float siluf_(float x) { return x * frcp(1.0f + fexp(-x)); }
__device__ __forceinline__ float gelu_tanh(float x) { const float u = 0.7978845608028654f * (x + 0.044715f * x * x * x); return x * (1.0f - frcp(1.0f + fexp(2.0f * u))); }
#ifdef EMU
__device__ __forceinline__ float wave_sum(float v) {
#pragma unroll
    for (int o = 1; o < 64; o <<= 1) v += __shfl_xor(v, o);
    return v;
}
#else
__device__ __forceinline__ float wave_sum(float v) {
    v += __builtin_bit_cast(float, __builtin_amdgcn_update_dpp(0, __builtin_bit_cast(int, v), 0xB1, 0xF, 0xF, true));
    v += __builtin_bit_cast(float, __builtin_amdgcn_update_dpp(0, __builtin_bit_cast(int, v), 0x4E, 0xF, 0xF, true));
    v += __builtin_bit_cast(float, __builtin_amdgcn_update_dpp(0, __builtin_bit_cast(int, v), 0x141, 0xF, 0xF, true));
    v += __builtin_bit_cast(float, __builtin_amdgcn_update_dpp(0, __builtin_bit_cast(int, v), 0x140, 0xF, 0xF, true));
    const int iv = __builtin_bit_cast(int, v);
    return (__builtin_bit_cast(float, __builtin_amdgcn_readlane(iv, 0)) + __builtin_bit_cast(float, __builtin_amdgcn_readlane(iv, 16))) +
           (__builtin_bit_cast(float, __builtin_amdgcn_readlane(iv, 32)) + __builtin_bit_cast(float, __builtin_amdgcn_readlane(iv, 48)));
}
#endif
__device__ __forceinline__ void dsincos(double a, double& s, double& c) {
    const double k = __builtin_rint(a * 0.15915494309189535);
    const double r = __builtin_fma(-k, 6.283185307179586, a) - k * 2.4492935982947064e-16;
    const double r2 = r * r;
    double ps = 1.0 / 51090942171709440000.0;
    ps = ps * r2 - 1.0 / 121645100408832000.0; ps = ps * r2 + 1.0 / 355687428096000.0; ps = ps * r2 - 1.0 / 1307674368000.0; ps = ps * r2 + 1.0 / 6227020800.0;
    ps = ps * r2 - 1.0 / 39916800.0; ps = ps * r2 + 1.0 / 362880.0; ps = ps * r2 - 1.0 / 5040.0; ps = ps * r2 + 1.0 / 120.0; ps = ps * r2 - 1.0 / 6.0; ps = ps * r2 + 1.0;
    s = ps * r;
    double pc = -1.0 / 1124000727777607680000.0;
    pc = pc * r2 + 1.0 / 2432902008176640000.0; pc = pc * r2 - 1.0 / 6402373705728000.0; pc = pc * r2 + 1.0 / 20922789888000.0; pc = pc * r2 - 1.0 / 87178291200.0;
    pc = pc * r2 + 1.0 / 479001600.0; pc = pc * r2 - 1.0 / 3628800.0; pc = pc * r2 + 1.0 / 40320.0; pc = pc * r2 - 1.0 / 720.0; pc = pc * r2 + 1.0 / 24.0; pc = pc * r2 - 0.5; pc = pc * r2 + 1.0;
    c = pc;
}

#ifdef EMU
__device__ __forceinline__ unsigned ld_agent(const unsigned* p) { return __atomic_load_n(p, __ATOMIC_RELAXED); }
#else
__device__ __forceinline__ unsigned ld_agent(const unsigned* p) { return __hip_atomic_load(p, __ATOMIC_RELAXED, __HIP_MEMORY_SCOPE_AGENT); }
#endif
struct Args { const void* in[32]; float* out; unsigned char* ws; int ph_lo, ph_hi; };
struct Frame {
    lu8* lds; unsigned char* ws; float* out;
    int tid, lane, wave, G, bid, rep;
    const float* x; const int* pos;
    const LAS unsigned long long* ptab;
    __device__ __forceinline__ const float* inp(int i) const { const unsigned long long v = ptab[i];
        const unsigned lo = (unsigned)__builtin_amdgcn_readfirstlane((int)(unsigned)v), hi = (unsigned)__builtin_amdgcn_readfirstlane((int)(unsigned)(v >> 32));
#ifdef EMU
        return (const float*)(((unsigned long long)hi << 32) | lo); }
#else
        return (const float*)(const __attribute__((address_space(1))) float*)(((unsigned long long)hi << 32) | lo); }
#endif
};

#define norm1_g inp(2)
#define w_in inp(3)
#define w_out inp(4)
#define s5_a_re inp(5)
#define s5_a_im inp(6)
#define s5_log_dt inp(7)
#define s5_b_re inp(8)
#define s5_b_im inp(9)
#define s5_c_re inp(10)
#define s5_c_im inp(11)
#define s5_d inp(12)
#define s5_w_glu inp(13)
#define s5_b_glu inp(14)
#define m2_conv_w inp(15)
#define m2_conv_b inp(16)
#define m2_dt_bias inp(17)
#define m2_a_log inp(18)
#define m2_d inp(19)
#define m2_norm_g inp(20)
#define hg_lb_logits inp(21)
#define hg_norm_g inp(22)
#define norm2_g inp(23)
#define moe_w_group inp(24)
#define moe_b_group inp(25)
#define moe_w_expert inp(26)
#define moe_b_expert inp(27)
#define moe_w_gate inp(28)
#define moe_w_up inp(29)
#define moe_w_down inp(30)
#define final_norm_g inp(31)
#define WSP(T, off) ((T*)(F.ws + (off)))
#ifdef EMU
#define CFENCE() ((void)0)
#else
#define CFENCE() asm volatile("" ::: "memory")
#endif
#ifdef EMU
#define LAUNDER(F) ((void)0)
#define LAUNDER_I(x) ((void)0)
#else
#define LAUNDER(F) do { size_t z_ = 0; asm volatile("" : "+v"((F).tid), "+v"((F).lane), "+s"((F).wave), "+s"(z_)); (F).ws = (F).ws + z_; } while (0)
#define LAUNDER_I(x) asm volatile("" : "+v"(x))
#endif

#ifndef EMU
#define XB_TMO      128
#define XB_XCNT(j)  (256  + 64 * (j))
#define XB_XSUB(j)  (1280 + 64 * (j))
#define XB_XGEN(j)  (2304 + 64 * (j))
#define XB_TOP      3328
#define XB_TOPGEN   3392
#define XCD_BAR_WORDS 3456
#define XB_SPIN_CAP (1u << 20)
__device__ __forceinline__ unsigned xb_ld(unsigned* p)              { return __hip_atomic_load(p, __ATOMIC_RELAXED, __HIP_MEMORY_SCOPE_AGENT); }
__device__ __forceinline__ unsigned xb_add(unsigned* p, unsigned v) { return __hip_atomic_fetch_add(p, v, __ATOMIC_RELAXED, __HIP_MEMORY_SCOPE_AGENT); }
__device__ __forceinline__ unsigned xb_xcc_id() { return (unsigned)__builtin_amdgcn_s_getreg((3 << 11) | 20) & 0xFu; }
#define XB_SPIN(cond, bar) do { unsigned _sp = 0; while (cond) { __builtin_amdgcn_s_sleep(1); \
    if ((++_sp & 255u) == 0u) { if (xb_ld(&(bar)[XB_TMO])) break; if (_sp > XB_SPIN_CAP) { atomicAdd(&(bar)[XB_TMO], 1u); break; } } } } while (0)
struct XcdBarrier { unsigned* bar; unsigned x; volatile LAS unsigned* st; };
__device__ __forceinline__ XcdBarrier xcd_barrier_post(unsigned* bar, volatile LAS unsigned* st) {
    XcdBarrier b; b.bar = bar; b.x = xb_xcc_id(); b.st = st;
    if (threadIdx.x == 0) (void)xb_add(&bar[XB_XCNT(b.x)], 1u);
    return b;
}
__device__ __forceinline__ void xcd_barrier_complete(unsigned* bar, unsigned x, unsigned& nloc, unsigned& nx) {
    const unsigned G = gridDim.x * gridDim.y * gridDim.z;
    unsigned sum, cnt, mine, sp = 0u;
    for (;;) {
        sum = 0u; cnt = 0u; mine = 0u;
#pragma unroll
        for (unsigned j = 0; j < 16; ++j) { const unsigned c = xb_ld(&bar[XB_XCNT(j)]); sum += c; cnt += (c > 0u) ? 1u : 0u; mine = (j == x) ? c : mine; }
        if (sum == G) break;
        __builtin_amdgcn_s_sleep(1);
        if ((++sp & 255u) == 0u) { if (xb_ld(&bar[XB_TMO])) break; if (sp > XB_SPIN_CAP) { atomicAdd(&bar[XB_TMO], 1u); break; } }
    }
    nloc = mine > 0u ? mine : 1u; nx = cnt > 0u ? cnt : 1u;
}
__device__ __forceinline__ void xcd_barrier(const XcdBarrier& b) {
    asm volatile("s_waitcnt vmcnt(0)" ::: "memory");
    __syncthreads();
    if (threadIdx.x == 0) {
        unsigned* bar = b.bar;
        __builtin_amdgcn_s_waitcnt(0);
        unsigned nloc = b.st[0], nx = b.st[1];
        if (nloc == 0u) { xcd_barrier_complete(bar, b.x, nloc, nx); b.st[0] = nloc; b.st[1] = nx; }
        const unsigned old = xb_add(&bar[XB_XSUB(b.x)], 1u);
        const unsigned gen = old / nloc;
        if (old + 1u == (gen + 1u) * nloc) {
            __builtin_amdgcn_fence(__ATOMIC_RELEASE, "agent");
            asm volatile("s_waitcnt vmcnt(0)" ::: "memory");
            const unsigned og = xb_add(&bar[XB_TOP], 1u);
            const unsigned tg = og / nx;
            if (og + 1u == (tg + 1u) * nx) xb_add(&bar[XB_TOPGEN], 1u);
            else XB_SPIN(xb_ld(&bar[XB_TOPGEN]) == tg, bar);
            __builtin_amdgcn_fence(__ATOMIC_ACQUIRE, "agent");
            xb_add(&bar[XB_XGEN(b.x)], 1u);
            asm volatile("s_waitcnt vmcnt(0)" ::: "memory");
        } else {
            XB_SPIN(xb_ld(&bar[XB_XGEN(b.x)]) == gen, bar);
            __builtin_amdgcn_fence(__ATOMIC_ACQUIRE, "agent");
            asm volatile("s_waitcnt vmcnt(0)" ::: "memory");
        }
    }
    __syncthreads();
}
#endif

constexpr int GT_BK = 128, GT_LD = GT_BK + 8;
constexpr int GT_BYTES = 2 * 128 * GT_LD * 2;
template <class AP, class BP, class EPI>
__device__ __forceinline__ void gemm128(lu8* lds, int K, const AP& ap, const BP& bp, const EPI& epi) {
    int tid = threadIdx.x; LAUNDER_I(tid);
    const int lane = tid & 63, wid = tid >> 6, wr = wid >> 1, wc = wid & 1, fr = lane & 15, fq = lane >> 4;
    lbf* As = (lbf*)lds; lbf* Bs = (lbf*)(lds + 128 * GT_LD * 2);
    f32x4 acc[2][4];
#pragma unroll
    for (int m = 0; m < 2; ++m)
#pragma unroll
        for (int n = 0; n < 4; ++n) acc[m][n] = (f32x4){0.f, 0.f, 0.f, 0.f};
    u32x4 ra[2][4], rb[2][4];
    const int nk = K / GT_BK;
#define GT_LOAD(slot, k0) do { _Pragma("unroll") for (int i = 0; i < 4; ++i) { const int p = tid + 512 * i, r = p >> 4, kc = p & 15; ra[slot][i] = *(const u32x4*)ap(r, (k0) + kc * 8); rb[slot][i] = *(const u32x4*)bp(r, (k0) + kc * 8); } } while (0)
    GT_LOAD(0, 0);
    if (nk > 1) GT_LOAD(1, GT_BK);
    for (int kt = 0; kt < nk; kt += 2) {
#pragma unroll
        for (int half = 0; half < 2; ++half) {
            if (kt + half < nk) {
                __syncthreads();
#pragma unroll
                for (int i = 0; i < 4; ++i) { const int p = tid + 512 * i, r = p >> 4, kc = p & 15; *(LAS u32x4*)(As + r * GT_LD + kc * 8) = ra[half][i]; *(LAS u32x4*)(Bs + r * GT_LD + kc * 8) = rb[half][i]; }
                __syncthreads();
                if (kt + half + 2 < nk) GT_LOAD(half, (kt + half + 2) * GT_BK);
#pragma unroll
                for (int ks = 0; ks < 4; ++ks) {
                    bf16x8 a[2], b[4];
#pragma unroll
                    for (int m = 0; m < 2; ++m) a[m] = *(const LAS bf16x8*)(As + (wr * 32 + m * 16 + fr) * GT_LD + ks * 32 + fq * 8);
#pragma unroll
                    for (int n = 0; n < 4; ++n) b[n] = *(const LAS bf16x8*)(Bs + (wc * 64 + n * 16 + fr) * GT_LD + ks * 32 + fq * 8);
#pragma unroll
                    for (int m = 0; m < 2; ++m)
#pragma unroll
                        for (int n = 0; n < 4; ++n) acc[m][n] = __builtin_amdgcn_mfma_f32_16x16x32_bf16(b[n], a[m], acc[m][n], 0, 0, 0);
                }
            }
        }
    }
#undef GT_LOAD
#pragma unroll
    for (int m = 0; m < 2; ++m)
#pragma unroll
        for (int n = 0; n < 4; ++n) epi(wr * 32 + m * 16 + fr, wc * 64 + n * 16 + 4 * fq, acc[m][n]);
}
struct PtrRM { const bf16* base; size_t ld; int rmax;
    __device__ __forceinline__ const bf16* operator()(int r, int k) const { return base + (size_t)(r < rmax ? r : rmax) * ld + k; } };

template <int NT, int KS>
__device__ __forceinline__ void wave_mma(f32x4 (&acc)[NT], const lbf* A, int lda, const lbf* B, int ldb, int lane) {
    const int fr = lane & 15, fq = lane >> 4;
#pragma unroll
    for (int ks = 0; ks < KS; ++ks) {
        const bf16x8 a = *(const LAS bf16x8*)(A + fr * lda + ks * 32 + fq * 8);
#pragma unroll
        for (int n = 0; n < NT; ++n) { const bf16x8 b = *(const LAS bf16x8*)(B + (n * 16 + fr) * ldb + ks * 32 + fq * 8); acc[n] = __builtin_amdgcn_mfma_f32_16x16x32_bf16(b, a, acc[n], 0, 0, 0); }
    }
}


namespace g8 {
constexpr int BM = 256, BK = 64, HALF = 128, HTB = HALF * BK * 2, STAGE_BYTES = 8 * HTB;
__host__ __device__ __forceinline__ int lds_byte(int r, int c) { const int st = (r >> 4) * 2 + (c >> 5), rr = r & 15, cc = c & 31, ob = rr * 64 + cc * 2; return st * 1024 + (ob ^ (((ob >> 9) & 1) << 5)); }
__host__ __device__ __forceinline__ void stage_rc(int b, int& R, int& C) { const int st = b / 1024, sb = b % 1024, swz = sb ^ (((sb >> 9) & 1) << 5); R = (st >> 1) * 16 + swz / 64; C = (st & 1) * 32 + (swz % 64) / 2; }
__host__ __device__ __forceinline__ int perm32(int rho) { const int n = rho >> 4, i = rho & 15; return 8 * (i >> 2) + 4 * n + (i & 3); }
struct Unit { size_t aoff, boff; int pm, pn; };
#ifdef EMU
#define G8_WAIT_V(n) ((void)0)
#define G8_WAIT_L(n) ((void)0)
#else
#define G8_WAIT_V(n) asm volatile("s_waitcnt vmcnt(" #n ")" ::: "memory")
#define G8_WAIT_L(n) asm volatile("s_waitcnt lgkmcnt(" #n ")" ::: "memory")
#endif
template <class Epi, class Sched, bool ALIGN_EPI = true, bool SP2 = true>
__device__ __forceinline__ void gemm_phase(lu8* lds, const bf16* Abase, const bf16* Bbase, const int K, const Sched& S, const Epi& E) {
    const int tid = threadIdx.x, wid = __builtin_amdgcn_readfirstlane(tid >> 6), lane = tid & 63, wr = wid >> 2, wc = wid & 3, fr = lane & 15, fq = lane >> 4;
    const int nt = K / BK;
    unsigned voffA[2], voffB[2];
#pragma unroll
    for (int i = 0; i < 2; ++i) { int R, C; stage_rc(tid * 16 + i * 8192, R, C); const int Rb = Epi::PERM ? ((R & ~31) + perm32(R & 31)) : R;
        voffA[i] = (unsigned)(R * K + C) * 2u; voffB[i] = (unsigned)(Rb * K + C) * 2u; }
    const size_t kstep = (size_t)(BK * 2), hstep = (size_t)HALF * K * 2;
    const unsigned ldsw = (unsigned)wid * 1024u;
    const int aoff = lds_byte(wr * 64 + fr, fq * 8), boff = lds_byte(wc * 32 + fr, fq * 8);
#define G8_SA(b, h) (((b) * 2 + (h)) * HTB)
#define G8_SB(b, h) ((4 + (b) * 2 + (h)) * HTB)
#define G8_STAGE(bufoff, gbase, voff) do { _Pragma("unroll") for (int _i = 0; _i < 2; ++_i) \
        __builtin_amdgcn_global_load_lds((const unsigned*)((const char*)(gbase) + (voff)[_i]), (LAS unsigned*)(lds + (bufoff) + ldsw + _i * 8192), 16, 0, 0); } while (0)
#define G8_STAGEA(bufoff, gbase, voff) do { _Pragma("unroll") for (int _i = 0; _i < 2; ++_i) \
        __builtin_amdgcn_global_load_lds((const unsigned*)((const char*)(gbase) + (voff)[_i]), (LAS unsigned*)(lds + (bufoff) + ldsw + _i * 8192), 16, 0, Sched::A_AUX); } while (0)
#define G8_LDA(dst, b, h) do { _Pragma("unroll") for (int m = 0; m < 4; ++m) _Pragma("unroll") for (int k = 0; k < 2; ++k) dst[m][k] = *(const LAS bf16x8*)(lds + G8_SA(b, h) + aoff + m * 2048 + k * 1024); } while (0)
#define G8_LDB(dst, b, h) do { _Pragma("unroll") for (int n = 0; n < 2; ++n) _Pragma("unroll") for (int k = 0; k < 2; ++k) dst[n][k] = *(const LAS bf16x8*)(lds + G8_SB(b, h) + boff + n * 2048 + k * 1024); } while (0)
#define G8_MMA(ai, bj, At, Bt) do { __builtin_amdgcn_s_setprio(1); _Pragma("unroll") for (int m = 0; m < 4; ++m) _Pragma("unroll") for (int n = 0; n < 2; ++n) _Pragma("unroll") for (int k = 0; k < 2; ++k) \
        acc[ai][bj][m][n] = __builtin_amdgcn_mfma_f32_16x16x32_bf16(Bt[n][k], At[m][k], acc[ai][bj][m][n], 0, 0, 0); __builtin_amdgcn_s_setprio(0); } while (0)
#define G8_BAR __builtin_amdgcn_s_barrier()
#define G8_SCHED __builtin_amdgcn_sched_barrier(0)
    Unit cur, nxt; int ui = 0; int pend = -1;
    if (!S.next(0, cur)) return;
    f32x4 acc[2][2][4][2];
#pragma unroll
    for (int a = 0; a < 2; ++a)
#pragma unroll
        for (int b = 0; b < 2; ++b)
#pragma unroll
            for (int m = 0; m < 4; ++m)
#pragma unroll
                for (int n = 0; n < 2; ++n) acc[a][b][m][n] = (f32x4){0.f, 0.f, 0.f, 0.f};
    bf16x8 At[4][2], B0[2][2], B1[2][2];
    const char* cA = (const char*)Abase + cur.aoff; const char* cB = (const char*)Bbase + cur.boff;
    if constexpr (SP2) {
        G8_STAGE(G8_SB(0, 0), cB, voffB); G8_STAGE(G8_SB(0, 1), cB + hstep, voffB); G8_STAGEA(G8_SA(0, 0), cA, voffA); G8_STAGEA(G8_SA(0, 1), cA + hstep, voffA);
        if (wr == 1) G8_BAR;
        G8_WAIT_V(2); G8_BAR;
        G8_STAGE(G8_SB(1, 0), cB + kstep, voffB); G8_STAGEA(G8_SA(1, 0), cA + kstep, voffA); G8_STAGE(G8_SB(1, 1), cB + hstep + kstep, voffB);
        G8_WAIT_V(6); G8_BAR;
    } else {
        G8_STAGE(G8_SB(0, 0), cB, voffB); G8_STAGEA(G8_SA(0, 0), cA, voffA); G8_STAGE(G8_SB(0, 1), cB + hstep, voffB); G8_STAGEA(G8_SA(0, 1), cA + hstep, voffA);
        if (wr == 1) G8_BAR;
        G8_WAIT_V(4); G8_BAR;
        G8_STAGE(G8_SB(1, 0), cB + kstep, voffB); G8_STAGEA(G8_SA(1, 0), cA + kstep, voffA); G8_STAGE(G8_SB(1, 1), cB + hstep + kstep, voffB);
        G8_WAIT_V(6); G8_BAR;
    }
    for (;;) {
        const bool has_next = S.next(ui + 1, nxt);
        const char* nA = has_next ? (const char*)Abase + nxt.aoff : cA; const char* nB = has_next ? (const char*)Bbase + nxt.boff : cB;
        for (int t = 0; t < nt; t += 2) {
            const bool last = (t == nt - 2);
            if constexpr (Epi::DEFER_PUB) { if (t == 2 && pend >= 0) { E.publish(pend, lane == 0); pend = -1; } }
            const char* a1 = cA + (size_t)(t + 1) * kstep;
            const char* a2 = last ? nA : cA + (size_t)(t + 2) * kstep; const char* b2 = last ? nB : cB + (size_t)(t + 2) * kstep;
            const char* a3 = a2 + kstep; const char* b3 = b2 + kstep;
            if constexpr (SP2) {
            G8_LDB(B0, 0, 0); G8_LDB(B1, 0, 1); G8_SCHED; G8_LDA(At, 0, 0); G8_STAGEA(G8_SA(1, 1), a1 + hstep, voffA);
            G8_WAIT_V(8); G8_WAIT_L(0); G8_BAR; G8_MMA(0, 0, At, B0); G8_MMA(0, 1, At, B1); G8_BAR; G8_SCHED;
            G8_LDA(At, 0, 1); G8_STAGE(G8_SB(0, 0), b2, voffB); G8_STAGE(G8_SB(0, 1), b2 + hstep, voffB); G8_STAGEA(G8_SA(0, 0), a2, voffA);
            G8_WAIT_V(8); G8_WAIT_L(0); G8_BAR; G8_MMA(1, 0, At, B0); G8_MMA(1, 1, At, B1); G8_BAR; G8_SCHED;
            G8_LDB(B0, 1, 0); G8_LDB(B1, 1, 1); G8_SCHED; G8_LDA(At, 1, 0); G8_STAGEA(G8_SA(0, 1), a2 + hstep, voffA);
            G8_WAIT_V(8); G8_WAIT_L(0); G8_BAR; G8_MMA(0, 0, At, B0); G8_MMA(0, 1, At, B1); G8_BAR; G8_SCHED;
            G8_LDA(At, 1, 1); G8_STAGE(G8_SB(1, 0), b3, voffB); G8_STAGE(G8_SB(1, 1), b3 + hstep, voffB); G8_STAGEA(G8_SA(1, 0), a3, voffA);
            G8_WAIT_V(8); G8_WAIT_L(0); G8_BAR; G8_MMA(1, 0, At, B0); G8_MMA(1, 1, At, B1); G8_BAR; G8_SCHED;
            } else {
            G8_LDB(B0, 0, 0); G8_SCHED; G8_LDA(At, 0, 0); G8_STAGEA(G8_SA(1, 1), a1 + hstep, voffA);
            G8_WAIT_L(8); G8_BAR; G8_WAIT_L(0); G8_MMA(0, 0, At, B0); G8_BAR; G8_SCHED;
            G8_LDB(B1, 0, 1); G8_STAGE(G8_SB(0, 0), b2, voffB);
            G8_BAR; G8_WAIT_L(0); G8_MMA(0, 1, At, B1); G8_BAR;
            G8_LDA(At, 0, 1); G8_STAGEA(G8_SA(0, 0), a2, voffA);
            G8_BAR; G8_WAIT_L(0); G8_MMA(1, 0, At, B0); G8_BAR; G8_SCHED;
            G8_STAGE(G8_SB(0, 1), b2 + hstep, voffB);
            G8_WAIT_V(6); G8_BAR; G8_MMA(1, 1, At, B1); G8_BAR;
            G8_LDB(B0, 1, 0); G8_SCHED; G8_LDA(At, 1, 0); G8_STAGEA(G8_SA(0, 1), a2 + hstep, voffA);
            G8_WAIT_L(8); G8_BAR; G8_WAIT_L(0); G8_MMA(0, 0, At, B0); G8_BAR; G8_SCHED;
            G8_LDB(B1, 1, 1); G8_STAGE(G8_SB(1, 0), b3, voffB);
            G8_BAR; G8_WAIT_L(0); G8_MMA(0, 1, At, B1); G8_BAR;
            G8_LDA(At, 1, 1); G8_STAGEA(G8_SA(1, 0), a3, voffA);
            G8_BAR; G8_WAIT_L(0); G8_MMA(1, 0, At, B0); G8_BAR; G8_SCHED;
            G8_STAGE(G8_SB(1, 1), b3 + hstep, voffB);
            G8_WAIT_V(6); G8_BAR; G8_MMA(1, 1, At, B1); G8_BAR;
            }
        }
        if constexpr (ALIGN_EPI) { if (wr == 0) G8_BAR; }
        E(acc, cur, wr, wc, fr, fq);
        if constexpr (Epi::DEFER_PUB) pend = cur.pm;
        if (!has_next) break;
#pragma unroll
        for (int a = 0; a < 2; ++a)
#pragma unroll
            for (int b = 0; b < 2; ++b)
#pragma unroll
                for (int m = 0; m < 4; ++m)
#pragma unroll
                    for (int n = 0; n < 2; ++n) acc[a][b][m][n] = (f32x4){0.f, 0.f, 0.f, 0.f};
        cur = nxt; cA = nA; cB = nB; ++ui;
        if constexpr (ALIGN_EPI) { if (wr == 1) G8_BAR; }
    }
    G8_WAIT_V(0);
    if constexpr (Epi::DEFER_PUB) { if (pend >= 0) E.publish(pend, lane == 0); }
    if constexpr (!ALIGN_EPI) { if (wr == 0) G8_BAR; }
    G8_BAR;
#undef G8_SA
#undef G8_SB
#undef G8_STAGE
#undef G8_STAGEA
#undef G8_LDA
#undef G8_LDB
#undef G8_MMA
#undef G8_BAR
#undef G8_SCHED
}
struct GridOrder { static constexpr int A_AUX = 0; int nM, nN, nwg, G, c; size_t astep, bstep;
    __device__ __forceinline__ bool next(int i, Unit& u) const {
        const long Lx = (long)i * G + c; if (Lx >= nwg) return false;
        int wgid = (int)Lx; { const int q = nwg / 8, r = nwg % 8, xcd = wgid % 8, off = wgid / 8; wgid = (xcd < r ? xcd * (q + 1) : r * (q + 1) + (xcd - r) * q) + off; }
        const int nig = 8 * nN, gid = wgid / nig, fm = gid * 8, gsz = (nM - fm) < 8 ? (nM - fm) : 8;
        u.pm = fm + ((wgid % nig) % gsz); u.pn = (wgid % nig) / gsz; u.aoff = (size_t)u.pm * astep; u.boff = (size_t)u.pn * bstep; return true; } };
struct OneUnit { static constexpr int A_AUX = 0; int pm, pn; size_t astep, bstep;
    __device__ __forceinline__ bool next(int i, Unit& u) const { if (i != 0) return false; u.pm = pm; u.pn = pn; u.aoff = (size_t)pm * astep; u.boff = (size_t)pn * bstep; return true; } };
struct MoeOrder { static constexpr int A_AUX = 0; int np, G, c; const li32* pe; size_t astep, estep, bstep;
    __device__ __forceinline__ bool next(int i, Unit& u) const {
        int Lx = i * G + c; const int nwg = np * 4; if (Lx >= nwg) return false;
        { const int q = nwg / 8, r = nwg % 8, xcd = Lx % 8, off = Lx / 8; Lx = (xcd < r ? xcd * (q + 1) : r * (q + 1) + (xcd - r) * q) + off; }
        u.pm = Lx >> 2; u.pn = Lx & 3; u.aoff = (size_t)u.pm * astep; const int e = __builtin_amdgcn_readfirstlane(pe[u.pm]); u.boff = (size_t)e * estep + (size_t)u.pn * bstep; return true; } };
struct EpiStore {
    static constexpr bool PERM = true, DEFER_PUB = false;
    bf16* O; int ldc;
    __device__ __forceinline__ void operator()(const f32x4 (&acc)[2][2][4][2], const Unit& u, int wr, int wc, int fr, int fq) const {
        const int row0 = u.pm * BM + wr * 64 + fr, col0 = u.pn * BM + wc * 32 + 8 * fq;
#pragma unroll
        for (int ai = 0; ai < 2; ++ai)
#pragma unroll
            for (int m = 0; m < 4; ++m) { bf16* rowp = O + (size_t)(row0 + ai * HALF + m * 16) * ldc + col0;
#pragma unroll
                for (int bj = 0; bj < 2; ++bj) { const f32x4 v0 = acc[ai][bj][m][0], v1 = acc[ai][bj][m][1];
                    u32x4 w; w.x = pk2(v0.x, v0.y); w.y = pk2(v0.z, v0.w); w.z = pk2(v1.x, v1.y); w.w = pk2(v1.z, v1.w); *(u32x4*)(rowp + bj * HALF) = w; } }
    } };
template <bool XBF>
struct EpiResid {
    static constexpr bool PERM = true, DEFER_PUB = false;
    const void* xin; bf16* out;
    __device__ __forceinline__ void operator()(const f32x4 (&acc)[2][2][4][2], const Unit& u, int wr, int wc, int fr, int fq) const {
        const int row0 = u.pm * BM + wr * 64 + fr, col0 = u.pn * BM + wc * 32 + 8 * fq;
#pragma unroll
        for (int ai = 0; ai < 2; ++ai)
#pragma unroll
            for (int m = 0; m < 4; ++m) { const size_t ro = (size_t)(row0 + ai * HALF + m * 16) * D + col0;
#pragma unroll
                for (int bj = 0; bj < 2; ++bj) { const size_t o = ro + bj * HALF; f32x4 x0, x1;
                    if (XBF) { const u32x4 xb = *(const u32x4*)((const bf16*)xin + o); x0 = (f32x4){bflo(xb.x), bfhi(xb.x), bflo(xb.y), bfhi(xb.y)}; x1 = (f32x4){bflo(xb.z), bfhi(xb.z), bflo(xb.w), bfhi(xb.w)}; }
                    else { x0 = *(const f32x4*)((const float*)xin + o); x1 = *(const f32x4*)((const float*)xin + o + 4); }
                    const f32x4 v0 = x0 + acc[ai][bj][m][0], v1 = x1 + acc[ai][bj][m][1];
                    u32x4 w; w.x = pk2(v0.x, v0.y); w.y = pk2(v0.z, v0.w); w.z = pk2(v1.x, v1.y); w.w = pk2(v1.z, v1.w); *(u32x4*)(out + o) = w; } }
    } };
struct EpiStoreU {
    static constexpr bool PERM = true, DEFER_PUB = false;
    bf16* O; int ldc; bf16* ug;
    __device__ __forceinline__ void operator()(const f32x4 (&acc)[2][2][4][2], const Unit& u, int wr, int wc, int fr, int fq) const {
        const int row0 = u.pm * BM + wr * 64 + fr, col0 = u.pn * BM + wc * 32 + 8 * fq;
#pragma unroll
        for (int ai = 0; ai < 2; ++ai)
#pragma unroll
            for (int m = 0; m < 4; ++m) { const int t = row0 + ai * HALF + m * 16; bf16* rowp = O + (size_t)t * ldc + col0;
#pragma unroll
                for (int bj = 0; bj < 2; ++bj) { const f32x4 v0 = acc[ai][bj][m][0], v1 = acc[ai][bj][m][1];
                    u32x4 w; w.x = pk2(v0.x, v0.y); w.y = pk2(v0.z, v0.w); w.z = pk2(v1.x, v1.y); w.w = pk2(v1.z, v1.w); *(u32x4*)(rowp + bj * HALF) = w;
                    if (u.pn == 0) { const int g = 8 * bj + 2 * wc + (fq >> 1); *(u32x4*)(ug + ((size_t)g * NR5 + (t >> 5)) * 640 + (t & 31) * 16 + 8 * (fq & 1)) = w; } } }
    } };
template <class Q>
struct EpiQuad {
    static constexpr bool PERM = false, DEFER_PUB = false;
    Q q;
    __device__ __forceinline__ void operator()(const f32x4 (&acc)[2][2][4][2], const Unit& u, int wr, int wc, int fr, int fq) const {
#pragma unroll
        for (int ai = 0; ai < 2; ++ai)
#pragma unroll
            for (int m = 0; m < 4; ++m)
#pragma unroll
                for (int bj = 0; bj < 2; ++bj)
#pragma unroll
                    for (int n = 0; n < 2; ++n) q(u.pm * BM + ai * HALF + wr * 64 + m * 16 + fr, u.pn * BM + bj * HALF + wc * 32 + n * 16 + 4 * fq, acc[ai][bj][m][n]);
    } };
struct EpiGateUp {
    static constexpr bool PERM = true, DEFER_PUB = false;
    bf16* act; unsigned act_bytes; unsigned* cnt;
    __device__ __forceinline__ void operator()(const f32x4 (&acc)[2][2][4][2], const Unit& u, int wr, int wc, int fr, int fq) const {
        const int row0 = u.pm * BM + wr * 64 + fr, col0 = u.pn * HALF + wc * 32 + 8 * fq;
#ifndef EMU
        const __amdgpu_buffer_rsrc_t rs = __builtin_amdgcn_make_buffer_rsrc(act, 0, (int)act_bytes, 0x00020000);
#endif
#pragma unroll
        for (int ai = 0; ai < 2; ++ai)
#pragma unroll
            for (int m = 0; m < 4; ++m) { const f32x4 g0 = acc[ai][0][m][0], g1 = acc[ai][0][m][1], u0 = acc[ai][1][m][0], u1 = acc[ai][1][m][1];
                u32x4 w; w.x = pk2(siluf_(g0.x) * u0.x, siluf_(g0.y) * u0.y); w.y = pk2(siluf_(g0.z) * u0.z, siluf_(g0.w) * u0.w);
                w.z = pk2(siluf_(g1.x) * u1.x, siluf_(g1.y) * u1.y); w.w = pk2(siluf_(g1.z) * u1.z, siluf_(g1.w) * u1.w);
                const size_t o = (size_t)(row0 + ai * HALF + m * 16) * 512 + col0;
#ifdef EMU
                *(u32x4*)(act + o) = w;
#else
                __builtin_amdgcn_raw_buffer_store_b128(w, rs, (unsigned)(o * 2), 0, 16);
#endif
            }
        G8_WAIT_V(0); publish(u.pm, fr == 0 && fq == 0);
    }
    __device__ __forceinline__ void publish(int pm, bool leader) const { if (leader) atomicAdd(cnt + pm * 16, 1u); } };
struct MoeOrderDep { static constexpr int A_AUX = 16; int np, G, rank, n3; const li32* pe; size_t astep, estep, bstep; const unsigned* cnt; int wid;
    __device__ __forceinline__ bool next(int i, Unit& u) const {
        const int nwg = np * 4; int Lx;
        if (n3 >= 0) { if (i == 0) Lx = rank; else if (i == 1) { if (rank >= G - n3) return false; Lx = G + rank; } else if (i == 2) { if (rank >= 2 * n3) return false; Lx = 2 * G - n3 + rank; } else return false; }
        else Lx = i * G + rank;
        if (Lx >= nwg) return false;
        { const int q = nwg / 8, r = nwg % 8, xcd = Lx % 8, off = Lx / 8; Lx = (xcd < r ? xcd * (q + 1) : r * (q + 1) + (xcd - r) * q) + off; }
        u.pm = Lx >> 2; u.pn = Lx & 3; u.aoff = (size_t)u.pm * astep; const int e = __builtin_amdgcn_readfirstlane(pe[u.pm]); u.boff = (size_t)e * estep + (size_t)u.pn * bstep;
        if (wid == 0) { unsigned spins = 0; while (ld_agent(cnt + u.pm * 16) < 32u && ++spins < (1u << 22)) __builtin_amdgcn_s_sleep(1); }
        if (i == 0) __syncthreads();
        return true; } };
}

constexpr int CW_DEP = 196608;
constexpr int CW_Q = 131072;
__device__ __forceinline__ int grab_unit(Frame& F, unsigned* ctr) {
    li32* slot = (li32*)(F.lds + MISC_OFF + 128);
    __syncthreads();
    if (F.tid == 0) *slot = (int)atomicAdd(ctr, 1u);
    __syncthreads();
    return *slot;
}
__device__ __forceinline__ void transpose_item(const float* src, int ldsrc, int scol0, int k0, bf16* dst, int K, int drow0, const float* scale, int lane) {
    const int kq = lane >> 3, n2 = lane & 7;
    const float* sp = src + (size_t)(k0 + 8 * kq) * ldsrc + scol0 + 4 * n2;
    f32x4 v[8];
#pragma unroll
    for (int i = 0; i < 8; ++i) v[i] = *(const f32x4*)(sp + (size_t)i * ldsrc);
    if (scale) { const f32x4 s0 = *(const f32x4*)(scale + k0 + 8 * kq), s1 = *(const f32x4*)(scale + k0 + 8 * kq + 4);
        v[0] *= s0.x; v[1] *= s0.y; v[2] *= s0.z; v[3] *= s0.w; v[4] *= s1.x; v[5] *= s1.y; v[6] *= s1.z; v[7] *= s1.w; }
    bf16* dp = dst + (size_t)(drow0 + 4 * n2) * K + k0 + 8 * kq;
#pragma unroll
    for (int j = 0; j < 4; ++j) { u32x4 o; o.x = pk2(v[0][j], v[1][j]); o.y = pk2(v[2][j], v[3][j]); o.z = pk2(v[4][j], v[5][j]); o.w = pk2(v[6][j], v[7][j]);
        *(u32x4*)(dp + (size_t)j * K) = o; }
}
constexpr int CONV_GU_UNITS = 16 * 2 * 256 / 32, CONV_D_UNITS = 16 * 256 / 32;
template <int NI>
__device__ __forceinline__ void transpose_items(const float* src, int ldsrc, int scol0, int k0, bf16* dst, int K, int drow0, int lane) {
    const int kq = lane >> 3, n2 = lane & 7;
    const float* sp = src + (size_t)(k0 + 8 * kq) * ldsrc + scol0 + 4 * n2;
    f32x4 v[NI][8];
#pragma unroll
    for (int i = 0; i < 8; ++i)
#pragma unroll
        for (int q = 0; q < NI; ++q) v[q][i] = *(const f32x4*)(sp + (size_t)i * ldsrc + 32 * q);
    bf16* dp = dst + (size_t)(drow0 + 4 * n2) * K + k0 + 8 * kq;
#pragma unroll
    for (int q = 0; q < NI; ++q)
#pragma unroll
        for (int j = 0; j < 4; ++j) { u32x4 o; o.x = pk2(v[q][0][j], v[q][1][j]); o.y = pk2(v[q][2][j], v[q][3][j]); o.z = pk2(v[q][4][j], v[q][5][j]); o.w = pk2(v[q][6][j], v[q][7][j]);
            *(u32x4*)(dp + (size_t)(32 * q + j) * K) = o; }
}
__device__ __forceinline__ void conv_gu_unit(Frame& F0, int l, int cu) {
    Frame F = F0; LAUNDER(F);
    const int it0 = cu * 32 + F.wave * 4, e = it0 >> 9, up = (it0 >> 8) & 1, r = it0 & 255, kb = r >> 4, nb0 = r & 15;
    const float* src = (up ? F.moe_w_up : F.moe_w_gate) + ((size_t)l * 16 + e) * 1024 * 512;
    const int ff0 = 32 * nb0, drow0 = (ff0 >> 7) * 256 + up * 128;
    transpose_items<4>(src, 512, ff0, 64 * kb, WSP(bf16, WS_WGU) + (size_t)e * 1024 * 1024, 1024, drow0, F.lane);
}
__device__ __forceinline__ void conv_d_unit(Frame& F0, int l, int cu) {
    Frame F = F0; LAUNDER(F);
    const int it0 = cu * 32 + F.wave * 4, e = it0 >> 8, r = it0 & 255, kb = r >> 5, nb0 = r & 31;
    transpose_items<4>(F.moe_w_down + ((size_t)l * 16 + e) * 512 * 1024, 1024, 32 * nb0, 64 * kb, WSP(bf16, WS_WD) + (size_t)e * 1024 * 512, 512, 32 * nb0, F.lane);
}
__device__ __forceinline__ void r1_row(Frame& F, int t, int mode, const LAS f32x4* dw) {
    const int lane = F.lane;
    f32x4 v[4];
    if (mode == 0) { const f32x4* xr = (const f32x4*)(F.x + (size_t)t * D) + lane;
#pragma unroll
        for (int j = 0; j < 4; ++j) v[j] = xr[64 * j]; }
    else { const u32x2* xr = (const u32x2*)(WSP(bf16, WS_XRES) + (size_t)t * D) + lane;
#pragma unroll
        for (int j = 0; j < 4; ++j) { const u32x2 xb = xr[64 * j]; v[j] = (f32x4){bflo(xb.x), bfhi(xb.x), bflo(xb.y), bfhi(xb.y)}; } }
    if (mode != 0) {
        const int* rt = WSP(int, WS_ROUTE) + ((size_t)(mode == 2 ? L : 0) + t) * 8; const float* rtf = (const float*)rt;
        const bf16* ym = WSP(bf16, WS_H2G);
#pragma unroll
        for (int k = 0; k < 2; ++k) { const int slot = rt[6 + k]; const float w = rtf[4 + k];
            const u32x2* yr = (const u32x2*)(ym + (size_t)slot * 1024) + lane;
#pragma unroll
            for (int j = 0; j < 4; ++j) { const u32x2 y = yr[64 * j]; v[j].x += w * bflo(y.x); v[j].y += w * bfhi(y.x); v[j].z += w * bflo(y.y); v[j].w += w * bfhi(y.y); } }
    }
    float ss = 0.f;
#pragma unroll
    for (int j = 0; j < 4; ++j) ss += (v[j].x * v[j].x + v[j].y * v[j].y) + (v[j].z * v[j].z + v[j].w * v[j].w);
    const float rstd = frsq(wave_sum(ss) * (1.0f / D) + EPS);
    if (mode == 2) {
        f32x4* o = (f32x4*)(F.out + (size_t)t * D) + lane; const f32x4* g = (const f32x4*)F.final_norm_g + lane;
#pragma unroll
        for (int j = 0; j < 4; ++j) o[64 * j] = v[j] * rstd * g[64 * j];
        return;
    }
    if (mode == 1) { u32x2* o = (u32x2*)((bf16*)F.out + (size_t)t * D) + lane;
#pragma unroll
        for (int j = 0; j < 4; ++j) { u32x2 w; w.x = pk2(v[j].x, v[j].y); w.y = pk2(v[j].z, v[j].w); o[64 * j] = w; } }
    u32x2* hb = (u32x2*)(WSP(bf16, WS_ACT) + (size_t)t * D) + lane;
    f32x4 da = (f32x4){0.f, 0.f, 0.f, 0.f};
#pragma unroll
    for (int j = 0; j < 4; ++j) { const f32x4 h = v[j] * rstd; u32x2 w; w.x = pk2(h.x, h.y); w.y = pk2(h.z, h.w); hb[64 * j] = w;
        const int k = 4 * lane + 256 * j; da += h.x * dw[k] + h.y * dw[k + 1] + h.z * dw[k + 2] + h.w * dw[k + 3]; }
    da.x = wave_sum(da.x); da.y = wave_sum(da.y); da.z = wave_sum(da.z); da.w = wave_sum(da.w);
    if (lane == 0) *(f32x4*)(WSP(float, WS_DTRAW) + (size_t)t * 4) = da;
}

__device__ __forceinline__ void r1_phase(Frame& F, int mode, int l) {
    LAS f32x4* dw = (LAS f32x4*)F.lds;
    if (mode != 2) { for (int k = F.tid; k < 1024; k += NTHREADS) { const float g = F.norm1_g[l * 1024 + k]; dw[k] = g * *(const f32x4*)(F.w_in + ((size_t)l * 1024 + k) * DIN + 2304); } }
    __syncthreads();
    const int gw = F.bid * 8 + F.wave, ngw = F.G * 8;
    for (int t = gw; t < L; t += ngw) r1_row(F, t, mode, dw);
}

__device__ __forceinline__ void phase_p0(Frame& F) {
    const int gw = F.bid * 8 + F.wave, ngw = F.G * 8, gt = F.bid * NTHREADS + F.tid, ngt = F.G * NTHREADS;
    {
        constexpr int I_IN = (1024 / 64) * (NPROJ / 32), I_OUT = (1024 / 64) * (1024 / 32), I_GLU = (256 / 64) * (256 / 32);
        constexpr int NIT = 2 * (I_IN + I_OUT + I_GLU);
        for (int it = gw; it < NIT; it += ngw) {
            const int l = it / (I_IN + I_OUT + I_GLU); int r = it % (I_IN + I_OUT + I_GLU);
            if (r < I_IN) { const int kb = r / (NPROJ / 32), nb = r % (NPROJ / 32); const int n0 = 32 * nb, sc0 = n0 < 2304 ? n0 : n0 + 4;
                transpose_item(F.w_in + (size_t)l * 1024 * DIN, DIN, sc0, 64 * kb, WSP(bf16, WS_WIN) + (size_t)l * NPROJ * 1024, 1024, n0, F.norm1_g + l * 1024, F.lane); }
            else if (r < I_IN + I_OUT) { r -= I_IN; const int kb = r / 32, nb = r % 32;
                transpose_item(F.w_out + (size_t)l * 1024 * 1024, 1024, 32 * nb, 64 * kb, WSP(bf16, WS_WOUT) + (size_t)l * 1024 * 1024, 1024, 32 * nb, nullptr, F.lane); }
            else { r -= I_IN + I_OUT; const int kb = r / 8, nb = r % 8;
                transpose_item(F.s5_w_glu + (size_t)l * 65536, 256, 32 * nb, 64 * kb, WSP(bf16, WS_WGLU) + (size_t)l * 65536, 256, 32 * nb, nullptr, F.lane); }
        }
    }
    for (int i = gt; i < 256; i += ngt) {
        const float a = F.hg_lb_logits[i], b = F.hg_lb_logits[256 + i], m = fmaxf(a, b), ea = fexp(a - m), eb = fexp(b - m);
        WSP(float, WS_LB)[i] = 0.f; WSP(float, WS_LB)[256 + i] = eb / (ea + eb); }
    for (int i = gt; i < L * 32; i += ngt) { const int t = i >> 5, j = i & 31;
        const float inv = powf(10000.0f, -(float)j / 32.0f); const float ang = (float)F.pos[t] * inv; double s, c; dsincos((double)ang, s, c);
        *(f32x2*)(WSP(float, WS_ROPE) + (size_t)i * 2) = (f32x2){(float)c, (float)s}; }
    for (int i = gt; i < 2 * 16 * 64 * 34; i += ngt) { const int e = i / 34, d = i % 34, l = e >> 10, g = (e >> 6) & 15;
        const double dt = exp((double)F.s5_log_dt[l * 16 + g]); const double are = fmin((double)F.s5_a_re[e], -1e-4), aim = (double)F.s5_a_im[e];
        const double mag = exp(are * dt * d); double sn, cs; dsincos(aim * dt * d, sn, cs);
        *(f32x2*)(WSP(float, WS_S5AP) + (size_t)e * 68 + 2 * d) = (f32x2){(float)(mag * cs), (float)(mag * sn)}; }
    for (int i = gt; i < 2 * 16 * 64; i += ngt) {
        const int l = i >> 10, g = (i >> 6) & 15;
        const double dt = exp((double)F.s5_log_dt[l * 16 + g]); const double are = fmin((double)F.s5_a_re[i], -1e-4), aim = (double)F.s5_a_im[i];
        const double mag = exp(are * dt); double sn, cs; dsincos(aim * dt, sn, cs); const double abr = mag * cs, abi = mag * sn;
        const double den = are * are + aim * aim;
        const double kre = ((abr - 1.0) * are + abi * aim) / den, kim = (abi * are - (abr - 1.0) * aim) / den;
        float* bb = WSP(float, WS_S5BB) + (size_t)i * 32;
        for (int q = 0; q < 16; ++q) { const double br = F.s5_b_re[(size_t)i * 16 + q], bi = F.s5_b_im[(size_t)i * 16 + q]; bb[2 * q] = (float)(kre * br - kim * bi); bb[2 * q + 1] = (float)(kre * bi + kim * br); }
    }
    __syncthreads();
    r1_phase(F, 0, 0);
}

__device__ __forceinline__ void s5_prep_a(Frame& F, int l, int chunk, int nchunk) {
    const float* AP = WSP(float, WS_S5AP) + (size_t)l * 16 * 64 * 68; const float* BB = WSP(float, WS_S5BB) + (size_t)l * 16 * 64 * 32;
    constexpr int N1 = 16 * 32 * 256, N2 = 16 * 128 * 512;
    if (nchunk == 256 && NTHREADS == 512) {
        const int lo = chunk * 512, g = lo >> 13, d0 = (lo >> 8) & 31;
        LAS f32x2* Cs = (LAS f32x2*)F.lds; LAS f32x2* Bs = Cs + 16 * 65; LAS f32x2* As = Bs + 1024;
        __syncthreads();
#pragma unroll
        for (int k = 0; k < 2; ++k) { const int idx = F.tid + 512 * k; const size_t ci = ((size_t)l * 16 + g) * 1024 + idx;
            Cs[(idx >> 6) * 65 + (idx & 63)] = (f32x2){F.s5_c_re[ci], F.s5_c_im[ci]}; Bs[idx] = *(const f32x2*)(BB + (size_t)g * 64 * 32 + 2 * idx); }
        if (F.tid < 128) As[F.tid] = *(const f32x2*)(AP + ((size_t)g * 64 + (F.tid & 63)) * 68 + 2 * (d0 + (F.tid >> 6)));
        __syncthreads();
        { const int i = lo + F.tid, dd = (F.tid >> 8) & 1, p = (F.tid >> 4) & 15, q = F.tid & 15; float s = 0.f;
#pragma unroll 8
          for (int n = 0; n < 64; ++n) { const f32x2 a = As[dd * 64 + n], b = Bs[n * 16 + q], c = Cs[p * 65 + n];
              const float tr = a.x * b.x - a.y * b.y, ti = a.x * b.y + a.y * b.x; s += c.x * tr - c.y * ti; }
          WSP(float, WS_S5KT)[i] = s; }
        __syncthreads();
    } else
    { const int per = (N1 + nchunk - 1) / nchunk, lo = chunk * per, hi = lo + per < N1 ? lo + per : N1;
      for (int i = lo + F.tid; i < hi; i += NTHREADS) { const int g = i >> 13, d = (i >> 8) & 31, p = (i >> 4) & 15, q = i & 15;
        float s = 0.f;
        for (int n = 0; n < 64; ++n) { const size_t gn = (size_t)g * 64 + n; const float cr = F.s5_c_re[((size_t)l * 16 + g) * 1024 + p * 64 + n], ci = F.s5_c_im[((size_t)l * 16 + g) * 1024 + p * 64 + n];
            const float ar = AP[gn * 68 + 2 * d], ai = AP[gn * 68 + 2 * d + 1], br = BB[gn * 32 + 2 * q], bi = BB[gn * 32 + 2 * q + 1];
            const float tr = ar * br - ai * bi, ti = ar * bi + ai * br; s += cr * tr - ci * ti; }
        WSP(float, WS_S5KT)[i] = s; } }
    if (nchunk == 256 && NTHREADS == 512) {
        const int i0 = chunk * 4096 + 8 * F.tid, g = i0 >> 16, m = (i0 >> 9) & 127, k0 = i0 & 511, n = m >> 1, j = k0 >> 4, q0 = k0 & 15; const size_t gn = (size_t)g * 64 + n;
        const f32x2 a = *(const f32x2*)(AP + gn * 68 + 2 * (31 - j)); const f32x4* bp = (const f32x4*)(BB + gn * 32 + 2 * q0);
        const f32x4 b0 = bp[0], b1 = bp[1], b2 = bp[2], b3 = bp[3]; const bool im = m & 1;
#define BINC_V(br, bi) (im ? (a.x * (bi) + a.y * (br)) : (a.x * (br) - a.y * (bi)))
        u32x4 o; o.x = pk2(BINC_V(b0.x, b0.y), BINC_V(b0.z, b0.w)); o.y = pk2(BINC_V(b1.x, b1.y), BINC_V(b1.z, b1.w)); o.z = pk2(BINC_V(b2.x, b2.y), BINC_V(b2.z, b2.w)); o.w = pk2(BINC_V(b3.x, b3.y), BINC_V(b3.z, b3.w));
#undef BINC_V
        *(u32x4*)(WSP(bf16, WS_S5BI) + i0) = o;
    } else
    { const int per = (N2 + nchunk - 1) / nchunk, lo = chunk * per, hi = lo + per < N2 ? lo + per : N2;
      for (int i = lo + F.tid; i < hi; i += NTHREADS) { const int g = i >> 16, m = (i >> 9) & 127, k = i & 511, n = m >> 1, j = k >> 4, q = k & 15; const size_t gn = (size_t)g * 64 + n;
        const float ar = AP[gn * 68 + 2 * (31 - j)], ai = AP[gn * 68 + 2 * (31 - j) + 1], br = BB[gn * 32 + 2 * q], bi = BB[gn * 32 + 2 * q + 1];
        WSP(bf16, WS_S5BI)[i] = (bf16)f2bf((m & 1) ? (ar * bi + ai * br) : (ar * br - ai * bi)); } }
}
__device__ __forceinline__ void s5_prep_b(Frame& F, int l, int chunk, int nchunk) {
    const float* AP = WSP(float, WS_S5AP) + (size_t)l * 16 * 64 * 68; const float* KT = WSP(float, WS_S5KT);
    constexpr int N = 16 * 512 * 640; const int per = (N + nchunk - 1) / nchunk, lo = chunk * per, hi = lo + per < N ? lo + per : N;
    if (nchunk == 256 && NTHREADS == 512) {
#pragma unroll 1
        for (int it = 0; it < 5; ++it) { const int i0 = chunk * 20480 + 8 * (F.tid + 512 * it);
            const int g = i0 / (512 * 640), r = i0 % (512 * 640), np = r / 640, k0 = r % 640, tl = np >> 4, p = np & 15;
            u32x4 o = (u32x4){0u, 0u, 0u, 0u};
            if (k0 < 512) { const int j = k0 >> 4, q0 = k0 & 15;
                if (tl >= j) { const f32x4* kp = (const f32x4*)(KT + (((size_t)g * 32 + (tl - j)) * 16 + p) * 16 + q0); const f32x4 x0 = kp[0], x1 = kp[1];
                    o.x = pk2(x0.x, x0.y); o.y = pk2(x0.z, x0.w); o.z = pk2(x1.x, x1.y); o.w = pk2(x1.z, x1.w); } }
            else { const int n0 = (k0 - 512) >> 1; const size_t cb = ((size_t)l * 16 + g) * 1024 + p * 64 + n0;
                const f32x4 cr = *(const f32x4*)(F.s5_c_re + cb), ci = *(const f32x4*)(F.s5_c_im + cb); const float* ap = AP + ((size_t)g * 64 + n0) * 68 + 2 * (tl + 1);
                const f32x2 a0 = *(const f32x2*)ap, a1 = *(const f32x2*)(ap + 68), a2 = *(const f32x2*)(ap + 136), a3 = *(const f32x2*)(ap + 204);
                o.x = pk2(cr.x * a0.x - ci.x * a0.y, -(cr.x * a0.y + ci.x * a0.x)); o.y = pk2(cr.y * a1.x - ci.y * a1.y, -(cr.y * a1.y + ci.y * a1.x));
                o.z = pk2(cr.z * a2.x - ci.z * a2.y, -(cr.z * a2.y + ci.z * a2.x)); o.w = pk2(cr.w * a3.x - ci.w * a3.y, -(cr.w * a3.y + ci.w * a3.x)); }
            *(u32x4*)(WSP(bf16, WS_S5MT) + i0) = o; }
        return;
    }
    for (int i = lo + F.tid; i < hi; i += NTHREADS) { const int g = i / (512 * 640), r = i % (512 * 640), np = r / 640, k = r % 640, tl = np >> 4, p = np & 15;
        float v;
        if (k < 512) { const int j = k >> 4, q = k & 15; v = tl >= j ? KT[(((size_t)g * 32 + (tl - j)) * 16 + p) * 16 + q] : 0.f; }
        else { const int n = (k - 512) >> 1; const size_t gn = (size_t)g * 64 + n; const float cr = F.s5_c_re[((size_t)l * 16 + g) * 1024 + p * 64 + n], ci = F.s5_c_im[((size_t)l * 16 + g) * 1024 + p * 64 + n];
            const float ar = AP[gn * 68 + 2 * (tl + 1)], ai = AP[gn * 68 + 2 * (tl + 1) + 1]; v = (k & 1) ? -(cr * ai + ci * ar) : (cr * ar - ci * ai); }
        WSP(bf16, WS_S5MT)[i] = (bf16)f2bf(v); }
}

struct EpiBf16Store { bf16* O; size_t ld; int r0, c0;
    __device__ __forceinline__ void operator()(int r, int c, f32x4 v) const { u32x2 w; w.x = pk2(v.x, v.y); w.y = pk2(v.z, v.w); *(u32x2*)(O + (size_t)(r0 + r) * ld + c0 + c) = w; } };
__device__ __forceinline__ void phase_g1(Frame& F, int l) {
    g8::GridOrder S{L / 256, NPROJ / 256 - 1, (L / 256) * (NPROJ / 256 - 1), F.G, F.bid, (size_t)256 * 1024 * 2, (size_t)256 * 1024 * 2};
    g8::EpiStoreU E{WSP(bf16, WS_BIG), NPROJ, WSP(bf16, WS_S5UG)};
    g8::gemm_phase(F.lds, WSP(bf16, WS_ACT), WSP(bf16, WS_WIN) + (size_t)l * NPROJ * 1024, 1024, S, E);
    if (l == 0) { unsigned* ctr = WSP(unsigned, WS_CTL) + CW_Q + 64 * 4 + 32 * F.rep;
      for (int u = grab_unit(F, ctr); u < 256; u = grab_unit(F, ctr)) s5_prep_a(F, 0, u, 256); }
}

constexpr int LD64 = 72, LD128 = 136;
template <bool HAS_DST, bool HAS_DSTT>
__device__ __forceinline__ void stage_rot(Frame& F, const bf16* proj, int t0, int col0, float scale, lbf* dst  , lbf* dstT  , const lf32* tscale  ) {
    const int t = F.tid >> 2, ib = (F.tid & 3) * 8;
    const bf16* row = proj + (size_t)(t0 + t) * NPROJ + col0;
    const u32x4 a = *(const u32x4*)(row + ib), b = *(const u32x4*)(row + 32 + ib);
    const f32x4* cs4 = (const f32x4*)(WSP(float, WS_ROPE) + ((size_t)(t0 + t) * 32 + ib) * 2);
    const f32x4 r0 = cs4[0], r1 = cs4[1], r2 = cs4[2], r3 = cs4[3];
    const float cs[16] = {r0.x, r0.y, r0.z, r0.w, r1.x, r1.y, r1.z, r1.w, r2.x, r2.y, r2.z, r2.w, r3.x, r3.y, r3.z, r3.w};
    float o1[8], o2[8];
    const unsigned aw[4] = {a.x, a.y, a.z, a.w}, bw[4] = {b.x, b.y, b.z, b.w};
#pragma unroll
    for (int j = 0; j < 8; ++j) { const float q1 = (j & 1) ? bfhi(aw[j >> 1]) : bflo(aw[j >> 1]), q2 = (j & 1) ? bfhi(bw[j >> 1]) : bflo(bw[j >> 1]); const float c = cs[2 * j], s = cs[2 * j + 1];
        o1[j] = (q1 * c - q2 * s) * scale; o2[j] = (q2 * c + q1 * s) * scale;
        }
    if (HAS_DST) { u32x4 w1, w2; w1.x = pk2(o1[0], o1[1]); w1.y = pk2(o1[2], o1[3]); w1.z = pk2(o1[4], o1[5]); w1.w = pk2(o1[6], o1[7]); w2.x = pk2(o2[0], o2[1]); w2.y = pk2(o2[2], o2[3]); w2.z = pk2(o2[4], o2[5]); w2.w = pk2(o2[6], o2[7]);
        *(LAS u32x4*)(dst + t * LD64 + ib) = w1; *(LAS u32x4*)(dst + t * LD64 + 32 + ib) = w2; }
    if (HAS_DSTT) { const float ts = tscale[t];
#pragma unroll
        for (int j = 0; j < 8; ++j) { dstT[(ib + j) * LD128 + t] = (bf16)f2bf(o1[j] * ts); dstT[(32 + ib + j) * LD128 + t] = (bf16)f2bf(o2[j] * ts); } }
}
__device__ __forceinline__ void stage_T64(Frame& F, const bf16* proj, int t0, int col0, lbf* dstT) {
#pragma unroll
    for (int i = 0; i < 2; ++i) { const int p = F.tid + 512 * i, s = p >> 3, eb = (p & 7) * 8;
        const u32x4 a = *(const u32x4*)(proj + (size_t)(t0 + s) * NPROJ + col0 + eb); const unsigned aw[4] = {a.x, a.y, a.z, a.w};
#pragma unroll
        for (int j = 0; j < 8; ++j) dstT[(eb + j) * LD128 + s] = (bf16)((j & 1) ? (aw[j >> 1] >> 16) : (aw[j >> 1] & 0xffffu)); }
}

__device__ __forceinline__ float ret_log2gamma(int h) { return log2f(1.0f - exp2f(-5.0f - (float)h)); }
__device__ __forceinline__ void ret_state_unit(Frame& F0, int c, int h) {
    Frame F = F0; LAUNDER(F);
    lbf* VT = (lbf*)F.lds; lbf* KT = VT + 64 * LD128; lf32* zeta = (lf32*)(KT + 64 * LD128);
    const bf16* proj = WSP(bf16, WS_BIG); const int t0 = c * CH; const float lg = ret_log2gamma(h);
    __syncthreads();
    if (F.tid < 128) zeta[F.tid] = fexp2((float)(CH - 1 - F.tid) * lg);
    __syncthreads();
    stage_T64(F, proj, t0, C_RV + h * 64, VT);
    stage_rot<false, true>(F, proj, t0, C_RK + h * 64, 0.125f, KT, KT, zeta);
    __syncthreads();
    f32x4 acc[2] = {(f32x4){0, 0, 0, 0}, (f32x4){0, 0, 0, 0}};
    const int w = F.wave;
    wave_mma<2, 4>(acc, VT + 16 * (w >> 1) * LD128, LD128, KT + 32 * (w & 1) * LD128, LD128, F.lane);
    float* st = WSP(float, WS_ST_RET) + ((size_t)c * 4 + h) * 4096;
    const int e = 16 * (w >> 1) + (F.lane & 15);
#pragma unroll
    for (int n = 0; n < 2; ++n) *(f32x4*)(st + e * 64 + 32 * (w & 1) + 16 * n + 4 * (F.lane >> 4)) = acc[n];
}
__device__ __forceinline__ void ret_out_unit(Frame& F0, int c, int h) {
    Frame F = F0; LAUNDER(F);
    lbf* Q = (lbf*)F.lds; lbf* K = Q + 128 * LD64; lbf* VT = K + 128 * LD64; lbf* RT = VT + 64 * LD128; lbf* P = RT + 64 * LD64;
    const bf16* proj = WSP(bf16, WS_BIG); const int t0 = c * CH; const float lg = ret_log2gamma(h);
    const int w = F.wave, lane = F.lane, fr = lane & 15, fq = lane >> 4;
    __syncthreads();
    stage_rot<true, false>(F, proj, t0, C_RQ + h * 64, 1.0f, Q, Q, (const lf32*)Q);
    stage_rot<true, false>(F, proj, t0, C_RK + h * 64, 0.125f, K, K, (const lf32*)K);
    stage_T64(F, proj, t0, C_RV + h * 64, VT);
    { const float* st = WSP(float, WS_ST_RET) + ((size_t)c * 4 + h) * 4096 + F.tid * 8; const f32x4 a = *(const f32x4*)st, b = *(const f32x4*)(st + 4);
      u32x4 o; o.x = pk2(a.x, a.y); o.y = pk2(a.z, a.w); o.z = pk2(b.x, b.y); o.w = pk2(b.z, b.w); *(LAS u32x4*)(RT + (F.tid >> 3) * LD64 + (F.tid & 7) * 8) = o; }
    __syncthreads();
    f32x4 sc[8];
#pragma unroll
    for (int n = 0; n < 8; ++n) sc[n] = (f32x4){0, 0, 0, 0};
    wave_mma<8, 2>(sc, Q + 16 * w * LD64, LD64, K, LD64, lane);
    lbf* Pw = P + w * 16 * LD128;
    const int tl = 16 * w + fr;
#pragma unroll
    for (int n = 0; n < 8; ++n) { float pv[4];
#pragma unroll
        for (int j = 0; j < 4; ++j) { const int s = 16 * n + 4 * fq + j; pv[j] = (s <= tl) ? sc[n][j] * fexp2((float)(tl - s) * lg) : 0.f; }
        u32x2 o; o.x = pk2(pv[0], pv[1]); o.y = pk2(pv[2], pv[3]); *(LAS u32x2*)(Pw + fr * LD128 + 16 * n + 4 * fq) = o; }
    __syncthreads();
    f32x4 oi[4], ox[4];
#pragma unroll
    for (int n = 0; n < 4; ++n) { oi[n] = (f32x4){0, 0, 0, 0}; ox[n] = (f32x4){0, 0, 0, 0}; }
    wave_mma<4, 4>(oi, Pw, LD128, VT, LD128, lane);
    wave_mma<4, 2>(ox, Q + 16 * w * LD64, LD64, RT, LD64, lane);
    const float xi = fexp2((float)(tl + 1) * lg);
    float s1 = 0.f;
#pragma unroll
    for (int n = 0; n < 4; ++n) {
        oi[n] = oi[n] + xi * ox[n];
        s1 += (oi[n].x + oi[n].y) + (oi[n].z + oi[n].w); }
    s1 += __shfl_xor(s1, 16); s1 += __shfl_xor(s1, 32);
    const float mean = s1 * (1.0f / 64.0f); float s2 = 0.f;
#pragma unroll
    for (int n = 0; n < 4; ++n) { oi[n] = oi[n] - mean; s2 += (oi[n].x * oi[n].x + oi[n].y * oi[n].y) + (oi[n].z * oi[n].z + oi[n].w * oi[n].w); }
    s2 += __shfl_xor(s2, 16); s2 += __shfl_xor(s2, 32);
    const float rstd = frsq(s2 * (1.0f / 64.0f) + EPS);
    const int t = t0 + tl; bf16* y = WSP(bf16, WS_ACT) + (size_t)t * 1024 + Y_RET + h * 64;
    const bf16* gp = proj + (size_t)t * NPROJ + C_RG + h * 64;
#pragma unroll
    for (int n = 0; n < 4; ++n) { const int e = 16 * n + 4 * fq; const u32x2 g = *(const u32x2*)(gp + e);
        const f32x4 v = oi[n] * rstd; u32x2 o; o.x = pk2(v.x * siluf_(bflo(g.x)), v.y * siluf_(bfhi(g.x))); o.y = pk2(v.z * siluf_(bflo(g.y)), v.w * siluf_(bfhi(g.y))); *(u32x2*)(y + e) = o; }
}

__device__ __forceinline__ void m2_conv8(Frame& F, int l, const bf16* proj, int t, int cc  , float (&o)[8]) {
    const float* cw = F.m2_conv_w + (size_t)l * 4 * 768 + cc; const float* cb = F.m2_conv_b + (size_t)l * 768 + cc;
#pragma unroll
    for (int j = 0; j < 8; ++j) o[j] = cb[j];
#pragma unroll
    for (int q = 0; q < 4; ++q) { const int ts = t - 3 + q; if (ts >= 0) { const u32x4 a = *(const u32x4*)(proj + (size_t)ts * NPROJ + C_MX + cc); const unsigned aw[4] = {a.x, a.y, a.z, a.w};
#pragma unroll
        for (int j = 0; j < 8; ++j) o[j] += cw[q * 768 + j] * ((j & 1) ? bfhi(aw[j >> 1]) : bflo(aw[j >> 1])); } }
#pragma unroll
    for (int j = 0; j < 8; ++j) o[j] = siluf_(o[j]);
}
__device__ __forceinline__ void m2_dt_acum(Frame& F, int l, int c, lf32* dts, lf32* acs) {
    const int h = F.tid >> 7, t = F.tid & 127, lane = F.lane; const float x = WSP(float, WS_DTRAW)[(size_t)(c * CH + t) * 4 + h] + F.m2_dt_bias[l * 4 + h];
    const float dt = x > 20.f ? x : log1pf(fexp(x)); dts[h * 128 + t] = dt;
    float a = -fexp(F.m2_a_log[l * 4 + h]) * dt;
#pragma unroll
    for (int off = 1; off < 64; off <<= 1) { const float o = __shfl(a, lane - off); if (lane >= off) a += o; }
    acs[h * 128 + t] = a;
    __syncthreads();
    if (t >= 64) acs[h * 128 + t] = a + acs[h * 128 + 63];
    __syncthreads();
}
__device__ __forceinline__ void m2_state_unit(Frame& F0, int l, int c, int g) {
    Frame F = F0; LAUNDER(F);
    lbf* XT = (lbf*)F.lds; lbf* BT = XT + 64 * LD128; lf32* dts = (lf32*)(BT + 128 * LD128); lf32* acs = dts + 512;
    const bf16* proj = WSP(bf16, WS_BIG); bf16* xbc = XBC_PTR(F); const int t0 = c * CH;
    __syncthreads();
    m2_dt_acum(F, l, c, dts, acs);
#pragma unroll 1
    for (int i = 0; i < 4; ++i) { const int p = F.tid + 512 * i, s = p >> 4, nb = (p & 15) * 8; float o[8];
        m2_conv8(F, l, proj, t0 + s, 256 + g * 128 + nb, o);
        u32x4 wv; wv.x = pk2(o[0], o[1]); wv.y = pk2(o[2], o[3]); wv.z = pk2(o[4], o[5]); wv.w = pk2(o[6], o[7]); *(u32x4*)(xbc + (size_t)(t0 + s) * 768 + 256 + g * 128 + nb) = wv;
#pragma unroll
        for (int j = 0; j < 8; ++j) BT[(nb + j) * LD128 + s] = (bf16)f2bf(o[j]);
        m2_conv8(F, l, proj, t0 + s, 512 + g * 128 + nb, o);
        wv.x = pk2(o[0], o[1]); wv.y = pk2(o[2], o[3]); wv.z = pk2(o[4], o[5]); wv.w = pk2(o[6], o[7]); *(u32x4*)(xbc + (size_t)(t0 + s) * 768 + 512 + g * 128 + nb) = wv; }
#pragma unroll 1
    for (int hh = 0; hh < 2; ++hh) { const int h = 2 * g + hh;
        const float alast = acs[h * 128 + 127];
#pragma unroll 1
        for (int i = 0; i < 2; ++i) { const int p = F.tid + 512 * i, s = p >> 3, eb = (p & 7) * 8; float o[8]; m2_conv8(F, l, proj, t0 + s, h * 64 + eb, o);
            u32x4 wv; wv.x = pk2(o[0], o[1]); wv.y = pk2(o[2], o[3]); wv.z = pk2(o[4], o[5]); wv.w = pk2(o[6], o[7]); *(u32x4*)(xbc + (size_t)(t0 + s) * 768 + h * 64 + eb) = wv;
            const float sc = dts[h * 128 + s] * fexp(alast - acs[h * 128 + s]);
#pragma unroll
            for (int j = 0; j < 8; ++j) XT[(eb + j) * LD128 + s] = (bf16)f2bf(o[j] * sc); }
        __syncthreads();
        f32x4 acc[4];
#pragma unroll
        for (int n = 0; n < 4; ++n) acc[n] = (f32x4){0, 0, 0, 0};
        const int w = F.wave;
        wave_mma<4, 4>(acc, XT + 16 * (w >> 1) * LD128, LD128, BT + 64 * (w & 1) * LD128, LD128, F.lane);
        float* st = WSP(float, WS_ST_M2) + ((size_t)c * 4 + h) * 8192; const int pr = 16 * (w >> 1) + (F.lane & 15);
#pragma unroll
        for (int n = 0; n < 4; ++n) *(f32x4*)(st + pr * 128 + 64 * (w & 1) + 16 * n + 4 * (F.lane >> 4)) = acc[n];
        if (F.tid == 0) WSP(float, WS_DEC_M2)[c * 4 + h] = fexp(alast);
        __syncthreads();
    }
}
__device__ __forceinline__ void m2_out_unit(Frame& F0, int l, int c) {
    Frame F = F0; LAUNDER(F);
    lbf* Cm = (lbf*)F.lds; lbf* Bm = Cm + 128 * LD128; lbf* XT = Bm + 128 * LD128; lbf* ST = XT + 64 * LD128; lf32* dts = (lf32*)(ST + 64 * LD128); lf32* acs = dts + 512;
    lbf* P = Bm;
    const bf16* proj = WSP(bf16, WS_BIG); const bf16* xbc = XBC_PTR(F); const int t0 = c * CH;
    const int w = F.wave, lane = F.lane, fr = lane & 15, fq = lane >> 4, tl = 16 * w + fr;
    __syncthreads();
    m2_dt_acum(F, l, c, dts, acs);
    float ss = 0.f;
    bf16* yrow = WSP(bf16, WS_ACT) + (size_t)(t0 + tl) * 1024 + Y_M2;
#pragma unroll 1
    for (int g = 0; g < 2; ++g) {
        __syncthreads();
#pragma unroll
        for (int i = 0; i < 4; ++i) { const int p = F.tid + 512 * i, s = p >> 4, nb = (p & 15) * 8; const bf16* xr = xbc + (size_t)(t0 + s) * 768 + g * 128 + nb;
            *(LAS u32x4*)(Cm + s * LD128 + nb) = *(const u32x4*)(xr + 512); *(LAS u32x4*)(Bm + s * LD128 + nb) = *(const u32x4*)(xr + 256); }
        __syncthreads();
        f32x4 sc[8];
#pragma unroll
        for (int n = 0; n < 8; ++n) sc[n] = (f32x4){0, 0, 0, 0};
        wave_mma<8, 4>(sc, Cm + 16 * w * LD128, LD128, Bm, LD128, lane);
#pragma unroll 1
        for (int hh = 0; hh < 2; ++hh) { const int h = 2 * g + hh;
            __syncthreads();
#pragma unroll
            for (int i = 0; i < 2; ++i) { const int p = F.tid + 512 * i, s = p >> 3, eb = (p & 7) * 8; const u32x4 a = *(const u32x4*)(xbc + (size_t)(t0 + s) * 768 + h * 64 + eb); const unsigned aw[4] = {a.x, a.y, a.z, a.w};
#pragma unroll
                for (int j = 0; j < 8; ++j) XT[(eb + j) * LD128 + s] = (bf16)((j & 1) ? (aw[j >> 1] >> 16) : (aw[j >> 1] & 0xffffu)); }
            { const float* st = WSP(float, WS_ST_M2) + ((size_t)c * 4 + h) * 8192;
#pragma unroll
              for (int i = 0; i < 2; ++i) { const int p = F.tid + 512 * i; const f32x4 a = *(const f32x4*)(st + p * 8), b = *(const f32x4*)(st + p * 8 + 4);
                u32x4 o; o.x = pk2(a.x, a.y); o.y = pk2(a.z, a.w); o.z = pk2(b.x, b.y); o.w = pk2(b.z, b.w); *(LAS u32x4*)(ST + (p >> 4) * LD128 + (p & 15) * 8) = o; } }
            const float at = acs[h * 128 + tl];
            lbf* Pw = P + w * 16 * LD128;
#pragma unroll
            for (int n = 0; n < 8; ++n) { float pv[4];
#pragma unroll
                for (int j = 0; j < 4; ++j) { const int s = 16 * n + 4 * fq + j; pv[j] = (s <= tl) ? sc[n][j] * fexp(at - acs[h * 128 + s]) * dts[h * 128 + s] : 0.f; }
                u32x2 o; o.x = pk2(pv[0], pv[1]); o.y = pk2(pv[2], pv[3]); *(LAS u32x2*)(Pw + fr * LD128 + 16 * n + 4 * fq) = o; CFENCE(); }
            __syncthreads();
            f32x4 yi[4], yx[4];
#pragma unroll
            for (int n = 0; n < 4; ++n) { yi[n] = (f32x4){0, 0, 0, 0}; yx[n] = (f32x4){0, 0, 0, 0}; }
            wave_mma<4, 4>(yi, Pw, LD128, XT, LD128, lane);
            wave_mma<4, 4>(yx, Cm + 16 * w * LD128, LD128, ST, LD128, lane);
            const float ea = fexp(at), dsk = F.m2_d[l * 4 + h];
            const bf16* zp = proj + (size_t)(t0 + tl) * NPROJ + C_MZ + h * 64;
#pragma unroll
            for (int n = 0; n < 4; ++n) { const int p0 = 16 * n + 4 * fq; const u32x2 z = *(const u32x2*)(zp + p0);
                f32x4 v = yi[n] + ea * yx[n];
                v.x += dsk * bf2f(XT[(p0 + 0) * LD128 + tl]); v.y += dsk * bf2f(XT[(p0 + 1) * LD128 + tl]); v.z += dsk * bf2f(XT[(p0 + 2) * LD128 + tl]); v.w += dsk * bf2f(XT[(p0 + 3) * LD128 + tl]);
                v.x *= siluf_(bflo(z.x)); v.y *= siluf_(bfhi(z.x)); v.z *= siluf_(bflo(z.y)); v.w *= siluf_(bfhi(z.y));
                ss += (v.x * v.x + v.y * v.y) + (v.z * v.z + v.w * v.w);
                u32x2 o; o.x = pk2(v.x, v.y); o.y = pk2(v.z, v.w); *(u32x2*)(yrow + h * 64 + p0) = o; CFENCE(); }
        }
    }
    ss += __shfl_xor(ss, 16); ss += __shfl_xor(ss, 32);
    const float rstd = frsq(ss * (1.0f / 256.0f) + EPS);
    const float* ng = F.m2_norm_g + l * 256;
#ifndef EMU
    asm volatile("s_waitcnt vmcnt(0)" ::: "memory");
#endif
#pragma unroll 4
    for (int q = 0; q < 16; ++q) { const int cc = (q >> 2) * 64 + 16 * (q & 3) + 4 * fq; const f32x4 gv = *(const f32x4*)(ng + cc); const u32x2 yv = *(const u32x2*)(yrow + cc);
        u32x2 o; o.x = pk2(bflo(yv.x) * rstd * gv.x, bfhi(yv.x) * rstd * gv.y); o.y = pk2(bflo(yv.y) * rstd * gv.z, bfhi(yv.y) * rstd * gv.w); *(u32x2*)(yrow + cc) = o; }
}

template <bool OUT>
__device__ __forceinline__ void hg_wave_unit(Frame& F0, int l, int sc, int h) {
    Frame F = F0; LAUNDER(F);
    constexpr int TB = 16;
    lf32* Fb = (lf32*)(F.lds + F.wave * 16384); lf32* Vb = Fb + 1024; lf32* Qb = Vb + 1024; lf32* Gb = Qb + 1024;
    const bf16* proj = WSP(bf16, WS_BIG); const int lane = F.lane, t0 = sc * HSC;
    const float lb = WSP(float, WS_LB)[l * 256 + h * 64 + lane];
    float S[64];
    if (OUT) { const float* sp = WSP(float, WS_ST_HG) + ((size_t)sc * 4 + h) * 4096 + lane;
#pragma unroll
        for (int d = 0; d < 64; ++d) S[d] = sp[d * 64]; }
    else {
#pragma unroll
        for (int d = 0; d < 64; ++d) S[d] = 0.f; }
    float lam = 1.0f;
    const float ng = OUT ? F.hg_norm_g[l * 256 + h * 64 + lane] : 0.f;
    bf16 rf[TB], rq[TB], rv[TB], rg[TB];
    const bf16* pb = proj + (size_t)t0 * NPROJ + h * 64 + lane;
#pragma unroll
    for (int tt = 0; tt < TB; ++tt) { const bf16* pr = pb + (size_t)tt * NPROJ; rf[tt] = pr[C_GF]; rv[tt] = pr[C_GI]; if (OUT) { rq[tt] = pr[C_GQ]; rg[tt] = pr[C_GG]; } }
#pragma unroll 1
    for (int tb = 0; tb < HSC; tb += TB) {
#pragma unroll
        for (int tt = 0; tt < TB; ++tt) {
            const float f = lb + (1.0f - lb) * sigmoidf_(bf2f(rf[tt])); Fb[tt * 64 + lane] = f; lam *= f; Vb[tt * 64 + lane] = bf2f(rv[tt]);
            if (OUT) { Qb[tt * 64 + lane] = siluf_(bf2f(rq[tt])); Gb[tt * 64 + lane] = siluf_(bf2f(rg[tt])) * ng; } }
        WAVE_SYNC();
        if (tb + TB < HSC) { const bf16* pn = pb + (size_t)(tb + TB) * NPROJ;
#pragma unroll
            for (int tt = 0; tt < TB; ++tt) { const bf16* pr = pn + (size_t)tt * NPROJ; rf[tt] = pr[C_GF]; rv[tt] = pr[C_GI]; if (OUT) { rq[tt] = pr[C_GQ]; rg[tt] = pr[C_GG]; } } }
#pragma unroll 2
        for (int tt = 0; tt < TB; ++tt) {
            const float v = Vb[tt * 64 + lane];
            float o0 = 0.f, o1 = 0.f, o2 = 0.f, o3 = 0.f;
#pragma unroll
            for (int d4 = 0; d4 < 16; ++d4) { const f32x4 f4 = *(const LAS f32x4*)(Fb + tt * 64 + 4 * d4);
                S[4 * d4 + 0] = f4.x * (S[4 * d4 + 0] - v) + v; S[4 * d4 + 1] = f4.y * (S[4 * d4 + 1] - v) + v; S[4 * d4 + 2] = f4.z * (S[4 * d4 + 2] - v) + v; S[4 * d4 + 3] = f4.w * (S[4 * d4 + 3] - v) + v;
                if (OUT) { const f32x4 q4 = *(const LAS f32x4*)(Qb + tt * 64 + 4 * d4); o0 += q4.x * S[4 * d4 + 0]; o1 += q4.y * S[4 * d4 + 1]; o2 += q4.z * S[4 * d4 + 2]; o3 += q4.w * S[4 * d4 + 3]; } }
            if (OUT) { const float o = (o0 + o1) + (o2 + o3); const float ssq = wave_sum(o * o); const float rstd = frsq(ssq * (1.0f / 64.0f) + EPS);
                WSP(bf16, WS_ACT)[(size_t)(t0 + tb + tt) * 1024 + Y_HG + h * 64 + lane] = (bf16)f2bf(o * rstd * Gb[tt * 64 + lane]); } }
        WAVE_SYNC();
    }
    if (!OUT) { float* sp = WSP(float, WS_ST_HG) + ((size_t)sc * 4 + h) * 4096 + lane;
#pragma unroll
        for (int d = 0; d < 64; ++d) sp[d * 64] = S[d];
        WSP(float, WS_DEC_HG)[((size_t)sc * 4 + h) * 64 + lane] = lam; }
}


__device__ __forceinline__ bf16x8 pack8(const float (&x)[8]) {
    u32x4 w; w.x = pk2(x[0], x[1]); w.y = pk2(x[2], x[3]); w.z = pk2(x[4], x[5]); w.w = pk2(x[6], x[7]); return __builtin_bit_cast(bf16x8, w); }
__device__ __forceinline__ void ld8f(const lf32* p, float (&x)[8]) { const f32x4 a = *(const LAS f32x4*)p, b = *(const LAS f32x4*)(p + 4); x[0] = a.x; x[1] = a.y; x[2] = a.z; x[3] = a.w; x[4] = b.x; x[5] = b.y; x[6] = b.z; x[7] = b.w; }
__device__ __forceinline__ void ld8b(const lbf* p, float (&x)[8]) { const u32x4 a = *(const LAS u32x4*)p; x[0] = bflo(a.x); x[1] = bfhi(a.x); x[2] = bflo(a.y); x[3] = bfhi(a.y); x[4] = bflo(a.z); x[5] = bfhi(a.z); x[6] = bflo(a.w); x[7] = bfhi(a.w); }
__device__ __forceinline__ void hg_logf_cumsum(Frame& F, int l, const bf16* proj, int t0, int h, lf32* bL, lf32* tot) {
    { const int t = F.tid >> 2, dq = (F.tid & 3) * 16; const bf16* pr = proj + (size_t)(t0 + t) * NPROJ + C_GF + h * 64 + dq; const float* lbp = WSP(float, WS_LB) + l * 256 + h * 64 + dq;
#pragma unroll
      for (int hh = 0; hh < 2; ++hh) { const u32x4 a = *(const u32x4*)(pr + 8 * hh); const unsigned aw[4] = {a.x, a.y, a.z, a.w}; float lf[8];
#pragma unroll
          for (int j = 0; j < 8; ++j) { const float x = (j & 1) ? bfhi(aw[j >> 1]) : bflo(aw[j >> 1]); const float lb = lbp[8 * hh + j]; lf[j] = flog(lb + (1.0f - lb) * sigmoidf_(x)); }
          *(LAS f32x4*)(bL + t * 64 + dq + 8 * hh) = (f32x4){lf[0], lf[1], lf[2], lf[3]}; *(LAS f32x4*)(bL + t * 64 + dq + 8 * hh + 4) = (f32x4){lf[4], lf[5], lf[6], lf[7]}; } }
    __syncthreads();
    const int d = F.tid & 63, sg = F.tid >> 6;
    { float run = 0.f;
#pragma unroll
      for (int j = 0; j < 16; ++j) { run += bL[(sg * 16 + j) * 64 + d]; bL[(sg * 16 + j) * 64 + d] = run; }
      tot[sg * 64 + d] = run; }
    __syncthreads();
    { float off = 0.f; for (int g = 0; g < sg; ++g) off += tot[g * 64 + d];
#pragma unroll
      for (int j = 0; j < 16; ++j) bL[(sg * 16 + j) * 64 + d] += off; }
    __syncthreads();
}
__device__ __forceinline__ void hg_state_unit(Frame& F0, int l, int c, int h) {
    Frame F = F0; LAUNDER(F);
    lf32* bL = (lf32*)F.lds; lf32* tot = bL + 128 * 64; lbf* VT = (lbf*)(tot + 512); lbf* KT = VT + 64 * LD128;
    const bf16* proj = WSP(bf16, WS_BIG); const int t0 = c * CH;
    __syncthreads();
    hg_logf_cumsum(F, l, proj, t0, h, bL, tot);
    stage_T64(F, proj, t0, C_GI + h * 64, VT);
    { const int s = F.tid >> 2, dq = (F.tid & 3) * 16; const bf16* pr = proj + (size_t)(t0 + s) * NPROJ + C_GF + h * 64 + dq; const float* lbp = WSP(float, WS_LB) + l * 256 + h * 64 + dq;
#pragma unroll
      for (int hh = 0; hh < 2; ++hh) { const u32x4 a = *(const u32x4*)(pr + 8 * hh); const unsigned aw[4] = {a.x, a.y, a.z, a.w};
#pragma unroll
          for (int j = 0; j < 8; ++j) { const int d = dq + 8 * hh + j; const float x = (j & 1) ? bfhi(aw[j >> 1]) : bflo(aw[j >> 1]); const float lb = lbp[8 * hh + j];
              const float k = 1.0f - (lb + (1.0f - lb) * sigmoidf_(x)); KT[d * LD128 + s] = (bf16)f2bf(k * fexp(bL[127 * 64 + d] - bL[s * 64 + d])); } } }
    __syncthreads();
    f32x4 acc[2] = {(f32x4){0, 0, 0, 0}, (f32x4){0, 0, 0, 0}};
    const int w = F.wave;
    wave_mma<2, 4>(acc, VT + 16 * (w >> 1) * LD128, LD128, KT + 32 * (w & 1) * LD128, LD128, F.lane);
    float* st = WSP(float, WS_ST_HG) + ((size_t)c * 4 + h) * 4096; const int e = 16 * (w >> 1) + (F.lane & 15);
#pragma unroll
    for (int n = 0; n < 2; ++n) *(f32x4*)(st + e * 64 + 32 * (w & 1) + 16 * n + 4 * (F.lane >> 4)) = acc[n];
    if (F.tid < 64) WSP(float, WS_DEC_HG)[((size_t)c * 4 + h) * 64 + F.tid] = fexp(bL[127 * 64 + F.tid]);
}
__device__ __forceinline__ void hg_out_unit(Frame& F0, int l, int c, int h) {
    Frame F = F0; LAUNDER(F);
    lf32* bL = (lf32*)F.lds; lf32* tot = bL + 128 * 64; lbf* Qr = (lbf*)(tot + 512); lbf* Kh = Qr + 128 * LD64; lbf* VT = Kh + 128 * LD64; lbf* ST = VT + 64 * LD128; lbf* P = ST + 64 * LD64;
    const bf16* proj = WSP(bf16, WS_BIG); const int t0 = c * CH;
    const int w = F.wave, lane = F.lane, fr = lane & 15, fq = lane >> 4, tl = 16 * w + fr;
    __syncthreads();
    hg_logf_cumsum(F, l, proj, t0, h, bL, tot);
    { const int t = F.tid >> 2, dq = (F.tid & 3) * 16, te = (t | 15); const bf16* pq = proj + (size_t)(t0 + t) * NPROJ + C_GQ + h * 64 + dq; const bf16* pf = proj + (size_t)(t0 + t) * NPROJ + C_GF + h * 64 + dq;
      const float* lbp = WSP(float, WS_LB) + l * 256 + h * 64 + dq;
#pragma unroll
      for (int hh = 0; hh < 2; ++hh) { const u32x4 a = *(const u32x4*)(pq + 8 * hh), b = *(const u32x4*)(pf + 8 * hh); const unsigned aw[4] = {a.x, a.y, a.z, a.w}, bw[4] = {b.x, b.y, b.z, b.w}; float qo[8], ko[8];
#pragma unroll
          for (int j = 0; j < 8; ++j) { const int d = dq + 8 * hh + j; const float xq = (j & 1) ? bfhi(aw[j >> 1]) : bflo(aw[j >> 1]), xf = (j & 1) ? bfhi(bw[j >> 1]) : bflo(bw[j >> 1]); const float lb = lbp[8 * hh + j];
              qo[j] = siluf_(xq); ko[j] = (1.0f - (lb + (1.0f - lb) * sigmoidf_(xf))) * fexp(bL[te * 64 + d] - bL[t * 64 + d]); }
          *(LAS bf16x8*)(Qr + t * LD64 + dq + 8 * hh) = pack8(qo); *(LAS bf16x8*)(Kh + t * LD64 + dq + 8 * hh) = pack8(ko); } }
    stage_T64(F, proj, t0, C_GI + h * 64, VT);
    { const float* st = WSP(float, WS_ST_HG) + ((size_t)c * 4 + h) * 4096 + F.tid * 8; const f32x4 a = *(const f32x4*)st, b = *(const f32x4*)(st + 4);
      u32x4 o; o.x = pk2(a.x, a.y); o.y = pk2(a.z, a.w); o.z = pk2(b.x, b.y); o.w = pk2(b.z, b.w); *(LAS u32x4*)(ST + (F.tid >> 3) * LD64 + (F.tid & 7) * 8) = o; }
    __syncthreads();
    float qv[2][8], bt[2][8];
#pragma unroll
    for (int ks = 0; ks < 2; ++ks) { ld8b(Qr + tl * LD64 + ks * 32 + fq * 8, qv[ks]); ld8f(bL + tl * 64 + ks * 32 + fq * 8, bt[ks]); }
    lbf* Pw = P + w * 16 * LD128;
    f32x4 ox[4];
#pragma unroll
    for (int n = 0; n < 4; ++n) ox[n] = (f32x4){0, 0, 0, 0};
#pragma unroll
    for (int ks = 0; ks < 2; ++ks) { float x[8];
#pragma unroll
        for (int j = 0; j < 8; ++j) x[j] = qv[ks][j] * fexp(bt[ks][j]);
        const bf16x8 a = pack8(x);
#pragma unroll
        for (int n = 0; n < 4; ++n) { const bf16x8 b = *(const LAS bf16x8*)(ST + (n * 16 + fr) * LD64 + ks * 32 + fq * 8); ox[n] = __builtin_amdgcn_mfma_f32_16x16x32_bf16(b, a, ox[n], 0, 0, 0); } }
    for (int j = 0; j < w; ++j) { f32x4 sc = (f32x4){0, 0, 0, 0};
#pragma unroll
        for (int ks = 0; ks < 2; ++ks) { float be[8], x[8]; ld8f(bL + (16 * j + 15) * 64 + ks * 32 + fq * 8, be);
#pragma unroll
            for (int q = 0; q < 8; ++q) x[q] = qv[ks][q] * fexp(bt[ks][q] - be[q]);
            const bf16x8 a = pack8(x); const bf16x8 b = *(const LAS bf16x8*)(Kh + (16 * j + fr) * LD64 + ks * 32 + fq * 8);
            sc = __builtin_amdgcn_mfma_f32_16x16x32_bf16(b, a, sc, 0, 0, 0); }
        u32x2 o; o.x = pk2(sc.x, sc.y); o.y = pk2(sc.z, sc.w); *(LAS u32x2*)(Pw + fr * LD128 + 16 * j + 4 * fq) = o; }
    { f32x4 sc = (f32x4){0, 0, 0, 0};
#pragma unroll
      for (int ks = 0; ks < 2; ++ks) { float br[8], bee[8], kk[8], x[8], y[8]; ld8f(bL + (16 * w + 7) * 64 + ks * 32 + fq * 8, br); ld8f(bL + (16 * w + 15) * 64 + ks * 32 + fq * 8, bee); ld8b(Kh + tl * LD64 + ks * 32 + fq * 8, kk);
#pragma unroll
          for (int q = 0; q < 8; ++q) { x[q] = qv[ks][q] * fexp(bt[ks][q] - br[q]); y[q] = kk[q] * fexp(br[q] - bee[q]); }
          sc = __builtin_amdgcn_mfma_f32_16x16x32_bf16(pack8(y), pack8(x), sc, 0, 0, 0); }
      float pv[4];
#pragma unroll
      for (int q = 0; q < 4; ++q) pv[q] = (4 * fq + q <= fr) ? sc[q] : 0.f;
      u32x2 o; o.x = pk2(pv[0], pv[1]); o.y = pk2(pv[2], pv[3]); *(LAS u32x2*)(Pw + fr * LD128 + 16 * w + 4 * fq) = o; }
    for (int j = w + 1; j < 8; ++j) *(LAS u32x2*)(Pw + fr * LD128 + 16 * j + 4 * fq) = (u32x2){0u, 0u};
    WAVE_SYNC();
    f32x4 oi[4];
#pragma unroll
    for (int n = 0; n < 4; ++n) oi[n] = (f32x4){0, 0, 0, 0};
    wave_mma<4, 4>(oi, Pw, LD128, VT, LD128, lane);
    float ss = 0.f;
#pragma unroll
    for (int n = 0; n < 4; ++n) { oi[n] = oi[n] + ox[n]; ss += (oi[n].x * oi[n].x + oi[n].y * oi[n].y) + (oi[n].z * oi[n].z + oi[n].w * oi[n].w); }
    ss += __shfl_xor(ss, 16); ss += __shfl_xor(ss, 32);
    const float rstd = frsq(ss * (1.0f / 64.0f) + EPS);
    const int t = t0 + tl; bf16* y = WSP(bf16, WS_ACT) + (size_t)t * 1024 + Y_HG + h * 64; const bf16* gp = proj + (size_t)t * NPROJ + C_GG + h * 64; const float* ng = F.hg_norm_g + l * 256 + h * 64;
#pragma unroll
    for (int n = 0; n < 4; ++n) { const int e = 16 * n + 4 * fq; const u32x2 g = *(const u32x2*)(gp + e); const f32x4 gn = *(const f32x4*)(ng + e); const f32x4 v = oi[n] * rstd * gn;
        u32x2 o; o.x = pk2(v.x * siluf_(bflo(g.x)), v.y * siluf_(bfhi(g.x))); o.y = pk2(v.z * siluf_(bflo(g.y)), v.w * siluf_(bfhi(g.y))); *(u32x2*)(y + e) = o; }
}

struct PtrS5A { const bf16* proj; const bf16* sp; int g, c0;
    __device__ __forceinline__ const bf16* operator()(int r, int k) const { int c = c0 + r; if (c >= NCH5) c = NCH5 - 1;
        return k < 512 ? proj + (size_t)(c * 32 + (k >> 4)) * NPROJ + C_S5U + g * 16 + (k & 15) : sp + ((size_t)c * 16 + g) * 128 + (k - 512); } };
struct EpiS5Inc { float* st; int g, c0;
    __device__ __forceinline__ void operator()(int r, int c, f32x4 v) const { const int ch = c0 + r; if (ch < NCH5) *(f32x4*)(st + ((size_t)ch * 16 + g) * 128 + c) = v; } };
struct EpiS5Out { const bf16* proj; bf16* ypre; const float* dsk; int g, c0, n0;
    __device__ __forceinline__ void operator()(int r, int c, f32x4 v) const { const int ch = c0 + r; if (ch >= NCH5) return; const int np = n0 + c, tl = np >> 4, p = np & 15, t = ch * 32 + tl;
        const u32x2 u = *(const u32x2*)(proj + (size_t)t * NPROJ + C_S5U + g * 16 + p); const float* d = dsk + g * 16 + p;
        const float y0 = gelu_tanh(v.x + d[0] * bflo(u.x)), y1 = gelu_tanh(v.y + d[1] * bfhi(u.x)), y2 = gelu_tanh(v.z + d[2] * bflo(u.y)), y3 = gelu_tanh(v.w + d[3] * bfhi(u.y));
        u32x2 o; o.x = pk2(y0, y1); o.y = pk2(y2, y3); *(u32x2*)(ypre + (size_t)t * 256 + g * 16 + p) = o; } };

constexpr int S5_CB = (NCH5 + 127) / 128;
__device__ __forceinline__ void phase_m1(Frame& F, int l) {
    constexpr int U_HG = NCH * 4, U_M2 = NCH * 2, U_RET = NCH * 4, U_S5 = 16 * S5_CB;
    unsigned* ctr = WSP(unsigned, WS_CTL) + CW_Q + 64 * (2 * l) + 32 * F.rep;
    constexpr int U_GG = L / 256;
    constexpr int NC = U_GG + U_HG + U_M2 + U_RET + U_S5 + 256;
    for (int u0 = grab_unit(F, ctr); u0 < NC + CONV_D_UNITS; u0 = grab_unit(F, ctr)) {
        if (u0 >= NC) { conv_d_unit(F, l, u0 - NC); continue; }
        if (u0 < U_GG) { g8::OneUnit S1{u0, NPROJ / 256 - 1, (size_t)256 * 1024 * 2, (size_t)256 * 1024 * 2}; g8::EpiStore E1{WSP(bf16, WS_BIG), NPROJ};
            g8::gemm_phase(F.lds, WSP(bf16, WS_ACT), WSP(bf16, WS_WIN) + (size_t)l * NPROJ * 1024, 1024, S1, E1); continue; }
        const int u = u0 - U_GG;
        if (u >= U_HG + U_M2 + U_RET + U_S5) { s5_prep_b(F, l, u - (U_HG + U_M2 + U_RET + U_S5), 256); continue; }
        if (u < U_HG) { hg_state_unit(F, l, u >> 2, u & 3); continue; }
        int r = u - U_HG;
        if (r < U_M2) { m2_state_unit(F, l, r >> 1, r & 1); continue; } r -= U_M2;
        if (r < U_RET) { ret_state_unit(F, r >> 2, r & 3); continue; } r -= U_RET;
        { const int g = r / S5_CB, cb = r % S5_CB; PtrS5A ap{WSP(bf16, WS_BIG), nullptr, g, cb * 128}; PtrRM bp{WSP(bf16, WS_S5BI) + (size_t)g * 128 * 512, 512, 127};
          EpiS5Inc e{WSP(float, WS_ST_S5), g, cb * 128}; gemm128(F.lds, 512, ap, bp, e); }
    }
}
constexpr int SL = 32;
template <int LEN, class DEC>
__device__ __forceinline__ void seg_scan_real(Frame& F0, float* base, size_t cstride, int chain0, int nchain_total, const DEC& dec) {
    Frame F = F0; LAUNDER(F);
    constexpr int NSEG = (LEN + SL - 1) / SL, CHB = NTHREADS / NSEG;
    lf32* Ts = (lf32*)F.lds; lf32* Qs = Ts + NTHREADS;
    const int ch = chain0 + (F.tid % CHB), sg = F.tid / CHB; const bool act = (F.tid < CHB * NSEG) && ch < nchain_total;
    float v[SL], d[SL]; float s = 0.f, q = 1.f;
    float* p = base + ch;
    __syncthreads();
    if (act) {
#pragma unroll
        for (int j = 0; j < SL; ++j) { const int c = sg * SL + j; const bool ok = c < LEN; v[j] = ok ? p[(size_t)c * cstride] : 0.f; d[j] = ok ? dec(ch, c) : 1.f; }
#pragma unroll
        for (int j = 0; j < SL; ++j) { s = d[j] * s + v[j]; q *= d[j]; }
        Ts[sg * CHB + (F.tid % CHB)] = s; Qs[sg * CHB + (F.tid % CHB)] = q;
    }
    __syncthreads();
    if (act) {
        float c0 = 0.f;
        for (int g = 0; g < sg; ++g) c0 = Qs[g * CHB + (F.tid % CHB)] * c0 + Ts[g * CHB + (F.tid % CHB)];
        s = c0;
#pragma unroll
        for (int j = 0; j < SL; ++j) { const int c = sg * SL + j; if (c < LEN) { p[(size_t)c * cstride] = s; s = d[j] * s + v[j]; } }
    }
}
struct DecConst { float d; __device__ __forceinline__ float operator()(int, int) const { return d; } };
struct DecM2 { const float* dc; __device__ __forceinline__ float operator()(int ch, int c) const { return dc[c * 4 + (ch >> 13)]; } };
struct DecHG { const float* dc; __device__ __forceinline__ float operator()(int ch, int c) const { return dc[(size_t)c * 256 + (ch >> 12) * 64 + (ch & 63)]; } };
template <int LEN>
__device__ __forceinline__ void seg_scan_s5(Frame& F0, int l, int chain0) {
    Frame F = F0; LAUNDER(F);
    constexpr int NSEG = (LEN + SL - 1) / SL, CHB = NTHREADS / NSEG;
    LAS f32x2* Ts = (LAS f32x2*)F.lds; LAS f32x2* Qs = Ts + NTHREADS;
    const int r = chain0 + (F.tid % CHB), sg = F.tid / CHB; const bool act = (F.tid < CHB * NSEG) && r < 1024;
    const float* ap = WSP(float, WS_S5AP) + ((size_t)l * 1024 + (act ? r : 0)) * 68 + 64; const float ar = ap[0], ai = ap[1];
    const f32x2* p = (const f32x2*)(WSP(float, WS_ST_S5) + 2 * r); bf16* qo = WSP(bf16, WS_S5UG) + (size_t)(r >> 6) * NR5 * 640 + 512 + 2 * (r & 63);
    f32x2 v[SL]; float sr = 0.f, si = 0.f, qr = 1.f, qi = 0.f;
    __syncthreads();
    if (act) {
#pragma unroll
        for (int j = 0; j < SL; ++j) { const int c = sg * SL + j; v[j] = (c < LEN) ? p[(size_t)c * 1024] : (f32x2){0.f, 0.f}; }
#pragma unroll
        for (int j = 0; j < SL; ++j) { const int c = sg * SL + j; if (c < LEN) { const float nr = ar * sr - ai * si + v[j].x, ni = ar * si + ai * sr + v[j].y; sr = nr; si = ni; const float tr = ar * qr - ai * qi, ti = ar * qi + ai * qr; qr = tr; qi = ti; } }
        Ts[sg * CHB + (F.tid % CHB)] = (f32x2){sr, si}; Qs[sg * CHB + (F.tid % CHB)] = (f32x2){qr, qi};
    }
    __syncthreads();
    if (act) {
        float cr = 0.f, ci = 0.f;
        for (int g = 0; g < sg; ++g) { const f32x2 Q = Qs[g * CHB + (F.tid % CHB)], T = Ts[g * CHB + (F.tid % CHB)]; const float nr = Q.x * cr - Q.y * ci + T.x, ni = Q.x * ci + Q.y * cr + T.y; cr = nr; ci = ni; }
        sr = cr; si = ci;
#pragma unroll
        for (int j = 0; j < SL; ++j) { const int c = sg * SL + j; if (c < LEN) { *(unsigned*)(qo + (size_t)c * 640) = pk2(sr, si); const float nr = ar * sr - ai * si + v[j].x, ni = ar * si + ai * sr + v[j].y; sr = nr; si = ni; } }
    }
}
__device__ __forceinline__ void phase_m2(Frame& F, int l) {
    constexpr int N_RET = 4 * 4096, N_M2 = 4 * 8192, N_HG = 4 * 4096, N_S5 = 16 * 64;
    constexpr int CB_R = NTHREADS / ((NCH + SL - 1) / SL), CB_H = NTHREADS / ((NCH + SL - 1) / SL), CB_S = NTHREADS / ((NCH5 + SL - 1) / SL);
    constexpr int U_S5 = (N_S5 + CB_S - 1) / CB_S, U_HG = (N_HG + CB_H - 1) / CB_H, U_M2 = (N_M2 + CB_R - 1) / CB_R, U_RET = (N_RET + CB_R - 1) / CB_R;
    unsigned* ctr = WSP(unsigned, WS_CTL) + CW_Q + 64 * (6 + l) + 32 * F.rep;
    for (int u = grab_unit(F, ctr); u < U_S5 + U_HG + U_M2 + U_RET; u = grab_unit(F, ctr)) {
        if (u < U_S5) { seg_scan_s5<NCH5>(F, l, u * CB_S); continue; }
        int r = u - U_S5;
        if (r < U_HG) { DecHG dh{WSP(float, WS_DEC_HG)}; seg_scan_real<NCH>(F, WSP(float, WS_ST_HG), 16384, r * CB_H, N_HG, dh); continue; }
        r -= U_HG;
        if (r < U_M2) { DecM2 dm{WSP(float, WS_DEC_M2)}; seg_scan_real<NCH>(F, WSP(float, WS_ST_M2), 32768, r * CB_R, N_M2, dm); continue; }
        r -= U_M2;
        { const int ch0 = r * CB_R; DecConst dcst{exp2f(128.0f * ret_log2gamma(ch0 >> 12))};
          seg_scan_real<NCH>(F, WSP(float, WS_ST_RET), 16384, ch0, N_RET, dcst); }
    }
}
__device__ __forceinline__ void phase_m3(Frame& F, int l) {
    constexpr int U_HG = NCH * 4, U_M2 = NCH, U_RET = NCH * 4, U_S5 = 16 * (NR5 / 256) * 2;
    unsigned* ctr = WSP(unsigned, WS_CTL) + CW_Q + 64 * (2 * l + 1) + 32 * F.rep;
    constexpr int NC = U_HG + U_M2 + U_RET + U_S5;
    for (int u0 = grab_unit(F, ctr); u0 < NC + CONV_GU_UNITS; u0 = grab_unit(F, ctr)) {
        if (u0 >= U_M2 + U_S5 && u0 < U_M2 + U_S5 + CONV_GU_UNITS) { conv_gu_unit(F, l, u0 - (U_M2 + U_S5)); continue; }
        const int u = u0 < U_M2 + U_S5 ? u0 : u0 - CONV_GU_UNITS;
#ifndef M3SKIP
#define M3SKIP 0
#endif
        if (u < U_M2) { if (!(M3SKIP & 2)) m2_out_unit(F, l, u); continue; }
        int r = u - U_M2;
        if (r >= U_S5) { r -= U_S5;
            if (r < U_HG) { if (!(M3SKIP & 1)) hg_out_unit(F, l, r >> 2, r & 3); continue; } r -= U_HG;
            if (!(M3SKIP & 4)) ret_out_unit(F, r >> 2, r & 3); continue; }
        if (M3SKIP & 8) continue;
        { const int g = r / (2 * (NR5 / 256)), pm = (r >> 1) % (NR5 / 256), pn = r & 1;
          g8::OneUnit S1{pm, pn, (size_t)256 * 640 * 2, (size_t)256 * 640 * 2};
          g8::EpiQuad<EpiS5Out> E1{EpiS5Out{WSP(bf16, WS_BIG), WSP(bf16, WS_YPRE), F.s5_d + l * 256, g, 0, 0}};
          g8::gemm_phase(F.lds, WSP(bf16, WS_S5UG) + (size_t)g * NR5 * 640, WSP(bf16, WS_S5MT) + (size_t)g * 512 * 640, 640, S1, E1); }
    }
}
struct EpiGlu { const bf16* ypre; bf16* y; const float* bias; int r0, c0;
    __device__ __forceinline__ void operator()(int r, int c, f32x4 v) const { const int t = r0 + r, j = c0 + c; const u32x2 u = *(const u32x2*)(ypre + (size_t)t * 256 + j); const f32x4 b = *(const f32x4*)(bias + j);
        u32x2 o; o.x = pk2(bflo(u.x) * sigmoidf_(v.x + b.x), bfhi(u.x) * sigmoidf_(v.y + b.y)); o.y = pk2(bflo(u.y) * sigmoidf_(v.z + b.z), bfhi(u.y) * sigmoidf_(v.w + b.w));
        *(u32x2*)(y + (size_t)t * 1024 + Y_S5 + j) = o; } };
__device__ __forceinline__ void phase_m4(Frame& F, int l) {
    constexpr int NM = L / 128;
    for (int u = F.bid; u < NM * 2; u += F.G) { const int pm = u >> 1, pn = u & 1;
        PtrRM ap{WSP(bf16, WS_YPRE) + (size_t)pm * 128 * 256, 256, 127}, bp{WSP(bf16, WS_WGLU) + (size_t)l * 65536 + (size_t)pn * 128 * 256, 256, 127};
        EpiGlu e{WSP(bf16, WS_YPRE), WSP(bf16, WS_ACT), F.s5_b_glu + l * 256, pm * 128, pn * 128}; gemm128(F.lds, 256, ap, bp, e); }
}

__device__ __forceinline__ void phase_g2(Frame& F, int l) {
    g8::GridOrder S{L / 256, 4, (L / 256) * 4, F.G, F.bid, (size_t)256 * 1024 * 2, (size_t)256 * 1024 * 2};
    if (l == 0) { g8::EpiResid<false> E{F.x, WSP(bf16, WS_XRES)}; g8::gemm_phase(F.lds, WSP(bf16, WS_ACT), WSP(bf16, WS_WOUT), 1024, S, E); }
    else { g8::EpiResid<true> E{F.out, WSP(bf16, WS_XRES)}; g8::gemm_phase(F.lds, WSP(bf16, WS_ACT), WSP(bf16, WS_WOUT) + (size_t)1048576, 1024, S, E); }
}

__device__ __forceinline__ void phase_r2(Frame& F, int l) {
    const int RPB = L / F.G;
    LAS f32x4* T = (LAS f32x4*)F.lds;
    li32* e_s = (li32*)(F.lds + 81920); li32* base_s = e_s + 128;
    int* hist = WSP(int, WS_HIST) + l * 256 * 16;
    const float* g2 = F.norm2_g + l * 1024; const float* wg = F.moe_w_group + (size_t)l * 4096; const float* we = F.moe_w_expert + (size_t)l * 16384;
    __syncthreads();
    for (int k = F.tid; k < 1024; k += NTHREADS) { const float g = g2[k]; const int ln = (k >> 2) & 63, a = k & 3, j = k >> 8; const int idx = (j * 4 + a) * 64 + ln;
        T[idx] = g * *(const f32x4*)(wg + (size_t)k * 4);
#pragma unroll
        for (int b = 0; b < 4; ++b) T[(b + 1) * 1024 + idx] = g * *(const f32x4*)(we + (size_t)k * 16 + 4 * b); }
    for (int rb = 0; rb < RPB; rb += 64) {
        __syncthreads();
        u32x2 xq[4];
        if (rb + F.wave * 8 < RPB) { const u32x2* x0 = (const u32x2*)(WSP(bf16, WS_XRES) + (size_t)(F.bid * RPB + rb + F.wave * 8) * D) + F.lane;
#pragma unroll
            for (int j = 0; j < 4; ++j) xq[j] = x0[64 * j]; }
        for (int rr = 0; rr < 8; ++rr) { const int ri = F.wave * 8 + rr; if (rb + ri >= RPB) break; const int t = F.bid * RPB + rb + ri; const int lane = F.lane;
            const u32x2* xr = (const u32x2*)(WSP(bf16, WS_XRES) + (size_t)t * D) + lane; float ss = 0.f; f32x4 v[4];
#pragma unroll
            for (int j = 0; j < 4; ++j) { const u32x2 xb = xq[j]; v[j] = (f32x4){bflo(xb.x), bfhi(xb.x), bflo(xb.y), bfhi(xb.y)}; ss += (v[j].x * v[j].x + v[j].y * v[j].y) + (v[j].z * v[j].z + v[j].w * v[j].w); }
            if (rr + 1 < 8 && rb + ri + 1 < RPB) {
#pragma unroll
                for (int j = 0; j < 4; ++j) xq[j] = xr[256 + 64 * j]; }
            const float rstd = frsq(wave_sum(ss) * (1.0f / D) + EPS);
            float lgg[4] = {0.f, 0.f, 0.f, 0.f};
            u32x2* hb = (u32x2*)(WSP(bf16, WS_ACT) + (size_t)t * D) + lane;
#pragma unroll
            for (int j = 0; j < 4; ++j) { const int k = 4 * lane + 256 * j; const f32x4 h = v[j] * rstd * *(const f32x4*)(g2 + k);
                u32x2 w; w.x = pk2(h.x, h.y); w.y = pk2(h.z, h.w); hb[64 * j] = w;
                const float xv[4] = {v[j].x, v[j].y, v[j].z, v[j].w};
#pragma unroll
                for (int a = 0; a < 4; ++a) { const f32x4 w4 = T[(j * 4 + a) * 64 + lane]; lgg[0] += xv[a] * w4.x; lgg[1] += xv[a] * w4.y; lgg[2] += xv[a] * w4.z; lgg[3] += xv[a] * w4.w; } }
            float gl[4]; float gm = -1e30f; int gi = 0;
#pragma unroll
            for (int q = 0; q < 4; ++q) { gl[q] = wave_sum(lgg[q]) * rstd + F.moe_b_group[l * 4 + q]; if (gl[q] > gm) { gm = gl[q]; gi = q; } }
            gi = __builtin_amdgcn_readfirstlane(gi);
            float lge[4] = {0.f, 0.f, 0.f, 0.f};
            { const LAS f32x4* Te = T + (1 + gi) * 1024;
#pragma unroll
              for (int j = 0; j < 4; ++j) { const float xv[4] = {v[j].x, v[j].y, v[j].z, v[j].w};
#pragma unroll
                for (int a = 0; a < 4; ++a) { const f32x4 w4 = Te[(j * 4 + a) * 64 + lane]; lge[0] += xv[a] * w4.x; lge[1] += xv[a] * w4.y; lge[2] += xv[a] * w4.z; lge[3] += xv[a] * w4.w; } } }
            float el[4];
#pragma unroll
            for (int q = 0; q < 4; ++q) el[q] = wave_sum(lge[q]) * rstd + F.moe_b_expert[l * 16 + gi * 4 + q];
            if (lane == 0) {
                float gs = 0.f;
#pragma unroll
                for (int q = 0; q < 4; ++q) gs += fexp(gl[q] - gm);
                const float pg = 1.0f / gs;
                int i0 = 0; float m0 = el[0];
#pragma unroll
                for (int q = 1; q < 4; ++q) if (el[q] > m0) { m0 = el[q]; i0 = q; }
                int i1 = -1; float m1 = -1e30f;
#pragma unroll
                for (int q = 0; q < 4; ++q) if (q != i0 && el[q] > m1) { m1 = el[q]; i1 = q; }
                if (i1 < 0) { i1 = (i0 + 1) & 3; m1 = m0; }
                const float p1 = fexp(m1 - m0);
                const float w0 = pg / (1.0f + p1), w1 = pg * p1 / (1.0f + p1);
                int* rt = WSP(int, WS_ROUTE) + ((size_t)l * L + t) * 8; float* rtf = (float*)rt;
                rt[0] = gi * 4 + i0; rt[1] = gi * 4 + i1; rtf[4] = w0; rtf[5] = w1;
                e_s[2 * ri] = gi * 4 + i0; e_s[2 * ri + 1] = gi * 4 + i1;
            } }
        __syncthreads();
        const int nrow = (RPB - rb) < 64 ? (RPB - rb) : 64;
        li32* cnt_s = base_s;
        int my_e = -1, my_rank = 0;
        if (F.wave < 2) { const int idx = F.wave * 64 + F.lane; my_e = idx < 2 * nrow ? e_s[idx] : -1;
#pragma unroll
            for (int q = 0; q < 16; ++q) { const unsigned long long m = __ballot(my_e == q); if (my_e == q) my_rank = __builtin_popcountll(m & ((1ull << F.lane) - 1ull)); if (F.lane == 0) cnt_s[F.wave * 16 + q] = __builtin_popcountll(m); } }
        __syncthreads();
        if (F.tid < 16) hist[F.bid * 16 + F.tid] = cnt_s[F.tid] + cnt_s[16 + F.tid];
        if (F.wave < 2 && my_e >= 0) { const int idx = F.wave * 64 + F.lane; const int pos = my_rank + (F.wave == 1 ? cnt_s[my_e] : 0);
            const int t = F.bid * RPB + rb + (idx >> 1); WSP(int, WS_ROUTE)[((size_t)l * L + t) * 8 + 2 + (idx & 1)] = pos; }
    }
}
__device__ __forceinline__ int moe_tables(Frame& F, int l, li32* base_s, li32* pe_s, li32* pref_s) {
    const int* hist = WSP(int, WS_HIST) + l * 256 * 16; const int G = F.G; li32* seg_s = pref_s + 256 * 16;
    const int e = F.tid & 15, sg = F.tid >> 4, per = (G + 31) / 32;
    __syncthreads();
    for (int i = F.tid; i < G * 16; i += NTHREADS) pref_s[i] = hist[i];
    __syncthreads();
    { int run = 0; for (int b = sg * per; b < (sg + 1) * per && b < G; ++b) { const int v = pref_s[b * 16 + e]; pref_s[b * 16 + e] = run; run += v; } seg_s[sg * 16 + e] = run; }
    __syncthreads();
    if (F.tid < 16) { int run = 0; for (int g = 0; g < 32; ++g) { const int v = seg_s[g * 16 + F.tid]; seg_s[g * 16 + F.tid] = run; run += v; } base_s[16 + F.tid] = run; }
    __syncthreads();
    { const int off = seg_s[sg * 16 + e]; for (int b = sg * per; b < (sg + 1) * per && b < G; ++b) pref_s[b * 16 + e] += off; }
    if (F.tid == 0) { int tot[16];
#pragma unroll
        for (int q = 0; q < 16; ++q) tot[q] = base_s[16 + q];
        int b = 0, np = 0;
#pragma unroll
        for (int q = 0; q < 16; ++q) { base_s[q] = b; const int pp = (tot[q] + 255) >> 8; for (int i = 0; i < pp; ++i) pe_s[np++] = q; b += pp * 256; }
        base_s[16] = np; }
    __syncthreads();
    return base_s[16];
}
constexpr size_t WS_MOETAB = WS_LB + 2048;
__device__ __forceinline__ int moe_tables_small(Frame& F, int l, li32* base_s, li32* pe_s) {
    const int* tab = WSP(int, WS_MOETAB) + l * 256;
    __syncthreads();
    if (F.tid < 32) base_s[F.tid] = tab[F.tid];
    if (F.tid >= 32 && F.tid < 32 + 160) pe_s[F.tid - 32] = tab[F.tid];
    __syncthreads();
    return base_s[16];
}
__device__ __forceinline__ void phase_ga(Frame& F, int l) {
    li32* base_s = (li32*)F.lds; li32* pe_s = base_s + 32; li32* pref_s = pe_s + 160;
    moe_tables(F, l, base_s, pe_s, pref_s);
    if (F.bid == 0) { int* tab = WSP(int, WS_MOETAB) + l * 256; if (F.tid < 32) tab[F.tid] = base_s[F.tid]; if (F.tid >= 32 && F.tid < 32 + 160) tab[F.tid] = pe_s[F.tid - 32]; }
    const int RPB = L / F.G;
    const int gw = F.bid * 8 + F.wave, ngw = F.G * 8;
    for (int t = gw; t < L; t += ngw) { int* rt = WSP(int, WS_ROUTE) + ((size_t)l * L + t) * 8;
        const int ob = (t / RPB) * 16; const int s0 = base_s[rt[0]] + pref_s[ob + rt[0]] + rt[2], s1 = base_s[rt[1]] + pref_s[ob + rt[1]] + rt[3];
        if (F.lane == 0) { rt[6] = s0; rt[7] = s1; }
        const u32x4* src = (const u32x4*)(WSP(bf16, WS_ACT) + (size_t)t * 1024) + F.lane; u32x4* d0 = (u32x4*)(WSP(bf16, WS_H2G) + (size_t)s0 * 1024) + F.lane; u32x4* d1 = (u32x4*)(WSP(bf16, WS_H2G) + (size_t)s1 * 1024) + F.lane;
        const u32x4 a = src[0], b = src[64]; d0[0] = a; d0[64] = b; d1[0] = a; d1[64] = b; }
}
__device__ __forceinline__ void phase_g3(Frame& F, int l) {
    li32* base_s = (li32*)(F.lds + g8::STAGE_BYTES); li32* pe_s = base_s + 32;
    const int np = moe_tables_small(F, l, base_s, pe_s);
    g8::MoeOrder S{np, F.G, F.bid, pe_s, (size_t)256 * 1024 * 2, (size_t)1024 * 1024 * 2, (size_t)256 * 1024 * 2};
    g8::EpiGateUp E{WSP(bf16, WS_ACTB), (unsigned)((size_t)NSLOTP * 512 * 2), WSP(unsigned, WS_CTL) + CW_DEP + l * 4096};
    g8::gemm_phase(F.lds, WSP(bf16, WS_H2G), WSP(bf16, WS_WGU), 1024, S, E);
}
__device__ __forceinline__ void phase_g4(Frame& F, int l) {
    li32* base_s = (li32*)(F.lds + g8::STAGE_BYTES); li32* pe_s = base_s + 32;
    const int np = moe_tables_small(F, l, base_s, pe_s);
    const int n3raw = np * 4 - 2 * F.G, n3 = (n3raw >= 0 && n3raw <= F.G / 4) ? n3raw : -1;
    const int rank = n3 < 0 ? (F.bid + F.G / 2) % F.G : (F.bid >= n3 ? F.bid - n3 : F.G - n3 + F.bid);
    g8::MoeOrderDep S{np, F.G, rank, n3, pe_s, (size_t)256 * 512 * 2, (size_t)1024 * 512 * 2, (size_t)256 * 512 * 2, WSP(unsigned, WS_CTL) + CW_DEP + l * 4096, F.wave};
    g8::EpiStore E{WSP(bf16, WS_H2G), 1024};
    g8::gemm_phase(F.lds, WSP(bf16, WS_ACTB), WSP(bf16, WS_WD), 512, S, E);
    if (l == 0) { unsigned* ctr = WSP(unsigned, WS_CTL) + CW_Q + 64 * 5 + 32 * F.rep;
      for (int u = grab_unit(F, ctr); u < 256; u = grab_unit(F, ctr)) s5_prep_a(F, 1, u, 256); }
}
#ifndef ONLY
#define ONLY -1
#endif
#define EN(k) (ONLY < 0 || ONLY == (k))
constexpr int NPHASE = 23;
__global__ void __launch_bounds__(NTHREADS, 2) fwd_kernel(Args a) {
#ifdef EMU
    lu8* lds = emu::ctx->lds;
#else
    __shared__ __attribute__((aligned(16))) unsigned char lds_raw[LDS_BYTES];
    lu8* lds = (lu8*)lds_raw;
#endif
    Frame F;
    F.lds = lds; F.ws = a.ws; F.out = a.out; F.tid = threadIdx.x; F.lane = F.tid & 63; F.wave = __builtin_amdgcn_readfirstlane(F.tid >> 6); F.G = gridDim.x; F.bid = blockIdx.x; F.rep = 0;
    F.x = (const float*)a.in[0]; F.pos = (const int*)a.in[1];
    { LAS unsigned long long* tab = (LAS unsigned long long*)(lds + MISC_OFF + 256); if (F.tid < 32) tab[F.tid] = (unsigned long long)a.in[F.tid]; F.ptab = tab; }
#ifndef EMU
    volatile LAS unsigned* misc = (volatile LAS unsigned*)(lds + MISC_OFF);
    for (int u = F.tid; u < 64; u += NTHREADS) misc[u] = 0u;
#endif
    __syncthreads();
#ifndef EMU
    XcdBarrier bar = xcd_barrier_post(WSP(unsigned, WS_CTL) + CW_BAR, misc + 8);
#endif
    const Frame F00 = F;
    const int lo = a.ph_lo, hi = a.ph_hi;
#ifdef EMU
#define GRID_BAR() ((void)0)
#else
#define GRID_BAR() xcd_barrier(bar)
#endif
#ifndef REPEAT_PH
#define REPEAT_PH -1
#endif
#define PH(k, en, stmt) if (lo <= (k) && (k) < hi) { Frame F = F00; LAUNDER(F); if (EN(en)) { stmt; } if ((k) + 1 < hi && (k) != 9 && (k) != 20) GRID_BAR(); \
        if ((k) == REPEAT_PH) { Frame F = F00; LAUNDER(F); F.rep = 1; stmt; GRID_BAR(); } }
    PH(0, 10, phase_p0(F))
    PH(1, 0, phase_g1(F, 0)) PH(2, 1, phase_m1(F, 0)) PH(3, 2, phase_m2(F, 0)) PH(4, 3, phase_m3(F, 0)) PH(5, 4, phase_m4(F, 0))
    PH(6, 5, phase_g2(F, 0)) PH(7, 6, phase_r2(F, 0)) PH(8, 7, phase_ga(F, 0)) PH(9, 8, phase_g3(F, 0)) PH(10, 9, phase_g4(F, 0))
    PH(11, 12, r1_phase(F, 1, 1))
    PH(12, 0, phase_g1(F, 1)) PH(13, 1, phase_m1(F, 1)) PH(14, 2, phase_m2(F, 1)) PH(15, 3, phase_m3(F, 1)) PH(16, 4, phase_m4(F, 1))
    PH(17, 5, phase_g2(F, 1)) PH(18, 6, phase_r2(F, 1)) PH(19, 7, phase_ga(F, 1)) PH(20, 8, phase_g3(F, 1)) PH(21, 9, phase_g4(F, 1))
    PH(22, 11, r1_phase(F, 2, 0))
#undef PH
}


#ifdef STOP_AFTER
__global__ void __launch_bounds__(512) diag0(unsigned char* ws) { unsigned* flag = (unsigned*)(ws + WS_CTL) + 70000; if (threadIdx.x < 8 && blockIdx.x == 0) flag[threadIdx.x] = threadIdx.x == 1 ? 0x7fffffffu : 0u; }
__global__ void __launch_bounds__(512) diag1(const float* out, unsigned char* ws) {
    const size_t N = (size_t)L * D; const unsigned short* act = (const unsigned short*)(ws + WS_ACT); unsigned* flag = (unsigned*)(ws + WS_CTL) + 70000;
    for (size_t i = (size_t)blockIdx.x * 512 + threadIdx.x; i < N; i += (size_t)gridDim.x * 512) { if ((act[i] & 0x7F80u) == 0x7F80u) { atomicAdd(flag, 1u); atomicMin(flag + 1, (unsigned)(i >> 10)); if (((i >> 8) & 3) == 1) atomicOr(flag + 2, 1u << ((i >> 4) & 3)); } }
}
__global__ void __launch_bounds__(512) diag2(float* out, const unsigned char* ws) {
    const size_t N = (size_t)L * D; const unsigned* flag = (const unsigned*)(ws + WS_CTL) + 70000;
    const float c = DIAG_SEL == 0 ? (float)flag[0] : DIAG_SEL == 1 ? (float)flag[1] + 1.f : DIAG_SEL == 2 ? (float)flag[2] * 10.f : DIAG_SEL == 4 ? (float)flag[16] * 10.f : (float)flag[3];
    for (size_t i = (size_t)blockIdx.x * 512 + threadIdx.x; i < N; i += (size_t)gridDim.x * 512) out[i] = c;
}
#endif
#ifdef EMU
extern "C" int emu_seq() { return L; }
extern "C" size_t emu_ws_bytes() { return WS_END; }
extern "C" void emu_dump_layout(FILE* f) {
#define LO(n) fprintf(f, #n " %zu\n", (size_t)n)
    LO(WS_WIN); LO(WS_WOUT); LO(WS_WGLU); LO(WS_WGU); LO(WS_WD); LO(WS_S5MT); LO(WS_S5BI); LO(WS_S5AP); LO(WS_S5BB); LO(WS_S5KT); LO(WS_ROPE); LO(WS_DTW); LO(WS_LB); LO(WS_ACT); LO(WS_YPRE);
    LO(WS_DTRAW); LO(WS_ROUTE); LO(WS_ST_RET); LO(WS_ST_M2); LO(WS_DEC_M2); LO(WS_ST_HG); LO(WS_DEC_HG); LO(WS_ST_S5); LO(WS_SP_S5); LO(WS_BIG); LO(WS_H2G); LO(WS_ACTB); LO(WS_S5UG); LO(WS_END);
    fprintf(f, "CNT %zu\n", (size_t)CW_CNT * 4);
}
#endif

extern "C" void kernel_launch(void* const* d_in, const int* in_sizes, int n_in, void* d_out, int out_size, void* d_ws, size_t ws_size, hipStream_t stream) {
    static int grid = 0;
    if (grid == 0) {
        if (n_in != 32 || out_size != L * D || ws_size < WS_END) { fprintf(stderr, "kernel_launch: unexpected shapes: n_in %d out %d ws %zu (need %zu)\n", n_in, out_size, ws_size, (size_t)WS_END); grid = -1; return; }
#ifdef EMU
        grid = getenv("EMU_GRID") ? atoi(getenv("EMU_GRID")) : L / 64;
#else
        int dev = 0, cus = 0, per_cu = 0;
        (void)hipGetDevice(&dev);
        (void)hipDeviceGetAttribute(&cus, hipDeviceAttributeMultiprocessorCount, dev);
        (void)hipOccupancyMaxActiveBlocksPerMultiprocessor(&per_cu, (const void*)fwd_kernel, NTHREADS, 0);
        (void)hipGetLastError();
        grid = cus > 0 ? cus : 256;
        if (per_cu < 1) { fprintf(stderr, "kernel_launch: occupancy query says 0 blocks/CU\n"); grid = -1; return; }
        if (L % grid != 0 || L / grid > 64 || grid > 256) { fprintf(stderr, "kernel_launch: grid %d unsupported (need L %% grid == 0, L / grid <= 64, grid <= 256)\n", grid); grid = -1; return; }
#endif
    }
    if (grid < 0) return;
    (void)hipMemsetAsync((char*)d_ws + WS_CTL, 0, CTL_ZERO_BYTES, stream);
    Args a{};
    for (int i = 0; i < 32; ++i) a.in[i] = d_in[i];
    a.out = (float*)d_out; a.ws = (unsigned char*)d_ws;
#ifdef EMU
    const int nph = getenv("EMU_PHASES") ? atoi(getenv("EMU_PHASES")) : NPHASE;
    for (int ph = 0; ph < nph; ++ph) { a.ph_lo = ph; a.ph_hi = ph + 1; Args b = a; fprintf(stderr, "emu: phase %d\n", ph);
        emu::launch(dim3(grid), dim3(NTHREADS), LDS_BYTES, [b]() { fwd_kernel(b); }); }
#else
#if defined(STOP_AFTER)
    for (int ph = 0; ph < STOP_AFTER; ++ph) { a.ph_lo = ph; a.ph_hi = ph + 1; hipLaunchKernelGGL(fwd_kernel, dim3(grid), dim3(NTHREADS), 0, stream, a); }
    hipLaunchKernelGGL(diag0, dim3(1), dim3(512), 0, stream, (unsigned char*)d_ws);
    hipLaunchKernelGGL(diag1, dim3(1024), dim3(512), 0, stream, (const float*)d_out, (unsigned char*)d_ws);
    hipLaunchKernelGGL(diag2, dim3(1024), dim3(512), 0, stream, (float*)d_out, (const unsigned char*)d_ws);
#elif defined(MULTI_LAUNCH)
    for (int ph = 0; ph < NPHASE; ++ph) { a.ph_lo = ph; a.ph_hi = ph + 1; hipLaunchKernelGGL(fwd_kernel, dim3(grid), dim3(NTHREADS), 0, stream, a); }
#else
    a.ph_lo = 0; a.ph_hi = NPHASE;
    void* args[] = {&a};
    hipError_t e = hipLaunchCooperativeKernel((const void*)fwd_kernel, dim3(grid), dim3(NTHREADS), args, 0, stream);
    if (e != hipSuccess) fprintf(stderr, "cooperative launch failed: %s (grid %d)\n", hipGetErrorString(e), grid);
#endif
#endif
}
```

```cpp
#ifndef EMU
#include <hip/hip_runtime.h>
#endif
#include <cstdio>
#include <cstdint>
#include <cmath>
#include <cstdlib>

#ifndef SEQ_LEN
#define SEQ_LEN 16384
#endif


typedef unsigned short bf16;
typedef short bf16x8 __attribute__((ext_vector_type(8)));
typedef float f32x4 __attribute__((ext_vector_type(4)));
typedef float f32x2 __attribute__((ext_vector_type(2)));
typedef unsigned u32x4 __attribute__((ext_vector_type(4)));
typedef unsigned u32x2 __attribute__((ext_vector_type(2)));
#ifdef EMU
#define LAS
#else
#define LAS __attribute__((address_space(3)))
#endif
typedef LAS bf16 lbf; typedef LAS float lf32; typedef LAS int li32; typedef LAS unsigned char lu8;

#ifdef EMU
#define WAVE_SYNC() emu::wave_barrier()
#else
#define WAVE_SYNC() do { __builtin_amdgcn_fence(__ATOMIC_RELEASE, "wavefront"); asm volatile("s_waitcnt lgkmcnt(0)" ::: "memory"); __builtin_amdgcn_wave_barrier(); } while (0)
#endif
constexpr int L = SEQ_LEN, D = 1024, NPROJ = 3328, DIN = 3332;
constexpr int C_S5U = 0, C_RQ = 256, C_RK = 512, C_RV = 768, C_RG = 1024, C_MZ = 1280, C_MX = 1536, C_MB = 1792, C_MC = 2048,
              C_GQ = 2304, C_GF = 2560, C_GI = 2816, C_GG = 3072;
constexpr int Y_S5 = 0, Y_RET = 256, Y_M2 = 512, Y_HG = 768;
constexpr int CH = 128, NCH = L / CH;
constexpr int HSC = 64, NHSC = L / HSC;
constexpr int T5 = 32, NCH5 = L / T5;
constexpr int NEXP = 16, FF = 512;
constexpr int NSLOTP = 2 * L + NEXP * 256;
constexpr float EPS = 1e-6f;
constexpr int NTHREADS = 512;
constexpr int LDS_BYTES = 147456;
constexpr int MISC_OFF = 147456 - 512;

constexpr size_t al(size_t x) { return (x + 4095) & ~(size_t)4095; }
constexpr size_t WS_CTL = 0, CTL_ZERO_BYTES = 1u << 20;
constexpr int CW_BAR = 4096;
constexpr int CW_CNT = 65536;
constexpr size_t WS_WIN = 1u << 20;
constexpr size_t WS_WOUT = WS_WIN + al((size_t)2 * NPROJ * 1024 * 2);
constexpr size_t WS_WGLU = WS_WOUT + al((size_t)2 * 1024 * 1024 * 2);
constexpr size_t WS_WGU = WS_WGLU + al((size_t)2 * 256 * 256 * 2);
constexpr size_t WS_WD = WS_WGU + al((size_t)16 * 1024 * 1024 * 2);
constexpr size_t WS_S5MT = WS_WD + al((size_t)16 * 1024 * 512 * 2);
constexpr size_t WS_S5BI = WS_S5MT + al((size_t)16 * 512 * 640 * 2);
constexpr size_t WS_S5AP = WS_S5BI + al((size_t)16 * 128 * 512 * 2);
constexpr size_t WS_S5BB = WS_S5AP + al((size_t)2 * 16 * 64 * 34 * 2 * 4);
constexpr size_t WS_S5KT = WS_S5BB + al((size_t)2 * 16 * 64 * 16 * 2 * 4);
constexpr size_t WS_ROPE = WS_S5KT + al((size_t)16 * 32 * 256 * 4);
constexpr size_t WS_DTW = WS_ROPE + al((size_t)L * 64 * 4);
constexpr size_t WS_HIST = WS_DTW;
constexpr size_t WS_LB = WS_DTW + al((size_t)2 * 1024 * 4 * 4);
constexpr size_t WS_ACT = WS_LB + al(2 * 256 * 4);
constexpr size_t WS_YPRE = WS_ACT + al((size_t)L * 1024 * 2);
constexpr size_t WS_DTRAW = WS_YPRE + al((size_t)L * 256 * 2);
constexpr size_t WS_ROUTE = WS_DTRAW + al((size_t)L * 4 * 4);
constexpr size_t WS_ST_RET = WS_ROUTE + al((size_t)2 * L * 8 * 4);
constexpr size_t WS_ST_M2 = WS_ST_RET + al((size_t)NCH * 4 * 4096 * 4);
constexpr size_t WS_DEC_M2 = WS_ST_M2 + al((size_t)NCH * 4 * 8192 * 4);
constexpr size_t WS_ST_HG = WS_DEC_M2 + al((size_t)NCH * 4 * 4);
constexpr size_t WS_DEC_HG = WS_ST_HG + al((size_t)NHSC * 4 * 4096 * 4);
constexpr size_t WS_ST_S5 = WS_DEC_HG + al((size_t)NHSC * 4 * 64 * 4);
constexpr size_t WS_SP_S5 = WS_ST_S5 + al((size_t)NCH5 * 16 * 128 * 4);
constexpr size_t WS_BIG = WS_SP_S5 + al((size_t)NCH5 * 16 * 128 * 2);
constexpr size_t BIG_BYTES = ((size_t)L * NPROJ * 2 > (size_t)NSLOTP * 1536 * 2) ? (size_t)L * NPROJ * 2 : (size_t)NSLOTP * 1536 * 2;
constexpr size_t WS_XRES = WS_ST_RET;
static_assert(WS_BIG - WS_ST_RET >= (size_t)L * 1024 * 2, "xres overlay");
#define XBC_PTR(F) ((bf16*)(F).out + (size_t)L * 1024)
static_assert((size_t)L * 768 * 2 <= (size_t)16 * 1024 * 1024 * 2, "xbc overlay");
constexpr size_t WS_H2G = WS_BIG, WS_ACTB = WS_BIG + (size_t)NSLOTP * 1024 * 2;
constexpr int NR5 = ((NCH5 + 255) / 256) * 256;
constexpr size_t WS_S5UG = WS_BIG + al(BIG_BYTES);
constexpr size_t WS_END = WS_S5UG + al((size_t)16 * NR5 * 640 * 2);

#ifdef EMU
__device__ __forceinline__ unsigned f2bf(float f) { unsigned u = __builtin_bit_cast(unsigned, f); return (u + 0x7fffu + ((u >> 16) & 1u)) >> 16; }
__device__ __forceinline__ unsigned pk2(float lo, float hi) { return f2bf(lo) | (f2bf(hi) << 16); }
#else
typedef __bf16 hw_bf16x2 __attribute__((ext_vector_type(2)));
__device__ __forceinline__ unsigned pk2(float lo, float hi) { return __builtin_bit_cast(unsigned, __builtin_convertvector((f32x2){lo, hi}, hw_bf16x2)); }
__device__ __forceinline__ unsigned f2bf(float f) { return pk2(f, 0.f) & 0xffffu; }
#endif
__device__ __forceinline__ float bf2f(unsigned short b) { return __builtin_bit_cast(float, ((unsigned)b) << 16); }
__device__ __forceinline__ float bflo(unsigned w) { return __builtin_bit_cast(float, w << 16); }
__device__ __forceinline__ float bfhi(unsigned w) { return __builtin_bit_cast(float, w & 0xffff0000u); }
#ifdef EMU
__device__ __forceinline__ float fexp(float x) { return expf(x); }
__device__ __forceinline__ float frcp(float x) { return 1.0f / x; }
__device__ __forceinline__ float frsq(float x) { return 1.0f / sqrtf(x); }
__device__ __forceinline__ float fexp2(float x) { return exp2f(x); }
__device__ __forceinline__ float flog(float x) { return logf(x); }
#else
__device__ __forceinline__ float fexp(float x) { return __builtin_amdgcn_exp2f(x * 1.4426950408889634f); }
__device__ __forceinline__ float frcp(float x) { return __builtin_amdgcn_rcpf(x); }
__device__ __forceinline__ float frsq(float x) { return __builtin_amdgcn_rsqf(x); }
__device__ __forceinline__ float fexp2(float x) { return __builtin_amdgcn_exp2f(x); }
__device__ __forceinline__ float flog(float x) { return __builtin_amdgcn_logf(x) * 0.6931471805599453f; }
#endif
__device__ __forceinline__ float sigmoidf_(float x) { return frcp(1.0f + fexp(-x)); }
__device__ __forceinline__ float siluf_(float x) { return x * frcp(1.0f + fexp(-x)); }
__device__ __forceinline__ float gelu_tanh(float x) { const float u = 0.7978845608028654f * (x + 0.044715f * x * x * x); return x * (1.0f - frcp(1.0f + fexp(2.0f * u))); }
#ifdef EMU
__device__ __forceinline__ float wave_sum(float v) {
#pragma unroll
    for (int o = 1; o < 64; o <<= 1) v += __shfl_xor(v, o);
    return v;
}
#else
__device__ __forceinline__ float wave_sum(float v) {
    v += __builtin_bit_cast(float, __builtin_amdgcn_update_dpp(0, __builtin_bit_cast(int, v), 0xB1, 0xF, 0xF, true));
    v += __builtin_bit_cast(float, __builtin_amdgcn_update_dpp(0, __builtin_bit_cast(int, v), 0x4E, 0xF, 0xF, true));
    v += __builtin_bit_cast(float, __builtin_amdgcn_update_dpp(0, __builtin_bit_cast(int, v), 0x141, 0xF, 0xF, true));
    v += __builtin_bit_cast(float, __builtin_amdgcn_update_dpp(0, __builtin_bit_cast(int, v), 0x140, 0xF, 0xF, true));
    const int iv = __builtin_bit_cast(int, v);
    return (__builtin_bit_cast(float, __builtin_amdgcn_readlane(iv, 0)) + __builtin_bit_cast(float, __builtin_amdgcn_readlane(iv, 16))) +
           (__builtin_bit_cast(float, __builtin_amdgcn_readlane(iv, 32)) + __builtin_bit_cast(float, __builtin_amdgcn_readlane(iv, 48)));
}
#endif
__device__ __forceinline__ void dsincos(double a, double& s, double& c) {
    const double k = __builtin_rint(a * 0.15915494309189535);
    const double r = __builtin_fma(-k, 6.283185307179586, a) - k * 2.4492935982947064e-16;
    const double r2 = r * r;
    double ps = 1.0 / 51090942171709440000.0;
    ps = ps * r2 - 1.0 / 121645100408832000.0; ps = ps * r2 + 1.0 / 355687428096000.0; ps = ps * r2 - 1.0 / 1307674368000.0; ps = ps * r2 + 1.0 / 6227020800.0;
    ps = ps * r2 - 1.0 / 39916800.0; ps = ps * r2 + 1.0 / 362880.0; ps = ps * r2 - 1.0 / 5040.0; ps = ps * r2 + 1.0 / 120.0; ps = ps * r2 - 1.0 / 6.0; ps = ps * r2 + 1.0;
    s = ps * r;
    double pc = -1.0 / 1124000727777607680000.0;
    pc = pc * r2 + 1.0 / 2432902008176640000.0; pc = pc * r2 - 1.0 / 6402373705728000.0; pc = pc * r2 + 1.0 / 20922789888000.0; pc = pc * r2 - 1.0 / 87178291200.0;
    pc = pc * r2 + 1.0 / 479001600.0; pc = pc * r2 - 1.0 / 3628800.0; pc = pc * r2 + 1.0 / 40320.0; pc = pc * r2 - 1.0 / 720.0; pc = pc * r2 + 1.0 / 24.0; pc = pc * r2 - 0.5; pc = pc * r2 + 1.0;
    c = pc;
}

#ifdef EMU
__device__ __forceinline__ unsigned ld_agent(const unsigned* p) { return __atomic_load_n(p, __ATOMIC_RELAXED); }
#else
__device__ __forceinline__ unsigned ld_agent(const unsigned* p) { return __hip_atomic_load(p, __ATOMIC_RELAXED, __HIP_MEMORY_SCOPE_AGENT); }
#endif
struct Args { const void* in[32]; float* out; unsigned char* ws; int ph_lo, ph_hi; };
struct Frame {
    lu8* lds; unsigned char* ws; float* out;
    int tid, lane, wave, G, bid, rep;
    const float* x; const int* pos;
    const LAS unsigned long long* ptab;
    __device__ __forceinline__ const float* inp(int i) const { const unsigned long long v = ptab[i];
        const unsigned lo = (unsigned)__builtin_amdgcn_readfirstlane((int)(unsigned)v), hi = (unsigned)__builtin_amdgcn_readfirstlane((int)(unsigned)(v >> 32));
#ifdef EMU
        return (const float*)(((unsigned long long)hi << 32) | lo); }
#else
        return (const float*)(const __attribute__((address_space(1))) float*)(((unsigned long long)hi << 32) | lo); }
#endif
};

#define norm1_g inp(2)
#define w_in inp(3)
#define w_out inp(4)
#define s5_a_re inp(5)
#define s5_a_im inp(6)
#define s5_log_dt inp(7)
#define s5_b_re inp(8)
#define s5_b_im inp(9)
#define s5_c_re inp(10)
#define s5_c_im inp(11)
#define s5_d inp(12)
#define s5_w_glu inp(13)
#define s5_b_glu inp(14)
#define m2_conv_w inp(15)
#define m2_conv_b inp(16)
#define m2_dt_bias inp(17)
#define m2_a_log inp(18)
#define m2_d inp(19)
#define m2_norm_g inp(20)
#define hg_lb_logits inp(21)
#define hg_norm_g inp(22)
#define norm2_g inp(23)
#define moe_w_group inp(24)
#define moe_b_group inp(25)
#define moe_w_expert inp(26)
#define moe_b_expert inp(27)
#define moe_w_gate inp(28)
#define moe_w_up inp(29)
#define moe_w_down inp(30)
#define final_norm_g inp(31)
#define WSP(T, off) ((T*)(F.ws + (off)))
#ifdef EMU
#define CFENCE() ((void)0)
#else
#define CFENCE() asm volatile("" ::: "memory")
#endif
#ifdef EMU
#define LAUNDER(F) ((void)0)
#define LAUNDER_I(x) ((void)0)
#else
#define LAUNDER(F) do { size_t z_ = 0; asm volatile("" : "+v"((F).tid), "+v"((F).lane), "+s"((F).wave), "+s"(z_)); (F).ws = (F).ws + z_; } while (0)
#define LAUNDER_I(x) asm volatile("" : "+v"(x))
#endif

#ifndef EMU
#define XB_TMO      128
#define XB_XCNT(j)  (256  + 64 * (j))
#define XB_XSUB(j)  (1280 + 64 * (j))
#define XB_XGEN(j)  (2304 + 64 * (j))
#define XB_TOP      3328
#define XB_TOPGEN   3392
#define XCD_BAR_WORDS 3456
#define XB_SPIN_CAP (1u << 20)
__device__ __forceinline__ unsigned xb_ld(unsigned* p)              { return __hip_atomic_load(p, __ATOMIC_RELAXED, __HIP_MEMORY_SCOPE_AGENT); }
__device__ __forceinline__ unsigned xb_add(unsigned* p, unsigned v) { return __hip_atomic_fetch_add(p, v, __ATOMIC_RELAXED, __HIP_MEMORY_SCOPE_AGENT); }
__device__ __forceinline__ unsigned xb_xcc_id() { return (unsigned)__builtin_amdgcn_s_getreg((3 << 11) | 20) & 0xFu; }
#define XB_SPIN(cond, bar) do { unsigned _sp = 0; while (cond) { __builtin_amdgcn_s_sleep(1); \
    if ((++_sp & 255u) == 0u) { if (xb_ld(&(bar)[XB_TMO])) break; if (_sp > XB_SPIN_CAP) { atomicAdd(&(bar)[XB_TMO], 1u); break; } } } } while (0)
struct XcdBarrier { unsigned* bar; unsigned x; volatile LAS unsigned* st; };
__device__ __forceinline__ XcdBarrier xcd_barrier_post(unsigned* bar, volatile LAS unsigned* st) {
    XcdBarrier b; b.bar = bar; b.x = xb_xcc_id(); b.st = st;
    if (threadIdx.x == 0) (void)xb_add(&bar[XB_XCNT(b.x)], 1u);
    return b;
}
__device__ __forceinline__ void xcd_barrier_complete(unsigned* bar, unsigned x, unsigned& nloc, unsigned& nx) {
    const unsigned G = gridDim.x * gridDim.y * gridDim.z;
    unsigned sum, cnt, mine, sp = 0u;
    for (;;) {
        sum = 0u; cnt = 0u; mine = 0u;
#pragma unroll
        for (unsigned j = 0; j < 16; ++j) { const unsigned c = xb_ld(&bar[XB_XCNT(j)]); sum += c; cnt += (c > 0u) ? 1u : 0u; mine = (j == x) ? c : mine; }
        if (sum == G) break;
        __builtin_amdgcn_s_sleep(1);
        if ((++sp & 255u) == 0u) { if (xb_ld(&bar[XB_TMO])) break; if (sp > XB_SPIN_CAP) { atomicAdd(&bar[XB_TMO], 1u); break; } }
    }
    nloc = mine > 0u ? mine : 1u; nx = cnt > 0u ? cnt : 1u;
}
__device__ __forceinline__ void xcd_barrier(const XcdBarrier& b) {
    asm volatile("s_waitcnt vmcnt(0)" ::: "memory");
    __syncthreads();
    if (threadIdx.x == 0) {
        unsigned* bar = b.bar;
        __builtin_amdgcn_s_waitcnt(0);
        unsigned nloc = b.st[0], nx = b.st[1];
        if (nloc == 0u) { xcd_barrier_complete(bar, b.x, nloc, nx); b.st[0] = nloc; b.st[1] = nx; }
        const unsigned old = xb_add(&bar[XB_XSUB(b.x)], 1u);
        const unsigned gen = old / nloc;
        if (old + 1u == (gen + 1u) * nloc) {
            __builtin_amdgcn_fence(__ATOMIC_RELEASE, "agent");
            asm volatile("s_waitcnt vmcnt(0)" ::: "memory");
            const unsigned og = xb_add(&bar[XB_TOP], 1u);
            const unsigned tg = og / nx;
            if (og + 1u == (tg + 1u) * nx) xb_add(&bar[XB_TOPGEN], 1u);
            else XB_SPIN(xb_ld(&bar[XB_TOPGEN]) == tg, bar);
            __builtin_amdgcn_fence(__ATOMIC_ACQUIRE, "agent");
            xb_add(&bar[XB_XGEN(b.x)], 1u);
            asm volatile("s_waitcnt vmcnt(0)" ::: "memory");
        } else {
            XB_SPIN(xb_ld(&bar[XB_XGEN(b.x)]) == gen, bar);
            __builtin_amdgcn_fence(__ATOMIC_ACQUIRE, "agent");
            asm volatile("s_waitcnt vmcnt(0)" ::: "memory");
        }
    }
    __syncthreads();
}
#endif

constexpr int GT_BK = 128, GT_LD = GT_BK + 8;
constexpr int GT_BYTES = 2 * 128 * GT_LD * 2;
template <class AP, class BP, class EPI>
__device__ __forceinline__ void gemm128(lu8* lds, int K, const AP& ap, const BP& bp, const EPI& epi) {
    int tid = threadIdx.x; LAUNDER_I(tid);
    const int lane = tid & 63, wid = tid >> 6, wr = wid >> 1, wc = wid & 1, fr = lane & 15, fq = lane >> 4;
    lbf* As = (lbf*)lds; lbf* Bs = (lbf*)(lds + 128 * GT_LD * 2);
    f32x4 acc[2][4];
#pragma unroll
    for (int m = 0; m < 2; ++m)
#pragma unroll
        for (int n = 0; n < 4; ++n) acc[m][n] = (f32x4){0.f, 0.f, 0.f, 0.f};
    u32x4 ra[2][4], rb[2][4];
    const int nk = K / GT_BK;
#define GT_LOAD(slot, k0) do { _Pragma("unroll") for (int i = 0; i < 4; ++i) { const int p = tid + 512 * i, r = p >> 4, kc = p & 15; ra[slot][i] = *(const u32x4*)ap(r, (k0) + kc * 8); rb[slot][i] = *(const u32x4*)bp(r, (k0) + kc * 8); } } while (0)
    GT_LOAD(0, 0);
    if (nk > 1) GT_LOAD(1, GT_BK);
    for (int kt = 0; kt < nk; kt += 2) {
#pragma unroll
        for (int half = 0; half < 2; ++half) {
            if (kt + half < nk) {
                __syncthreads();
#pragma unroll
                for (int i = 0; i < 4; ++i) { const int p = tid + 512 * i, r = p >> 4, kc = p & 15; *(LAS u32x4*)(As + r * GT_LD + kc * 8) = ra[half][i]; *(LAS u32x4*)(Bs + r * GT_LD + kc * 8) = rb[half][i]; }
                __syncthreads();
                if (kt + half + 2 < nk) GT_LOAD(half, (kt + half + 2) * GT_BK);
#pragma unroll
                for (int ks = 0; ks < 4; ++ks) {
                    bf16x8 a[2], b[4];
#pragma unroll
                    for (int m = 0; m < 2; ++m) a[m] = *(const LAS bf16x8*)(As + (wr * 32 + m * 16 + fr) * GT_LD + ks * 32 + fq * 8);
#pragma unroll
                    for (int n = 0; n < 4; ++n) b[n] = *(const LAS bf16x8*)(Bs + (wc * 64 + n * 16 + fr) * GT_LD + ks * 32 + fq * 8);
#pragma unroll
                    for (int m = 0; m < 2; ++m)
#pragma unroll
                        for (int n = 0; n < 4; ++n) acc[m][n] = __builtin_amdgcn_mfma_f32_16x16x32_bf16(b[n], a[m], acc[m][n], 0, 0, 0);
                }
            }
        }
    }
#undef GT_LOAD
#pragma unroll
    for (int m = 0; m < 2; ++m)
#pragma unroll
        for (int n = 0; n < 4; ++n) epi(wr * 32 + m * 16 + fr, wc * 64 + n * 16 + 4 * fq, acc[m][n]);
}
struct PtrRM { const bf16* base; size_t ld; int rmax;
    __device__ __forceinline__ const bf16* operator()(int r, int k) const { return base + (size_t)(r < rmax ? r : rmax) * ld + k; } };

template <int NT, int KS>
__device__ __forceinline__ void wave_mma(f32x4 (&acc)[NT], const lbf* A, int lda, const lbf* B, int ldb, int lane) {
    const int fr = lane & 15, fq = lane >> 4;
#pragma unroll
    for (int ks = 0; ks < KS; ++ks) {
        const bf16x8 a = *(const LAS bf16x8*)(A + fr * lda + ks * 32 + fq * 8);
#pragma unroll
        for (int n = 0; n < NT; ++n) { const bf16x8 b = *(const LAS bf16x8*)(B + (n * 16 + fr) * ldb + ks * 32 + fq * 8); acc[n] = __builtin_amdgcn_mfma_f32_16x16x32_bf16(b, a, acc[n], 0, 0, 0); }
    }
}


namespace g8 {
constexpr int BM = 256, BK = 64, HALF = 128, HTB = HALF * BK * 2, STAGE_BYTES = 8 * HTB;
__host__ __device__ __forceinline__ int lds_byte(int r, int c) { const int st = (r >> 4) * 2 + (c >> 5), rr = r & 15, cc = c & 31, ob = rr * 64 + cc * 2; return st * 1024 + (ob ^ (((ob >> 9) & 1) << 5)); }
__host__ __device__ __forceinline__ void stage_rc(int b, int& R, int& C) { const int st = b / 1024, sb = b % 1024, swz = sb ^ (((sb >> 9) & 1) << 5); R = (st >> 1) * 16 + swz / 64; C = (st & 1) * 32 + (swz % 64) / 2; }
__host__ __device__ __forceinline__ int perm32(int rho) { const int n = rho >> 4, i = rho & 15; return 8 * (i >> 2) + 4 * n + (i & 3); }
struct Unit { size_t aoff, boff; int pm, pn; };
#ifdef EMU
#define G8_WAIT_V(n) ((void)0)
#define G8_WAIT_L(n) ((void)0)
#else
#define G8_WAIT_V(n) asm volatile("s_waitcnt vmcnt(" #n ")" ::: "memory")
#define G8_WAIT_L(n) asm volatile("s_waitcnt lgkmcnt(" #n ")" ::: "memory")
#endif
template <class Epi, class Sched, bool ALIGN_EPI = true, bool SP2 = true>
__device__ __forceinline__ void gemm_phase(lu8* lds, const bf16* Abase, const bf16* Bbase, const int K, const Sched& S, const Epi& E) {
    const int tid = threadIdx.x, wid = __builtin_amdgcn_readfirstlane(tid >> 6), lane = tid & 63, wr = wid >> 2, wc = wid & 3, fr = lane & 15, fq = lane >> 4;
    const int nt = K / BK;
    unsigned voffA[2], voffB[2];
#pragma unroll
    for (int i = 0; i < 2; ++i) { int R, C; stage_rc(tid * 16 + i * 8192, R, C); const int Rb = Epi::PERM ? ((R & ~31) + perm32(R & 31)) : R;
        voffA[i] = (unsigned)(R * K + C) * 2u; voffB[i] = (unsigned)(Rb * K + C) * 2u; }
    const size_t kstep = (size_t)(BK * 2), hstep = (size_t)HALF * K * 2;
    const unsigned ldsw = (unsigned)wid * 1024u;
    const int aoff = lds_byte(wr * 64 + fr, fq * 8), boff = lds_byte(wc * 32 + fr, fq * 8);
#define G8_SA(b, h) (((b) * 2 + (h)) * HTB)
#define G8_SB(b, h) ((4 + (b) * 2 + (h)) * HTB)
#define G8_STAGE(bufoff, gbase, voff) do { _Pragma("unroll") for (int _i = 0; _i < 2; ++_i) \
        __builtin_amdgcn_global_load_lds((const unsigned*)((const char*)(gbase) + (voff)[_i]), (LAS unsigned*)(lds + (bufoff) + ldsw + _i * 8192), 16, 0, 0); } while (0)
#define G8_STAGEA(bufoff, gbase, voff) do { _Pragma("unroll") for (int _i = 0; _i < 2; ++_i) \
        __builtin_amdgcn_global_load_lds((const unsigned*)((const char*)(gbase) + (voff)[_i]), (LAS unsigned*)(lds + (bufoff) + ldsw + _i * 8192), 16, 0, Sched::A_AUX); } while (0)
#define G8_LDA(dst, b, h) do { _Pragma("unroll") for (int m = 0; m < 4; ++m) _Pragma("unroll") for (int k = 0; k < 2; ++k) dst[m][k] = *(const LAS bf16x8*)(lds + G8_SA(b, h) + aoff + m * 2048 + k * 1024); } while (0)
#define G8_LDB(dst, b, h) do { _Pragma("unroll") for (int n = 0; n < 2; ++n) _Pragma("unroll") for (int k = 0; k < 2; ++k) dst[n][k] = *(const LAS bf16x8*)(lds + G8_SB(b, h) + boff + n * 2048 + k * 1024); } while (0)
#define G8_MMA(ai, bj, At, Bt) do { __builtin_amdgcn_s_setprio(1); _Pragma("unroll") for (int m = 0; m < 4; ++m) _Pragma("unroll") for (int n = 0; n < 2; ++n) _Pragma("unroll") for (int k = 0; k < 2; ++k) \
        acc[ai][bj][m][n] = __builtin_amdgcn_mfma_f32_16x16x32_bf16(Bt[n][k], At[m][k], acc[ai][bj][m][n], 0, 0, 0); __builtin_amdgcn_s_setprio(0); } while (0)
#define G8_BAR __builtin_amdgcn_s_barrier()
#define G8_SCHED __builtin_amdgcn_sched_barrier(0)
    Unit cur, nxt; int ui = 0; int pend = -1;
    if (!S.next(0, cur)) return;
    f32x4 acc[2][2][4][2];
#pragma unroll
    for (int a = 0; a < 2; ++a)
#pragma unroll
        for (int b = 0; b < 2; ++b)
#pragma unroll
            for (int m = 0; m < 4; ++m)
#pragma unroll
                for (int n = 0; n < 2; ++n) acc[a][b][m][n] = (f32x4){0.f, 0.f, 0.f, 0.f};
    bf16x8 At[4][2], B0[2][2], B1[2][2];
    const char* cA = (const char*)Abase + cur.aoff; const char* cB = (const char*)Bbase + cur.boff;
    if constexpr (SP2) {
        G8_STAGE(G8_SB(0, 0), cB, voffB); G8_STAGE(G8_SB(0, 1), cB + hstep, voffB); G8_STAGEA(G8_SA(0, 0), cA, voffA); G8_STAGEA(G8_SA(0, 1), cA + hstep, voffA);
        if (wr == 1) G8_BAR;
        G8_WAIT_V(2); G8_BAR;
        G8_STAGE(G8_SB(1, 0), cB + kstep, voffB); G8_STAGEA(G8_SA(1, 0), cA + kstep, voffA); G8_STAGE(G8_SB(1, 1), cB + hstep + kstep, voffB);
        G8_WAIT_V(6); G8_BAR;
    } else {
        G8_STAGE(G8_SB(0, 0), cB, voffB); G8_STAGEA(G8_SA(0, 0), cA, voffA); G8_STAGE(G8_SB(0, 1), cB + hstep, voffB); G8_STAGEA(G8_SA(0, 1), cA + hstep, voffA);
        if (wr == 1) G8_BAR;
        G8_WAIT_V(4); G8_BAR;
        G8_STAGE(G8_SB(1, 0), cB + kstep, voffB); G8_STAGEA(G8_SA(1, 0), cA + kstep, voffA); G8_STAGE(G8_SB(1, 1), cB + hstep + kstep, voffB);
        G8_WAIT_V(6); G8_BAR;
    }
    for (;;) {
        const bool has_next = S.next(ui + 1, nxt);
        const char* nA = has_next ? (const char*)Abase + nxt.aoff : cA; const char* nB = has_next ? (const char*)Bbase + nxt.boff : cB;
        for (int t = 0; t < nt; t += 2) {
            const bool last = (t == nt - 2);
            if constexpr (Epi::DEFER_PUB) { if (t == 2 && pend >= 0) { E.publish(pend, lane == 0); pend = -1; } }
            const char* a1 = cA + (size_t)(t + 1) * kstep;
            const char* a2 = last ? nA : cA + (size_t)(t + 2) * kstep; const char* b2 = last ? nB : cB + (size_t)(t + 2) * kstep;
            const char* a3 = a2 + kstep; const char* b3 = b2 + kstep;
            if constexpr (SP2) {
            G8_LDB(B0, 0, 0); G8_LDB(B1, 0, 1); G8_SCHED; G8_LDA(At, 0, 0); G8_STAGEA(G8_SA(1, 1), a1 + hstep, voffA);
            G8_WAIT_V(8); G8_WAIT_L(0); G8_BAR; G8_MMA(0, 0, At, B0); G8_MMA(0, 1, At, B1); G8_BAR; G8_SCHED;
            G8_LDA(At, 0, 1); G8_STAGE(G8_SB(0, 0), b2, voffB); G8_STAGE(G8_SB(0, 1), b2 + hstep, voffB); G8_STAGEA(G8_SA(0, 0), a2, voffA);
            G8_WAIT_V(8); G8_WAIT_L(0); G8_BAR; G8_MMA(1, 0, At, B0); G8_MMA(1, 1, At, B1); G8_BAR; G8_SCHED;
            G8_LDB(B0, 1, 0); G8_LDB(B1, 1, 1); G8_SCHED; G8_LDA(At, 1, 0); G8_STAGEA(G8_SA(0, 1), a2 + hstep, voffA);
            G8_WAIT_V(8); G8_WAIT_L(0); G8_BAR; G8_MMA(0, 0, At, B0); G8_MMA(0, 1, At, B1); G8_BAR; G8_SCHED;
            G8_LDA(At, 1, 1); G8_STAGE(G8_SB(1, 0), b3, voffB); G8_STAGE(G8_SB(1, 1), b3 + hstep, voffB); G8_STAGEA(G8_SA(1, 0), a3, voffA);
            G8_WAIT_V(8); G8_WAIT_L(0); G8_BAR; G8_MMA(1, 0, At, B0); G8_MMA(1, 1, At, B1); G8_BAR; G8_SCHED;
            } else {
            G8_LDB(B0, 0, 0); G8_SCHED; G8_LDA(At, 0, 0); G8_STAGEA(G8_SA(1, 1), a1 + hstep, voffA);
            G8_WAIT_L(8); G8_BAR; G8_WAIT_L(0); G8_MMA(0, 0, At, B0); G8_BAR; G8_SCHED;
            G8_LDB(B1, 0, 1); G8_STAGE(G8_SB(0, 0), b2, voffB);
            G8_BAR; G8_WAIT_L(0); G8_MMA(0, 1, At, B1); G8_BAR;
            G8_LDA(At, 0, 1); G8_STAGEA(G8_SA(0, 0), a2, voffA);
            G8_BAR; G8_WAIT_L(0); G8_MMA(1, 0, At, B0); G8_BAR; G8_SCHED;
            G8_STAGE(G8_SB(0, 1), b2 + hstep, voffB);
            G8_WAIT_V(6); G8_BAR; G8_MMA(1, 1, At, B1); G8_BAR;
            G8_LDB(B0, 1, 0); G8_SCHED; G8_LDA(At, 1, 0); G8_STAGEA(G8_SA(0, 1), a2 + hstep, voffA);
            G8_WAIT_L(8); G8_BAR; G8_WAIT_L(0); G8_MMA(0, 0, At, B0); G8_BAR; G8_SCHED;
            G8_LDB(B1, 1, 1); G8_STAGE(G8_SB(1, 0), b3, voffB);
            G8_BAR; G8_WAIT_L(0); G8_MMA(0, 1, At, B1); G8_BAR;
            G8_LDA(At, 1, 1); G8_STAGEA(G8_SA(1, 0), a3, voffA);
            G8_BAR; G8_WAIT_L(0); G8_MMA(1, 0, At, B0); G8_BAR; G8_SCHED;
            G8_STAGE(G8_SB(1, 1), b3 + hstep, voffB);
            G8_WAIT_V(6); G8_BAR; G8_MMA(1, 1, At, B1); G8_BAR;
            }
        }
        if constexpr (ALIGN_EPI) { if (wr == 0) G8_BAR; }
        E(acc, cur, wr, wc, fr, fq);
        if constexpr (Epi::DEFER_PUB) pend = cur.pm;
        if (!has_next) break;
#pragma unroll
        for (int a = 0; a < 2; ++a)
#pragma unroll
            for (int b = 0; b < 2; ++b)
#pragma unroll
                for (int m = 0; m < 4; ++m)
#pragma unroll
                    for (int n = 0; n < 2; ++n) acc[a][b][m][n] = (f32x4){0.f, 0.f, 0.f, 0.f};
        cur = nxt; cA = nA; cB = nB; ++ui;
        if constexpr (ALIGN_EPI) { if (wr == 1) G8_BAR; }
    }
    G8_WAIT_V(0);
    if constexpr (Epi::DEFER_PUB) { if (pend >= 0) E.publish(pend, lane == 0); }
    if constexpr (!ALIGN_EPI) { if (wr == 0) G8_BAR; }
    G8_BAR;
#undef G8_SA
#undef G8_SB
#undef G8_STAGE
#undef G8_STAGEA
#undef G8_LDA
#undef G8_LDB
#undef G8_MMA
#undef G8_BAR
#undef G8_SCHED
}
struct GridOrder { static constexpr int A_AUX = 0; int nM, nN, nwg, G, c; size_t astep, bstep;
    __device__ __forceinline__ bool next(int i, Unit& u) const {
        const long Lx = (long)i * G + c; if (Lx >= nwg) return false;
        int wgid = (int)Lx; { const int q = nwg / 8, r = nwg % 8, xcd = wgid % 8, off = wgid / 8; wgid = (xcd < r ? xcd * (q + 1) : r * (q + 1) + (xcd - r) * q) + off; }
        const int nig = 8 * nN, gid = wgid / nig, fm = gid * 8, gsz = (nM - fm) < 8 ? (nM - fm) : 8;
        u.pm = fm + ((wgid % nig) % gsz); u.pn = (wgid % nig) / gsz; u.aoff = (size_t)u.pm * astep; u.boff = (size_t)u.pn * bstep; return true; } };
struct OneUnit { static constexpr int A_AUX = 0; int pm, pn; size_t astep, bstep;
    __device__ __forceinline__ bool next(int i, Unit& u) const { if (i != 0) return false; u.pm = pm; u.pn = pn; u.aoff = (size_t)pm * astep; u.boff = (size_t)pn * bstep; return true; } };
struct MoeOrder { static constexpr int A_AUX = 0; int np, G, c; const li32* pe; size_t astep, estep, bstep;
    __device__ __forceinline__ bool next(int i, Unit& u) const {
        int Lx = i * G + c; const int nwg = np * 4; if (Lx >= nwg) return false;
        { const int q = nwg / 8, r = nwg % 8, xcd = Lx % 8, off = Lx / 8; Lx = (xcd < r ? xcd * (q + 1) : r * (q + 1) + (xcd - r) * q) + off; }
        u.pm = Lx >> 2; u.pn = Lx & 3; u.aoff = (size_t)u.pm * astep; const int e = __builtin_amdgcn_readfirstlane(pe[u.pm]); u.boff = (size_t)e * estep + (size_t)u.pn * bstep; return true; } };
struct EpiStore {
    static constexpr bool PERM = true, DEFER_PUB = false;
    bf16* O; int ldc;
    __device__ __forceinline__ void operator()(const f32x4 (&acc)[2][2][4][2], const Unit& u, int wr, int wc, int fr, int fq) const {
        const int row0 = u.pm * BM + wr * 64 + fr, col0 = u.pn * BM + wc * 32 + 8 * fq;
#pragma unroll
        for (int ai = 0; ai < 2; ++ai)
#pragma unroll
            for (int m = 0; m < 4; ++m) { bf16* rowp = O + (size_t)(row0 + ai * HALF + m * 16) * ldc + col0;
#pragma unroll
                for (int bj = 0; bj < 2; ++bj) { const f32x4 v0 = acc[ai][bj][m][0], v1 = acc[ai][bj][m][1];
                    u32x4 w; w.x = pk2(v0.x, v0.y); w.y = pk2(v0.z, v0.w); w.z = pk2(v1.x, v1.y); w.w = pk2(v1.z, v1.w); *(u32x4*)(rowp + bj * HALF) = w; } }
    } };
template <bool XBF>
struct EpiResid {
    static constexpr bool PERM = true, DEFER_PUB = false;
    const void* xin; bf16* out;
    __device__ __forceinline__ void operator()(const f32x4 (&acc)[2][2][4][2], const Unit& u, int wr, int wc, int fr, int fq) const {
        const int row0 = u.pm * BM + wr * 64 + fr, col0 = u.pn * BM + wc * 32 + 8 * fq;
#pragma unroll
        for (int ai = 0; ai < 2; ++ai)
#pragma unroll
            for (int m = 0; m < 4; ++m) { const size_t ro = (size_t)(row0 + ai * HALF + m * 16) * D + col0;
#pragma unroll
                for (int bj = 0; bj < 2; ++bj) { const size_t o = ro + bj * HALF; f32x4 x0, x1;
                    if (XBF) { const u32x4 xb = *(const u32x4*)((const bf16*)xin + o); x0 = (f32x4){bflo(xb.x), bfhi(xb.x), bflo(xb.y), bfhi(xb.y)}; x1 = (f32x4){bflo(xb.z), bfhi(xb.z), bflo(xb.w), bfhi(xb.w)}; }
                    else { x0 = *(const f32x4*)((const float*)xin + o); x1 = *(const f32x4*)((const float*)xin + o + 4); }
                    const f32x4 v0 = x0 + acc[ai][bj][m][0], v1 = x1 + acc[ai][bj][m][1];
                    u32x4 w; w.x = pk2(v0.x, v0.y); w.y = pk2(v0.z, v0.w); w.z = pk2(v1.x, v1.y); w.w = pk2(v1.z, v1.w); *(u32x4*)(out + o) = w; } }
    } };
struct EpiStoreU {
    static constexpr bool PERM = true, DEFER_PUB = false;
    bf16* O; int ldc; bf16* ug;
    __device__ __forceinline__ void operator()(const f32x4 (&acc)[2][2][4][2], const Unit& u, int wr, int wc, int fr, int fq) const {
        const int row0 = u.pm * BM + wr * 64 + fr, col0 = u.pn * BM + wc * 32 + 8 * fq;
#pragma unroll
        for (int ai = 0; ai < 2; ++ai)
#pragma unroll
            for (int m = 0; m < 4; ++m) { const int t = row0 + ai * HALF + m * 16; bf16* rowp = O + (size_t)t * ldc + col0;
#pragma unroll
                for (int bj = 0; bj < 2; ++bj) { const f32x4 v0 = acc[ai][bj][m][0], v1 = acc[ai][bj][m][1];
                    u32x4 w; w.x = pk2(v0.x, v0.y); w.y = pk2(v0.z, v0.w); w.z = pk2(v1.x, v1.y); w.w = pk2(v1.z, v1.w); *(u32x4*)(rowp + bj * HALF) = w;
                    if (u.pn == 0) { const int g = 8 * bj + 2 * wc + (fq >> 1); *(u32x4*)(ug + ((size_t)g * NR5 + (t >> 5)) * 640 + (t & 31) * 16 + 8 * (fq & 1)) = w; } } }
    } };
template <class Q>
struct EpiQuad {
    static constexpr bool PERM = false, DEFER_PUB = false;
    Q q;
    __device__ __forceinline__ void operator()(const f32x4 (&acc)[2][2][4][2], const Unit& u, int wr, int wc, int fr, int fq) const {
#pragma unroll
        for (int ai = 0; ai < 2; ++ai)
#pragma unroll
            for (int m = 0; m < 4; ++m)
#pragma unroll
                for (int bj = 0; bj < 2; ++bj)
#pragma unroll
                    for (int n = 0; n < 2; ++n) q(u.pm * BM + ai * HALF + wr * 64 + m * 16 + fr, u.pn * BM + bj * HALF + wc * 32 + n * 16 + 4 * fq, acc[ai][bj][m][n]);
    } };
struct EpiGateUp {
    static constexpr bool PERM = true, DEFER_PUB = false;
    bf16* act; unsigned act_bytes; unsigned* cnt;
    __device__ __forceinline__ void operator()(const f32x4 (&acc)[2][2][4][2], const Unit& u, int wr, int wc, int fr, int fq) const {
        const int row0 = u.pm * BM + wr * 64 + fr, col0 = u.pn * HALF + wc * 32 + 8 * fq;
#ifndef EMU
        const __amdgpu_buffer_rsrc_t rs = __builtin_amdgcn_make_buffer_rsrc(act, 0, (int)act_bytes, 0x00020000);
#endif
#pragma unroll
        for (int ai = 0; ai < 2; ++ai)
#pragma unroll
            for (int m = 0; m < 4; ++m) { const f32x4 g0 = acc[ai][0][m][0], g1 = acc[ai][0][m][1], u0 = acc[ai][1][m][0], u1 = acc[ai][1][m][1];
                u32x4 w; w.x = pk2(siluf_(g0.x) * u0.x, siluf_(g0.y) * u0.y); w.y = pk2(siluf_(g0.z) * u0.z, siluf_(g0.w) * u0.w);
                w.z = pk2(siluf_(g1.x) * u1.x, siluf_(g1.y) * u1.y); w.w = pk2(siluf_(g1.z) * u1.z, siluf_(g1.w) * u1.w);
                const size_t o = (size_t)(row0 + ai * HALF + m * 16) * 512 + col0;
#ifdef EMU
                *(u32x4*)(act + o) = w;
#else
                __builtin_amdgcn_raw_buffer_store_b128(w, rs, (unsigned)(o * 2), 0, 16);
#endif
            }
        G8_WAIT_V(0); publish(u.pm, fr == 0 && fq == 0);
    }
    __device__ __forceinline__ void publish(int pm, bool leader) const { if (leader) atomicAdd(cnt + pm * 16, 1u); } };
struct MoeOrderDep { static constexpr int A_AUX = 16; int np, G, rank, n3; const li32* pe; size_t astep, estep, bstep; const unsigned* cnt; int wid;
    __device__ __forceinline__ bool next(int i, Unit& u) const {
        const int nwg = np * 4; int Lx;
        if (n3 >= 0) { if (i == 0) Lx = rank; else if (i == 1) { if (rank >= G - n3) return false; Lx = G + rank; } else if (i == 2) { if (rank >= 2 * n3) return false; Lx = 2 * G - n3 + rank; } else return false; }
        else Lx = i * G + rank;
        if (Lx >= nwg) return false;
        { const int q = nwg / 8, r = nwg % 8, xcd = Lx % 8, off = Lx / 8; Lx = (xcd < r ? xcd * (q + 1) : r * (q + 1) + (xcd - r) * q) + off; }
        u.pm = Lx >> 2; u.pn = Lx & 3; u.aoff = (size_t)u.pm * astep; const int e = __builtin_amdgcn_readfirstlane(pe[u.pm]); u.boff = (size_t)e * estep + (size_t)u.pn * bstep;
        if (wid == 0) { unsigned spins = 0; while (ld_agent(cnt + u.pm * 16) < 32u && ++spins < (1u << 22)) __builtin_amdgcn_s_sleep(1); }
        if (i == 0) __syncthreads();
        return true; } };
}

constexpr int CW_DEP = 196608;
constexpr int CW_Q = 131072;
__device__ __forceinline__ int grab_unit(Frame& F, unsigned* ctr) {
    li32* slot = (li32*)(F.lds + MISC_OFF + 128);
    __syncthreads();
    if (F.tid == 0) *slot = (int)atomicAdd(ctr, 1u);
    __syncthreads();
    return *slot;
}
__device__ __forceinline__ void transpose_item(const float* src, int ldsrc, int scol0, int k0, bf16* dst, int K, int drow0, const float* scale, int lane) {
    const int kq = lane >> 3, n2 = lane & 7;
    const float* sp = src + (size_t)(k0 + 8 * kq) * ldsrc + scol0 + 4 * n2;
    f32x4 v[8];
#pragma unroll
    for (int i = 0; i < 8; ++i) v[i] = *(const f32x4*)(sp + (size_t)i * ldsrc);
    if (scale) { const f32x4 s0 = *(const f32x4*)(scale + k0 + 8 * kq), s1 = *(const f32x4*)(scale + k0 + 8 * kq + 4);
        v[0] *= s0.x; v[1] *= s0.y; v[2] *= s0.z; v[3] *= s0.w; v[4] *= s1.x; v[5] *= s1.y; v[6] *= s1.z; v[7] *= s1.w; }
    bf16* dp = dst + (size_t)(drow0 + 4 * n2) * K + k0 + 8 * kq;
#pragma unroll
    for (int j = 0; j < 4; ++j) { u32x4 o; o.x = pk2(v[0][j], v[1][j]); o.y = pk2(v[2][j], v[3][j]); o.z = pk2(v[4][j], v[5][j]); o.w = pk2(v[6][j], v[7][j]);
        *(u32x4*)(dp + (size_t)j * K) = o; }
}
constexpr int CONV_GU_UNITS = 16 * 2 * 256 / 32, CONV_D_UNITS = 16 * 256 / 32;
template <int NI>
__device__ __forceinline__ void transpose_items(const float* src, int ldsrc, int scol0, int k0, bf16* dst, int K, int drow0, int lane) {
    const int kq = lane >> 3, n2 = lane & 7;
    const float* sp = src + (size_t)(k0 + 8 * kq) * ldsrc + scol0 + 4 * n2;
    f32x4 v[NI][8];
#pragma unroll
    for (int i = 0; i < 8; ++i)
#pragma unroll
        for (int q = 0; q < NI; ++q) v[q][i] = *(const f32x4*)(sp + (size_t)i * ldsrc + 32 * q);
    bf16* dp = dst + (size_t)(drow0 + 4 * n2) * K + k0 + 8 * kq;
#pragma unroll
    for (int q = 0; q < NI; ++q)
#pragma unroll
        for (int j = 0; j < 4; ++j) { u32x4 o; o.x = pk2(v[q][0][j], v[q][1][j]); o.y = pk2(v[q][2][j], v[q][3][j]); o.z = pk2(v[q][4][j], v[q][5][j]); o.w = pk2(v[q][6][j], v[q][7][j]);
            *(u32x4*)(dp + (size_t)(32 * q + j) * K) = o; }
}
__device__ __forceinline__ void conv_gu_unit(Frame& F0, int l, int cu) {
    Frame F = F0; LAUNDER(F);
    const int it0 = cu * 32 + F.wave * 4, e = it0 >> 9, up = (it0 >> 8) & 1, r = it0 & 255, kb = r >> 4, nb0 = r & 15;
    const float* src = (up ? F.moe_w_up : F.moe_w_gate) + ((size_t)l * 16 + e) * 1024 * 512;
    const int ff0 = 32 * nb0, drow0 = (ff0 >> 7) * 256 + up * 128;
    transpose_items<4>(src, 512, ff0, 64 * kb, WSP(bf16, WS_WGU) + (size_t)e * 1024 * 1024, 1024, drow0, F.lane);
}
__device__ __forceinline__ void conv_d_unit(Frame& F0, int l, int cu) {
    Frame F = F0; LAUNDER(F);
    const int it0 = cu * 32 + F.wave * 4, e = it0 >> 8, r = it0 & 255, kb = r >> 5, nb0 = r & 31;
    transpose_items<4>(F.moe_w_down + ((size_t)l * 16 + e) * 512 * 1024, 1024, 32 * nb0, 64 * kb, WSP(bf16, WS_WD) + (size_t)e * 1024 * 512, 512, 32 * nb0, F.lane);
}
__device__ __forceinline__ void r1_row(Frame& F, int t, int mode, const LAS f32x4* dw) {
    const int lane = F.lane;
    f32x4 v[4];
    if (mode == 0) { const f32x4* xr = (const f32x4*)(F.x + (size_t)t * D) + lane;
#pragma unroll
        for (int j = 0; j < 4; ++j) v[j] = xr[64 * j]; }
    else { const u32x2* xr = (const u32x2*)(WSP(bf16, WS_XRES) + (size_t)t * D) + lane;
#pragma unroll
        for (int j = 0; j < 4; ++j) { const u32x2 xb = xr[64 * j]; v[j] = (f32x4){bflo(xb.x), bfhi(xb.x), bflo(xb.y), bfhi(xb.y)}; } }
    if (mode != 0) {
        const int* rt = WSP(int, WS_ROUTE) + ((size_t)(mode == 2 ? L : 0) + t) * 8; const float* rtf = (const float*)rt;
        const bf16* ym = WSP(bf16, WS_H2G);
#pragma unroll
        for (int k = 0; k < 2; ++k) { const int slot = rt[6 + k]; const float w = rtf[4 + k];
            const u32x2* yr = (const u32x2*)(ym + (size_t)slot * 1024) + lane;
#pragma unroll
            for (int j = 0; j < 4; ++j) { const u32x2 y = yr[64 * j]; v[j].x += w * bflo(y.x); v[j].y += w * bfhi(y.x); v[j].z += w * bflo(y.y); v[j].w += w * bfhi(y.y); } }
    }
    float ss = 0.f;
#pragma unroll
    for (int j = 0; j < 4; ++j) ss += (v[j].x * v[j].x + v[j].y * v[j].y) + (v[j].z * v[j].z + v[j].w * v[j].w);
    const float rstd = frsq(wave_sum(ss) * (1.0f / D) + EPS);
    if (mode == 2) {
        f32x4* o = (f32x4*)(F.out + (size_t)t * D) + lane; const f32x4* g = (const f32x4*)F.final_norm_g + lane;
#pragma unroll
        for (int j = 0; j < 4; ++j) o[64 * j] = v[j] * rstd * g[64 * j];
        return;
    }
    if (mode == 1) { u32x2* o = (u32x2*)((bf16*)F.out + (size_t)t * D) + lane;
#pragma unroll
        for (int j = 0; j < 4; ++j) { u32x2 w; w.x = pk2(v[j].x, v[j].y); w.y = pk2(v[j].z, v[j].w); o[64 * j] = w; } }
    u32x2* hb = (u32x2*)(WSP(bf16, WS_ACT) + (size_t)t * D) + lane;
    f32x4 da = (f32x4){0.f, 0.f, 0.f, 0.f};
#pragma unroll
    for (int j = 0; j < 4; ++j) { const f32x4 h = v[j] * rstd; u32x2 w; w.x = pk2(h.x, h.y); w.y = pk2(h.z, h.w); hb[64 * j] = w;
        const int k = 4 * lane + 256 * j; da += h.x * dw[k] + h.y * dw[k + 1] + h.z * dw[k + 2] + h.w * dw[k + 3]; }
    da.x = wave_sum(da.x); da.y = wave_sum(da.y); da.z = wave_sum(da.z); da.w = wave_sum(da.w);
    if (lane == 0) *(f32x4*)(WSP(float, WS_DTRAW) + (size_t)t * 4) = da;
}

__device__ __forceinline__ void r1_phase(Frame& F, int mode, int l) {
    LAS f32x4* dw = (LAS f32x4*)F.lds;
    if (mode != 2) { for (int k = F.tid; k < 1024; k += NTHREADS) { const float g = F.norm1_g[l * 1024 + k]; dw[k] = g * *(const f32x4*)(F.w_in + ((size_t)l * 1024 + k) * DIN + 2304); } }
    __syncthreads();
    const int gw = F.bid * 8 + F.wave, ngw = F.G * 8;
    for (int t = gw; t < L; t += ngw) r1_row(F, t, mode, dw);
}

__device__ __forceinline__ void phase_p0(Frame& F) {
    const int gw = F.bid * 8 + F.wave, ngw = F.G * 8, gt = F.bid * NTHREADS + F.tid, ngt = F.G * NTHREADS;
    {
        constexpr int I_IN = (1024 / 64) * (NPROJ / 32), I_OUT = (1024 / 64) * (1024 / 32), I_GLU = (256 / 64) * (256 / 32);
        constexpr int NIT = 2 * (I_IN + I_OUT + I_GLU);
        for (int it = gw; it < NIT; it += ngw) {
            const int l = it / (I_IN + I_OUT + I_GLU); int r = it % (I_IN + I_OUT + I_GLU);
            if (r < I_IN) { const int kb = r / (NPROJ / 32), nb = r % (NPROJ / 32); const int n0 = 32 * nb, sc0 = n0 < 2304 ? n0 : n0 + 4;
                transpose_item(F.w_in + (size_t)l * 1024 * DIN, DIN, sc0, 64 * kb, WSP(bf16, WS_WIN) + (size_t)l * NPROJ * 1024, 1024, n0, F.norm1_g + l * 1024, F.lane); }
            else if (r < I_IN + I_OUT) { r -= I_IN; const int kb = r / 32, nb = r % 32;
                transpose_item(F.w_out + (size_t)l * 1024 * 1024, 1024, 32 * nb, 64 * kb, WSP(bf16, WS_WOUT) + (size_t)l * 1024 * 1024, 1024, 32 * nb, nullptr, F.lane); }
            else { r -= I_IN + I_OUT; const int kb = r / 8, nb = r % 8;
                transpose_item(F.s5_w_glu + (size_t)l * 65536, 256, 32 * nb, 64 * kb, WSP(bf16, WS_WGLU) + (size_t)l * 65536, 256, 32 * nb, nullptr, F.lane); }
        }
    }
    for (int i = gt; i < 256; i += ngt) {
        const float a = F.hg_lb_logits[i], b = F.hg_lb_logits[256 + i], m = fmaxf(a, b), ea = fexp(a - m), eb = fexp(b - m);
        WSP(float, WS_LB)[i] = 0.f; WSP(float, WS_LB)[256 + i] = eb / (ea + eb); }
    for (int i = gt; i < L * 32; i += ngt) { const int t = i >> 5, j = i & 31;
        const float inv = powf(10000.0f, -(float)j / 32.0f); const float ang = (float)F.pos[t] * inv; double s, c; dsincos((double)ang, s, c);
        *(f32x2*)(WSP(float, WS_ROPE) + (size_t)i * 2) = (f32x2){(float)c, (float)s}; }
    for (int i = gt; i < 2 * 16 * 64 * 34; i += ngt) { const int e = i / 34, d = i % 34, l = e >> 10, g = (e >> 6) & 15;
        const double dt = exp((double)F.s5_log_dt[l * 16 + g]); const double are = fmin((double)F.s5_a_re[e], -1e-4), aim = (double)F.s5_a_im[e];
        const double mag = exp(are * dt * d); double sn, cs; dsincos(aim * dt * d, sn, cs);
        *(f32x2*)(WSP(float, WS_S5AP) + (size_t)e * 68 + 2 * d) = (f32x2){(float)(mag * cs), (float)(mag * sn)}; }
    for (int i = gt; i < 2 * 16 * 64; i += ngt) {
        const int l = i >> 10, g = (i >> 6) & 15;
        const double dt = exp((double)F.s5_log_dt[l * 16 + g]); const double are = fmin((double)F.s5_a_re[i], -1e-4), aim = (double)F.s5_a_im[i];
        const double mag = exp(are * dt); double sn, cs; dsincos(aim * dt, sn, cs); const double abr = mag * cs, abi = mag * sn;
        const double den = are * are + aim * aim;
        const double kre = ((abr - 1.0) * are + abi * aim) / den, kim = (abi * are - (abr - 1.0) * aim) / den;
        float* bb = WSP(float, WS_S5BB) + (size_t)i * 32;
        for (int q = 0; q < 16; ++q) { const double br = F.s5_b_re[(size_t)i * 16 + q], bi = F.s5_b_im[(size_t)i * 16 + q]; bb[2 * q] = (float)(kre * br - kim * bi); bb[2 * q + 1] = (float)(kre * bi + kim * br); }
    }
    __syncthreads();
    r1_phase(F, 0, 0);
}

__device__ __forceinline__ void s5_prep_a(Frame& F, int l, int chunk, int nchunk) {
    const float* AP = WSP(float, WS_S5AP) + (size_t)l * 16 * 64 * 68; const float* BB = WSP(float, WS_S5BB) + (size_t)l * 16 * 64 * 32;
    constexpr int N1 = 16 * 32 * 256, N2 = 16 * 128 * 512;
    if (nchunk == 256 && NTHREADS == 512) {
        const int lo = chunk * 512, g = lo >> 13, d0 = (lo >> 8) & 31;
        LAS f32x2* Cs = (LAS f32x2*)F.lds; LAS f32x2* Bs = Cs + 16 * 65; LAS f32x2* As = Bs + 1024;
        __syncthreads();
#pragma unroll
        for (int k = 0; k < 2; ++k) { const int idx = F.tid + 512 * k; const size_t ci = ((size_t)l * 16 + g) * 1024 + idx;
            Cs[(idx >> 6) * 65 + (idx & 63)] = (f32x2){F.s5_c_re[ci], F.s5_c_im[ci]}; Bs[idx] = *(const f32x2*)(BB + (size_t)g * 64 * 32 + 2 * idx); }
        if (F.tid < 128) As[F.tid] = *(const f32x2*)(AP + ((size_t)g * 64 + (F.tid & 63)) * 68 + 2 * (d0 + (F.tid >> 6)));
        __syncthreads();
        { const int i = lo + F.tid, dd = (F.tid >> 8) & 1, p = (F.tid >> 4) & 15, q = F.tid & 15; float s = 0.f;
#pragma unroll 8
          for (int n = 0; n < 64; ++n) { const f32x2 a = As[dd * 64 + n], b = Bs[n * 16 + q], c = Cs[p * 65 + n];
              const float tr = a.x * b.x - a.y * b.y, ti = a.x * b.y + a.y * b.x; s += c.x * tr - c.y * ti; }
          WSP(float, WS_S5KT)[i] = s; }
        __syncthreads();
    } else
    { const int per = (N1 + nchunk - 1) / nchunk, lo = chunk * per, hi = lo + per < N1 ? lo + per : N1;
      for (int i = lo + F.tid; i < hi; i += NTHREADS) { const int g = i >> 13, d = (i >> 8) & 31, p = (i >> 4) & 15, q = i & 15;
        float s = 0.f;
        for (int n = 0; n < 64; ++n) { const size_t gn = (size_t)g * 64 + n; const float cr = F.s5_c_re[((size_t)l * 16 + g) * 1024 + p * 64 + n], ci = F.s5_c_im[((size_t)l * 16 + g) * 1024 + p * 64 + n];
            const float ar = AP[gn * 68 + 2 * d], ai = AP[gn * 68 + 2 * d + 1], br = BB[gn * 32 + 2 * q], bi = BB[gn * 32 + 2 * q + 1];
            const float tr = ar * br - ai * bi, ti = ar * bi + ai * br; s += cr * tr - ci * ti; }
        WSP(float, WS_S5KT)[i] = s; } }
    if (nchunk == 256 && NTHREADS == 512) {
        const int i0 = chunk * 4096 + 8 * F.tid, g = i0 >> 16, m = (i0 >> 9) & 127, k0 = i0 & 511, n = m >> 1, j = k0 >> 4, q0 = k0 & 15; const size_t gn = (size_t)g * 64 + n;
        const f32x2 a = *(const f32x2*)(AP + gn * 68 + 2 * (31 - j)); const f32x4* bp = (const f32x4*)(BB + gn * 32 + 2 * q0);
        const f32x4 b0 = bp[0], b1 = bp[1], b2 = bp[2], b3 = bp[3]; const bool im = m & 1;
#define BINC_V(br, bi) (im ? (a.x * (bi) + a.y * (br)) : (a.x * (br) - a.y * (bi)))
        u32x4 o; o.x = pk2(BINC_V(b0.x, b0.y), BINC_V(b0.z, b0.w)); o.y = pk2(BINC_V(b1.x, b1.y), BINC_V(b1.z, b1.w)); o.z = pk2(BINC_V(b2.x, b2.y), BINC_V(b2.z, b2.w)); o.w = pk2(BINC_V(b3.x, b3.y), BINC_V(b3.z, b3.w));
#undef BINC_V
        *(u32x4*)(WSP(bf16, WS_S5BI) + i0) = o;
    } else
    { const int per = (N2 + nchunk - 1) / nchunk, lo = chunk * per, hi = lo + per < N2 ? lo + per : N2;
      for (int i = lo + F.tid; i < hi; i += NTHREADS) { const int g = i >> 16, m = (i >> 9) & 127, k = i & 511, n = m >> 1, j = k >> 4, q = k & 15; const size_t gn = (size_t)g * 64 + n;
        const float ar = AP[gn * 68 + 2 * (31 - j)], ai = AP[gn * 68 + 2 * (31 - j) + 1], br = BB[gn * 32 + 2 * q], bi = BB[gn * 32 + 2 * q + 1];
        WSP(bf16, WS_S5BI)[i] = (bf16)f2bf((m & 1) ? (ar * bi + ai * br) : (ar * br - ai * bi)); } }
}
__device__ __forceinline__ void s5_prep_b(Frame& F, int l, int chunk, int nchunk) {
    const float* AP = WSP(float, WS_S5AP) + (size_t)l * 16 * 64 * 68; const float* KT = WSP(float, WS_S5KT);
    constexpr int N = 16 * 512 * 640; const int per = (N + nchunk - 1) / nchunk, lo = chunk * per, hi = lo + per < N ? lo + per : N;
    if (nchunk == 256 && NTHREADS == 512) {
#pragma unroll 1
        for (int it = 0; it < 5; ++it) { const int i0 = chunk * 20480 + 8 * (F.tid + 512 * it);
            const int g = i0 / (512 * 640), r = i0 % (512 * 640), np = r / 640, k0 = r % 640, tl = np >> 4, p = np & 15;
            u32x4 o = (u32x4){0u, 0u, 0u, 0u};
            if (k0 < 512) { const int j = k0 >> 4, q0 = k0 & 15;
                if (tl >= j) { const f32x4* kp = (const f32x4*)(KT + (((size_t)g * 32 + (tl - j)) * 16 + p) * 16 + q0); const f32x4 x0 = kp[0], x1 = kp[1];
                    o.x = pk2(x0.x, x0.y); o.y = pk2(x0.z, x0.w); o.z = pk2(x1.x, x1.y); o.w = pk2(x1.z, x1.w); } }
            else { const int n0 = (k0 - 512) >> 1; const size_t cb = ((size_t)l * 16 + g) * 1024 + p * 64 + n0;
                const f32x4 cr = *(const f32x4*)(F.s5_c_re + cb), ci = *(const f32x4*)(F.s5_c_im + cb); const float* ap = AP + ((size_t)g * 64 + n0) * 68 + 2 * (tl + 1);
                const f32x2 a0 = *(const f32x2*)ap, a1 = *(const f32x2*)(ap + 68), a2 = *(const f32x2*)(ap + 136), a3 = *(const f32x2*)(ap + 204);
                o.x = pk2(cr.x * a0.x - ci.x * a0.y, -(cr.x * a0.y + ci.x * a0.x)); o.y = pk2(cr.y * a1.x - ci.y * a1.y, -(cr.y * a1.y + ci.y * a1.x));
                o.z = pk2(cr.z * a2.x - ci.z * a2.y, -(cr.z * a2.y + ci.z * a2.x)); o.w = pk2(cr.w * a3.x - ci.w * a3.y, -(cr.w * a3.y + ci.w * a3.x)); }
            *(u32x4*)(WSP(bf16, WS_S5MT) + i0) = o; }
        return;
    }
    for (int i = lo + F.tid; i < hi; i += NTHREADS) { const int g = i / (512 * 640), r = i % (512 * 640), np = r / 640, k = r % 640, tl = np >> 4, p = np & 15;
        float v;
        if (k < 512) { const int j = k >> 4, q = k & 15; v = tl >= j ? KT[(((size_t)g * 32 + (tl - j)) * 16 + p) * 16 + q] : 0.f; }
        else { const int n = (k - 512) >> 1; const size_t gn = (size_t)g * 64 + n; const float cr = F.s5_c_re[((size_t)l * 16 + g) * 1024 + p * 64 + n], ci = F.s5_c_im[((size_t)l * 16 + g) * 1024 + p * 64 + n];
            const float ar = AP[gn * 68 + 2 * (tl + 1)], ai = AP[gn * 68 + 2 * (tl + 1) + 1]; v = (k & 1) ? -(cr * ai + ci * ar) : (cr * ar - ci * ai); }
        WSP(bf16, WS_S5MT)[i] = (bf16)f2bf(v); }
}

struct EpiBf16Store { bf16* O; size_t ld; int r0, c0;
    __device__ __forceinline__ void operator()(int r, int c, f32x4 v) const { u32x2 w; w.x = pk2(v.x, v.y); w.y = pk2(v.z, v.w); *(u32x2*)(O + (size_t)(r0 + r) * ld + c0 + c) = w; } };
__device__ __forceinline__ void phase_g1(Frame& F, int l) {
    g8::GridOrder S{L / 256, NPROJ / 256 - 1, (L / 256) * (NPROJ / 256 - 1), F.G, F.bid, (size_t)256 * 1024 * 2, (size_t)256 * 1024 * 2};
    g8::EpiStoreU E{WSP(bf16, WS_BIG), NPROJ, WSP(bf16, WS_S5UG)};
    g8::gemm_phase(F.lds, WSP(bf16, WS_ACT), WSP(bf16, WS_WIN) + (size_t)l * NPROJ * 1024, 1024, S, E);
    if (l == 0) { unsigned* ctr = WSP(unsigned, WS_CTL) + CW_Q + 64 * 4 + 32 * F.rep;
      for (int u = grab_unit(F, ctr); u < 256; u = grab_unit(F, ctr)) s5_prep_a(F, 0, u, 256); }
}

constexpr int LD64 = 72, LD128 = 136;
template <bool HAS_DST, bool HAS_DSTT>
__device__ __forceinline__ void stage_rot(Frame& F, const bf16* proj, int t0, int col0, float scale, lbf* dst  , lbf* dstT  , const lf32* tscale  ) {
    const int t = F.tid >> 2, ib = (F.tid & 3) * 8;
    const bf16* row = proj + (size_t)(t0 + t) * NPROJ + col0;
    const u32x4 a = *(const u32x4*)(row + ib), b = *(const u32x4*)(row + 32 + ib);
    const f32x4* cs4 = (const f32x4*)(WSP(float, WS_ROPE) + ((size_t)(t0 + t) * 32 + ib) * 2);
    const f32x4 r0 = cs4[0], r1 = cs4[1], r2 = cs4[2], r3 = cs4[3];
    const float cs[16] = {r0.x, r0.y, r0.z, r0.w, r1.x, r1.y, r1.z, r1.w, r2.x, r2.y, r2.z, r2.w, r3.x, r3.y, r3.z, r3.w};
    float o1[8], o2[8];
    const unsigned aw[4] = {a.x, a.y, a.z, a.w}, bw[4] = {b.x, b.y, b.z, b.w};
#pragma unroll
    for (int j = 0; j < 8; ++j) { const float q1 = (j & 1) ? bfhi(aw[j >> 1]) : bflo(aw[j >> 1]), q2 = (j & 1) ? bfhi(bw[j >> 1]) : bflo(bw[j >> 1]); const float c = cs[2 * j], s = cs[2 * j + 1];
        o1[j] = (q1 * c - q2 * s) * scale; o2[j] = (q2 * c + q1 * s) * scale;
        }
    if (HAS_DST) { u32x4 w1, w2; w1.x = pk2(o1[0], o1[1]); w1.y = pk2(o1[2], o1[3]); w1.z = pk2(o1[4], o1[5]); w1.w = pk2(o1[6], o1[7]); w2.x = pk2(o2[0], o2[1]); w2.y = pk2(o2[2], o2[3]); w2.z = pk2(o2[4], o2[5]); w2.w = pk2(o2[6], o2[7]);
        *(LAS u32x4*)(dst + t * LD64 + ib) = w1; *(LAS u32x4*)(dst + t * LD64 + 32 + ib) = w2; }
    if (HAS_DSTT) { const float ts = tscale[t];
#pragma unroll
        for (int j = 0; j < 8; ++j) { dstT[(ib + j) * LD128 + t] = (bf16)f2bf(o1[j] * ts); dstT[(32 + ib + j) * LD128 + t] = (bf16)f2bf(o2[j] * ts); } }
}
__device__ __forceinline__ void stage_T64(Frame& F, const bf16* proj, int t0, int col0, lbf* dstT) {
#pragma unroll
    for (int i = 0; i < 2; ++i) { const int p = F.tid + 512 * i, s = p >> 3, eb = (p & 7) * 8;
        const u32x4 a = *(const u32x4*)(proj + (size_t)(t0 + s) * NPROJ + col0 + eb); const unsigned aw[4] = {a.x, a.y, a.z, a.w};
#pragma unroll
        for (int j = 0; j < 8; ++j) dstT[(eb + j) * LD128 + s] = (bf16)((j & 1) ? (aw[j >> 1] >> 16) : (aw[j >> 1] & 0xffffu)); }
}

__device__ __forceinline__ float ret_log2gamma(int h) { return log2f(1.0f - exp2f(-5.0f - (float)h)); }
__device__ __forceinline__ void ret_state_unit(Frame& F0, int c, int h) {
    Frame F = F0; LAUNDER(F);
    lbf* VT = (lbf*)F.lds; lbf* KT = VT + 64 * LD128; lf32* zeta = (lf32*)(KT + 64 * LD128);
    const bf16* proj = WSP(bf16, WS_BIG); const int t0 = c * CH; const float lg = ret_log2gamma(h);
    __syncthreads();
    if (F.tid < 128) zeta[F.tid] = fexp2((float)(CH - 1 - F.tid) * lg);
    __syncthreads();
    stage_T64(F, proj, t0, C_RV + h * 64, VT);
    stage_rot<false, true>(F, proj, t0, C_RK + h * 64, 0.125f, KT, KT, zeta);
    __syncthreads();
    f32x4 acc[2] = {(f32x4){0, 0, 0, 0}, (f32x4){0, 0, 0, 0}};
    const int w = F.wave;
    wave_mma<2, 4>(acc, VT + 16 * (w >> 1) * LD128, LD128, KT + 32 * (w & 1) * LD128, LD128, F.lane);
    float* st = WSP(float, WS_ST_RET) + ((size_t)c * 4 + h) * 4096;
    const int e = 16 * (w >> 1) + (F.lane & 15);
#pragma unroll
    for (int n = 0; n < 2; ++n) *(f32x4*)(st + e * 64 + 32 * (w & 1) + 16 * n + 4 * (F.lane >> 4)) = acc[n];
}
__device__ __forceinline__ void ret_out_unit(Frame& F0, int c, int h) {
    Frame F = F0; LAUNDER(F);
    lbf* Q = (lbf*)F.lds; lbf* K = Q + 128 * LD64; lbf* VT = K + 128 * LD64; lbf* RT = VT + 64 * LD128; lbf* P = RT + 64 * LD64;
    const bf16* proj = WSP(bf16, WS_BIG); const int t0 = c * CH; const float lg = ret_log2gamma(h);
    const int w = F.wave, lane = F.lane, fr = lane & 15, fq = lane >> 4;
    __syncthreads();
    stage_rot<true, false>(F, proj, t0, C_RQ + h * 64, 1.0f, Q, Q, (const lf32*)Q);
    stage_rot<true, false>(F, proj, t0, C_RK + h * 64, 0.125f, K, K, (const lf32*)K);
    stage_T64(F, proj, t0, C_RV + h * 64, VT);
    { const float* st = WSP(float, WS_ST_RET) + ((size_t)c * 4 + h) * 4096 + F.tid * 8; const f32x4 a = *(const f32x4*)st, b = *(const f32x4*)(st + 4);
      u32x4 o; o.x = pk2(a.x, a.y); o.y = pk2(a.z, a.w); o.z = pk2(b.x, b.y); o.w = pk2(b.z, b.w); *(LAS u32x4*)(RT + (F.tid >> 3) * LD64 + (F.tid & 7) * 8) = o; }
    __syncthreads();
    f32x4 sc[8];
#pragma unroll
    for (int n = 0; n < 8; ++n) sc[n] = (f32x4){0, 0, 0, 0};
    wave_mma<8, 2>(sc, Q + 16 * w * LD64, LD64, K, LD64, lane);
    lbf* Pw = P + w * 16 * LD128;
    const int tl = 16 * w + fr;
#pragma unroll
    for (int n = 0; n < 8; ++n) { float pv[4];
#pragma unroll
        for (int j = 0; j < 4; ++j) { const int s = 16 * n + 4 * fq + j; pv[j] = (s <= tl) ? sc[n][j] * fexp2((float)(tl - s) * lg) : 0.f; }
        u32x2 o; o.x = pk2(pv[0], pv[1]); o.y = pk2(pv[2], pv[3]); *(LAS u32x2*)(Pw + fr * LD128 + 16 * n + 4 * fq) = o; }
    __syncthreads();
    f32x4 oi[4], ox[4];
#pragma unroll
    for (int n = 0; n < 4; ++n) { oi[n] = (f32x4){0, 0, 0, 0}; ox[n] = (f32x4){0, 0, 0, 0}; }
    wave_mma<4, 4>(oi, Pw, LD128, VT, LD128, lane);
    wave_mma<4, 2>(ox, Q + 16 * w * LD64, LD64, RT, LD64, lane);
    const float xi = fexp2((float)(tl + 1) * lg);
    float s1 = 0.f;
#pragma unroll
    for (int n = 0; n < 4; ++n) {
        oi[n] = oi[n] + xi * ox[n];
        s1 += (oi[n].x + oi[n].y) + (oi[n].z + oi[n].w); }
    s1 += __shfl_xor(s1, 16); s1 += __shfl_xor(s1, 32);
    const float mean = s1 * (1.0f / 64.0f); float s2 = 0.f;
#pragma unroll
    for (int n = 0; n < 4; ++n) { oi[n] = oi[n] - mean; s2 += (oi[n].x * oi[n].x + oi[n].y * oi[n].y) + (oi[n].z * oi[n].z + oi[n].w * oi[n].w); }
    s2 += __shfl_xor(s2, 16); s2 += __shfl_xor(s2, 32);
    const float rstd = frsq(s2 * (1.0f / 64.0f) + EPS);
    const int t = t0 + tl; bf16* y = WSP(bf16, WS_ACT) + (size_t)t * 1024 + Y_RET + h * 64;
    const bf16* gp = proj + (size_t)t * NPROJ + C_RG + h * 64;
#pragma unroll
    for (int n = 0; n < 4; ++n) { const int e = 16 * n + 4 * fq; const u32x2 g = *(const u32x2*)(gp + e);
        const f32x4 v = oi[n] * rstd; u32x2 o; o.x = pk2(v.x * siluf_(bflo(g.x)), v.y * siluf_(bfhi(g.x))); o.y = pk2(v.z * siluf_(bflo(g.y)), v.w * siluf_(bfhi(g.y))); *(u32x2*)(y + e) = o; }
}

__device__ __forceinline__ void m2_conv8(Frame& F, int l, const bf16* proj, int t, int cc  , float (&o)[8]) {
    const float* cw = F.m2_conv_w + (size_t)l * 4 * 768 + cc; const float* cb = F.m2_conv_b + (size_t)l * 768 + cc;
#pragma unroll
    for (int j = 0; j < 8; ++j) o[j] = cb[j];
#pragma unroll
    for (int q = 0; q < 4; ++q) { const int ts = t - 3 + q; if (ts >= 0) { const u32x4 a = *(const u32x4*)(proj + (size_t)ts * NPROJ + C_MX + cc); const unsigned aw[4] = {a.x, a.y, a.z, a.w};
#pragma unroll
        for (int j = 0; j < 8; ++j) o[j] += cw[q * 768 + j] * ((j & 1) ? bfhi(aw[j >> 1]) : bflo(aw[j >> 1])); } }
#pragma unroll
    for (int j = 0; j < 8; ++j) o[j] = siluf_(o[j]);
}
__device__ __forceinline__ void m2_dt_acum(Frame& F, int l, int c, lf32* dts, lf32* acs) {
    const int h = F.tid >> 7, t = F.tid & 127, lane = F.lane; const float x = WSP(float, WS_DTRAW)[(size_t)(c * CH + t) * 4 + h] + F.m2_dt_bias[l * 4 + h];
    const float dt = x > 20.f ? x : log1pf(fexp(x)); dts[h * 128 + t] = dt;
    float a = -fexp(F.m2_a_log[l * 4 + h]) * dt;
#pragma unroll
    for (int off = 1; off < 64; off <<= 1) { const float o = __shfl(a, lane - off); if (lane >= off) a += o; }
    acs[h * 128 + t] = a;
    __syncthreads();
    if (t >= 64) acs[h * 128 + t] = a + acs[h * 128 + 63];
    __syncthreads();
}
__device__ __forceinline__ void m2_state_unit(Frame& F0, int l, int c, int g) {
    Frame F = F0; LAUNDER(F);
    lbf* XT = (lbf*)F.lds; lbf* BT = XT + 64 * LD128; lf32* dts = (lf32*)(BT + 128 * LD128); lf32* acs = dts + 512;
    const bf16* proj = WSP(bf16, WS_BIG); bf16* xbc = XBC_PTR(F); const int t0 = c * CH;
    __syncthreads();
    m2_dt_acum(F, l, c, dts, acs);
#pragma unroll 1
    for (int i = 0; i < 4; ++i) { const int p = F.tid + 512 * i, s = p >> 4, nb = (p & 15) * 8; float o[8];
        m2_conv8(F, l, proj, t0 + s, 256 + g * 128 + nb, o);
        u32x4 wv; wv.x = pk2(o[0], o[1]); wv.y = pk2(o[2], o[3]); wv.z = pk2(o[4], o[5]); wv.w = pk2(o[6], o[7]); *(u32x4*)(xbc + (size_t)(t0 + s) * 768 + 256 + g * 128 + nb) = wv;
#pragma unroll
        for (int j = 0; j < 8; ++j) BT[(nb + j) * LD128 + s] = (bf16)f2bf(o[j]);
        m2_conv8(F, l, proj, t0 + s, 512 + g * 128 + nb, o);
        wv.x = pk2(o[0], o[1]); wv.y = pk2(o[2], o[3]); wv.z = pk2(o[4], o[5]); wv.w = pk2(o[6], o[7]); *(u32x4*)(xbc + (size_t)(t0 + s) * 768 + 512 + g * 128 + nb) = wv; }
#pragma unroll 1
    for (int hh = 0; hh < 2; ++hh) { const int h = 2 * g + hh;
        const float alast = acs[h * 128 + 127];
#pragma unroll 1
        for (int i = 0; i < 2; ++i) { const int p = F.tid + 512 * i, s = p >> 3, eb = (p & 7) * 8; float o[8]; m2_conv8(F, l, proj, t0 + s, h * 64 + eb, o);
            u32x4 wv; wv.x = pk2(o[0], o[1]); wv.y = pk2(o[2], o[3]); wv.z = pk2(o[4], o[5]); wv.w = pk2(o[6], o[7]); *(u32x4*)(xbc + (size_t)(t0 + s) * 768 + h * 64 + eb) = wv;
            const float sc = dts[h * 128 + s] * fexp(alast - acs[h * 128 + s]);
#pragma unroll
            for (int j = 0; j < 8; ++j) XT[(eb + j) * LD128 + s] = (bf16)f2bf(o[j] * sc); }
        __syncthreads();
        f32x4 acc[4];
#pragma unroll
        for (int n = 0; n < 4; ++n) acc[n] = (f32x4){0, 0, 0, 0};
        const int w = F.wave;
        wave_mma<4, 4>(acc, XT + 16 * (w >> 1) * LD128, LD128, BT + 64 * (w & 1) * LD128, LD128, F.lane);
        float* st = WSP(float, WS_ST_M2) + ((size_t)c * 4 + h) * 8192; const int pr = 16 * (w >> 1) + (F.lane & 15);
#pragma unroll
        for (int n = 0; n < 4; ++n) *(f32x4*)(st + pr * 128 + 64 * (w & 1) + 16 * n + 4 * (F.lane >> 4)) = acc[n];
        if (F.tid == 0) WSP(float, WS_DEC_M2)[c * 4 + h] = fexp(alast);
        __syncthreads();
    }
}
__device__ __forceinline__ void m2_out_unit(Frame& F0, int l, int c) {
    Frame F = F0; LAUNDER(F);
    lbf* Cm = (lbf*)F.lds; lbf* Bm = Cm + 128 * LD128; lbf* XT = Bm + 128 * LD128; lbf* ST = XT + 64 * LD128; lf32* dts = (lf32*)(ST + 64 * LD128); lf32* acs = dts + 512;
    lbf* P = Bm;
    const bf16* proj = WSP(bf16, WS_BIG); const bf16* xbc = XBC_PTR(F); const int t0 = c * CH;
    const int w = F.wave, lane = F.lane, fr = lane & 15, fq = lane >> 4, tl = 16 * w + fr;
    u32x4 rC[4], rB[4], rX[2]; f32x4 rSa[2], rSb[2];
#define M2O_LD_CB(g_) do { _Pragma("unroll") for (int i = 0; i < 4; ++i) { const int p = F.tid + 512 * i, s = p >> 4, nb = (p & 15) * 8; const bf16* xr = xbc + (size_t)(t0 + s) * 768 + (g_) * 128 + nb; \
        rC[i] = *(const u32x4*)(xr + 512); rB[i] = *(const u32x4*)(xr + 256); } } while (0)
#define M2O_LD_XS(h_) do { const float* st_ = WSP(float, WS_ST_M2) + ((size_t)c * 4 + (h_)) * 8192; _Pragma("unroll") for (int i = 0; i < 2; ++i) { const int p = F.tid + 512 * i, s = p >> 3, eb = (p & 7) * 8; \
        rX[i] = *(const u32x4*)(xbc + (size_t)(t0 + s) * 768 + (h_) * 64 + eb); rSa[i] = *(const f32x4*)(st_ + p * 8); rSb[i] = *(const f32x4*)(st_ + p * 8 + 4); } } while (0)
    __syncthreads();
    M2O_LD_CB(0);
    m2_dt_acum(F, l, c, dts, acs);
    float ss = 0.f;
    bf16* yrow = WSP(bf16, WS_ACT) + (size_t)(t0 + tl) * 1024 + Y_M2;
#pragma unroll 1
    for (int g = 0; g < 2; ++g) {
        __syncthreads();
#pragma unroll
        for (int i = 0; i < 4; ++i) { const int p = F.tid + 512 * i, s = p >> 4, nb = (p & 15) * 8; *(LAS u32x4*)(Cm + s * LD128 + nb) = rC[i]; *(LAS u32x4*)(Bm + s * LD128 + nb) = rB[i]; }
        M2O_LD_XS(2 * g);
        __syncthreads();
        f32x4 sc[8];
#pragma unroll
        for (int n = 0; n < 8; ++n) sc[n] = (f32x4){0, 0, 0, 0};
        wave_mma<8, 4>(sc, Cm + 16 * w * LD128, LD128, Bm, LD128, lane);
#pragma unroll 1
        for (int hh = 0; hh < 2; ++hh) { const int h = 2 * g + hh;
            __syncthreads();
#pragma unroll
            for (int i = 0; i < 2; ++i) { const int p = F.tid + 512 * i, s = p >> 3, eb = (p & 7) * 8; const unsigned aw[4] = {rX[i].x, rX[i].y, rX[i].z, rX[i].w};
#pragma unroll
                for (int j = 0; j < 8; ++j) XT[(eb + j) * LD128 + s] = (bf16)((j & 1) ? (aw[j >> 1] >> 16) : (aw[j >> 1] & 0xffffu));
                u32x4 o; o.x = pk2(rSa[i].x, rSa[i].y); o.y = pk2(rSa[i].z, rSa[i].w); o.z = pk2(rSb[i].x, rSb[i].y); o.w = pk2(rSb[i].z, rSb[i].w); *(LAS u32x4*)(ST + (p >> 4) * LD128 + (p & 15) * 8) = o; }
            const bf16* zp = proj + (size_t)(t0 + tl) * NPROJ + C_MZ + h * 64;
            u32x2 zr[4];
#pragma unroll
            for (int n = 0; n < 4; ++n) zr[n] = *(const u32x2*)(zp + 16 * n + 4 * fq);
            if (hh == 0) M2O_LD_XS(h + 1); else if (g == 0) M2O_LD_CB(1);
            const float at = acs[h * 128 + tl];
            lbf* Pw = P + w * 16 * LD128;
#pragma unroll
            for (int n = 0; n < 8; ++n) { float pv[4];
#pragma unroll
                for (int j = 0; j < 4; ++j) { const int s = 16 * n + 4 * fq + j; pv[j] = (s <= tl) ? sc[n][j] * fexp(at - acs[h * 128 + s]) * dts[h * 128 + s] : 0.f; }
                u32x2 o; o.x = pk2(pv[0], pv[1]); o.y = pk2(pv[2], pv[3]); *(LAS u32x2*)(Pw + fr * LD128 + 16 * n + 4 * fq) = o; CFENCE(); }
            __syncthreads();
            f32x4 yi[4], yx[4];
#pragma unroll
            for (int n = 0; n < 4; ++n) { yi[n] = (f32x4){0, 0, 0, 0}; yx[n] = (f32x4){0, 0, 0, 0}; }
            wave_mma<4, 4>(yi, Pw, LD128, XT, LD128, lane);
            wave_mma<4, 4>(yx, Cm + 16 * w * LD128, LD128, ST, LD128, lane);
            const float ea = fexp(at), dsk = F.m2_d[l * 4 + h];
#pragma unroll
            for (int n = 0; n < 4; ++n) { const int p0 = 16 * n + 4 * fq; const u32x2 z = zr[n];
                f32x4 v = yi[n] + ea * yx[n];
                v.x += dsk * bf2f(XT[(p0 + 0) * LD128 + tl]); v.y += dsk * bf2f(XT[(p0 + 1) * LD128 + tl]); v.z += dsk * bf2f(XT[(p0 + 2) * LD128 + tl]); v.w += dsk * bf2f(XT[(p0 + 3) * LD128 + tl]);
                v.x *= siluf_(bflo(z.x)); v.y *= siluf_(bfhi(z.x)); v.z *= siluf_(bflo(z.y)); v.w *= siluf_(bfhi(z.y));
                ss += (v.x * v.x + v.y * v.y) + (v.z * v.z + v.w * v.w);
                u32x2 o; o.x = pk2(v.x, v.y); o.y = pk2(v.z, v.w); *(u32x2*)(yrow + h * 64 + p0) = o; CFENCE(); }
        }
    }
#undef M2O_LD_CB
#undef M2O_LD_XS
    ss += __shfl_xor(ss, 16); ss += __shfl_xor(ss, 32);
    const float rstd = frsq(ss * (1.0f / 256.0f) + EPS);
    const float* ng = F.m2_norm_g + l * 256;
#ifndef EMU
    asm volatile("s_waitcnt vmcnt(0)" ::: "memory");
#endif
#pragma unroll 4
    for (int q = 0; q < 16; ++q) { const int cc = (q >> 2) * 64 + 16 * (q & 3) + 4 * fq; const f32x4 gv = *(const f32x4*)(ng + cc); const u32x2 yv = *(const u32x2*)(yrow + cc);
        u32x2 o; o.x = pk2(bflo(yv.x) * rstd * gv.x, bfhi(yv.x) * rstd * gv.y); o.y = pk2(bflo(yv.y) * rstd * gv.z, bfhi(yv.y) * rstd * gv.w); *(u32x2*)(yrow + cc) = o; }
}

template <bool OUT>
__device__ __forceinline__ void hg_wave_unit(Frame& F0, int l, int sc, int h) {
    Frame F = F0; LAUNDER(F);
    constexpr int TB = 16;
    lf32* Fb = (lf32*)(F.lds + F.wave * 16384); lf32* Vb = Fb + 1024; lf32* Qb = Vb + 1024; lf32* Gb = Qb + 1024;
    const bf16* proj = WSP(bf16, WS_BIG); const int lane = F.lane, t0 = sc * HSC;
    const float lb = WSP(float, WS_LB)[l * 256 + h * 64 + lane];
    float S[64];
    if (OUT) { const float* sp = WSP(float, WS_ST_HG) + ((size_t)sc * 4 + h) * 4096 + lane;
#pragma unroll
        for (int d = 0; d < 64; ++d) S[d] = sp[d * 64]; }
    else {
#pragma unroll
        for (int d = 0; d < 64; ++d) S[d] = 0.f; }
    float lam = 1.0f;
    const float ng = OUT ? F.hg_norm_g[l * 256 + h * 64 + lane] : 0.f;
    bf16 rf[TB], rq[TB], rv[TB], rg[TB];
    const bf16* pb = proj + (size_t)t0 * NPROJ + h * 64 + lane;
#pragma unroll
    for (int tt = 0; tt < TB; ++tt) { const bf16* pr = pb + (size_t)tt * NPROJ; rf[tt] = pr[C_GF]; rv[tt] = pr[C_GI]; if (OUT) { rq[tt] = pr[C_GQ]; rg[tt] = pr[C_GG]; } }
#pragma unroll 1
    for (int tb = 0; tb < HSC; tb += TB) {
#pragma unroll
        for (int tt = 0; tt < TB; ++tt) {
            const float f = lb + (1.0f - lb) * sigmoidf_(bf2f(rf[tt])); Fb[tt * 64 + lane] = f; lam *= f; Vb[tt * 64 + lane] = bf2f(rv[tt]);
            if (OUT) { Qb[tt * 64 + lane] = siluf_(bf2f(rq[tt])); Gb[tt * 64 + lane] = siluf_(bf2f(rg[tt])) * ng; } }
        WAVE_SYNC();
        if (tb + TB < HSC) { const bf16* pn = pb + (size_t)(tb + TB) * NPROJ;
#pragma unroll
            for (int tt = 0; tt < TB; ++tt) { const bf16* pr = pn + (size_t)tt * NPROJ; rf[tt] = pr[C_GF]; rv[tt] = pr[C_GI]; if (OUT) { rq[tt] = pr[C_GQ]; rg[tt] = pr[C_GG]; } } }
#pragma unroll 2
        for (int tt = 0; tt < TB; ++tt) {
            const float v = Vb[tt * 64 + lane];
            float o0 = 0.f, o1 = 0.f, o2 = 0.f, o3 = 0.f;
#pragma unroll
            for (int d4 = 0; d4 < 16; ++d4) { const f32x4 f4 = *(const LAS f32x4*)(Fb + tt * 64 + 4 * d4);
                S[4 * d4 + 0] = f4.x * (S[4 * d4 + 0] - v) + v; S[4 * d4 + 1] = f4.y * (S[4 * d4 + 1] - v) + v; S[4 * d4 + 2] = f4.z * (S[4 * d4 + 2] - v) + v; S[4 * d4 + 3] = f4.w * (S[4 * d4 + 3] - v) + v;
                if (OUT) { const f32x4 q4 = *(const LAS f32x4*)(Qb + tt * 64 + 4 * d4); o0 += q4.x * S[4 * d4 + 0]; o1 += q4.y * S[4 * d4 + 1]; o2 += q4.z * S[4 * d4 + 2]; o3 += q4.w * S[4 * d4 + 3]; } }
            if (OUT) { const float o = (o0 + o1) + (o2 + o3); const float ssq = wave_sum(o * o); const float rstd = frsq(ssq * (1.0f / 64.0f) + EPS);
                WSP(bf16, WS_ACT)[(size_t)(t0 + tb + tt) * 1024 + Y_HG + h * 64 + lane] = (bf16)f2bf(o * rstd * Gb[tt * 64 + lane]); } }
        WAVE_SYNC();
    }
    if (!OUT) { float* sp = WSP(float, WS_ST_HG) + ((size_t)sc * 4 + h) * 4096 + lane;
#pragma unroll
        for (int d = 0; d < 64; ++d) sp[d * 64] = S[d];
        WSP(float, WS_DEC_HG)[((size_t)sc * 4 + h) * 64 + lane] = lam; }
}


__device__ __forceinline__ bf16x8 pack8(const float (&x)[8]) {
    u32x4 w; w.x = pk2(x[0], x[1]); w.y = pk2(x[2], x[3]); w.z = pk2(x[4], x[5]); w.w = pk2(x[6], x[7]); return __builtin_bit_cast(bf16x8, w); }
__device__ __forceinline__ void ld8f(const lf32* p, float (&x)[8]) { const f32x4 a = *(const LAS f32x4*)p, b = *(const LAS f32x4*)(p + 4); x[0] = a.x; x[1] = a.y; x[2] = a.z; x[3] = a.w; x[4] = b.x; x[5] = b.y; x[6] = b.z; x[7] = b.w; }
__device__ __forceinline__ void ld8b(const lbf* p, float (&x)[8]) { const u32x4 a = *(const LAS u32x4*)p; x[0] = bflo(a.x); x[1] = bfhi(a.x); x[2] = bflo(a.y); x[3] = bfhi(a.y); x[4] = bflo(a.z); x[5] = bfhi(a.z); x[6] = bflo(a.w); x[7] = bfhi(a.w); }
__device__ __forceinline__ void hg_logf_cumsum(Frame& F, int l, const bf16* proj, int t0, int h, lf32* bL, lf32* tot) {
    { const int t = F.tid >> 2, dq = (F.tid & 3) * 16; const bf16* pr = proj + (size_t)(t0 + t) * NPROJ + C_GF + h * 64 + dq; const float* lbp = WSP(float, WS_LB) + l * 256 + h * 64 + dq;
#pragma unroll
      for (int hh = 0; hh < 2; ++hh) { const u32x4 a = *(const u32x4*)(pr + 8 * hh); const unsigned aw[4] = {a.x, a.y, a.z, a.w}; float lf[8];
#pragma unroll
          for (int j = 0; j < 8; ++j) { const float x = (j & 1) ? bfhi(aw[j >> 1]) : bflo(aw[j >> 1]); const float lb = lbp[8 * hh + j]; lf[j] = flog(lb + (1.0f - lb) * sigmoidf_(x)); }
          *(LAS f32x4*)(bL + t * 64 + dq + 8 * hh) = (f32x4){lf[0], lf[1], lf[2], lf[3]}; *(LAS f32x4*)(bL + t * 64 + dq + 8 * hh + 4) = (f32x4){lf[4], lf[5], lf[6], lf[7]}; } }
    __syncthreads();
    const int d = F.tid & 63, sg = F.tid >> 6;
    { float run = 0.f;
#pragma unroll
      for (int j = 0; j < 16; ++j) { run += bL[(sg * 16 + j) * 64 + d]; bL[(sg * 16 + j) * 64 + d] = run; }
      tot[sg * 64 + d] = run; }
    __syncthreads();
    { float off = 0.f; for (int g = 0; g < sg; ++g) off += tot[g * 64 + d];
#pragma unroll
      for (int j = 0; j < 16; ++j) bL[(sg * 16 + j) * 64 + d] += off; }
    __syncthreads();
}
__device__ __forceinline__ void hg_state_unit(Frame& F0, int l, int c, int h) {
    Frame F = F0; LAUNDER(F);
    lf32* bL = (lf32*)F.lds; lf32* tot = bL + 128 * 64; lbf* VT = (lbf*)(tot + 512); lbf* KT = VT + 64 * LD128;
    const bf16* proj = WSP(bf16, WS_BIG); const int t0 = c * CH;
    __syncthreads();
    hg_logf_cumsum(F, l, proj, t0, h, bL, tot);
    stage_T64(F, proj, t0, C_GI + h * 64, VT);
    { const int s = F.tid >> 2, dq = (F.tid & 3) * 16; const bf16* pr = proj + (size_t)(t0 + s) * NPROJ + C_GF + h * 64 + dq; const float* lbp = WSP(float, WS_LB) + l * 256 + h * 64 + dq;
#pragma unroll
      for (int hh = 0; hh < 2; ++hh) { const u32x4 a = *(const u32x4*)(pr + 8 * hh); const unsigned aw[4] = {a.x, a.y, a.z, a.w};
#pragma unroll
          for (int j = 0; j < 8; ++j) { const int d = dq + 8 * hh + j; const float x = (j & 1) ? bfhi(aw[j >> 1]) : bflo(aw[j >> 1]); const float lb = lbp[8 * hh + j];
              const float k = 1.0f - (lb + (1.0f - lb) * sigmoidf_(x)); KT[d * LD128 + s] = (bf16)f2bf(k * fexp(bL[127 * 64 + d] - bL[s * 64 + d])); } } }
    __syncthreads();
    f32x4 acc[2] = {(f32x4){0, 0, 0, 0}, (f32x4){0, 0, 0, 0}};
    const int w = F.wave;
    wave_mma<2, 4>(acc, VT + 16 * (w >> 1) * LD128, LD128, KT + 32 * (w & 1) * LD128, LD128, F.lane);
    float* st = WSP(float, WS_ST_HG) + ((size_t)c * 4 + h) * 4096; const int e = 16 * (w >> 1) + (F.lane & 15);
#pragma unroll
    for (int n = 0; n < 2; ++n) *(f32x4*)(st + e * 64 + 32 * (w & 1) + 16 * n + 4 * (F.lane >> 4)) = acc[n];
    if (F.tid < 64) WSP(float, WS_DEC_HG)[((size_t)c * 4 + h) * 64 + F.tid] = fexp(bL[127 * 64 + F.tid]);
}
__device__ __forceinline__ void hg_out_unit(Frame& F0, int l, int c, int h) {
    Frame F = F0; LAUNDER(F);
    lf32* bL = (lf32*)F.lds; lf32* tot = bL + 128 * 64; lbf* Qr = (lbf*)(tot + 512); lbf* Kh = Qr + 128 * LD64; lbf* VT = Kh + 128 * LD64; lbf* ST = VT + 64 * LD128; lbf* P = ST + 64 * LD64;
    const bf16* proj = WSP(bf16, WS_BIG); const int t0 = c * CH;
    const int w = F.wave, lane = F.lane, fr = lane & 15, fq = lane >> 4, tl = 16 * w + fr;
    __syncthreads();
    hg_logf_cumsum(F, l, proj, t0, h, bL, tot);
    { const int t = F.tid >> 2, dq = (F.tid & 3) * 16, te = (t | 15); const bf16* pq = proj + (size_t)(t0 + t) * NPROJ + C_GQ + h * 64 + dq; const bf16* pf = proj + (size_t)(t0 + t) * NPROJ + C_GF + h * 64 + dq;
      const float* lbp = WSP(float, WS_LB) + l * 256 + h * 64 + dq;
#pragma unroll
      for (int hh = 0; hh < 2; ++hh) { const u32x4 a = *(const u32x4*)(pq + 8 * hh), b = *(const u32x4*)(pf + 8 * hh); const unsigned aw[4] = {a.x, a.y, a.z, a.w}, bw[4] = {b.x, b.y, b.z, b.w}; float qo[8], ko[8];
#pragma unroll
          for (int j = 0; j < 8; ++j) { const int d = dq + 8 * hh + j; const float xq = (j & 1) ? bfhi(aw[j >> 1]) : bflo(aw[j >> 1]), xf = (j & 1) ? bfhi(bw[j >> 1]) : bflo(bw[j >> 1]); const float lb = lbp[8 * hh + j];
              qo[j] = siluf_(xq); ko[j] = (1.0f - (lb + (1.0f - lb) * sigmoidf_(xf))) * fexp(bL[te * 64 + d] - bL[t * 64 + d]); }
          *(LAS bf16x8*)(Qr + t * LD64 + dq + 8 * hh) = pack8(qo); *(LAS bf16x8*)(Kh + t * LD64 + dq + 8 * hh) = pack8(ko); } }
    stage_T64(F, proj, t0, C_GI + h * 64, VT);
    { const float* st = WSP(float, WS_ST_HG) + ((size_t)c * 4 + h) * 4096 + F.tid * 8; const f32x4 a = *(const f32x4*)st, b = *(const f32x4*)(st + 4);
      u32x4 o; o.x = pk2(a.x, a.y); o.y = pk2(a.z, a.w); o.z = pk2(b.x, b.y); o.w = pk2(b.z, b.w); *(LAS u32x4*)(ST + (F.tid >> 3) * LD64 + (F.tid & 7) * 8) = o; }
    __syncthreads();
    float qv[2][8], bt[2][8];
#pragma unroll
    for (int ks = 0; ks < 2; ++ks) { ld8b(Qr + tl * LD64 + ks * 32 + fq * 8, qv[ks]); ld8f(bL + tl * 64 + ks * 32 + fq * 8, bt[ks]); }
    lbf* Pw = P + w * 16 * LD128;
    f32x4 ox[4];
#pragma unroll
    for (int n = 0; n < 4; ++n) ox[n] = (f32x4){0, 0, 0, 0};
#pragma unroll
    for (int ks = 0; ks < 2; ++ks) { float x[8];
#pragma unroll
        for (int j = 0; j < 8; ++j) x[j] = qv[ks][j] * fexp(bt[ks][j]);
        const bf16x8 a = pack8(x);
#pragma unroll
        for (int n = 0; n < 4; ++n) { const bf16x8 b = *(const LAS bf16x8*)(ST + (n * 16 + fr) * LD64 + ks * 32 + fq * 8); ox[n] = __builtin_amdgcn_mfma_f32_16x16x32_bf16(b, a, ox[n], 0, 0, 0); } }
    for (int j = 0; j < w; ++j) { f32x4 sc = (f32x4){0, 0, 0, 0};
#pragma unroll
        for (int ks = 0; ks < 2; ++ks) { float be[8], x[8]; ld8f(bL + (16 * j + 15) * 64 + ks * 32 + fq * 8, be);
#pragma unroll
            for (int q = 0; q < 8; ++q) x[q] = qv[ks][q] * fexp(bt[ks][q] - be[q]);
            const bf16x8 a = pack8(x); const bf16x8 b = *(const LAS bf16x8*)(Kh + (16 * j + fr) * LD64 + ks * 32 + fq * 8);
            sc = __builtin_amdgcn_mfma_f32_16x16x32_bf16(b, a, sc, 0, 0, 0); }
        u32x2 o; o.x = pk2(sc.x, sc.y); o.y = pk2(sc.z, sc.w); *(LAS u32x2*)(Pw + fr * LD128 + 16 * j + 4 * fq) = o; }
    { f32x4 sc = (f32x4){0, 0, 0, 0};
#pragma unroll
      for (int ks = 0; ks < 2; ++ks) { float br[8], bee[8], kk[8], x[8], y[8]; ld8f(bL + (16 * w + 7) * 64 + ks * 32 + fq * 8, br); ld8f(bL + (16 * w + 15) * 64 + ks * 32 + fq * 8, bee); ld8b(Kh + tl * LD64 + ks * 32 + fq * 8, kk);
#pragma unroll
          for (int q = 0; q < 8; ++q) { x[q] = qv[ks][q] * fexp(bt[ks][q] - br[q]); y[q] = kk[q] * fexp(br[q] - bee[q]); }
          sc = __builtin_amdgcn_mfma_f32_16x16x32_bf16(pack8(y), pack8(x), sc, 0, 0, 0); }
      float pv[4];
#pragma unroll
      for (int q = 0; q < 4; ++q) pv[q] = (4 * fq + q <= fr) ? sc[q] : 0.f;
      u32x2 o; o.x = pk2(pv[0], pv[1]); o.y = pk2(pv[2], pv[3]); *(LAS u32x2*)(Pw + fr * LD128 + 16 * w + 4 * fq) = o; }
    for (int j = w + 1; j < 8; ++j) *(LAS u32x2*)(Pw + fr * LD128 + 16 * j + 4 * fq) = (u32x2){0u, 0u};
    WAVE_SYNC();
    f32x4 oi[4];
#pragma unroll
    for (int n = 0; n < 4; ++n) oi[n] = (f32x4){0, 0, 0, 0};
    wave_mma<4, 4>(oi, Pw, LD128, VT, LD128, lane);
    float ss = 0.f;
#pragma unroll
    for (int n = 0; n < 4; ++n) { oi[n] = oi[n] + ox[n]; ss += (oi[n].x * oi[n].x + oi[n].y * oi[n].y) + (oi[n].z * oi[n].z + oi[n].w * oi[n].w); }
    ss += __shfl_xor(ss, 16); ss += __shfl_xor(ss, 32);
    const float rstd = frsq(ss * (1.0f / 64.0f) + EPS);
    const int t = t0 + tl; bf16* y = WSP(bf16, WS_ACT) + (size_t)t * 1024 + Y_HG + h * 64; const bf16* gp = proj + (size_t)t * NPROJ + C_GG + h * 64; const float* ng = F.hg_norm_g + l * 256 + h * 64;
#pragma unroll
    for (int n = 0; n < 4; ++n) { const int e = 16 * n + 4 * fq; const u32x2 g = *(const u32x2*)(gp + e); const f32x4 gn = *(const f32x4*)(ng + e); const f32x4 v = oi[n] * rstd * gn;
        u32x2 o; o.x = pk2(v.x * siluf_(bflo(g.x)), v.y * siluf_(bfhi(g.x))); o.y = pk2(v.z * siluf_(bflo(g.y)), v.w * siluf_(bfhi(g.y))); *(u32x2*)(y + e) = o; }
}

struct PtrS5A { const bf16* proj; const bf16* sp; int g, c0;
    __device__ __forceinline__ const bf16* operator()(int r, int k) const { int c = c0 + r; if (c >= NCH5) c = NCH5 - 1;
        return k < 512 ? proj + (size_t)(c * 32 + (k >> 4)) * NPROJ + C_S5U + g * 16 + (k & 15) : sp + ((size_t)c * 16 + g) * 128 + (k - 512); } };
struct EpiS5Inc { float* st; int g, c0;
    __device__ __forceinline__ void operator()(int r, int c, f32x4 v) const { const int ch = c0 + r; if (ch < NCH5) *(f32x4*)(st + ((size_t)ch * 16 + g) * 128 + c) = v; } };
struct EpiS5Out { const bf16* proj; bf16* ypre; const float* dsk; int g, c0, n0;
    __device__ __forceinline__ void operator()(int r, int c, f32x4 v) const { const int ch = c0 + r; if (ch >= NCH5) return; const int np = n0 + c, tl = np >> 4, p = np & 15, t = ch * 32 + tl;
        const u32x2 u = *(const u32x2*)(proj + (size_t)t * NPROJ + C_S5U + g * 16 + p); const float* d = dsk + g * 16 + p;
        const float y0 = gelu_tanh(v.x + d[0] * bflo(u.x)), y1 = gelu_tanh(v.y + d[1] * bfhi(u.x)), y2 = gelu_tanh(v.z + d[2] * bflo(u.y)), y3 = gelu_tanh(v.w + d[3] * bfhi(u.y));
        u32x2 o; o.x = pk2(y0, y1); o.y = pk2(y2, y3); *(u32x2*)(ypre + (size_t)t * 256 + g * 16 + p) = o; } };

constexpr int S5_CB = (NCH5 + 127) / 128;
__device__ __forceinline__ void phase_m1(Frame& F, int l) {
    constexpr int U_HG = NCH * 4, U_M2 = NCH * 2, U_RET = NCH * 4, U_S5 = 16 * S5_CB;
    unsigned* ctr = WSP(unsigned, WS_CTL) + CW_Q + 64 * (2 * l) + 32 * F.rep;
    constexpr int U_GG = L / 256;
    constexpr int NC = U_GG + U_HG + U_M2 + U_RET + U_S5 + 256;
    for (int u0 = grab_unit(F, ctr); u0 < NC + CONV_D_UNITS; u0 = grab_unit(F, ctr)) {
        if (u0 >= NC) { conv_d_unit(F, l, u0 - NC); continue; }
        if (u0 < U_GG) { g8::OneUnit S1{u0, NPROJ / 256 - 1, (size_t)256 * 1024 * 2, (size_t)256 * 1024 * 2}; g8::EpiStore E1{WSP(bf16, WS_BIG), NPROJ};
            g8::gemm_phase(F.lds, WSP(bf16, WS_ACT), WSP(bf16, WS_WIN) + (size_t)l * NPROJ * 1024, 1024, S1, E1); continue; }
        const int u = u0 - U_GG;
        if (u >= U_HG + U_M2 + U_RET + U_S5) { s5_prep_b(F, l, u - (U_HG + U_M2 + U_RET + U_S5), 256); continue; }
        if (u < U_HG) { hg_state_unit(F, l, u >> 2, u & 3); continue; }
        int r = u - U_HG;
        if (r < U_M2) { m2_state_unit(F, l, r >> 1, r & 1); continue; } r -= U_M2;
        if (r < U_RET) { ret_state_unit(F, r >> 2, r & 3); continue; } r -= U_RET;
        { const int g = r / S5_CB, cb = r % S5_CB; PtrS5A ap{WSP(bf16, WS_BIG), nullptr, g, cb * 128}; PtrRM bp{WSP(bf16, WS_S5BI) + (size_t)g * 128 * 512, 512, 127};
          EpiS5Inc e{WSP(float, WS_ST_S5), g, cb * 128}; gemm128(F.lds, 512, ap, bp, e); }
    }
}
constexpr int SL = 32;
template <int LEN, class DEC>
__device__ __forceinline__ void seg_scan_real(Frame& F0, float* base, size_t cstride, int chain0, int nchain_total, const DEC& dec) {
    Frame F = F0; LAUNDER(F);
    constexpr int NSEG = (LEN + SL - 1) / SL, CHB = NTHREADS / NSEG;
    lf32* Ts = (lf32*)F.lds; lf32* Qs = Ts + NTHREADS;
    const int ch = chain0 + (F.tid % CHB), sg = F.tid / CHB; const bool act = (F.tid < CHB * NSEG) && ch < nchain_total;
    float v[SL], d[SL]; float s = 0.f, q = 1.f;
    float* p = base + ch;
    __syncthreads();
    if (act) {
#pragma unroll
        for (int j = 0; j < SL; ++j) { const int c = sg * SL + j; const bool ok = c < LEN; v[j] = ok ? p[(size_t)c * cstride] : 0.f; d[j] = ok ? dec(ch, c) : 1.f; }
#pragma unroll
        for (int j = 0; j < SL; ++j) { s = d[j] * s + v[j]; q *= d[j]; }
        Ts[sg * CHB + (F.tid % CHB)] = s; Qs[sg * CHB + (F.tid % CHB)] = q;
    }
    __syncthreads();
    if (act) {
        float c0 = 0.f;
        for (int g = 0; g < sg; ++g) c0 = Qs[g * CHB + (F.tid % CHB)] * c0 + Ts[g * CHB + (F.tid % CHB)];
        s = c0;
#pragma unroll
        for (int j = 0; j < SL; ++j) { const int c = sg * SL + j; if (c < LEN) { p[(size_t)c * cstride] = s; s = d[j] * s + v[j]; } }
    }
}
struct DecConst { float d; __device__ __forceinline__ float operator()(int, int) const { return d; } };
struct DecM2 { const float* dc; __device__ __forceinline__ float operator()(int ch, int c) const { return dc[c * 4 + (ch >> 13)]; } };
struct DecHG { const float* dc; __device__ __forceinline__ float operator()(int ch, int c) const { return dc[(size_t)c * 256 + (ch >> 12) * 64 + (ch & 63)]; } };
template <int LEN>
__device__ __forceinline__ void seg_scan_s5(Frame& F0, int l, int chain0) {
    Frame F = F0; LAUNDER(F);
    constexpr int NSEG = (LEN + SL - 1) / SL, CHB = NTHREADS / NSEG;
    LAS f32x2* Ts = (LAS f32x2*)F.lds; LAS f32x2* Qs = Ts + NTHREADS;
    const int r = chain0 + (F.tid % CHB), sg = F.tid / CHB; const bool act = (F.tid < CHB * NSEG) && r < 1024;
    const float* ap = WSP(float, WS_S5AP) + ((size_t)l * 1024 + (act ? r : 0)) * 68 + 64; const float ar = ap[0], ai = ap[1];
    const f32x2* p = (const f32x2*)(WSP(float, WS_ST_S5) + 2 * r); bf16* qo = WSP(bf16, WS_S5UG) + (size_t)(r >> 6) * NR5 * 640 + 512 + 2 * (r & 63);
    f32x2 v[SL]; float sr = 0.f, si = 0.f, qr = 1.f, qi = 0.f;
    __syncthreads();
    if (act) {
#pragma unroll
        for (int j = 0; j < SL; ++j) { const int c = sg * SL + j; v[j] = (c < LEN) ? p[(size_t)c * 1024] : (f32x2){0.f, 0.f}; }
#pragma unroll
        for (int j = 0; j < SL; ++j) { const int c = sg * SL + j; if (c < LEN) { const float nr = ar * sr - ai * si + v[j].x, ni = ar * si + ai * sr + v[j].y; sr = nr; si = ni; const float tr = ar * qr - ai * qi, ti = ar * qi + ai * qr; qr = tr; qi = ti; } }
        Ts[sg * CHB + (F.tid % CHB)] = (f32x2){sr, si}; Qs[sg * CHB + (F.tid % CHB)] = (f32x2){qr, qi};
    }
    __syncthreads();
    if (act) {
        float cr = 0.f, ci = 0.f;
        for (int g = 0; g < sg; ++g) { const f32x2 Q = Qs[g * CHB + (F.tid % CHB)], T = Ts[g * CHB + (F.tid % CHB)]; const float nr = Q.x * cr - Q.y * ci + T.x, ni = Q.x * ci + Q.y * cr + T.y; cr = nr; ci = ni; }
        sr = cr; si = ci;
#pragma unroll
        for (int j = 0; j < SL; ++j) { const int c = sg * SL + j; if (c < LEN) { *(unsigned*)(qo + (size_t)c * 640) = pk2(sr, si); const float nr = ar * sr - ai * si + v[j].x, ni = ar * si + ai * sr + v[j].y; sr = nr; si = ni; } }
    }
}
__device__ __forceinline__ void phase_m2(Frame& F, int l) {
    constexpr int N_RET = 4 * 4096, N_M2 = 4 * 8192, N_HG = 4 * 4096, N_S5 = 16 * 64;
    constexpr int CB_R = NTHREADS / ((NCH + SL - 1) / SL), CB_H = NTHREADS / ((NCH + SL - 1) / SL), CB_S = NTHREADS / ((NCH5 + SL - 1) / SL);
    constexpr int U_S5 = (N_S5 + CB_S - 1) / CB_S, U_HG = (N_HG + CB_H - 1) / CB_H, U_M2 = (N_M2 + CB_R - 1) / CB_R, U_RET = (N_RET + CB_R - 1) / CB_R;
    unsigned* ctr = WSP(unsigned, WS_CTL) + CW_Q + 64 * (6 + l) + 32 * F.rep;
    for (int u = grab_unit(F, ctr); u < U_S5 + U_HG + U_M2 + U_RET; u = grab_unit(F, ctr)) {
        if (u < U_S5) { seg_scan_s5<NCH5>(F, l, u * CB_S); continue; }
        int r = u - U_S5;
        if (r < U_HG) { DecHG dh{WSP(float, WS_DEC_HG)}; seg_scan_real<NCH>(F, WSP(float, WS_ST_HG), 16384, r * CB_H, N_HG, dh); continue; }
        r -= U_HG;
        if (r < U_M2) { DecM2 dm{WSP(float, WS_DEC_M2)}; seg_scan_real<NCH>(F, WSP(float, WS_ST_M2), 32768, r * CB_R, N_M2, dm); continue; }
        r -= U_M2;
        { const int ch0 = r * CB_R; DecConst dcst{exp2f(128.0f * ret_log2gamma(ch0 >> 12))};
          seg_scan_real<NCH>(F, WSP(float, WS_ST_RET), 16384, ch0, N_RET, dcst); }
    }
}
__device__ __forceinline__ void phase_m3(Frame& F, int l) {
    constexpr int U_HG = NCH * 4, U_M2 = NCH, U_RET = NCH * 4, U_S5 = 16 * (NR5 / 256) * 2;
    unsigned* ctr = WSP(unsigned, WS_CTL) + CW_Q + 64 * (2 * l + 1) + 32 * F.rep;
    constexpr int NC = U_HG + U_M2 + U_RET + U_S5;
    for (int u0 = grab_unit(F, ctr); u0 < NC + CONV_GU_UNITS; u0 = grab_unit(F, ctr)) {
        if (u0 >= U_M2 + U_S5 && u0 < U_M2 + U_S5 + CONV_GU_UNITS) { conv_gu_unit(F, l, u0 - (U_M2 + U_S5)); continue; }
        const int u = u0 < U_M2 + U_S5 ? u0 : u0 - CONV_GU_UNITS;
#ifndef M3SKIP
#define M3SKIP 0
#endif
        if (u < U_M2) { if (!(M3SKIP & 2)) m2_out_unit(F, l, u); continue; }
        int r = u - U_M2;
        if (r >= U_S5) { r -= U_S5;
            if (r < U_HG) { if (!(M3SKIP & 1)) hg_out_unit(F, l, r >> 2, r & 3); continue; } r -= U_HG;
            if (!(M3SKIP & 4)) ret_out_unit(F, r >> 2, r & 3); continue; }
        if (M3SKIP & 8) continue;
        { const int g = r / (2 * (NR5 / 256)), pm = (r >> 1) % (NR5 / 256), pn = r & 1;
          g8::OneUnit S1{pm, pn, (size_t)256 * 640 * 2, (size_t)256 * 640 * 2};
          g8::EpiQuad<EpiS5Out> E1{EpiS5Out{WSP(bf16, WS_BIG), WSP(bf16, WS_YPRE), F.s5_d + l * 256, g, 0, 0}};
          g8::gemm_phase(F.lds, WSP(bf16, WS_S5UG) + (size_t)g * NR5 * 640, WSP(bf16, WS_S5MT) + (size_t)g * 512 * 640, 640, S1, E1); }
    }
}
struct EpiGlu { const bf16* ypre; bf16* y; const float* bias; int r0, c0;
    __device__ __forceinline__ void operator()(int r, int c, f32x4 v) const { const int t = r0 + r, j = c0 + c; const u32x2 u = *(const u32x2*)(ypre + (size_t)t * 256 + j); const f32x4 b = *(const f32x4*)(bias + j);
        u32x2 o; o.x = pk2(bflo(u.x) * sigmoidf_(v.x + b.x), bfhi(u.x) * sigmoidf_(v.y + b.y)); o.y = pk2(bflo(u.y) * sigmoidf_(v.z + b.z), bfhi(u.y) * sigmoidf_(v.w + b.w));
        *(u32x2*)(y + (size_t)t * 1024 + Y_S5 + j) = o; } };
__device__ __forceinline__ void phase_m4(Frame& F, int l) {
    constexpr int NM = L / 128;
    for (int u = F.bid; u < NM * 2; u += F.G) { const int pm = u >> 1, pn = u & 1;
        PtrRM ap{WSP(bf16, WS_YPRE) + (size_t)pm * 128 * 256, 256, 127}, bp{WSP(bf16, WS_WGLU) + (size_t)l * 65536 + (size_t)pn * 128 * 256, 256, 127};
        EpiGlu e{WSP(bf16, WS_YPRE), WSP(bf16, WS_ACT), F.s5_b_glu + l * 256, pm * 128, pn * 128}; gemm128(F.lds, 256, ap, bp, e); }
}

__device__ __forceinline__ void phase_g2(Frame& F, int l) {
    g8::GridOrder S{L / 256, 4, (L / 256) * 4, F.G, F.bid, (size_t)256 * 1024 * 2, (size_t)256 * 1024 * 2};
    if (l == 0) { g8::EpiResid<false> E{F.x, WSP(bf16, WS_XRES)}; g8::gemm_phase(F.lds, WSP(bf16, WS_ACT), WSP(bf16, WS_WOUT), 1024, S, E); }
    else { g8::EpiResid<true> E{F.out, WSP(bf16, WS_XRES)}; g8::gemm_phase(F.lds, WSP(bf16, WS_ACT), WSP(bf16, WS_WOUT) + (size_t)1048576, 1024, S, E); }
}

__device__ __forceinline__ void phase_r2(Frame& F, int l) {
    const int RPB = L / F.G;
    LAS f32x4* T = (LAS f32x4*)F.lds;
    li32* e_s = (li32*)(F.lds + 81920); li32* base_s = e_s + 128;
    int* hist = WSP(int, WS_HIST) + l * 256 * 16;
    const float* g2 = F.norm2_g + l * 1024; const float* wg = F.moe_w_group + (size_t)l * 4096; const float* we = F.moe_w_expert + (size_t)l * 16384;
    __syncthreads();
    for (int k = F.tid; k < 1024; k += NTHREADS) { const float g = g2[k]; const int ln = (k >> 2) & 63, a = k & 3, j = k >> 8; const int idx = (j * 4 + a) * 64 + ln;
        T[idx] = g * *(const f32x4*)(wg + (size_t)k * 4);
#pragma unroll
        for (int b = 0; b < 4; ++b) T[(b + 1) * 1024 + idx] = g * *(const f32x4*)(we + (size_t)k * 16 + 4 * b); }
    for (int rb = 0; rb < RPB; rb += 64) {
        __syncthreads();
        u32x2 xq[4];
        if (rb + F.wave * 8 < RPB) { const u32x2* x0 = (const u32x2*)(WSP(bf16, WS_XRES) + (size_t)(F.bid * RPB + rb + F.wave * 8) * D) + F.lane;
#pragma unroll
            for (int j = 0; j < 4; ++j) xq[j] = x0[64 * j]; }
        for (int rr = 0; rr < 8; ++rr) { const int ri = F.wave * 8 + rr; if (rb + ri >= RPB) break; const int t = F.bid * RPB + rb + ri; const int lane = F.lane;
            const u32x2* xr = (const u32x2*)(WSP(bf16, WS_XRES) + (size_t)t * D) + lane; float ss = 0.f; f32x4 v[4];
#pragma unroll
            for (int j = 0; j < 4; ++j) { const u32x2 xb = xq[j]; v[j] = (f32x4){bflo(xb.x), bfhi(xb.x), bflo(xb.y), bfhi(xb.y)}; ss += (v[j].x * v[j].x + v[j].y * v[j].y) + (v[j].z * v[j].z + v[j].w * v[j].w); }
            if (rr + 1 < 8 && rb + ri + 1 < RPB) {
#pragma unroll
                for (int j = 0; j < 4; ++j) xq[j] = xr[256 + 64 * j]; }
            const float rstd = frsq(wave_sum(ss) * (1.0f / D) + EPS);
            float lgg[4] = {0.f, 0.f, 0.f, 0.f};
            u32x2* hb = (u32x2*)(WSP(bf16, WS_ACT) + (size_t)t * D) + lane;
#pragma unroll
            for (int j = 0; j < 4; ++j) { const int k = 4 * lane + 256 * j; const f32x4 h = v[j] * rstd * *(const f32x4*)(g2 + k);
                u32x2 w; w.x = pk2(h.x, h.y); w.y = pk2(h.z, h.w); hb[64 * j] = w;
                const float xv[4] = {v[j].x, v[j].y, v[j].z, v[j].w};
#pragma unroll
                for (int a = 0; a < 4; ++a) { const f32x4 w4 = T[(j * 4 + a) * 64 + lane]; lgg[0] += xv[a] * w4.x; lgg[1] += xv[a] * w4.y; lgg[2] += xv[a] * w4.z; lgg[3] += xv[a] * w4.w; } }
            float gl[4]; float gm = -1e30f; int gi = 0;
#pragma unroll
            for (int q = 0; q < 4; ++q) { gl[q] = wave_sum(lgg[q]) * rstd + F.moe_b_group[l * 4 + q]; if (gl[q] > gm) { gm = gl[q]; gi = q; } }
            gi = __builtin_amdgcn_readfirstlane(gi);
            float lge[4] = {0.f, 0.f, 0.f, 0.f};
            { const LAS f32x4* Te = T + (1 + gi) * 1024;
#pragma unroll
              for (int j = 0; j < 4; ++j) { const float xv[4] = {v[j].x, v[j].y, v[j].z, v[j].w};
#pragma unroll
                for (int a = 0; a < 4; ++a) { const f32x4 w4 = Te[(j * 4 + a) * 64 + lane]; lge[0] += xv[a] * w4.x; lge[1] += xv[a] * w4.y; lge[2] += xv[a] * w4.z; lge[3] += xv[a] * w4.w; } } }
            float el[4];
#pragma unroll
            for (int q = 0; q < 4; ++q) el[q] = wave_sum(lge[q]) * rstd + F.moe_b_expert[l * 16 + gi * 4 + q];
            if (lane == 0) {
                float gs = 0.f;
#pragma unroll
                for (int q = 0; q < 4; ++q) gs += fexp(gl[q] - gm);
                const float pg = 1.0f / gs;
                int i0 = 0; float m0 = el[0];
#pragma unroll
                for (int q = 1; q < 4; ++q) if (el[q] > m0) { m0 = el[q]; i0 = q; }
                int i1 = -1; float m1 = -1e30f;
#pragma unroll
                for (int q = 0; q < 4; ++q) if (q != i0 && el[q] > m1) { m1 = el[q]; i1 = q; }
                if (i1 < 0) { i1 = (i0 + 1) & 3; m1 = m0; }
                const float p1 = fexp(m1 - m0);
                const float w0 = pg / (1.0f + p1), w1 = pg * p1 / (1.0f + p1);
                int* rt = WSP(int, WS_ROUTE) + ((size_t)l * L + t) * 8; float* rtf = (float*)rt;
                rt[0] = gi * 4 + i0; rt[1] = gi * 4 + i1; rtf[4] = w0; rtf[5] = w1;
                e_s[2 * ri] = gi * 4 + i0; e_s[2 * ri + 1] = gi * 4 + i1;
            } }
        __syncthreads();
        const int nrow = (RPB - rb) < 64 ? (RPB - rb) : 64;
        li32* cnt_s = base_s;
        int my_e = -1, my_rank = 0;
        if (F.wave < 2) { const int idx = F.wave * 64 + F.lane; my_e = idx < 2 * nrow ? e_s[idx] : -1;
#pragma unroll
            for (int q = 0; q < 16; ++q) { const unsigned long long m = __ballot(my_e == q); if (my_e == q) my_rank = __builtin_popcountll(m & ((1ull << F.lane) - 1ull)); if (F.lane == 0) cnt_s[F.wave * 16 + q] = __builtin_popcountll(m); } }
        __syncthreads();
        if (F.tid < 16) hist[F.bid * 16 + F.tid] = cnt_s[F.tid] + cnt_s[16 + F.tid];
        if (F.wave < 2 && my_e >= 0) { const int idx = F.wave * 64 + F.lane; const int pos = my_rank + (F.wave == 1 ? cnt_s[my_e] : 0);
            const int t = F.bid * RPB + rb + (idx >> 1); WSP(int, WS_ROUTE)[((size_t)l * L + t) * 8 + 2 + (idx & 1)] = pos; }
    }
}
__device__ __forceinline__ int moe_tables(Frame& F, int l, li32* base_s, li32* pe_s, li32* pref_s) {
    const int* hist = WSP(int, WS_HIST) + l * 256 * 16; const int G = F.G; li32* seg_s = pref_s + 256 * 16;
    const int e = F.tid & 15, sg = F.tid >> 4, per = (G + 31) / 32;
    __syncthreads();
    for (int i = F.tid; i < G * 16; i += NTHREADS) pref_s[i] = hist[i];
    __syncthreads();
    { int run = 0; for (int b = sg * per; b < (sg + 1) * per && b < G; ++b) { const int v = pref_s[b * 16 + e]; pref_s[b * 16 + e] = run; run += v; } seg_s[sg * 16 + e] = run; }
    __syncthreads();
    if (F.tid < 16) { int run = 0; for (int g = 0; g < 32; ++g) { const int v = seg_s[g * 16 + F.tid]; seg_s[g * 16 + F.tid] = run; run += v; } base_s[16 + F.tid] = run; }
    __syncthreads();
    { const int off = seg_s[sg * 16 + e]; for (int b = sg * per; b < (sg + 1) * per && b < G; ++b) pref_s[b * 16 + e] += off; }
    if (F.tid == 0) { int tot[16];
#pragma unroll
        for (int q = 0; q < 16; ++q) tot[q] = base_s[16 + q];
        int b = 0, np = 0;
#pragma unroll
        for (int q = 0; q < 16; ++q) { base_s[q] = b; const int pp = (tot[q] + 255) >> 8; for (int i = 0; i < pp; ++i) pe_s[np++] = q; b += pp * 256; }
        base_s[16] = np; }
    __syncthreads();
    return base_s[16];
}
constexpr size_t WS_MOETAB = WS_LB + 2048;
__device__ __forceinline__ int moe_tables_small(Frame& F, int l, li32* base_s, li32* pe_s) {
    const int* tab = WSP(int, WS_MOETAB) + l * 256;
    __syncthreads();
    if (F.tid < 32) base_s[F.tid] = tab[F.tid];
    if (F.tid >= 32 && F.tid < 32 + 160) pe_s[F.tid - 32] = tab[F.tid];
    __syncthreads();
    return base_s[16];
}
__device__ __forceinline__ void phase_ga(Frame& F, int l) {
    li32* base_s = (li32*)F.lds; li32* pe_s = base_s + 32; li32* pref_s = pe_s + 160;
    moe_tables(F, l, base_s, pe_s, pref_s);
    if (F.bid == 0) { int* tab = WSP(int, WS_MOETAB) + l * 256; if (F.tid < 32) tab[F.tid] = base_s[F.tid]; if (F.tid >= 32 && F.tid < 32 + 160) tab[F.tid] = pe_s[F.tid - 32]; }
    const int RPB = L / F.G;
    const int gw = F.bid * 8 + F.wave, ngw = F.G * 8;
    for (int t = gw; t < L; t += ngw) { int* rt = WSP(int, WS_ROUTE) + ((size_t)l * L + t) * 8;
        const int ob = (t / RPB) * 16; const int s0 = base_s[rt[0]] + pref_s[ob + rt[0]] + rt[2], s1 = base_s[rt[1]] + pref_s[ob + rt[1]] + rt[3];
        if (F.lane == 0) { rt[6] = s0; rt[7] = s1; }
        const u32x4* src = (const u32x4*)(WSP(bf16, WS_ACT) + (size_t)t * 1024) + F.lane; u32x4* d0 = (u32x4*)(WSP(bf16, WS_H2G) + (size_t)s0 * 1024) + F.lane; u32x4* d1 = (u32x4*)(WSP(bf16, WS_H2G) + (size_t)s1 * 1024) + F.lane;
        const u32x4 a = src[0], b = src[64]; d0[0] = a; d0[64] = b; d1[0] = a; d1[64] = b; }
}
__device__ __forceinline__ void phase_g3(Frame& F, int l) {
    li32* base_s = (li32*)(F.lds + g8::STAGE_BYTES); li32* pe_s = base_s + 32;
    const int np = moe_tables_small(F, l, base_s, pe_s);
    g8::MoeOrder S{np, F.G, F.bid, pe_s, (size_t)256 * 1024 * 2, (size_t)1024 * 1024 * 2, (size_t)256 * 1024 * 2};
    g8::EpiGateUp E{WSP(bf16, WS_ACTB), (unsigned)((size_t)NSLOTP * 512 * 2), WSP(unsigned, WS_CTL) + CW_DEP + l * 4096};
    g8::gemm_phase(F.lds, WSP(bf16, WS_H2G), WSP(bf16, WS_WGU), 1024, S, E);
}
__device__ __forceinline__ void phase_g4(Frame& F, int l) {
    li32* base_s = (li32*)(F.lds + g8::STAGE_BYTES); li32* pe_s = base_s + 32;
    const int np = moe_tables_small(F, l, base_s, pe_s);
    const int n3raw = np * 4 - 2 * F.G, n3 = (n3raw >= 0 && n3raw <= F.G / 4) ? n3raw : -1;
    const int rank = n3 < 0 ? (F.bid + F.G / 2) % F.G : (F.bid >= n3 ? F.bid - n3 : F.G - n3 + F.bid);
    g8::MoeOrderDep S{np, F.G, rank, n3, pe_s, (size_t)256 * 512 * 2, (size_t)1024 * 512 * 2, (size_t)256 * 512 * 2, WSP(unsigned, WS_CTL) + CW_DEP + l * 4096, F.wave};
    g8::EpiStore E{WSP(bf16, WS_H2G), 1024};
    g8::gemm_phase(F.lds, WSP(bf16, WS_ACTB), WSP(bf16, WS_WD), 512, S, E);
    if (l == 0) { unsigned* ctr = WSP(unsigned, WS_CTL) + CW_Q + 64 * 5 + 32 * F.rep;
      for (int u = grab_unit(F, ctr); u < 256; u = grab_unit(F, ctr)) s5_prep_a(F, 1, u, 256); }
}
#ifndef ONLY
#define ONLY -1
#endif
#define EN(k) (ONLY < 0 || ONLY == (k))
constexpr int NPHASE = 23;
__global__ void __launch_bounds__(NTHREADS, 2) fwd_kernel(Args a) {
#ifdef EMU
    lu8* lds = emu::ctx->lds;
#else
    __shared__ __attribute__((aligned(16))) unsigned char lds_raw[LDS_BYTES];
    lu8* lds = (lu8*)lds_raw;
#endif
    Frame F;
    F.lds = lds; F.ws = a.ws; F.out = a.out; F.tid = threadIdx.x; F.lane = F.tid & 63; F.wave = __builtin_amdgcn_readfirstlane(F.tid >> 6); F.G = gridDim.x; F.bid = blockIdx.x; F.rep = 0;
    F.x = (const float*)a.in[0]; F.pos = (const int*)a.in[1];
    { LAS unsigned long long* tab = (LAS unsigned long long*)(lds + MISC_OFF + 256); if (F.tid < 32) tab[F.tid] = (unsigned long long)a.in[F.tid]; F.ptab = tab; }
#ifndef EMU
    volatile LAS unsigned* misc = (volatile LAS unsigned*)(lds + MISC_OFF);
    for (int u = F.tid; u < 64; u += NTHREADS) misc[u] = 0u;
#endif
    __syncthreads();
#ifndef EMU
    XcdBarrier bar = xcd_barrier_post(WSP(unsigned, WS_CTL) + CW_BAR, misc + 8);
#endif
    const Frame F00 = F;
    const int lo = a.ph_lo, hi = a.ph_hi;
#ifdef EMU
#define GRID_BAR() ((void)0)
#else
#define GRID_BAR() xcd_barrier(bar)
#endif
#ifndef REPEAT_PH
#define REPEAT_PH -1
#endif
#define PH(k, en, stmt) if (lo <= (k) && (k) < hi) { Frame F = F00; LAUNDER(F); if (EN(en)) { stmt; } if ((k) + 1 < hi && (k) != 9 && (k) != 20) GRID_BAR(); \
        if ((k) == REPEAT_PH) { Frame F = F00; LAUNDER(F); F.rep = 1; stmt; GRID_BAR(); } }
    PH(0, 10, phase_p0(F))
    PH(1, 0, phase_g1(F, 0)) PH(2, 1, phase_m1(F, 0)) PH(3, 2, phase_m2(F, 0)) PH(4, 3, phase_m3(F, 0)) PH(5, 4, phase_m4(F, 0))
    PH(6, 5, phase_g2(F, 0)) PH(7, 6, phase_r2(F, 0)) PH(8, 7, phase_ga(F, 0)) PH(9, 8, phase_g3(F, 0)) PH(10, 9, phase_g4(F, 0))
    PH(11, 12, r1_phase(F, 1, 1))
    PH(12, 0, phase_g1(F, 1)) PH(13, 1, phase_m1(F, 1)) PH(14, 2, phase_m2(F, 1)) PH(15, 3, phase_m3(F, 1)) PH(16, 4, phase_m4(F, 1))
    PH(17, 5, phase_g2(F, 1)) PH(18, 6, phase_r2(F, 1)) PH(19, 7, phase_ga(F, 1)) PH(20, 8, phase_g3(F, 1)) PH(21, 9, phase_g4(F, 1))
    PH(22, 11, r1_phase(F, 2, 0))
#undef PH
}


#ifdef STOP_AFTER
__global__ void __launch_bounds__(512) diag0(unsigned char* ws) { unsigned* flag = (unsigned*)(ws + WS_CTL) + 70000; if (threadIdx.x < 8 && blockIdx.x == 0) flag[threadIdx.x] = threadIdx.x == 1 ? 0x7fffffffu : 0u; }
__global__ void __launch_bounds__(512) diag1(const float* out, unsigned char* ws) {
    const size_t N = (size_t)L * D; const unsigned short* act = (const unsigned short*)(ws + WS_ACT); unsigned* flag = (unsigned*)(ws + WS_CTL) + 70000;
    for (size_t i = (size_t)blockIdx.x * 512 + threadIdx.x; i < N; i += (size_t)gridDim.x * 512) { if ((act[i] & 0x7F80u) == 0x7F80u) { atomicAdd(flag, 1u); atomicMin(flag + 1, (unsigned)(i >> 10)); if (((i >> 8) & 3) == 1) atomicOr(flag + 2, 1u << ((i >> 4) & 3)); } }
}
__global__ void __launch_bounds__(512) diag2(float* out, const unsigned char* ws) {
    const size_t N = (size_t)L * D; const unsigned* flag = (const unsigned*)(ws + WS_CTL) + 70000;
    const float c = DIAG_SEL == 0 ? (float)flag[0] : DIAG_SEL == 1 ? (float)flag[1] + 1.f : DIAG_SEL == 2 ? (float)flag[2] * 10.f : DIAG_SEL == 4 ? (float)flag[16] * 10.f : (float)flag[3];
    for (size_t i = (size_t)blockIdx.x * 512 + threadIdx.x; i < N; i += (size_t)gridDim.x * 512) out[i] = c;
}
#endif
#ifdef EMU
extern "C" int emu_seq() { return L; }
extern "C" size_t emu_ws_bytes() { return WS_END; }
extern "C" void emu_dump_layout(FILE* f) {
#define LO(n) fprintf(f, #n " %zu\n", (size_t)n)
    LO(WS_WIN); LO(WS_WOUT); LO(WS_WGLU); LO(WS_WGU); LO(WS_WD); LO(WS_S5MT); LO(WS_S5BI); LO(WS_S5AP); LO(WS_S5BB); LO(WS_S5KT); LO(WS_ROPE); LO(WS_DTW); LO(WS_LB); LO(WS_ACT); LO(WS_YPRE);
    LO(WS_DTRAW); LO(WS_ROUTE); LO(WS_ST_RET); LO(WS_ST_M2); LO(WS_DEC_M2); LO(WS_ST_HG); LO(WS_DEC_HG); LO(WS_ST_S5); LO(WS_SP_S5); LO(WS_BIG); LO(WS_H2G); LO(WS_ACTB); LO(WS_S5UG); LO(WS_END);
    fprintf(f, "CNT %zu\n", (size_t)CW_CNT * 4);
}
#endif

extern "C" void kernel_launch(void* const* d_in, const int* in_sizes, int n_in, void* d_out, int out_size, void* d_ws, size_t ws_size, hipStream_t stream) {
    static int grid = 0;
    if (grid == 0) {
        if (n_in != 32 || out_size != L * D || ws_size < WS_END) { fprintf(stderr, "kernel_launch: unexpected shapes: n_in %d out %d ws %zu (need %zu)\n", n_in, out_size, ws_size, (size_t)WS_END); grid = -1; return; }
#ifdef EMU
        grid = getenv("EMU_GRID") ? atoi(getenv("EMU_GRID")) : L / 64;
#else
        int dev = 0, cus = 0, per_cu = 0;
        (void)hipGetDevice(&dev);
        (void)hipDeviceGetAttribute(&cus, hipDeviceAttributeMultiprocessorCount, dev);
        (void)hipOccupancyMaxActiveBlocksPerMultiprocessor(&per_cu, (const void*)fwd_kernel, NTHREADS, 0);
        (void)hipGetLastError();
        grid = cus > 0 ? cus : 256;
        if (per_cu < 1) { fprintf(stderr, "kernel_launch: occupancy query says 0 blocks/CU\n"); grid = -1; return; }
        if (L % grid != 0 || L / grid > 64 || grid > 256) { fprintf(stderr, "kernel_launch: grid %d unsupported (need L %% grid == 0, L / grid <= 64, grid <= 256)\n", grid); grid = -1; return; }
#endif
    }
    if (grid < 0) return;
    (void)hipMemsetAsync((char*)d_ws + WS_CTL, 0, CTL_ZERO_BYTES, stream);
    Args a{};
    for (int i = 0; i < 32; ++i) a.in[i] = d_in[i];
    a.out = (float*)d_out; a.ws = (unsigned char*)d_ws;
#ifdef EMU
    const int nph = getenv("EMU_PHASES") ? atoi(getenv("EMU_PHASES")) : NPHASE;
    for (int ph = 0; ph < nph; ++ph) { a.ph_lo = ph; a.ph_hi = ph + 1; Args b = a; fprintf(stderr, "emu: phase %d\n", ph);
        emu::launch(dim3(grid), dim3(NTHREADS), LDS_BYTES, [b]() { fwd_kernel(b); }); }
#else
#if defined(STOP_AFTER)
    for (int ph = 0; ph < STOP_AFTER; ++ph) { a.ph_lo = ph; a.ph_hi = ph + 1; hipLaunchKernelGGL(fwd_kernel, dim3(grid), dim3(NTHREADS), 0, stream, a); }
    hipLaunchKernelGGL(diag0, dim3(1), dim3(512), 0, stream, (unsigned char*)d_ws);
    hipLaunchKernelGGL(diag1, dim3(1024), dim3(512), 0, stream, (const float*)d_out, (unsigned char*)d_ws);
    hipLaunchKernelGGL(diag2, dim3(1024), dim3(512), 0, stream, (float*)d_out, (const unsigned char*)d_ws);
#elif defined(MULTI_LAUNCH)
    for (int ph = 0; ph < NPHASE; ++ph) { a.ph_lo = ph; a.ph_hi = ph + 1; hipLaunchKernelGGL(fwd_kernel, dim3(grid), dim3(NTHREADS), 0, stream, a); }
#else
    a.ph_lo = 0; a.ph_hi = NPHASE;
    void* args[] = {&a};
    hipError_t e = hipLaunchCooperativeKernel((const void*)fwd_kernel, dim3(grid), dim3(NTHREADS), args, 0, stream);
    if (e != hipSuccess) fprintf(stderr, "cooperative launch failed: %s (grid %d)\n", hipGetErrorString(e), grid);
#endif
#endif
}
```

```cpp
#ifndef EMU
#include <hip/hip_runtime.h>
#endif
#include <cstdio>
#include <cstdint>
#include <cmath>
#include <cstdlib>

#ifndef SEQ_LEN
#define SEQ_LEN 16384
#endif


typedef unsigned short bf16;
typedef short bf16x8 __attribute__((ext_vector_type(8)));
typedef float f32x4 __attribute__((ext_vector_type(4)));
typedef float f32x2 __attribute__((ext_vector_type(2)));
typedef unsigned u32x4 __attribute__((ext_vector_type(4)));
typedef unsigned u32x2 __attribute__((ext_vector_type(2)));
#ifdef EMU
#define LAS
#else
#define LAS __attribute__((address_space(3)))
#endif
typedef LAS bf16 lbf; typedef LAS float lf32; typedef LAS int li32; typedef LAS unsigned char lu8;

#ifdef EMU
#define WAVE_SYNC() emu::wave_barrier()
#else
#define WAVE_SYNC() do { __builtin_amdgcn_fence(__ATOMIC_RELEASE, "wavefront"); asm volatile("s_waitcnt lgkmcnt(0)" ::: "memory"); __builtin_amdgcn_wave_barrier(); } while (0)
#endif
constexpr int L = SEQ_LEN, D = 1024, NPROJ = 3328, DIN = 3332;
constexpr int C_S5U = 0, C_RQ = 256, C_RK = 512, C_RV = 768, C_RG = 1024, C_MZ = 1280, C_MX = 1536, C_MB = 1792, C_MC = 2048,
              C_GQ = 2304, C_GF = 2560, C_GI = 2816, C_GG = 3072;
constexpr int Y_S5 = 0, Y_RET = 256, Y_M2 = 512, Y_HG = 768;
constexpr int CH = 128, NCH = L / CH;
constexpr int HSC = 64, NHSC = L / HSC;
constexpr int T5 = 32, NCH5 = L / T5;
constexpr int NEXP = 16, FF = 512;
constexpr int NSLOTP = 2 * L + NEXP * 256;
constexpr float EPS = 1e-6f;
constexpr int NTHREADS = 512;
constexpr int LDS_BYTES = 147456;
constexpr int MISC_OFF = 147456 - 512;

constexpr size_t al(size_t x) { return (x + 4095) & ~(size_t)4095; }
constexpr size_t WS_CTL = 0, CTL_ZERO_BYTES = 1u << 20;
constexpr int CW_BAR = 4096;
constexpr int CW_CNT = 65536;
constexpr size_t WS_WIN = 1u << 20;
constexpr size_t WS_WOUT = WS_WIN + al((size_t)2 * NPROJ * 1024 * 2);
constexpr size_t WS_WGLU = WS_WOUT + al((size_t)2 * 1024 * 1024 * 2);
constexpr size_t WS_WGU = WS_WGLU + al((size_t)2 * 256 * 256 * 2);
constexpr size_t WS_WD = WS_WGU + al((size_t)16 * 1024 * 1024 * 2);
constexpr size_t WS_S5MT = WS_WD + al((size_t)16 * 1024 * 512 * 2);
constexpr size_t WS_S5BI = WS_S5MT + al((size_t)16 * 512 * 640 * 2);
constexpr size_t WS_S5AP = WS_S5BI + al((size_t)16 * 128 * 512 * 2);
constexpr size_t WS_S5BB = WS_S5AP + al((size_t)2 * 16 * 64 * 34 * 2 * 4);
constexpr size_t WS_S5KT = WS_S5BB + al((size_t)2 * 16 * 64 * 16 * 2 * 4);
constexpr size_t WS_ROPE = WS_S5KT + al((size_t)16 * 32 * 256 * 4);
constexpr size_t WS_DTW = WS_ROPE + al((size_t)L * 64 * 4);
constexpr size_t WS_HIST = WS_DTW;
constexpr size_t WS_LB = WS_DTW + al((size_t)2 * 1024 * 4 * 4);
constexpr size_t WS_ACT = WS_LB + al(2 * 256 * 4);
constexpr size_t WS_YPRE = WS_ACT + al((size_t)L * 1024 * 2);
constexpr size_t WS_DTRAW = WS_YPRE + al((size_t)L * 256 * 2);
constexpr size_t WS_ROUTE = WS_DTRAW + al((size_t)L * 4 * 4);
constexpr size_t WS_ST_RET = WS_ROUTE + al((size_t)2 * L * 8 * 4);
constexpr size_t WS_ST_M2 = WS_ST_RET + al((size_t)NCH * 4 * 4096 * 4);
constexpr size_t WS_DEC_M2 = WS_ST_M2 + al((size_t)NCH * 4 * 8192 * 4);
constexpr size_t WS_ST_HG = WS_DEC_M2 + al((size_t)NCH * 4 * 4);
constexpr size_t WS_DEC_HG = WS_ST_HG + al((size_t)NHSC * 4 * 4096 * 4);
constexpr size_t WS_ST_S5 = WS_DEC_HG + al((size_t)NHSC * 4 * 64 * 4);
constexpr size_t WS_SP_S5 = WS_ST_S5 + al((size_t)NCH5 * 16 * 128 * 4);
constexpr size_t WS_BIG = WS_SP_S5 + al((size_t)NCH5 * 16 * 128 * 2);
constexpr size_t BIG_BYTES = ((size_t)L * NPROJ * 2 > (size_t)NSLOTP * 1536 * 2) ? (size_t)L * NPROJ * 2 : (size_t)NSLOTP * 1536 * 2;
constexpr size_t WS_XRES = WS_ST_RET;
static_assert(WS_BIG - WS_ST_RET >= (size_t)L * 1024 * 2, "xres overlay");
#define XBC_PTR(F) ((bf16*)(F).out + (size_t)L * 1024)
static_assert((size_t)L * 768 * 2 <= (size_t)16 * 1024 * 1024 * 2, "xbc overlay");
constexpr size_t WS_H2G = WS_BIG, WS_ACTB = WS_BIG + (size_t)NSLOTP * 1024 * 2;
constexpr int NR5 = ((NCH5 + 255) / 256) * 256;
constexpr size_t WS_S5UG = WS_BIG + al(BIG_BYTES);
constexpr size_t WS_END = WS_S5UG + al((size_t)16 * NR5 * 640 * 2);

#ifdef EMU
__device__ __forceinline__ unsigned f2bf(float f) { unsigned u = __builtin_bit_cast(unsigned, f); return (u + 0x7fffu + ((u >> 16) & 1u)) >> 16; }
__device__ __forceinline__ unsigned pk2(float lo, float hi) { return f2bf(lo) | (f2bf(hi) << 16); }
#else
typedef __bf16 hw_bf16x2 __attribute__((ext_vector_type(2)));
__device__ __forceinline__ unsigned pk2(float lo, float hi) { return __builtin_bit_cast(unsigned, __builtin_convertvector((f32x2){lo, hi}, hw_bf16x2)); }
__device__ __forceinline__ unsigned f2bf(float f) { return pk2(f, 0.f) & 0xffffu; }
#endif
__device__ __forceinline__ float bf2f(unsigned short b) { return __builtin_bit_cast(float, ((unsigned)b) << 16); }
__device__ __forceinline__ float bflo(unsigned w) { return __builtin_bit_cast(float, w << 16); }
__device__ __forceinline__ float bfhi(unsigned w) { return __builtin_bit_cast(float, w & 0xffff0000u); }
#ifdef EMU
__device__ __forceinline__ float fexp(float x) { return expf(x); }
__device__ __forceinline__ float frcp(float x) { return 1.0f / x; }
__device__ __forceinline__ float frsq(float x) { return 1.0f / sqrtf(x); }
__device__ __forceinline__ float fexp2(float x) { return exp2f(x); }
__device__ __forceinline__ float flog(float x) { return logf(x); }
#else
__device__ __forceinline__ float fexp(float x) { return __builtin_amdgcn_exp2f(x * 1.4426950408889634f); }
__device__ __forceinline__ float frcp(float x) { return __builtin_amdgcn_rcpf(x); }
__device__ __forceinline__ float frsq(float x) { return __builtin_amdgcn_rsqf(x); }
__device__ __forceinline__ float fexp2(float x) { return __builtin_amdgcn_exp2f(x); }
__device__ __forceinline__ float flog(float x) { return __builtin_amdgcn_logf(x) * 0.6931471805599453f; }
#endif
__device__ __forceinline__ float sigmoidf_(float x) { return frcp(1.0f + fexp(-x)); }
__device__ __forceinline__ float siluf_(float x) { return x * frcp(1.0f + fexp(-x)); }
__device__ __forceinline__ float gelu_tanh(float x) { const float u = 0.7978845608028654f * (x + 0.044715f * x * x * x); return x * (1.0f - frcp(1.0f + fexp(2.0f * u))); }
#ifdef EMU
__device__ __forceinline__ float wave_sum(float v) {
#pragma unroll
    for (int o = 1; o < 64; o <<= 1) v += __shfl_xor(v, o);
    return v;
}
#else
__device__ __forceinline__ float wave_sum(float v) {
    v += __builtin_bit_cast(float, __builtin_amdgcn_update_dpp(0, __builtin_bit_cast(int, v), 0xB1, 0xF, 0xF, true));
    v += __builtin_bit_cast(float, __builtin_amdgcn_update_dpp(0, __builtin_bit_cast(int, v), 0x4E, 0xF, 0xF, true));
    v += __builtin_bit_cast(float, __builtin_amdgcn_update_dpp(0, __builtin_bit_cast(int, v), 0x141, 0xF, 0xF, true));
    v += __builtin_bit_cast(float, __builtin_amdgcn_update_dpp(0, __builtin_bit_cast(int, v), 0x140, 0xF, 0xF, true));
    const int iv = __builtin_bit_cast(int, v);
    return (__builtin_bit_cast(float, __builtin_amdgcn_readlane(iv, 0)) + __builtin_bit_cast(float, __builtin_amdgcn_readlane(iv, 16))) +
           (__builtin_bit_cast(float, __builtin_amdgcn_readlane(iv, 32)) + __builtin_bit_cast(float, __builtin_amdgcn_readlane(iv, 48)));
}
#endif
__device__ __forceinline__ void dsincos(double a, double& s, double& c) {
    const double k = __builtin_rint(a * 0.15915494309189535);
    const double r = __builtin_fma(-k, 6.283185307179586, a) - k * 2.4492935982947064e-16;
    const double r2 = r * r;
    double ps = 1.0 / 51090942171709440000.0;
    ps = ps * r2 - 1.0 / 121645100408832000.0; ps = ps * r2 + 1.0 / 355687428096000.0; ps = ps * r2 - 1.0 / 1307674368000.0; ps = ps * r2 + 1.0 / 6227020800.0;
    ps = ps * r2 - 1.0 / 39916800.0; ps = ps * r2 + 1.0 / 362880.0; ps = ps * r2 - 1.0 / 5040.0; ps = ps * r2 + 1.0 / 120.0; ps = ps * r2 - 1.0 / 6.0; ps = ps * r2 + 1.0;
    s = ps * r;
    double pc = -1.0 / 1124000727777607680000.0;
    pc = pc * r2 + 1.0 / 2432902008176640000.0; pc = pc * r2 - 1.0 / 6402373705728000.0; pc = pc * r2 + 1.0 / 20922789888000.0; pc = pc * r2 - 1.0 / 87178291200.0;
    pc = pc * r2 + 1.0 / 479001600.0; pc = pc * r2 - 1.0 / 3628800.0; pc = pc * r2 + 1.0 / 40320.0; pc = pc * r2 - 1.0 / 720.0; pc = pc * r2 + 1.0 / 24.0; pc = pc * r2 - 0.5; pc = pc * r2 + 1.0;
    c = pc;
}

#ifdef EMU
__device__ __forceinline__ unsigned ld_agent(const unsigned* p) { return __atomic_load_n(p, __ATOMIC_RELAXED); }
#else
__device__ __forceinline__ unsigned ld_agent(const unsigned* p) { return __hip_atomic_load(p, __ATOMIC_RELAXED, __HIP_MEMORY_SCOPE_AGENT); }
#endif
struct Args { const void* in[32]; float* out; unsigned char* ws; int ph_lo, ph_hi; };
struct Frame {
    lu8* lds; unsigned char* ws; float* out;
    int tid, lane, wave, G, bid, rep;
    const float* x; const int* pos;
    const LAS unsigned long long* ptab;
    __device__ __forceinline__ const float* inp(int i) const { const unsigned long long v = ptab[i];
        const unsigned lo = (unsigned)__builtin_amdgcn_readfirstlane((int)(unsigned)v), hi = (unsigned)__builtin_amdgcn_readfirstlane((int)(unsigned)(v >> 32));
#ifdef EMU
        return (const float*)(((unsigned long long)hi << 32) | lo); }
#else
        return (const float*)(const __attribute__((address_space(1))) float*)(((unsigned long long)hi << 32) | lo); }
#endif
};

#define norm1_g inp(2)
#define w_in inp(3)
#define w_out inp(4)
#define s5_a_re inp(5)
#define s5_a_im inp(6)
#define s5_log_dt inp(7)
#define s5_b_re inp(8)
#define s5_b_im inp(9)
#define s5_c_re inp(10)
#define s5_c_im inp(11)
#define s5_d inp(12)
#define s5_w_glu inp(13)
#define s5_b_glu inp(14)
#define m2_conv_w inp(15)
#define m2_conv_b inp(16)
#define m2_dt_bias inp(17)
#define m2_a_log inp(18)
#define m2_d inp(19)
#define m2_norm_g inp(20)
#define hg_lb_logits inp(21)
#define hg_norm_g inp(22)
#define norm2_g inp(23)
#define moe_w_group inp(24)
#define moe_b_group inp(25)
#define moe_w_expert inp(26)
#define moe_b_expert inp(27)
#define moe_w_gate inp(28)
#define moe_w_up inp(29)
#define moe_w_down inp(30)
#define final_norm_g inp(31)
#define WSP(T, off) ((T*)(F.ws + (off)))
#ifdef EMU
#define CFENCE() ((void)0)
#else
#define CFENCE() asm volatile("" ::: "memory")
#endif
#ifdef EMU
#define LAUNDER(F) ((void)0)
#define LAUNDER_I(x) ((void)0)
#else
#define LAUNDER(F) do { size_t z_ = 0; asm volatile("" : "+v"((F).tid), "+v"((F).lane), "+s"((F).wave), "+s"(z_)); (F).ws = (F).ws + z_; } while (0)
#define LAUNDER_I(x) asm volatile("" : "+v"(x))
#endif

#ifndef EMU
#define XB_TMO      128
#define XB_XCNT(j)  (256  + 64 * (j))
#define XB_XSUB(j)  (1280 + 64 * (j))
#define XB_XGEN(j)  (2304 + 64 * (j))
#define XB_TOP      3328
#define XB_TOPGEN   3392
#define XCD_BAR_WORDS 3456
#define XB_SPIN_CAP (1u << 20)
__device__ __forceinline__ unsigned xb_ld(unsigned* p)              { return __hip_atomic_load(p, __ATOMIC_RELAXED, __HIP_MEMORY_SCOPE_AGENT); }
__device__ __forceinline__ unsigned xb_add(unsigned* p, unsigned v) { return __hip_atomic_fetch_add(p, v, __ATOMIC_RELAXED, __HIP_MEMORY_SCOPE_AGENT); }
__device__ __forceinline__ unsigned xb_xcc_id() { return (unsigned)__builtin_amdgcn_s_getreg((3 << 11) | 20) & 0xFu; }
#define XB_SPIN(cond, bar) do { unsigned _sp = 0; while (cond) { __builtin_amdgcn_s_sleep(1); \
    if ((++_sp & 255u) == 0u) { if (xb_ld(&(bar)[XB_TMO])) break; if (_sp > XB_SPIN_CAP) { atomicAdd(&(bar)[XB_TMO], 1u); break; } } } } while (0)
struct XcdBarrier { unsigned* bar; unsigned x; volatile LAS unsigned* st; };
__device__ __forceinline__ XcdBarrier xcd_barrier_post(unsigned* bar, volatile LAS unsigned* st) {
    XcdBarrier b; b.bar = bar; b.x = xb_xcc_id(); b.st = st;
    if (threadIdx.x == 0) (void)xb_add(&bar[XB_XCNT(b.x)], 1u);
    return b;
}
__device__ __forceinline__ void xcd_barrier_complete(unsigned* bar, unsigned x, unsigned& nloc, unsigned& nx) {
    const unsigned G = gridDim.x * gridDim.y * gridDim.z;
    unsigned sum, cnt, mine, sp = 0u;
    for (;;) {
        sum = 0u; cnt = 0u; mine = 0u;
#pragma unroll
        for (unsigned j = 0; j < 16; ++j) { const unsigned c = xb_ld(&bar[XB_XCNT(j)]); sum += c; cnt += (c > 0u) ? 1u : 0u; mine = (j == x) ? c : mine; }
        if (sum == G) break;
        __builtin_amdgcn_s_sleep(1);
        if ((++sp & 255u) == 0u) { if (xb_ld(&bar[XB_TMO])) break; if (sp > XB_SPIN_CAP) { atomicAdd(&bar[XB_TMO], 1u); break; } }
    }
    nloc = mine > 0u ? mine : 1u; nx = cnt > 0u ? cnt : 1u;
}
__device__ __forceinline__ void xcd_barrier(const XcdBarrier& b) {
    asm volatile("s_waitcnt vmcnt(0)" ::: "memory");
    __syncthreads();
    if (threadIdx.x == 0) {
        unsigned* bar = b.bar;
        __builtin_amdgcn_s_waitcnt(0);
        unsigned nloc = b.st[0], nx = b.st[1];
        if (nloc == 0u) { xcd_barrier_complete(bar, b.x, nloc, nx); b.st[0] = nloc; b.st[1] = nx; }
        const unsigned old = xb_add(&bar[XB_XSUB(b.x)], 1u);
        const unsigned gen = old / nloc;
        if (old + 1u == (gen + 1u) * nloc) {
            __builtin_amdgcn_fence(__ATOMIC_RELEASE, "agent");
            asm volatile("s_waitcnt vmcnt(0)" ::: "memory");
            const unsigned og = xb_add(&bar[XB_TOP], 1u);
            const unsigned tg = og / nx;
            if (og + 1u == (tg + 1u) * nx) xb_add(&bar[XB_TOPGEN], 1u);
            else XB_SPIN(xb_ld(&bar[XB_TOPGEN]) == tg, bar);
            __builtin_amdgcn_fence(__ATOMIC_ACQUIRE, "agent");
            xb_add(&bar[XB_XGEN(b.x)], 1u);
            asm volatile("s_waitcnt vmcnt(0)" ::: "memory");
        } else {
            XB_SPIN(xb_ld(&bar[XB_XGEN(b.x)]) == gen, bar);
            __builtin_amdgcn_fence(__ATOMIC_ACQUIRE, "agent");
            asm volatile("s_waitcnt vmcnt(0)" ::: "memory");
        }
    }
    __syncthreads();
}
#endif

constexpr int GT_BK = 128, GT_LD = GT_BK + 8;
constexpr int GT_BYTES = 2 * 128 * GT_LD * 2;
template <class AP, class BP, class EPI>
__device__ __forceinline__ void gemm128(lu8* lds, int K, const AP& ap, const BP& bp, const EPI& epi) {
    int tid = threadIdx.x; LAUNDER_I(tid);
    const int lane = tid & 63, wid = tid >> 6, wr = wid >> 1, wc = wid & 1, fr = lane & 15, fq = lane >> 4;
    lbf* As = (lbf*)lds; lbf* Bs = (lbf*)(lds + 128 * GT_LD * 2);
    f32x4 acc[2][4];
#pragma unroll
    for (int m = 0; m < 2; ++m)
#pragma unroll
        for (int n = 0; n < 4; ++n) acc[m][n] = (f32x4){0.f, 0.f, 0.f, 0.f};
    u32x4 ra[2][4], rb[2][4];
    const int nk = K / GT_BK;
#define GT_LOAD(slot, k0) do { _Pragma("unroll") for (int i = 0; i < 4; ++i) { const int p = tid + 512 * i, r = p >> 4, kc = p & 15; ra[slot][i] = *(const u32x4*)ap(r, (k0) + kc * 8); rb[slot][i] = *(const u32x4*)bp(r, (k0) + kc * 8); } } while (0)
    GT_LOAD(0, 0);
    if (nk > 1) GT_LOAD(1, GT_BK);
    for (int kt = 0; kt < nk; kt += 2) {
#pragma unroll
        for (int half = 0; half < 2; ++half) {
            if (kt + half < nk) {
                __syncthreads();
#pragma unroll
                for (int i = 0; i < 4; ++i) { const int p = tid + 512 * i, r = p >> 4, kc = p & 15; *(LAS u32x4*)(As + r * GT_LD + kc * 8) = ra[half][i]; *(LAS u32x4*)(Bs + r * GT_LD + kc * 8) = rb[half][i]; }
                __syncthreads();
                if (kt + half + 2 < nk) GT_LOAD(half, (kt + half + 2) * GT_BK);
#pragma unroll
                for (int ks = 0; ks < 4; ++ks) {
                    bf16x8 a[2], b[4];
#pragma unroll
                    for (int m = 0; m < 2; ++m) a[m] = *(const LAS bf16x8*)(As + (wr * 32 + m * 16 + fr) * GT_LD + ks * 32 + fq * 8);
#pragma unroll
                    for (int n = 0; n < 4; ++n) b[n] = *(const LAS bf16x8*)(Bs + (wc * 64 + n * 16 + fr) * GT_LD + ks * 32 + fq * 8);
#pragma unroll
                    for (int m = 0; m < 2; ++m)
#pragma unroll
                        for (int n = 0; n < 4; ++n) acc[m][n] = __builtin_amdgcn_mfma_f32_16x16x32_bf16(b[n], a[m], acc[m][n], 0, 0, 0);
                }
            }
        }
    }
#undef GT_LOAD
    if constexpr (EPI::HAS_PRE) {
        typename EPI::Pre pre[2][4];
#pragma unroll
        for (int m = 0; m < 2; ++m)
#pragma unroll
            for (int n = 0; n < 4; ++n) pre[m][n] = epi.load(wr * 32 + m * 16 + fr, wc * 64 + n * 16 + 4 * fq);
#pragma unroll
        for (int m = 0; m < 2; ++m)
#pragma unroll
            for (int n = 0; n < 4; ++n) epi.fin(wr * 32 + m * 16 + fr, wc * 64 + n * 16 + 4 * fq, acc[m][n], pre[m][n]);
    } else {
#pragma unroll
    for (int m = 0; m < 2; ++m)
#pragma unroll
        for (int n = 0; n < 4; ++n) epi(wr * 32 + m * 16 + fr, wc * 64 + n * 16 + 4 * fq, acc[m][n]);
    }
}
struct PtrRM { const bf16* base; size_t ld; int rmax;
    __device__ __forceinline__ const bf16* operator()(int r, int k) const { return base + (size_t)(r < rmax ? r : rmax) * ld + k; } };

template <int NT, int KS>
__device__ __forceinline__ void wave_mma(f32x4 (&acc)[NT], const lbf* A, int lda, const lbf* B, int ldb, int lane) {
    const int fr = lane & 15, fq = lane >> 4;
#pragma unroll
    for (int ks = 0; ks < KS; ++ks) {
        const bf16x8 a = *(const LAS bf16x8*)(A + fr * lda + ks * 32 + fq * 8);
#pragma unroll
        for (int n = 0; n < NT; ++n) { const bf16x8 b = *(const LAS bf16x8*)(B + (n * 16 + fr) * ldb + ks * 32 + fq * 8); acc[n] = __builtin_amdgcn_mfma_f32_16x16x32_bf16(b, a, acc[n], 0, 0, 0); }
    }
}


namespace g8 {
constexpr int BM = 256, BK = 64, HALF = 128, HTB = HALF * BK * 2, STAGE_BYTES = 8 * HTB;
__host__ __device__ __forceinline__ int lds_byte(int r, int c) { const int st = (r >> 4) * 2 + (c >> 5), rr = r & 15, cc = c & 31, ob = rr * 64 + cc * 2; return st * 1024 + (ob ^ (((ob >> 9) & 1) << 5)); }
__host__ __device__ __forceinline__ void stage_rc(int b, int& R, int& C) { const int st = b / 1024, sb = b % 1024, swz = sb ^ (((sb >> 9) & 1) << 5); R = (st >> 1) * 16 + swz / 64; C = (st & 1) * 32 + (swz % 64) / 2; }
__host__ __device__ __forceinline__ int perm32(int rho) { const int n = rho >> 4, i = rho & 15; return 8 * (i >> 2) + 4 * n + (i & 3); }
struct Unit { size_t aoff, boff; int pm, pn; };
#ifdef EMU
#define G8_WAIT_V(n) ((void)0)
#define G8_WAIT_L(n) ((void)0)
#else
#define G8_WAIT_V(n) asm volatile("s_waitcnt vmcnt(" #n ")" ::: "memory")
#define G8_WAIT_L(n) asm volatile("s_waitcnt lgkmcnt(" #n ")" ::: "memory")
#endif
template <class Epi, class Sched, bool ALIGN_EPI = true, bool SP2 = true>
__device__ __forceinline__ void gemm_phase(lu8* lds, const bf16* Abase, const bf16* Bbase, const int K, const Sched& S, const Epi& E) {
    const int tid = threadIdx.x, wid = __builtin_amdgcn_readfirstlane(tid >> 6), lane = tid & 63, wr = wid >> 2, wc = wid & 3, fr = lane & 15, fq = lane >> 4;
    const int nt = K / BK;
    unsigned voffA[2], voffB[2];
#pragma unroll
    for (int i = 0; i < 2; ++i) { int R, C; stage_rc(tid * 16 + i * 8192, R, C); const int Rb = Epi::PERM ? ((R & ~31) + perm32(R & 31)) : R;
        voffA[i] = (unsigned)(R * K + C) * 2u; voffB[i] = (unsigned)(Rb * K + C) * 2u; }
    const size_t kstep = (size_t)(BK * 2), hstep = (size_t)HALF * K * 2;
    const unsigned ldsw = (unsigned)wid * 1024u;
    const int aoff = lds_byte(wr * 64 + fr, fq * 8), boff = lds_byte(wc * 32 + fr, fq * 8);
#define G8_SA(b, h) (((b) * 2 + (h)) * HTB)
#define G8_SB(b, h) ((4 + (b) * 2 + (h)) * HTB)
#define G8_STAGE(bufoff, gbase, voff) do { _Pragma("unroll") for (int _i = 0; _i < 2; ++_i) \
        __builtin_amdgcn_global_load_lds((const unsigned*)((const char*)(gbase) + (voff)[_i]), (LAS unsigned*)(lds + (bufoff) + ldsw + _i * 8192), 16, 0, 0); } while (0)
#define G8_STAGEA(bufoff, gbase, voff) do { _Pragma("unroll") for (int _i = 0; _i < 2; ++_i) \
        __builtin_amdgcn_global_load_lds((const unsigned*)((const char*)(gbase) + (voff)[_i]), (LAS unsigned*)(lds + (bufoff) + ldsw + _i * 8192), 16, 0, Sched::A_AUX); } while (0)
#define G8_LDA(dst, b, h) do { _Pragma("unroll") for (int m = 0; m < 4; ++m) _Pragma("unroll") for (int k = 0; k < 2; ++k) dst[m][k] = *(const LAS bf16x8*)(lds + G8_SA(b, h) + aoff + m * 2048 + k * 1024); } while (0)
#define G8_LDB(dst, b, h) do { _Pragma("unroll") for (int n = 0; n < 2; ++n) _Pragma("unroll") for (int k = 0; k < 2; ++k) dst[n][k] = *(const LAS bf16x8*)(lds + G8_SB(b, h) + boff + n * 2048 + k * 1024); } while (0)
#define G8_MMA(ai, bj, At, Bt) do { __builtin_amdgcn_s_setprio(1); _Pragma("unroll") for (int m = 0; m < 4; ++m) _Pragma("unroll") for (int n = 0; n < 2; ++n) _Pragma("unroll") for (int k = 0; k < 2; ++k) \
        acc[ai][bj][m][n] = __builtin_amdgcn_mfma_f32_16x16x32_bf16(Bt[n][k], At[m][k], acc[ai][bj][m][n], 0, 0, 0); __builtin_amdgcn_s_setprio(0); } while (0)
#define G8_BAR __builtin_amdgcn_s_barrier()
#define G8_SCHED __builtin_amdgcn_sched_barrier(0)
    Unit cur, nxt; int ui = 0; int pend = -1;
    if (!S.next(0, cur)) return;
    f32x4 acc[2][2][4][2];
    bool pre = false;
    if constexpr (Epi::INIT_ACC) pre = E.want_pre(cur);
    if (pre) { if constexpr (Epi::INIT_ACC) E.init(acc, cur, wr, wc, fr, fq); }
    else {
#pragma unroll
    for (int a = 0; a < 2; ++a)
#pragma unroll
        for (int b = 0; b < 2; ++b)
#pragma unroll
            for (int m = 0; m < 4; ++m)
#pragma unroll
                for (int n = 0; n < 2; ++n) acc[a][b][m][n] = (f32x4){0.f, 0.f, 0.f, 0.f};
    }
    bf16x8 At[4][2], B0[2][2], B1[2][2];
    const char* cA = (const char*)Abase + cur.aoff; const char* cB = (const char*)Bbase + cur.boff;
    if constexpr (SP2) {
        G8_STAGE(G8_SB(0, 0), cB, voffB); G8_STAGE(G8_SB(0, 1), cB + hstep, voffB); G8_STAGEA(G8_SA(0, 0), cA, voffA); G8_STAGEA(G8_SA(0, 1), cA + hstep, voffA);
        if (wr == 1) G8_BAR;
        G8_WAIT_V(2); G8_BAR;
        G8_STAGE(G8_SB(1, 0), cB + kstep, voffB); G8_STAGEA(G8_SA(1, 0), cA + kstep, voffA); G8_STAGE(G8_SB(1, 1), cB + hstep + kstep, voffB);
        G8_WAIT_V(6); G8_BAR;
    } else {
        G8_STAGE(G8_SB(0, 0), cB, voffB); G8_STAGEA(G8_SA(0, 0), cA, voffA); G8_STAGE(G8_SB(0, 1), cB + hstep, voffB); G8_STAGEA(G8_SA(0, 1), cA + hstep, voffA);
        if (wr == 1) G8_BAR;
        G8_WAIT_V(4); G8_BAR;
        G8_STAGE(G8_SB(1, 0), cB + kstep, voffB); G8_STAGEA(G8_SA(1, 0), cA + kstep, voffA); G8_STAGE(G8_SB(1, 1), cB + hstep + kstep, voffB);
        G8_WAIT_V(6); G8_BAR;
    }
    for (;;) {
        const bool has_next = S.next(ui + 1, nxt);
        const char* nA = has_next ? (const char*)Abase + nxt.aoff : cA; const char* nB = has_next ? (const char*)Bbase + nxt.boff : cB;
        for (int t = 0; t < nt; t += 2) {
            const bool last = (t == nt - 2);
            if constexpr (Epi::DEFER_PUB) { if (t == 2 && pend >= 0) { E.publish(pend, lane == 0); pend = -1; } }
            const char* a1 = cA + (size_t)(t + 1) * kstep;
            const char* a2 = last ? nA : cA + (size_t)(t + 2) * kstep; const char* b2 = last ? nB : cB + (size_t)(t + 2) * kstep;
            const char* a3 = a2 + kstep; const char* b3 = b2 + kstep;
            if constexpr (SP2) {
            G8_LDB(B0, 0, 0); G8_LDB(B1, 0, 1); G8_SCHED; G8_LDA(At, 0, 0); G8_STAGEA(G8_SA(1, 1), a1 + hstep, voffA);
            G8_WAIT_V(8); G8_WAIT_L(0); G8_BAR; G8_MMA(0, 0, At, B0); G8_MMA(0, 1, At, B1); G8_BAR; G8_SCHED;
            G8_LDA(At, 0, 1); G8_STAGE(G8_SB(0, 0), b2, voffB); G8_STAGE(G8_SB(0, 1), b2 + hstep, voffB); G8_STAGEA(G8_SA(0, 0), a2, voffA);
            G8_WAIT_V(8); G8_WAIT_L(0); G8_BAR; G8_MMA(1, 0, At, B0); G8_MMA(1, 1, At, B1); G8_BAR; G8_SCHED;
            G8_LDB(B0, 1, 0); G8_LDB(B1, 1, 1); G8_SCHED; G8_LDA(At, 1, 0); G8_STAGEA(G8_SA(0, 1), a2 + hstep, voffA);
            G8_WAIT_V(8); G8_WAIT_L(0); G8_BAR; G8_MMA(0, 0, At, B0); G8_MMA(0, 1, At, B1); G8_BAR; G8_SCHED;
            G8_LDA(At, 1, 1); G8_STAGE(G8_SB(1, 0), b3, voffB); G8_STAGE(G8_SB(1, 1), b3 + hstep, voffB); G8_STAGEA(G8_SA(1, 0), a3, voffA);
            G8_WAIT_V(8); G8_WAIT_L(0); G8_BAR; G8_MMA(1, 0, At, B0); G8_MMA(1, 1, At, B1); G8_BAR; G8_SCHED;
            } else {
            G8_LDB(B0, 0, 0); G8_SCHED; G8_LDA(At, 0, 0); G8_STAGEA(G8_SA(1, 1), a1 + hstep, voffA);
            G8_WAIT_L(8); G8_BAR; G8_WAIT_L(0); G8_MMA(0, 0, At, B0); G8_BAR; G8_SCHED;
            G8_LDB(B1, 0, 1); G8_STAGE(G8_SB(0, 0), b2, voffB);
            G8_BAR; G8_WAIT_L(0); G8_MMA(0, 1, At, B1); G8_BAR;
            G8_LDA(At, 0, 1); G8_STAGEA(G8_SA(0, 0), a2, voffA);
            G8_BAR; G8_WAIT_L(0); G8_MMA(1, 0, At, B0); G8_BAR; G8_SCHED;
            G8_STAGE(G8_SB(0, 1), b2 + hstep, voffB);
            G8_WAIT_V(6); G8_BAR; G8_MMA(1, 1, At, B1); G8_BAR;
            G8_LDB(B0, 1, 0); G8_SCHED; G8_LDA(At, 1, 0); G8_STAGEA(G8_SA(0, 1), a2 + hstep, voffA);
            G8_WAIT_L(8); G8_BAR; G8_WAIT_L(0); G8_MMA(0, 0, At, B0); G8_BAR; G8_SCHED;
            G8_LDB(B1, 1, 1); G8_STAGE(G8_SB(1, 0), b3, voffB);
            G8_BAR; G8_WAIT_L(0); G8_MMA(0, 1, At, B1); G8_BAR;
            G8_LDA(At, 1, 1); G8_STAGEA(G8_SA(1, 0), a3, voffA);
            G8_BAR; G8_WAIT_L(0); G8_MMA(1, 0, At, B0); G8_BAR; G8_SCHED;
            G8_STAGE(G8_SB(1, 1), b3 + hstep, voffB);
            G8_WAIT_V(6); G8_BAR; G8_MMA(1, 1, At, B1); G8_BAR;
            }
        }
        if constexpr (ALIGN_EPI) { if (wr == 0) G8_BAR; }
        if constexpr (Epi::INIT_ACC) { E.ep(acc, cur, wr, wc, fr, fq, pre); pre = false; } else E(acc, cur, wr, wc, fr, fq);
        if constexpr (Epi::DEFER_PUB) pend = cur.pm;
        if (!has_next) break;
#pragma unroll
        for (int a = 0; a < 2; ++a)
#pragma unroll
            for (int b = 0; b < 2; ++b)
#pragma unroll
                for (int m = 0; m < 4; ++m)
#pragma unroll
                    for (int n = 0; n < 2; ++n) acc[a][b][m][n] = (f32x4){0.f, 0.f, 0.f, 0.f};
        cur = nxt; cA = nA; cB = nB; ++ui;
        if constexpr (ALIGN_EPI) { if (wr == 1) G8_BAR; }
    }
    G8_WAIT_V(0);
    if constexpr (Epi::DEFER_PUB) { if (pend >= 0) E.publish(pend, lane == 0); }
    if constexpr (!ALIGN_EPI) { if (wr == 0) G8_BAR; }
    G8_BAR;
#undef G8_SA
#undef G8_SB
#undef G8_STAGE
#undef G8_STAGEA
#undef G8_LDA
#undef G8_LDB
#undef G8_MMA
#undef G8_BAR
#undef G8_SCHED
}
struct GridOrder { static constexpr int A_AUX = 0; int nM, nN, nwg, G, c; size_t astep, bstep;
    __device__ __forceinline__ bool next(int i, Unit& u) const {
        const long Lx = (long)i * G + c; if (Lx >= nwg) return false;
        int wgid = (int)Lx; { const int q = nwg / 8, r = nwg % 8, xcd = wgid % 8, off = wgid / 8; wgid = (xcd < r ? xcd * (q + 1) : r * (q + 1) + (xcd - r) * q) + off; }
        const int nig = 8 * nN, gid = wgid / nig, fm = gid * 8, gsz = (nM - fm) < 8 ? (nM - fm) : 8;
        u.pm = fm + ((wgid % nig) % gsz); u.pn = (wgid % nig) / gsz; u.aoff = (size_t)u.pm * astep; u.boff = (size_t)u.pn * bstep; return true; } };
struct OneUnit { static constexpr int A_AUX = 0; int pm, pn; size_t astep, bstep;
    __device__ __forceinline__ bool next(int i, Unit& u) const { if (i != 0) return false; u.pm = pm; u.pn = pn; u.aoff = (size_t)pm * astep; u.boff = (size_t)pn * bstep; return true; } };
struct MoeOrder { static constexpr int A_AUX = 0; int np, G, c; const li32* pe; size_t astep, estep, bstep;
    __device__ __forceinline__ bool next(int i, Unit& u) const {
        int Lx = i * G + c; const int nwg = np * 4; if (Lx >= nwg) return false;
        { const int q = nwg / 8, r = nwg % 8, xcd = Lx % 8, off = Lx / 8; Lx = (xcd < r ? xcd * (q + 1) : r * (q + 1) + (xcd - r) * q) + off; }
        u.pm = Lx >> 2; u.pn = Lx & 3; u.aoff = (size_t)u.pm * astep; const int e = __builtin_amdgcn_readfirstlane(pe[u.pm]); u.boff = (size_t)e * estep + (size_t)u.pn * bstep; return true; } };
struct EpiStore {
    static constexpr bool PERM = true, DEFER_PUB = false, INIT_ACC = false;
    bf16* O; int ldc;
    __device__ __forceinline__ void operator()(const f32x4 (&acc)[2][2][4][2], const Unit& u, int wr, int wc, int fr, int fq) const {
        const int row0 = u.pm * BM + wr * 64 + fr, col0 = u.pn * BM + wc * 32 + 8 * fq;
#pragma unroll
        for (int ai = 0; ai < 2; ++ai)
#pragma unroll
            for (int m = 0; m < 4; ++m) { bf16* rowp = O + (size_t)(row0 + ai * HALF + m * 16) * ldc + col0;
#pragma unroll
                for (int bj = 0; bj < 2; ++bj) { const f32x4 v0 = acc[ai][bj][m][0], v1 = acc[ai][bj][m][1];
                    u32x4 w; w.x = pk2(v0.x, v0.y); w.y = pk2(v0.z, v0.w); w.z = pk2(v1.x, v1.y); w.w = pk2(v1.z, v1.w); *(u32x4*)(rowp + bj * HALF) = w; } }
    } };
template <bool XBF>
struct EpiResid {
    static constexpr bool PERM = true, DEFER_PUB = false, INIT_ACC = true;
    const void* xin; bf16* out;
    __device__ __forceinline__ bool want_pre(const Unit& u) const { return (u.pm & 1) != 0; }
    __device__ __forceinline__ void init(f32x4 (&acc)[2][2][4][2], const Unit& u, int wr, int wc, int fr, int fq) const {
        const int row0 = u.pm * BM + wr * 64 + fr, col0 = u.pn * BM + wc * 32 + 8 * fq;
#pragma unroll
        for (int ai = 0; ai < 2; ++ai)
#pragma unroll
            for (int m = 0; m < 4; ++m)
#pragma unroll
                for (int bj = 0; bj < 2; ++bj) { const size_t o = (size_t)(row0 + ai * HALF + m * 16) * D + col0 + bj * HALF;
                    if (XBF) { const u32x4 xb = *(const u32x4*)((const bf16*)xin + o); acc[ai][bj][m][0] = (f32x4){bflo(xb.x), bfhi(xb.x), bflo(xb.y), bfhi(xb.y)}; acc[ai][bj][m][1] = (f32x4){bflo(xb.z), bfhi(xb.z), bflo(xb.w), bfhi(xb.w)}; }
                    else { acc[ai][bj][m][0] = *(const f32x4*)((const float*)xin + o); acc[ai][bj][m][1] = *(const f32x4*)((const float*)xin + o + 4); } }
    }
    __device__ __forceinline__ void ep(const f32x4 (&acc)[2][2][4][2], const Unit& u, int wr, int wc, int fr, int fq, bool pre) const {
        const int row0 = u.pm * BM + wr * 64 + fr, col0 = u.pn * BM + wc * 32 + 8 * fq;
        if (pre) {
#pragma unroll
            for (int ai = 0; ai < 2; ++ai)
#pragma unroll
                for (int m = 0; m < 4; ++m)
#pragma unroll
                    for (int bj = 0; bj < 2; ++bj) { const size_t o = (size_t)(row0 + ai * HALF + m * 16) * D + col0 + bj * HALF; const f32x4 v0 = acc[ai][bj][m][0], v1 = acc[ai][bj][m][1];
                        u32x4 w; w.x = pk2(v0.x, v0.y); w.y = pk2(v0.z, v0.w); w.z = pk2(v1.x, v1.y); w.w = pk2(v1.z, v1.w); *(u32x4*)(out + o) = w; }
            return;
        }
#pragma unroll
        for (int ai = 0; ai < 2; ++ai) {
            f32x4 x0[4][2], x1[4][2];
#pragma unroll
            for (int m = 0; m < 4; ++m)
#pragma unroll
                for (int bj = 0; bj < 2; ++bj) { const size_t o = (size_t)(row0 + ai * HALF + m * 16) * D + col0 + bj * HALF;
                    if (XBF) { const u32x4 xb = *(const u32x4*)((const bf16*)xin + o); x0[m][bj] = (f32x4){bflo(xb.x), bfhi(xb.x), bflo(xb.y), bfhi(xb.y)}; x1[m][bj] = (f32x4){bflo(xb.z), bfhi(xb.z), bflo(xb.w), bfhi(xb.w)}; }
                    else { x0[m][bj] = *(const f32x4*)((const float*)xin + o); x1[m][bj] = *(const f32x4*)((const float*)xin + o + 4); } }
#pragma unroll
            for (int m = 0; m < 4; ++m)
#pragma unroll
                for (int bj = 0; bj < 2; ++bj) { const size_t o = (size_t)(row0 + ai * HALF + m * 16) * D + col0 + bj * HALF;
                    const f32x4 v0 = x0[m][bj] + acc[ai][bj][m][0], v1 = x1[m][bj] + acc[ai][bj][m][1];
                    u32x4 w; w.x = pk2(v0.x, v0.y); w.y = pk2(v0.z, v0.w); w.z = pk2(v1.x, v1.y); w.w = pk2(v1.z, v1.w); *(u32x4*)(out + o) = w; }
        }
    } };
struct EpiStoreU {
    static constexpr bool PERM = true, DEFER_PUB = false, INIT_ACC = false;
    bf16* O; int ldc; bf16* ug;
    __device__ __forceinline__ void operator()(const f32x4 (&acc)[2][2][4][2], const Unit& u, int wr, int wc, int fr, int fq) const {
        const int row0 = u.pm * BM + wr * 64 + fr, col0 = u.pn * BM + wc * 32 + 8 * fq;
#pragma unroll
        for (int ai = 0; ai < 2; ++ai)
#pragma unroll
            for (int m = 0; m < 4; ++m) { const int t = row0 + ai * HALF + m * 16; bf16* rowp = O + (size_t)t * ldc + col0;
#pragma unroll
                for (int bj = 0; bj < 2; ++bj) { const f32x4 v0 = acc[ai][bj][m][0], v1 = acc[ai][bj][m][1];
                    u32x4 w; w.x = pk2(v0.x, v0.y); w.y = pk2(v0.z, v0.w); w.z = pk2(v1.x, v1.y); w.w = pk2(v1.z, v1.w); *(u32x4*)(rowp + bj * HALF) = w;
                    if (u.pn == 0) { const int g = 8 * bj + 2 * wc + (fq >> 1); *(u32x4*)(ug + ((size_t)g * NR5 + (t >> 5)) * 640 + (t & 31) * 16 + 8 * (fq & 1)) = w; } } }
    } };
struct EpiS5OutG {
    static constexpr bool PERM = false, DEFER_PUB = false, INIT_ACC = false;
    const bf16* proj; bf16* ypre; const float* dsk; int g; int nch5, c_s5u, nproj;
    __device__ __forceinline__ void operator()(const f32x4 (&acc)[2][2][4][2], const Unit& u, int wr, int wc, int fr, int fq) const {
        const f32x4 d = *(const f32x4*)(dsk + g * 16 + 4 * fq);
#pragma unroll
        for (int ai = 0; ai < 2; ++ai) {
            u32x2 uu[4][2][2];
#pragma unroll
            for (int m = 0; m < 4; ++m) { const int ch = u.pm * BM + ai * HALF + wr * 64 + m * 16 + fr;
#pragma unroll
                for (int bj = 0; bj < 2; ++bj)
#pragma unroll
                    for (int n = 0; n < 2; ++n) { const int tl = u.pn * 16 + bj * 8 + wc * 2 + n; const size_t t = (size_t)(ch < nch5 ? ch : 0) * 32 + tl;
                        uu[m][bj][n] = *(const u32x2*)(proj + t * nproj + c_s5u + g * 16 + 4 * fq); } }
#pragma unroll
            for (int m = 0; m < 4; ++m) { const int ch = u.pm * BM + ai * HALF + wr * 64 + m * 16 + fr;
#pragma unroll
                for (int bj = 0; bj < 2; ++bj)
#pragma unroll
                    for (int n = 0; n < 2; ++n) { const int tl = u.pn * 16 + bj * 8 + wc * 2 + n; const size_t t = (size_t)ch * 32 + tl; const f32x4 v = acc[ai][bj][m][n]; const u32x2 x = uu[m][bj][n];
                        const float y0 = gelu_tanh(v.x + d.x * bflo(x.x)), y1 = gelu_tanh(v.y + d.y * bfhi(x.x)), y2 = gelu_tanh(v.z + d.z * bflo(x.y)), y3 = gelu_tanh(v.w + d.w * bfhi(x.y));
                        u32x2 o; o.x = pk2(y0, y1); o.y = pk2(y2, y3); if (ch < nch5) *(u32x2*)(ypre + t * 256 + g * 16 + 4 * fq) = o; } }
        }
    } };
struct EpiGateUp {
    static constexpr bool PERM = true, DEFER_PUB = false, INIT_ACC = false;
    bf16* act; unsigned act_bytes; unsigned* cnt;
    __device__ __forceinline__ void operator()(const f32x4 (&acc)[2][2][4][2], const Unit& u, int wr, int wc, int fr, int fq) const {
        const int row0 = u.pm * BM + wr * 64 + fr, col0 = u.pn * HALF + wc * 32 + 8 * fq;
#ifndef EMU
        const __amdgpu_buffer_rsrc_t rs = __builtin_amdgcn_make_buffer_rsrc(act, 0, (int)act_bytes, 0x00020000);
#endif
#pragma unroll
        for (int ai = 0; ai < 2; ++ai)
#pragma unroll
            for (int m = 0; m < 4; ++m) { const f32x4 g0 = acc[ai][0][m][0], g1 = acc[ai][0][m][1], u0 = acc[ai][1][m][0], u1 = acc[ai][1][m][1];
                u32x4 w; w.x = pk2(siluf_(g0.x) * u0.x, siluf_(g0.y) * u0.y); w.y = pk2(siluf_(g0.z) * u0.z, siluf_(g0.w) * u0.w);
                w.z = pk2(siluf_(g1.x) * u1.x, siluf_(g1.y) * u1.y); w.w = pk2(siluf_(g1.z) * u1.z, siluf_(g1.w) * u1.w);
                const size_t o = (size_t)(row0 + ai * HALF + m * 16) * 512 + col0;
#ifdef EMU
                *(u32x4*)(act + o) = w;
#else
                __builtin_amdgcn_raw_buffer_store_b128(w, rs, (unsigned)(o * 2), 0, 16);
#endif
            }
        G8_WAIT_V(0); publish(u.pm, fr == 0 && fq == 0);
    }
    __device__ __forceinline__ void publish(int pm, bool leader) const { if (leader) atomicAdd(cnt + pm * 16, 1u); } };
struct MoeOrderDep { static constexpr int A_AUX = 16; int np, G, rank, n3; const li32* pe; size_t astep, estep, bstep; const unsigned* cnt; int wid;
    __device__ __forceinline__ bool next(int i, Unit& u) const {
        const int nwg = np * 4; int Lx;
        if (n3 >= 0) { if (i == 0) Lx = rank; else if (i == 1) { if (rank >= G - n3) return false; Lx = G + rank; } else if (i == 2) { if (rank >= 2 * n3) return false; Lx = 2 * G - n3 + rank; } else return false; }
        else Lx = i * G + rank;
        if (Lx >= nwg) return false;
        { const int q = nwg / 8, r = nwg % 8, xcd = Lx % 8, off = Lx / 8; Lx = (xcd < r ? xcd * (q + 1) : r * (q + 1) + (xcd - r) * q) + off; }
        u.pm = Lx >> 2; u.pn = Lx & 3; u.aoff = (size_t)u.pm * astep; const int e = __builtin_amdgcn_readfirstlane(pe[u.pm]); u.boff = (size_t)e * estep + (size_t)u.pn * bstep;
        if (wid == 0) { unsigned spins = 0; while (ld_agent(cnt + u.pm * 16) < 32u && ++spins < (1u << 22)) __builtin_amdgcn_s_sleep(1); }
        if (i == 0) __syncthreads();
        return true; } };
}

constexpr int CW_DEP = 196608;
constexpr int CW_Q = 131072;
__device__ __forceinline__ int grab_unit(Frame& F, unsigned* ctr) {
    li32* slot = (li32*)(F.lds + MISC_OFF + 128);
    __syncthreads();
    if (F.tid == 0) *slot = (int)atomicAdd(ctr, 1u);
    __syncthreads();
    return *slot;
}
__device__ __forceinline__ void transpose_item(const float* src, int ldsrc, int scol0, int k0, bf16* dst, int K, int drow0, const float* scale, int lane) {
    const int kq = lane >> 3, n2 = lane & 7;
    const float* sp = src + (size_t)(k0 + 8 * kq) * ldsrc + scol0 + 4 * n2;
    f32x4 v[8];
#pragma unroll
    for (int i = 0; i < 8; ++i) v[i] = *(const f32x4*)(sp + (size_t)i * ldsrc);
    if (scale) { const f32x4 s0 = *(const f32x4*)(scale + k0 + 8 * kq), s1 = *(const f32x4*)(scale + k0 + 8 * kq + 4);
        v[0] *= s0.x; v[1] *= s0.y; v[2] *= s0.z; v[3] *= s0.w; v[4] *= s1.x; v[5] *= s1.y; v[6] *= s1.z; v[7] *= s1.w; }
    bf16* dp = dst + (size_t)(drow0 + 4 * n2) * K + k0 + 8 * kq;
#pragma unroll
    for (int j = 0; j < 4; ++j) { u32x4 o; o.x = pk2(v[0][j], v[1][j]); o.y = pk2(v[2][j], v[3][j]); o.z = pk2(v[4][j], v[5][j]); o.w = pk2(v[6][j], v[7][j]);
        *(u32x4*)(dp + (size_t)j * K) = o; }
}
constexpr int CONV_GU_UNITS = 16 * 2 * 256 / 32, CONV_D_UNITS = 16 * 256 / 32;
template <int NI>
__device__ __forceinline__ void transpose_items(const float* src, int ldsrc, int scol0, int k0, bf16* dst, int K, int drow0, int lane) {
    const int kq = lane >> 3, n2 = lane & 7;
    const float* sp = src + (size_t)(k0 + 8 * kq) * ldsrc + scol0 + 4 * n2;
    f32x4 v[NI][8];
#pragma unroll
    for (int i = 0; i < 8; ++i)
#pragma unroll
        for (int q = 0; q < NI; ++q) v[q][i] = *(const f32x4*)(sp + (size_t)i * ldsrc + 32 * q);
    bf16* dp = dst + (size_t)(drow0 + 4 * n2) * K + k0 + 8 * kq;
#pragma unroll
    for (int q = 0; q < NI; ++q)
#pragma unroll
        for (int j = 0; j < 4; ++j) { u32x4 o; o.x = pk2(v[q][0][j], v[q][1][j]); o.y = pk2(v[q][2][j], v[q][3][j]); o.z = pk2(v[q][4][j], v[q][5][j]); o.w = pk2(v[q][6][j], v[q][7][j]);
            *(u32x4*)(dp + (size_t)(32 * q + j) * K) = o; }
}
__device__ __forceinline__ void conv_gu_unit(Frame& F0, int l, int cu) {
    Frame F = F0; LAUNDER(F);
    const int it0 = cu * 32 + F.wave * 4, e = it0 >> 9, up = (it0 >> 8) & 1, r = it0 & 255, kb = r >> 4, nb0 = r & 15;
    const float* src = (up ? F.moe_w_up : F.moe_w_gate) + ((size_t)l * 16 + e) * 1024 * 512;
    const int ff0 = 32 * nb0, drow0 = (ff0 >> 7) * 256 + up * 128;
    transpose_items<4>(src, 512, ff0, 64 * kb, WSP(bf16, WS_WGU) + (size_t)e * 1024 * 1024, 1024, drow0, F.lane);
}
__device__ __forceinline__ void conv_d_unit(Frame& F0, int l, int cu) {
    Frame F = F0; LAUNDER(F);
    const int it0 = cu * 32 + F.wave * 4, e = it0 >> 8, r = it0 & 255, kb = r >> 5, nb0 = r & 31;
    transpose_items<4>(F.moe_w_down + ((size_t)l * 16 + e) * 512 * 1024, 1024, 32 * nb0, 64 * kb, WSP(bf16, WS_WD) + (size_t)e * 1024 * 512, 512, 32 * nb0, F.lane);
}
__device__ __forceinline__ void r1_row(Frame& F, int t, int mode, const LAS f32x4* dw) {
    const int lane = F.lane;
    f32x4 v[4];
    if (mode == 0) { const f32x4* xr = (const f32x4*)(F.x + (size_t)t * D) + lane;
#pragma unroll
        for (int j = 0; j < 4; ++j) v[j] = xr[64 * j]; }
    else { const u32x2* xr = (const u32x2*)(WSP(bf16, WS_XRES) + (size_t)t * D) + lane;
#pragma unroll
        for (int j = 0; j < 4; ++j) { const u32x2 xb = xr[64 * j]; v[j] = (f32x4){bflo(xb.x), bfhi(xb.x), bflo(xb.y), bfhi(xb.y)}; } }
    if (mode != 0) {
        const int* rt = WSP(int, WS_ROUTE) + ((size_t)(mode == 2 ? L : 0) + t) * 8; const float* rtf = (const float*)rt;
        const bf16* ym = WSP(bf16, WS_H2G);
#pragma unroll
        for (int k = 0; k < 2; ++k) { const int slot = rt[6 + k]; const float w = rtf[4 + k];
            const u32x2* yr = (const u32x2*)(ym + (size_t)slot * 1024) + lane;
#pragma unroll
            for (int j = 0; j < 4; ++j) { const u32x2 y = yr[64 * j]; v[j].x += w * bflo(y.x); v[j].y += w * bfhi(y.x); v[j].z += w * bflo(y.y); v[j].w += w * bfhi(y.y); } }
    }
    float ss = 0.f;
#pragma unroll
    for (int j = 0; j < 4; ++j) ss += (v[j].x * v[j].x + v[j].y * v[j].y) + (v[j].z * v[j].z + v[j].w * v[j].w);
    const float rstd = frsq(wave_sum(ss) * (1.0f / D) + EPS);
    if (mode == 2) {
        f32x4* o = (f32x4*)(F.out + (size_t)t * D) + lane; const f32x4* g = (const f32x4*)F.final_norm_g + lane;
#pragma unroll
        for (int j = 0; j < 4; ++j) o[64 * j] = v[j] * rstd * g[64 * j];
        return;
    }
    if (mode == 1) { u32x2* o = (u32x2*)((bf16*)F.out + (size_t)t * D) + lane;
#pragma unroll
        for (int j = 0; j < 4; ++j) { u32x2 w; w.x = pk2(v[j].x, v[j].y); w.y = pk2(v[j].z, v[j].w); o[64 * j] = w; } }
    u32x2* hb = (u32x2*)(WSP(bf16, WS_ACT) + (size_t)t * D) + lane;
    f32x4 da = (f32x4){0.f, 0.f, 0.f, 0.f};
#pragma unroll
    for (int j = 0; j < 4; ++j) { const f32x4 h = v[j] * rstd; u32x2 w; w.x = pk2(h.x, h.y); w.y = pk2(h.z, h.w); hb[64 * j] = w;
        const int k = 4 * lane + 256 * j; da += h.x * dw[k] + h.y * dw[k + 1] + h.z * dw[k + 2] + h.w * dw[k + 3]; }
    da.x = wave_sum(da.x); da.y = wave_sum(da.y); da.z = wave_sum(da.z); da.w = wave_sum(da.w);
    if (lane == 0) *(f32x4*)(WSP(float, WS_DTRAW) + (size_t)t * 4) = da;
}

__device__ __forceinline__ void r1_phase(Frame& F, int mode, int l) {
    LAS f32x4* dw = (LAS f32x4*)F.lds;
    if (mode != 2) { for (int k = F.tid; k < 1024; k += NTHREADS) { const float g = F.norm1_g[l * 1024 + k]; dw[k] = g * *(const f32x4*)(F.w_in + ((size_t)l * 1024 + k) * DIN + 2304); } }
    __syncthreads();
    const int gw = F.bid * 8 + F.wave, ngw = F.G * 8;
    for (int t = gw; t < L; t += ngw) r1_row(F, t, mode, dw);
}

__device__ __forceinline__ void phase_p0(Frame& F) {
    const int gw = F.bid * 8 + F.wave, ngw = F.G * 8, gt = F.bid * NTHREADS + F.tid, ngt = F.G * NTHREADS;
    {
        constexpr int I_IN = (1024 / 64) * (NPROJ / 32), I_OUT = (1024 / 64) * (1024 / 32), I_GLU = (256 / 64) * (256 / 32);
        constexpr int NIT = 2 * (I_IN + I_OUT + I_GLU);
        for (int it = gw; it < NIT; it += ngw) {
            const int l = it / (I_IN + I_OUT + I_GLU); int r = it % (I_IN + I_OUT + I_GLU);
            if (r < I_IN) { const int kb = r / (NPROJ / 32), nb = r % (NPROJ / 32); const int n0 = 32 * nb, sc0 = n0 < 2304 ? n0 : n0 + 4;
                transpose_item(F.w_in + (size_t)l * 1024 * DIN, DIN, sc0, 64 * kb, WSP(bf16, WS_WIN) + (size_t)l * NPROJ * 1024, 1024, n0, F.norm1_g + l * 1024, F.lane); }
            else if (r < I_IN + I_OUT) { r -= I_IN; const int kb = r / 32, nb = r % 32;
                transpose_item(F.w_out + (size_t)l * 1024 * 1024, 1024, 32 * nb, 64 * kb, WSP(bf16, WS_WOUT) + (size_t)l * 1024 * 1024, 1024, 32 * nb, nullptr, F.lane); }
            else { r -= I_IN + I_OUT; const int kb = r / 8, nb = r % 8;
                transpose_item(F.s5_w_glu + (size_t)l * 65536, 256, 32 * nb, 64 * kb, WSP(bf16, WS_WGLU) + (size_t)l * 65536, 256, 32 * nb, nullptr, F.lane); }
        }
    }
    for (int i = gt; i < 256; i += ngt) {
        const float a = F.hg_lb_logits[i], b = F.hg_lb_logits[256 + i], m = fmaxf(a, b), ea = fexp(a - m), eb = fexp(b - m);
        WSP(float, WS_LB)[i] = 0.f; WSP(float, WS_LB)[256 + i] = eb / (ea + eb); }
    for (int i = gt; i < L * 32; i += ngt) { const int t = i >> 5, j = i & 31;
        const float inv = powf(10000.0f, -(float)j / 32.0f); const float ang = (float)F.pos[t] * inv; double s, c; dsincos((double)ang, s, c);
        *(f32x2*)(WSP(float, WS_ROPE) + (size_t)i * 2) = (f32x2){(float)c, (float)s}; }
    for (int i = gt; i < 2 * 16 * 64 * 34; i += ngt) { const int e = i / 34, d = i % 34, l = e >> 10, g = (e >> 6) & 15;
        const double dt = exp((double)F.s5_log_dt[l * 16 + g]); const double are = fmin((double)F.s5_a_re[e], -1e-4), aim = (double)F.s5_a_im[e];
        const double mag = exp(are * dt * d); double sn, cs; dsincos(aim * dt * d, sn, cs);
        *(f32x2*)(WSP(float, WS_S5AP) + (size_t)e * 68 + 2 * d) = (f32x2){(float)(mag * cs), (float)(mag * sn)}; }
    for (int i = gt; i < 2 * 16 * 64; i += ngt) {
        const int l = i >> 10, g = (i >> 6) & 15;
        const double dt = exp((double)F.s5_log_dt[l * 16 + g]); const double are = fmin((double)F.s5_a_re[i], -1e-4), aim = (double)F.s5_a_im[i];
        const double mag = exp(are * dt); double sn, cs; dsincos(aim * dt, sn, cs); const double abr = mag * cs, abi = mag * sn;
        const double den = are * are + aim * aim;
        const double kre = ((abr - 1.0) * are + abi * aim) / den, kim = (abi * are - (abr - 1.0) * aim) / den;
        float* bb = WSP(float, WS_S5BB) + (size_t)i * 32;
        for (int q = 0; q < 16; ++q) { const double br = F.s5_b_re[(size_t)i * 16 + q], bi = F.s5_b_im[(size_t)i * 16 + q]; bb[2 * q] = (float)(kre * br - kim * bi); bb[2 * q + 1] = (float)(kre * bi + kim * br); }
    }
    __syncthreads();
    r1_phase(F, 0, 0);
}

__device__ __forceinline__ void s5_prep_a(Frame& F, int l, int chunk, int nchunk) {
    const float* AP = WSP(float, WS_S5AP) + (size_t)l * 16 * 64 * 68; const float* BB = WSP(float, WS_S5BB) + (size_t)l * 16 * 64 * 32;
    constexpr int N1 = 16 * 32 * 256, N2 = 16 * 128 * 512;
    if (nchunk == 256 && NTHREADS == 512) {
        const int lo = chunk * 512, g = lo >> 13, d0 = (lo >> 8) & 31;
        LAS f32x2* Cs = (LAS f32x2*)F.lds; LAS f32x2* Bs = Cs + 16 * 65; LAS f32x2* As = Bs + 1024;
        __syncthreads();
#pragma unroll
        for (int k = 0; k < 2; ++k) { const int idx = F.tid + 512 * k; const size_t ci = ((size_t)l * 16 + g) * 1024 + idx;
            Cs[(idx >> 6) * 65 + (idx & 63)] = (f32x2){F.s5_c_re[ci], F.s5_c_im[ci]}; Bs[idx] = *(const f32x2*)(BB + (size_t)g * 64 * 32 + 2 * idx); }
        if (F.tid < 128) As[F.tid] = *(const f32x2*)(AP + ((size_t)g * 64 + (F.tid & 63)) * 68 + 2 * (d0 + (F.tid >> 6)));
        __syncthreads();
        { const int i = lo + F.tid, dd = (F.tid >> 8) & 1, p = (F.tid >> 4) & 15, q = F.tid & 15; float s = 0.f;
#pragma unroll 8
          for (int n = 0; n < 64; ++n) { const f32x2 a = As[dd * 64 + n], b = Bs[n * 16 + q], c = Cs[p * 65 + n];
              const float tr = a.x * b.x - a.y * b.y, ti = a.x * b.y + a.y * b.x; s += c.x * tr - c.y * ti; }
          WSP(float, WS_S5KT)[i] = s; }
        __syncthreads();
    } else
    { const int per = (N1 + nchunk - 1) / nchunk, lo = chunk * per, hi = lo + per < N1 ? lo + per : N1;
      for (int i = lo + F.tid; i < hi; i += NTHREADS) { const int g = i >> 13, d = (i >> 8) & 31, p = (i >> 4) & 15, q = i & 15;
        float s = 0.f;
        for (int n = 0; n < 64; ++n) { const size_t gn = (size_t)g * 64 + n; const float cr = F.s5_c_re[((size_t)l * 16 + g) * 1024 + p * 64 + n], ci = F.s5_c_im[((size_t)l * 16 + g) * 1024 + p * 64 + n];
            const float ar = AP[gn * 68 + 2 * d], ai = AP[gn * 68 + 2 * d + 1], br = BB[gn * 32 + 2 * q], bi = BB[gn * 32 + 2 * q + 1];
            const float tr = ar * br - ai * bi, ti = ar * bi + ai * br; s += cr * tr - ci * ti; }
        WSP(float, WS_S5KT)[i] = s; } }
    if (nchunk == 256 && NTHREADS == 512) {
        const int i0 = chunk * 4096 + 8 * F.tid, g = i0 >> 16, m = (i0 >> 9) & 127, k0 = i0 & 511, n = m >> 1, j = k0 >> 4, q0 = k0 & 15; const size_t gn = (size_t)g * 64 + n;
        const f32x2 a = *(const f32x2*)(AP + gn * 68 + 2 * (31 - j)); const f32x4* bp = (const f32x4*)(BB + gn * 32 + 2 * q0);
        const f32x4 b0 = bp[0], b1 = bp[1], b2 = bp[2], b3 = bp[3]; const bool im = m & 1;
#define BINC_V(br, bi) (im ? (a.x * (bi) + a.y * (br)) : (a.x * (br) - a.y * (bi)))
        u32x4 o; o.x = pk2(BINC_V(b0.x, b0.y), BINC_V(b0.z, b0.w)); o.y = pk2(BINC_V(b1.x, b1.y), BINC_V(b1.z, b1.w)); o.z = pk2(BINC_V(b2.x, b2.y), BINC_V(b2.z, b2.w)); o.w = pk2(BINC_V(b3.x, b3.y), BINC_V(b3.z, b3.w));
#undef BINC_V
        *(u32x4*)(WSP(bf16, WS_S5BI) + i0) = o;
    } else
    { const int per = (N2 + nchunk - 1) / nchunk, lo = chunk * per, hi = lo + per < N2 ? lo + per : N2;
      for (int i = lo + F.tid; i < hi; i += NTHREADS) { const int g = i >> 16, m = (i >> 9) & 127, k = i & 511, n = m >> 1, j = k >> 4, q = k & 15; const size_t gn = (size_t)g * 64 + n;
        const float ar = AP[gn * 68 + 2 * (31 - j)], ai = AP[gn * 68 + 2 * (31 - j) + 1], br = BB[gn * 32 + 2 * q], bi = BB[gn * 32 + 2 * q + 1];
        WSP(bf16, WS_S5BI)[i] = (bf16)f2bf((m & 1) ? (ar * bi + ai * br) : (ar * br - ai * bi)); } }
}
__device__ __forceinline__ void s5_prep_b(Frame& F, int l, int chunk, int nchunk) {
    const float* AP = WSP(float, WS_S5AP) + (size_t)l * 16 * 64 * 68; const float* KT = WSP(float, WS_S5KT);
    constexpr int N = 16 * 512 * 640; const int per = (N + nchunk - 1) / nchunk, lo = chunk * per, hi = lo + per < N ? lo + per : N;
    if (nchunk == 256 && NTHREADS == 512) {
#pragma unroll 1
        for (int it = 0; it < 5; ++it) { const int i0 = chunk * 20480 + 8 * (F.tid + 512 * it);
            const int g = i0 / (512 * 640), r = i0 % (512 * 640), np = r / 640, k0 = r % 640, tl = np >> 4, p = np & 15;
            u32x4 o = (u32x4){0u, 0u, 0u, 0u};
            if (k0 < 512) { const int j = k0 >> 4, q0 = k0 & 15;
                if (tl >= j) { const f32x4* kp = (const f32x4*)(KT + (((size_t)g * 32 + (tl - j)) * 16 + p) * 16 + q0); const f32x4 x0 = kp[0], x1 = kp[1];
                    o.x = pk2(x0.x, x0.y); o.y = pk2(x0.z, x0.w); o.z = pk2(x1.x, x1.y); o.w = pk2(x1.z, x1.w); } }
            else { const int n0 = (k0 - 512) >> 1; const size_t cb = ((size_t)l * 16 + g) * 1024 + p * 64 + n0;
                const f32x4 cr = *(const f32x4*)(F.s5_c_re + cb), ci = *(const f32x4*)(F.s5_c_im + cb); const float* ap = AP + ((size_t)g * 64 + n0) * 68 + 2 * (tl + 1);
                const f32x2 a0 = *(const f32x2*)ap, a1 = *(const f32x2*)(ap + 68), a2 = *(const f32x2*)(ap + 136), a3 = *(const f32x2*)(ap + 204);
                o.x = pk2(cr.x * a0.x - ci.x * a0.y, -(cr.x * a0.y + ci.x * a0.x)); o.y = pk2(cr.y * a1.x - ci.y * a1.y, -(cr.y * a1.y + ci.y * a1.x));
                o.z = pk2(cr.z * a2.x - ci.z * a2.y, -(cr.z * a2.y + ci.z * a2.x)); o.w = pk2(cr.w * a3.x - ci.w * a3.y, -(cr.w * a3.y + ci.w * a3.x)); }
            *(u32x4*)(WSP(bf16, WS_S5MT) + i0) = o; }
        return;
    }
    for (int i = lo + F.tid; i < hi; i += NTHREADS) { const int g = i / (512 * 640), r = i % (512 * 640), np = r / 640, k = r % 640, tl = np >> 4, p = np & 15;
        float v;
        if (k < 512) { const int j = k >> 4, q = k & 15; v = tl >= j ? KT[(((size_t)g * 32 + (tl - j)) * 16 + p) * 16 + q] : 0.f; }
        else { const int n = (k - 512) >> 1; const size_t gn = (size_t)g * 64 + n; const float cr = F.s5_c_re[((size_t)l * 16 + g) * 1024 + p * 64 + n], ci = F.s5_c_im[((size_t)l * 16 + g) * 1024 + p * 64 + n];
            const float ar = AP[gn * 68 + 2 * (tl + 1)], ai = AP[gn * 68 + 2 * (tl + 1) + 1]; v = (k & 1) ? -(cr * ai + ci * ar) : (cr * ar - ci * ai); }
        WSP(bf16, WS_S5MT)[i] = (bf16)f2bf(v); }
}

struct EpiBf16Store { static constexpr bool HAS_PRE = false; bf16* O; size_t ld; int r0, c0;
    __device__ __forceinline__ void operator()(int r, int c, f32x4 v) const { u32x2 w; w.x = pk2(v.x, v.y); w.y = pk2(v.z, v.w); *(u32x2*)(O + (size_t)(r0 + r) * ld + c0 + c) = w; } };
__device__ __forceinline__ void phase_g1(Frame& F, int l) {
    g8::GridOrder S{L / 256, NPROJ / 256 - 1, (L / 256) * (NPROJ / 256 - 1), F.G, F.bid, (size_t)256 * 1024 * 2, (size_t)256 * 1024 * 2};
    g8::EpiStoreU E{WSP(bf16, WS_BIG), NPROJ, WSP(bf16, WS_S5UG)};
    g8::gemm_phase(F.lds, WSP(bf16, WS_ACT), WSP(bf16, WS_WIN) + (size_t)l * NPROJ * 1024, 1024, S, E);
    if (l == 0) { unsigned* ctr = WSP(unsigned, WS_CTL) + CW_Q + 64 * 4 + 32 * F.rep;
      for (int u = grab_unit(F, ctr); u < 256; u = grab_unit(F, ctr)) s5_prep_a(F, 0, u, 256); }
}

constexpr int LD64 = 72, LD128 = 136;
template <bool HAS_DST, bool HAS_DSTT>
__device__ __forceinline__ void stage_rot(Frame& F, const bf16* proj, int t0, int col0, float scale, lbf* dst  , lbf* dstT  , const lf32* tscale  ) {
    const int t = F.tid >> 2, ib = (F.tid & 3) * 8;
    const bf16* row = proj + (size_t)(t0 + t) * NPROJ + col0;
    const u32x4 a = *(const u32x4*)(row + ib), b = *(const u32x4*)(row + 32 + ib);
    const f32x4* cs4 = (const f32x4*)(WSP(float, WS_ROPE) + ((size_t)(t0 + t) * 32 + ib) * 2);
    const f32x4 r0 = cs4[0], r1 = cs4[1], r2 = cs4[2], r3 = cs4[3];
    const float cs[16] = {r0.x, r0.y, r0.z, r0.w, r1.x, r1.y, r1.z, r1.w, r2.x, r2.y, r2.z, r2.w, r3.x, r3.y, r3.z, r3.w};
    float o1[8], o2[8];
    const unsigned aw[4] = {a.x, a.y, a.z, a.w}, bw[4] = {b.x, b.y, b.z, b.w};
#pragma unroll
    for (int j = 0; j < 8; ++j) { const float q1 = (j & 1) ? bfhi(aw[j >> 1]) : bflo(aw[j >> 1]), q2 = (j & 1) ? bfhi(bw[j >> 1]) : bflo(bw[j >> 1]); const float c = cs[2 * j], s = cs[2 * j + 1];
        o1[j] = (q1 * c - q2 * s) * scale; o2[j] = (q2 * c + q1 * s) * scale;
        }
    if (HAS_DST) { u32x4 w1, w2; w1.x = pk2(o1[0], o1[1]); w1.y = pk2(o1[2], o1[3]); w1.z = pk2(o1[4], o1[5]); w1.w = pk2(o1[6], o1[7]); w2.x = pk2(o2[0], o2[1]); w2.y = pk2(o2[2], o2[3]); w2.z = pk2(o2[4], o2[5]); w2.w = pk2(o2[6], o2[7]);
        *(LAS u32x4*)(dst + t * LD64 + ib) = w1; *(LAS u32x4*)(dst + t * LD64 + 32 + ib) = w2; }
    if (HAS_DSTT) { const float ts = tscale[t];
#pragma unroll
        for (int j = 0; j < 8; ++j) { dstT[(ib + j) * LD128 + t] = (bf16)f2bf(o1[j] * ts); dstT[(32 + ib + j) * LD128 + t] = (bf16)f2bf(o2[j] * ts); } }
}
__device__ __forceinline__ void hg_logf_cumsum_r(Frame& F, const u32x4 (&rf)[2], const float (&lb)[16], lf32* bL, lf32* tot) {
    { const int t = F.tid >> 2, dq = (F.tid & 3) * 16;
#pragma unroll
      for (int hh = 0; hh < 2; ++hh) { const unsigned aw[4] = {rf[hh].x, rf[hh].y, rf[hh].z, rf[hh].w}; float lf[8];
#pragma unroll
          for (int j = 0; j < 8; ++j) { const float x = (j & 1) ? bfhi(aw[j >> 1]) : bflo(aw[j >> 1]); const float b = lb[8 * hh + j]; lf[j] = flog(b + (1.0f - b) * sigmoidf_(x)); }
          *(LAS f32x4*)(bL + t * 64 + dq + 8 * hh) = (f32x4){lf[0], lf[1], lf[2], lf[3]}; *(LAS f32x4*)(bL + t * 64 + dq + 8 * hh + 4) = (f32x4){lf[4], lf[5], lf[6], lf[7]}; } }
    __syncthreads();
    const int d = F.tid & 63, sg = F.tid >> 6;
    { float run = 0.f;
#pragma unroll
      for (int j = 0; j < 16; ++j) { run += bL[(sg * 16 + j) * 64 + d]; bL[(sg * 16 + j) * 64 + d] = run; }
      tot[sg * 64 + d] = run; }
    __syncthreads();
    { float off = 0.f; for (int g = 0; g < sg; ++g) off += tot[g * 64 + d];
#pragma unroll
      for (int j = 0; j < 16; ++j) bL[(sg * 16 + j) * 64 + d] += off; }
    __syncthreads();
}
__device__ __forceinline__ void stage_T64(Frame& F, const bf16* proj, int t0, int col0, lbf* dstT) {
#pragma unroll
    for (int i = 0; i < 2; ++i) { const int p = F.tid + 512 * i, s = p >> 3, eb = (p & 7) * 8;
        const u32x4 a = *(const u32x4*)(proj + (size_t)(t0 + s) * NPROJ + col0 + eb); const unsigned aw[4] = {a.x, a.y, a.z, a.w};
#pragma unroll
        for (int j = 0; j < 8; ++j) dstT[(eb + j) * LD128 + s] = (bf16)((j & 1) ? (aw[j >> 1] >> 16) : (aw[j >> 1] & 0xffffu)); }
}

__device__ __forceinline__ float ret_log2gamma(int h) { return log2f(1.0f - exp2f(-5.0f - (float)h)); }
__device__ __forceinline__ void ret_state_unit(Frame& F0, int c, int h) {
    Frame F = F0; LAUNDER(F);
    lbf* VT = (lbf*)F.lds; lbf* KT = VT + 64 * LD128; lf32* zeta = (lf32*)(KT + 64 * LD128);
    const bf16* proj = WSP(bf16, WS_BIG); const int t0 = c * CH; const float lg = ret_log2gamma(h);
    __syncthreads();
    if (F.tid < 128) zeta[F.tid] = fexp2((float)(CH - 1 - F.tid) * lg);
    __syncthreads();
    stage_T64(F, proj, t0, C_RV + h * 64, VT);
    stage_rot<false, true>(F, proj, t0, C_RK + h * 64, 0.125f, KT, KT, zeta);
    __syncthreads();
    f32x4 acc[2] = {(f32x4){0, 0, 0, 0}, (f32x4){0, 0, 0, 0}};
    const int w = F.wave;
    wave_mma<2, 4>(acc, VT + 16 * (w >> 1) * LD128, LD128, KT + 32 * (w & 1) * LD128, LD128, F.lane);
    float* st = WSP(float, WS_ST_RET) + ((size_t)c * 4 + h) * 4096;
    const int e = 16 * (w >> 1) + (F.lane & 15);
#pragma unroll
    for (int n = 0; n < 2; ++n) *(f32x4*)(st + e * 64 + 32 * (w & 1) + 16 * n + 4 * (F.lane >> 4)) = acc[n];
}
__device__ __forceinline__ void ret_out_unit(Frame& F0, int c, int h) {
    Frame F = F0; LAUNDER(F);
    lbf* Q = (lbf*)F.lds; lbf* K = Q + 128 * LD64; lbf* VT = K + 128 * LD64; lbf* RT = VT + 64 * LD128; lbf* P = RT + 64 * LD64;
    const bf16* proj = WSP(bf16, WS_BIG); const int t0 = c * CH; const float lg = ret_log2gamma(h);
    const int w = F.wave, lane = F.lane, fr = lane & 15, fq = lane >> 4;
    __syncthreads();
    stage_rot<true, false>(F, proj, t0, C_RQ + h * 64, 1.0f, Q, Q, (const lf32*)Q);
    stage_rot<true, false>(F, proj, t0, C_RK + h * 64, 0.125f, K, K, (const lf32*)K);
    stage_T64(F, proj, t0, C_RV + h * 64, VT);
    { const float* st = WSP(float, WS_ST_RET) + ((size_t)c * 4 + h) * 4096 + F.tid * 8; const f32x4 a = *(const f32x4*)st, b = *(const f32x4*)(st + 4);
      u32x4 o; o.x = pk2(a.x, a.y); o.y = pk2(a.z, a.w); o.z = pk2(b.x, b.y); o.w = pk2(b.z, b.w); *(LAS u32x4*)(RT + (F.tid >> 3) * LD64 + (F.tid & 7) * 8) = o; }
    __syncthreads();
    f32x4 sc[8];
#pragma unroll
    for (int n = 0; n < 8; ++n) sc[n] = (f32x4){0, 0, 0, 0};
    wave_mma<8, 2>(sc, Q + 16 * w * LD64, LD64, K, LD64, lane);
    lbf* Pw = P + w * 16 * LD128;
    const int tl = 16 * w + fr;
#pragma unroll
    for (int n = 0; n < 8; ++n) { float pv[4];
#pragma unroll
        for (int j = 0; j < 4; ++j) { const int s = 16 * n + 4 * fq + j; pv[j] = (s <= tl) ? sc[n][j] * fexp2((float)(tl - s) * lg) : 0.f; }
        u32x2 o; o.x = pk2(pv[0], pv[1]); o.y = pk2(pv[2], pv[3]); *(LAS u32x2*)(Pw + fr * LD128 + 16 * n + 4 * fq) = o; }
    __syncthreads();
    f32x4 oi[4], ox[4];
#pragma unroll
    for (int n = 0; n < 4; ++n) { oi[n] = (f32x4){0, 0, 0, 0}; ox[n] = (f32x4){0, 0, 0, 0}; }
    wave_mma<4, 4>(oi, Pw, LD128, VT, LD128, lane);
    wave_mma<4, 2>(ox, Q + 16 * w * LD64, LD64, RT, LD64, lane);
    const float xi = fexp2((float)(tl + 1) * lg);
    float s1 = 0.f;
#pragma unroll
    for (int n = 0; n < 4; ++n) {
        oi[n] = oi[n] + xi * ox[n];
        s1 += (oi[n].x + oi[n].y) + (oi[n].z + oi[n].w); }
    s1 += __shfl_xor(s1, 16); s1 += __shfl_xor(s1, 32);
    const float mean = s1 * (1.0f / 64.0f); float s2 = 0.f;
#pragma unroll
    for (int n = 0; n < 4; ++n) { oi[n] = oi[n] - mean; s2 += (oi[n].x * oi[n].x + oi[n].y * oi[n].y) + (oi[n].z * oi[n].z + oi[n].w * oi[n].w); }
    s2 += __shfl_xor(s2, 16); s2 += __shfl_xor(s2, 32);
    const float rstd = frsq(s2 * (1.0f / 64.0f) + EPS);
    const int t = t0 + tl; bf16* y = WSP(bf16, WS_ACT) + (size_t)t * 1024 + Y_RET + h * 64;
    const bf16* gp = proj + (size_t)t * NPROJ + C_RG + h * 64;
#pragma unroll
    for (int n = 0; n < 4; ++n) { const int e = 16 * n + 4 * fq; const u32x2 g = *(const u32x2*)(gp + e);
        const f32x4 v = oi[n] * rstd; u32x2 o; o.x = pk2(v.x * siluf_(bflo(g.x)), v.y * siluf_(bfhi(g.x))); o.y = pk2(v.z * siluf_(bflo(g.y)), v.w * siluf_(bfhi(g.y))); *(u32x2*)(y + e) = o; }
}

__device__ __forceinline__ void m2_conv8(Frame& F, int l, const bf16* proj, int t, int cc  , float (&o)[8]) {
    const float* cw = F.m2_conv_w + (size_t)l * 4 * 768 + cc; const float* cb = F.m2_conv_b + (size_t)l * 768 + cc;
#pragma unroll
    for (int j = 0; j < 8; ++j) o[j] = cb[j];
#pragma unroll
    for (int q = 0; q < 4; ++q) { const int ts = t - 3 + q; if (ts >= 0) { const u32x4 a = *(const u32x4*)(proj + (size_t)ts * NPROJ + C_MX + cc); const unsigned aw[4] = {a.x, a.y, a.z, a.w};
#pragma unroll
        for (int j = 0; j < 8; ++j) o[j] += cw[q * 768 + j] * ((j & 1) ? bfhi(aw[j >> 1]) : bflo(aw[j >> 1])); } }
#pragma unroll
    for (int j = 0; j < 8; ++j) o[j] = siluf_(o[j]);
}
__device__ __forceinline__ void m2_dt_acum(Frame& F, int l, int c, lf32* dts, lf32* acs) {
    const int h = F.tid >> 7, t = F.tid & 127, lane = F.lane; const float x = WSP(float, WS_DTRAW)[(size_t)(c * CH + t) * 4 + h] + F.m2_dt_bias[l * 4 + h];
    const float dt = x > 20.f ? x : log1pf(fexp(x)); dts[h * 128 + t] = dt;
    float a = -fexp(F.m2_a_log[l * 4 + h]) * dt;
#pragma unroll
    for (int off = 1; off < 64; off <<= 1) { const float o = __shfl(a, lane - off); if (lane >= off) a += o; }
    acs[h * 128 + t] = a;
    __syncthreads();
    if (t >= 64) acs[h * 128 + t] = a + acs[h * 128 + 63];
    __syncthreads();
}
__device__ __forceinline__ void m2_state_unit(Frame& F0, int l, int c, int g) {
    Frame F = F0; LAUNDER(F);
    lbf* XT = (lbf*)F.lds; lbf* BT = XT + 64 * LD128; lf32* dts = (lf32*)(BT + 128 * LD128); lf32* acs = dts + 512;
    const bf16* proj = WSP(bf16, WS_BIG); bf16* xbc = XBC_PTR(F); const int t0 = c * CH;
    __syncthreads();
    m2_dt_acum(F, l, c, dts, acs);
#pragma unroll 1
    for (int i = 0; i < 4; ++i) { const int p = F.tid + 512 * i, s = p >> 4, nb = (p & 15) * 8; float o[8];
        m2_conv8(F, l, proj, t0 + s, 256 + g * 128 + nb, o);
        u32x4 wv; wv.x = pk2(o[0], o[1]); wv.y = pk2(o[2], o[3]); wv.z = pk2(o[4], o[5]); wv.w = pk2(o[6], o[7]); *(u32x4*)(xbc + (size_t)(t0 + s) * 768 + 256 + g * 128 + nb) = wv;
#pragma unroll
        for (int j = 0; j < 8; ++j) BT[(nb + j) * LD128 + s] = (bf16)f2bf(o[j]);
        m2_conv8(F, l, proj, t0 + s, 512 + g * 128 + nb, o);
        wv.x = pk2(o[0], o[1]); wv.y = pk2(o[2], o[3]); wv.z = pk2(o[4], o[5]); wv.w = pk2(o[6], o[7]); *(u32x4*)(xbc + (size_t)(t0 + s) * 768 + 512 + g * 128 + nb) = wv; }
#pragma unroll 1
    for (int hh = 0; hh < 2; ++hh) { const int h = 2 * g + hh;
        const float alast = acs[h * 128 + 127];
#pragma unroll 1
        for (int i = 0; i < 2; ++i) { const int p = F.tid + 512 * i, s = p >> 3, eb = (p & 7) * 8; float o[8]; m2_conv8(F, l, proj, t0 + s, h * 64 + eb, o);
            u32x4 wv; wv.x = pk2(o[0], o[1]); wv.y = pk2(o[2], o[3]); wv.z = pk2(o[4], o[5]); wv.w = pk2(o[6], o[7]); *(u32x4*)(xbc + (size_t)(t0 + s) * 768 + h * 64 + eb) = wv;
            const float sc = dts[h * 128 + s] * fexp(alast - acs[h * 128 + s]);
#pragma unroll
            for (int j = 0; j < 8; ++j) XT[(eb + j) * LD128 + s] = (bf16)f2bf(o[j] * sc); }
        __syncthreads();
        f32x4 acc[4];
#pragma unroll
        for (int n = 0; n < 4; ++n) acc[n] = (f32x4){0, 0, 0, 0};
        const int w = F.wave;
        wave_mma<4, 4>(acc, XT + 16 * (w >> 1) * LD128, LD128, BT + 64 * (w & 1) * LD128, LD128, F.lane);
        float* st = WSP(float, WS_ST_M2) + ((size_t)c * 4 + h) * 8192; const int pr = 16 * (w >> 1) + (F.lane & 15);
#pragma unroll
        for (int n = 0; n < 4; ++n) *(f32x4*)(st + pr * 128 + 64 * (w & 1) + 16 * n + 4 * (F.lane >> 4)) = acc[n];
        if (F.tid == 0) WSP(float, WS_DEC_M2)[c * 4 + h] = fexp(alast);
        __syncthreads();
    }
}
__device__ __forceinline__ void m2_out_unit(Frame& F0, int l, int c) {
    Frame F = F0; LAUNDER(F);
    lbf* Cm = (lbf*)F.lds; lbf* Bm = Cm + 128 * LD128; lbf* XT = Bm + 128 * LD128; lbf* ST = XT + 64 * LD128; lf32* dts = (lf32*)(ST + 64 * LD128); lf32* acs = dts + 512;
    lbf* P = Bm;
    const bf16* proj = WSP(bf16, WS_BIG); const bf16* xbc = XBC_PTR(F); const int t0 = c * CH;
    const int w = F.wave, lane = F.lane, fr = lane & 15, fq = lane >> 4, tl = 16 * w + fr;
    u32x4 rC[4], rB[4], rX[2]; f32x4 rSa[2], rSb[2];
#define M2O_LD_CB(g_) do { _Pragma("unroll") for (int i = 0; i < 4; ++i) { const int p = F.tid + 512 * i, s = p >> 4, nb = (p & 15) * 8; const bf16* xr = xbc + (size_t)(t0 + s) * 768 + (g_) * 128 + nb; \
        rC[i] = *(const u32x4*)(xr + 512); rB[i] = *(const u32x4*)(xr + 256); } } while (0)
#define M2O_LD_XS(h_) do { const float* st_ = WSP(float, WS_ST_M2) + ((size_t)c * 4 + (h_)) * 8192; _Pragma("unroll") for (int i = 0; i < 2; ++i) { const int p = F.tid + 512 * i, s = p >> 3, eb = (p & 7) * 8; \
        rX[i] = *(const u32x4*)(xbc + (size_t)(t0 + s) * 768 + (h_) * 64 + eb); rSa[i] = *(const f32x4*)(st_ + p * 8); rSb[i] = *(const f32x4*)(st_ + p * 8 + 4); } } while (0)
    __syncthreads();
    M2O_LD_CB(0);
    m2_dt_acum(F, l, c, dts, acs);
    float ss = 0.f;
    bf16* yrow = WSP(bf16, WS_ACT) + (size_t)(t0 + tl) * 1024 + Y_M2;
#pragma unroll 1
    for (int g = 0; g < 2; ++g) {
        __syncthreads();
#pragma unroll
        for (int i = 0; i < 4; ++i) { const int p = F.tid + 512 * i, s = p >> 4, nb = (p & 15) * 8; *(LAS u32x4*)(Cm + s * LD128 + nb) = rC[i]; *(LAS u32x4*)(Bm + s * LD128 + nb) = rB[i]; }
        M2O_LD_XS(2 * g);
        __syncthreads();
        f32x4 sc[8];
#pragma unroll
        for (int n = 0; n < 8; ++n) sc[n] = (f32x4){0, 0, 0, 0};
        wave_mma<8, 4>(sc, Cm + 16 * w * LD128, LD128, Bm, LD128, lane);
#pragma unroll 1
        for (int hh = 0; hh < 2; ++hh) { const int h = 2 * g + hh;
            __syncthreads();
#pragma unroll
            for (int i = 0; i < 2; ++i) { const int p = F.tid + 512 * i, s = p >> 3, eb = (p & 7) * 8; const unsigned aw[4] = {rX[i].x, rX[i].y, rX[i].z, rX[i].w};
#pragma unroll
                for (int j = 0; j < 8; ++j) XT[(eb + j) * LD128 + s] = (bf16)((j & 1) ? (aw[j >> 1] >> 16) : (aw[j >> 1] & 0xffffu));
                u32x4 o; o.x = pk2(rSa[i].x, rSa[i].y); o.y = pk2(rSa[i].z, rSa[i].w); o.z = pk2(rSb[i].x, rSb[i].y); o.w = pk2(rSb[i].z, rSb[i].w); *(LAS u32x4*)(ST + (p >> 4) * LD128 + (p & 15) * 8) = o; }
            const bf16* zp = proj + (size_t)(t0 + tl) * NPROJ + C_MZ + h * 64;
            u32x2 zr[4];
#pragma unroll
            for (int n = 0; n < 4; ++n) zr[n] = *(const u32x2*)(zp + 16 * n + 4 * fq);
            if (hh == 0) M2O_LD_XS(h + 1); else if (g == 0) M2O_LD_CB(1);
            const float at = acs[h * 128 + tl];
            lbf* Pw = P + w * 16 * LD128;
#pragma unroll
            for (int n = 0; n < 8; ++n) { float pv[4];
#pragma unroll
                for (int j = 0; j < 4; ++j) { const int s = 16 * n + 4 * fq + j; pv[j] = (s <= tl) ? sc[n][j] * fexp(at - acs[h * 128 + s]) * dts[h * 128 + s] : 0.f; }
                u32x2 o; o.x = pk2(pv[0], pv[1]); o.y = pk2(pv[2], pv[3]); *(LAS u32x2*)(Pw + fr * LD128 + 16 * n + 4 * fq) = o; CFENCE(); }
            __syncthreads();
            f32x4 yi[4], yx[4];
#pragma unroll
            for (int n = 0; n < 4; ++n) { yi[n] = (f32x4){0, 0, 0, 0}; yx[n] = (f32x4){0, 0, 0, 0}; }
            wave_mma<4, 4>(yi, Pw, LD128, XT, LD128, lane);
            wave_mma<4, 4>(yx, Cm + 16 * w * LD128, LD128, ST, LD128, lane);
            const float ea = fexp(at), dsk = F.m2_d[l * 4 + h];
#pragma unroll
            for (int n = 0; n < 4; ++n) { const int p0 = 16 * n + 4 * fq; const u32x2 z = zr[n];
                f32x4 v = yi[n] + ea * yx[n];
                v.x += dsk * bf2f(XT[(p0 + 0) * LD128 + tl]); v.y += dsk * bf2f(XT[(p0 + 1) * LD128 + tl]); v.z += dsk * bf2f(XT[(p0 + 2) * LD128 + tl]); v.w += dsk * bf2f(XT[(p0 + 3) * LD128 + tl]);
                v.x *= siluf_(bflo(z.x)); v.y *= siluf_(bfhi(z.x)); v.z *= siluf_(bflo(z.y)); v.w *= siluf_(bfhi(z.y));
                ss += (v.x * v.x + v.y * v.y) + (v.z * v.z + v.w * v.w);
                u32x2 o; o.x = pk2(v.x, v.y); o.y = pk2(v.z, v.w); *(u32x2*)(yrow + h * 64 + p0) = o; CFENCE(); }
        }
    }
#undef M2O_LD_CB
#undef M2O_LD_XS
    ss += __shfl_xor(ss, 16); ss += __shfl_xor(ss, 32);
    const float rstd = frsq(ss * (1.0f / 256.0f) + EPS);
    const float* ng = F.m2_norm_g + l * 256;
#ifndef EMU
    asm volatile("s_waitcnt vmcnt(0)" ::: "memory");
#endif
#pragma unroll
    for (int qh = 0; qh < 2; ++qh) {
        f32x4 gv[8]; u32x2 yv[8];
#pragma unroll
        for (int q = 0; q < 8; ++q) { const int cc = (2 * qh + (q >> 2)) * 64 + 16 * (q & 3) + 4 * fq; gv[q] = *(const f32x4*)(ng + cc); yv[q] = *(const u32x2*)(yrow + cc); }
#pragma unroll
        for (int q = 0; q < 8; ++q) { const int cc = (2 * qh + (q >> 2)) * 64 + 16 * (q & 3) + 4 * fq;
            u32x2 o; o.x = pk2(bflo(yv[q].x) * rstd * gv[q].x, bfhi(yv[q].x) * rstd * gv[q].y); o.y = pk2(bflo(yv[q].y) * rstd * gv[q].z, bfhi(yv[q].y) * rstd * gv[q].w); *(u32x2*)(yrow + cc) = o; } }
}

template <bool OUT>
__device__ __forceinline__ void hg_wave_unit(Frame& F0, int l, int sc, int h) {
    Frame F = F0; LAUNDER(F);
    constexpr int TB = 16;
    lf32* Fb = (lf32*)(F.lds + F.wave * 16384); lf32* Vb = Fb + 1024; lf32* Qb = Vb + 1024; lf32* Gb = Qb + 1024;
    const bf16* proj = WSP(bf16, WS_BIG); const int lane = F.lane, t0 = sc * HSC;
    const float lb = WSP(float, WS_LB)[l * 256 + h * 64 + lane];
    float S[64];
    if (OUT) { const float* sp = WSP(float, WS_ST_HG) + ((size_t)sc * 4 + h) * 4096 + lane;
#pragma unroll
        for (int d = 0; d < 64; ++d) S[d] = sp[d * 64]; }
    else {
#pragma unroll
        for (int d = 0; d < 64; ++d) S[d] = 0.f; }
    float lam = 1.0f;
    const float ng = OUT ? F.hg_norm_g[l * 256 + h * 64 + lane] : 0.f;
    bf16 rf[TB], rq[TB], rv[TB], rg[TB];
    const bf16* pb = proj + (size_t)t0 * NPROJ + h * 64 + lane;
#pragma unroll
    for (int tt = 0; tt < TB; ++tt) { const bf16* pr = pb + (size_t)tt * NPROJ; rf[tt] = pr[C_GF]; rv[tt] = pr[C_GI]; if (OUT) { rq[tt] = pr[C_GQ]; rg[tt] = pr[C_GG]; } }
#pragma unroll 1
    for (int tb = 0; tb < HSC; tb += TB) {
#pragma unroll
        for (int tt = 0; tt < TB; ++tt) {
            const float f = lb + (1.0f - lb) * sigmoidf_(bf2f(rf[tt])); Fb[tt * 64 + lane] = f; lam *= f; Vb[tt * 64 + lane] = bf2f(rv[tt]);
            if (OUT) { Qb[tt * 64 + lane] = siluf_(bf2f(rq[tt])); Gb[tt * 64 + lane] = siluf_(bf2f(rg[tt])) * ng; } }
        WAVE_SYNC();
        if (tb + TB < HSC) { const bf16* pn = pb + (size_t)(tb + TB) * NPROJ;
#pragma unroll
            for (int tt = 0; tt < TB; ++tt) { const bf16* pr = pn + (size_t)tt * NPROJ; rf[tt] = pr[C_GF]; rv[tt] = pr[C_GI]; if (OUT) { rq[tt] = pr[C_GQ]; rg[tt] = pr[C_GG]; } } }
#pragma unroll 2
        for (int tt = 0; tt < TB; ++tt) {
            const float v = Vb[tt * 64 + lane];
            float o0 = 0.f, o1 = 0.f, o2 = 0.f, o3 = 0.f;
#pragma unroll
            for (int d4 = 0; d4 < 16; ++d4) { const f32x4 f4 = *(const LAS f32x4*)(Fb + tt * 64 + 4 * d4);
                S[4 * d4 + 0] = f4.x * (S[4 * d4 + 0] - v) + v; S[4 * d4 + 1] = f4.y * (S[4 * d4 + 1] - v) + v; S[4 * d4 + 2] = f4.z * (S[4 * d4 + 2] - v) + v; S[4 * d4 + 3] = f4.w * (S[4 * d4 + 3] - v) + v;
                if (OUT) { const f32x4 q4 = *(const LAS f32x4*)(Qb + tt * 64 + 4 * d4); o0 += q4.x * S[4 * d4 + 0]; o1 += q4.y * S[4 * d4 + 1]; o2 += q4.z * S[4 * d4 + 2]; o3 += q4.w * S[4 * d4 + 3]; } }
            if (OUT) { const float o = (o0 + o1) + (o2 + o3); const float ssq = wave_sum(o * o); const float rstd = frsq(ssq * (1.0f / 64.0f) + EPS);
                WSP(bf16, WS_ACT)[(size_t)(t0 + tb + tt) * 1024 + Y_HG + h * 64 + lane] = (bf16)f2bf(o * rstd * Gb[tt * 64 + lane]); } }
        WAVE_SYNC();
    }
    if (!OUT) { float* sp = WSP(float, WS_ST_HG) + ((size_t)sc * 4 + h) * 4096 + lane;
#pragma unroll
        for (int d = 0; d < 64; ++d) sp[d * 64] = S[d];
        WSP(float, WS_DEC_HG)[((size_t)sc * 4 + h) * 64 + lane] = lam; }
}


__device__ __forceinline__ bf16x8 pack8(const float (&x)[8]) {
    u32x4 w; w.x = pk2(x[0], x[1]); w.y = pk2(x[2], x[3]); w.z = pk2(x[4], x[5]); w.w = pk2(x[6], x[7]); return __builtin_bit_cast(bf16x8, w); }
__device__ __forceinline__ void ld8f(const lf32* p, float (&x)[8]) { const f32x4 a = *(const LAS f32x4*)p, b = *(const LAS f32x4*)(p + 4); x[0] = a.x; x[1] = a.y; x[2] = a.z; x[3] = a.w; x[4] = b.x; x[5] = b.y; x[6] = b.z; x[7] = b.w; }
__device__ __forceinline__ void ld8b(const lbf* p, float (&x)[8]) { const u32x4 a = *(const LAS u32x4*)p; x[0] = bflo(a.x); x[1] = bfhi(a.x); x[2] = bflo(a.y); x[3] = bfhi(a.y); x[4] = bflo(a.z); x[5] = bfhi(a.z); x[6] = bflo(a.w); x[7] = bfhi(a.w); }
__device__ __forceinline__ void hg_logf_cumsum(Frame& F, int l, const bf16* proj, int t0, int h, lf32* bL, lf32* tot) {
    { const int t = F.tid >> 2, dq = (F.tid & 3) * 16; const bf16* pr = proj + (size_t)(t0 + t) * NPROJ + C_GF + h * 64 + dq; const float* lbp = WSP(float, WS_LB) + l * 256 + h * 64 + dq;
#pragma unroll
      for (int hh = 0; hh < 2; ++hh) { const u32x4 a = *(const u32x4*)(pr + 8 * hh); const unsigned aw[4] = {a.x, a.y, a.z, a.w}; float lf[8];
#pragma unroll
          for (int j = 0; j < 8; ++j) { const float x = (j & 1) ? bfhi(aw[j >> 1]) : bflo(aw[j >> 1]); const float lb = lbp[8 * hh + j]; lf[j] = flog(lb + (1.0f - lb) * sigmoidf_(x)); }
          *(LAS f32x4*)(bL + t * 64 + dq + 8 * hh) = (f32x4){lf[0], lf[1], lf[2], lf[3]}; *(LAS f32x4*)(bL + t * 64 + dq + 8 * hh + 4) = (f32x4){lf[4], lf[5], lf[6], lf[7]}; } }
    __syncthreads();
    const int d = F.tid & 63, sg = F.tid >> 6;
    { float run = 0.f;
#pragma unroll
      for (int j = 0; j < 16; ++j) { run += bL[(sg * 16 + j) * 64 + d]; bL[(sg * 16 + j) * 64 + d] = run; }
      tot[sg * 64 + d] = run; }
    __syncthreads();
    { float off = 0.f; for (int g = 0; g < sg; ++g) off += tot[g * 64 + d];
#pragma unroll
      for (int j = 0; j < 16; ++j) bL[(sg * 16 + j) * 64 + d] += off; }
    __syncthreads();
}
__device__ __forceinline__ void hg_state_unit(Frame& F0, int l, int c, int h) {
    Frame F = F0; LAUNDER(F);
    lf32* bL = (lf32*)F.lds; lf32* tot = bL + 128 * 64; lbf* VT = (lbf*)(tot + 512); lbf* KT = VT + 64 * LD128;
    const bf16* proj = WSP(bf16, WS_BIG); const int t0 = c * CH;
    __syncthreads();
    hg_logf_cumsum(F, l, proj, t0, h, bL, tot);
    stage_T64(F, proj, t0, C_GI + h * 64, VT);
    { const int s = F.tid >> 2, dq = (F.tid & 3) * 16; const bf16* pr = proj + (size_t)(t0 + s) * NPROJ + C_GF + h * 64 + dq; const float* lbp = WSP(float, WS_LB) + l * 256 + h * 64 + dq;
#pragma unroll
      for (int hh = 0; hh < 2; ++hh) { const u32x4 a = *(const u32x4*)(pr + 8 * hh); const unsigned aw[4] = {a.x, a.y, a.z, a.w};
#pragma unroll
          for (int j = 0; j < 8; ++j) { const int d = dq + 8 * hh + j; const float x = (j & 1) ? bfhi(aw[j >> 1]) : bflo(aw[j >> 1]); const float lb = lbp[8 * hh + j];
              const float k = 1.0f - (lb + (1.0f - lb) * sigmoidf_(x)); KT[d * LD128 + s] = (bf16)f2bf(k * fexp(bL[127 * 64 + d] - bL[s * 64 + d])); } } }
    __syncthreads();
    f32x4 acc[2] = {(f32x4){0, 0, 0, 0}, (f32x4){0, 0, 0, 0}};
    const int w = F.wave;
    wave_mma<2, 4>(acc, VT + 16 * (w >> 1) * LD128, LD128, KT + 32 * (w & 1) * LD128, LD128, F.lane);
    float* st = WSP(float, WS_ST_HG) + ((size_t)c * 4 + h) * 4096; const int e = 16 * (w >> 1) + (F.lane & 15);
#pragma unroll
    for (int n = 0; n < 2; ++n) *(f32x4*)(st + e * 64 + 32 * (w & 1) + 16 * n + 4 * (F.lane >> 4)) = acc[n];
    if (F.tid < 64) WSP(float, WS_DEC_HG)[((size_t)c * 4 + h) * 64 + F.tid] = fexp(bL[127 * 64 + F.tid]);
}
__device__ __forceinline__ void hg_out_unit(Frame& F0, int l, int c, int h) {
    Frame F = F0; LAUNDER(F);
    lf32* bL = (lf32*)F.lds; lf32* tot = bL + 128 * 64; lbf* Qr = (lbf*)(tot + 512); lbf* Kh = Qr + 128 * LD64; lbf* VT = Kh + 128 * LD64; lbf* ST = VT + 64 * LD128; lbf* P = ST + 64 * LD64;
    const bf16* proj = WSP(bf16, WS_BIG); const int t0 = c * CH;
    const int w = F.wave, lane = F.lane, fr = lane & 15, fq = lane >> 4, tl = 16 * w + fr;
    __syncthreads();
    u32x4 rq[2], rf[2], rv[2]; f32x4 rsa, rsb; u32x2 rg[4]; f32x4 rn[4]; float lb[16];
    { const int t = F.tid >> 2, dq = (F.tid & 3) * 16; const bf16* pq = proj + (size_t)(t0 + t) * NPROJ + C_GQ + h * 64 + dq; const bf16* pf = proj + (size_t)(t0 + t) * NPROJ + C_GF + h * 64 + dq;
      const f32x4* lbp = (const f32x4*)(WSP(float, WS_LB) + l * 256 + h * 64 + dq);
#pragma unroll
      for (int hh = 0; hh < 2; ++hh) { rq[hh] = *(const u32x4*)(pq + 8 * hh); rf[hh] = *(const u32x4*)(pf + 8 * hh); }
#pragma unroll
      for (int i = 0; i < 4; ++i) { const f32x4 x = lbp[i]; lb[4 * i] = x.x; lb[4 * i + 1] = x.y; lb[4 * i + 2] = x.z; lb[4 * i + 3] = x.w; }
#pragma unroll
      for (int i = 0; i < 2; ++i) { const int p = F.tid + 512 * i, s = p >> 3, eb = (p & 7) * 8; rv[i] = *(const u32x4*)(proj + (size_t)(t0 + s) * NPROJ + C_GI + h * 64 + eb); }
      const float* st = WSP(float, WS_ST_HG) + ((size_t)c * 4 + h) * 4096 + F.tid * 8; rsa = *(const f32x4*)st; rsb = *(const f32x4*)(st + 4);
      const bf16* gp0 = proj + (size_t)(t0 + tl) * NPROJ + C_GG + h * 64; const float* ng0 = F.hg_norm_g + l * 256 + h * 64;
#pragma unroll
      for (int n = 0; n < 4; ++n) { rg[n] = *(const u32x2*)(gp0 + 16 * n + 4 * fq); rn[n] = *(const f32x4*)(ng0 + 16 * n + 4 * fq); } }
    hg_logf_cumsum_r(F, rf, lb, bL, tot);
    { const int t = F.tid >> 2, dq = (F.tid & 3) * 16, te = (t | 15);
#pragma unroll
      for (int hh = 0; hh < 2; ++hh) { const unsigned aw[4] = {rq[hh].x, rq[hh].y, rq[hh].z, rq[hh].w}, bw[4] = {rf[hh].x, rf[hh].y, rf[hh].z, rf[hh].w}; float qo[8], ko[8];
#pragma unroll
          for (int j = 0; j < 8; ++j) { const int d = dq + 8 * hh + j; const float xq = (j & 1) ? bfhi(aw[j >> 1]) : bflo(aw[j >> 1]), xf = (j & 1) ? bfhi(bw[j >> 1]) : bflo(bw[j >> 1]); const float lbv = lb[8 * hh + j];
              qo[j] = siluf_(xq); ko[j] = (1.0f - (lbv + (1.0f - lbv) * sigmoidf_(xf))) * fexp(bL[te * 64 + d] - bL[t * 64 + d]); }
          *(LAS bf16x8*)(Qr + t * LD64 + dq + 8 * hh) = pack8(qo); *(LAS bf16x8*)(Kh + t * LD64 + dq + 8 * hh) = pack8(ko); } }
#pragma unroll
    for (int i = 0; i < 2; ++i) { const int p = F.tid + 512 * i, s = p >> 3, eb = (p & 7) * 8; const unsigned aw[4] = {rv[i].x, rv[i].y, rv[i].z, rv[i].w};
#pragma unroll
        for (int j = 0; j < 8; ++j) VT[(eb + j) * LD128 + s] = (bf16)((j & 1) ? (aw[j >> 1] >> 16) : (aw[j >> 1] & 0xffffu)); }
    { u32x4 o; o.x = pk2(rsa.x, rsa.y); o.y = pk2(rsa.z, rsa.w); o.z = pk2(rsb.x, rsb.y); o.w = pk2(rsb.z, rsb.w); *(LAS u32x4*)(ST + (F.tid >> 3) * LD64 + (F.tid & 7) * 8) = o; }
    __syncthreads();
    float qv[2][8], bt[2][8];
#pragma unroll
    for (int ks = 0; ks < 2; ++ks) { ld8b(Qr + tl * LD64 + ks * 32 + fq * 8, qv[ks]); ld8f(bL + tl * 64 + ks * 32 + fq * 8, bt[ks]); }
    lbf* Pw = P + w * 16 * LD128;
    f32x4 ox[4];
#pragma unroll
    for (int n = 0; n < 4; ++n) ox[n] = (f32x4){0, 0, 0, 0};
#pragma unroll
    for (int ks = 0; ks < 2; ++ks) { float x[8];
#pragma unroll
        for (int j = 0; j < 8; ++j) x[j] = qv[ks][j] * fexp(bt[ks][j]);
        const bf16x8 a = pack8(x);
#pragma unroll
        for (int n = 0; n < 4; ++n) { const bf16x8 b = *(const LAS bf16x8*)(ST + (n * 16 + fr) * LD64 + ks * 32 + fq * 8); ox[n] = __builtin_amdgcn_mfma_f32_16x16x32_bf16(b, a, ox[n], 0, 0, 0); } }
    for (int j = 0; j < w; ++j) { f32x4 sc = (f32x4){0, 0, 0, 0};
#pragma unroll
        for (int ks = 0; ks < 2; ++ks) { float be[8], x[8]; ld8f(bL + (16 * j + 15) * 64 + ks * 32 + fq * 8, be);
#pragma unroll
            for (int q = 0; q < 8; ++q) x[q] = qv[ks][q] * fexp(bt[ks][q] - be[q]);
            const bf16x8 a = pack8(x); const bf16x8 b = *(const LAS bf16x8*)(Kh + (16 * j + fr) * LD64 + ks * 32 + fq * 8);
            sc = __builtin_amdgcn_mfma_f32_16x16x32_bf16(b, a, sc, 0, 0, 0); }
        u32x2 o; o.x = pk2(sc.x, sc.y); o.y = pk2(sc.z, sc.w); *(LAS u32x2*)(Pw + fr * LD128 + 16 * j + 4 * fq) = o; }
    { f32x4 sc = (f32x4){0, 0, 0, 0};
#pragma unroll
      for (int ks = 0; ks < 2; ++ks) { float br[8], bee[8], kk[8], x[8], y[8]; ld8f(bL + (16 * w + 7) * 64 + ks * 32 + fq * 8, br); ld8f(bL + (16 * w + 15) * 64 + ks * 32 + fq * 8, bee); ld8b(Kh + tl * LD64 + ks * 32 + fq * 8, kk);
#pragma unroll
          for (int q = 0; q < 8; ++q) { x[q] = qv[ks][q] * fexp(bt[ks][q] - br[q]); y[q] = kk[q] * fexp(br[q] - bee[q]); }
          sc = __builtin_amdgcn_mfma_f32_16x16x32_bf16(pack8(y), pack8(x), sc, 0, 0, 0); }
      float pv[4];
#pragma unroll
      for (int q = 0; q < 4; ++q) pv[q] = (4 * fq + q <= fr) ? sc[q] : 0.f;
      u32x2 o; o.x = pk2(pv[0], pv[1]); o.y = pk2(pv[2], pv[3]); *(LAS u32x2*)(Pw + fr * LD128 + 16 * w + 4 * fq) = o; }
    for (int j = w + 1; j < 8; ++j) *(LAS u32x2*)(Pw + fr * LD128 + 16 * j + 4 * fq) = (u32x2){0u, 0u};
    WAVE_SYNC();
    f32x4 oi[4];
#pragma unroll
    for (int n = 0; n < 4; ++n) oi[n] = (f32x4){0, 0, 0, 0};
    wave_mma<4, 4>(oi, Pw, LD128, VT, LD128, lane);
    float ss = 0.f;
#pragma unroll
    for (int n = 0; n < 4; ++n) { oi[n] = oi[n] + ox[n]; ss += (oi[n].x * oi[n].x + oi[n].y * oi[n].y) + (oi[n].z * oi[n].z + oi[n].w * oi[n].w); }
    ss += __shfl_xor(ss, 16); ss += __shfl_xor(ss, 32);
    const float rstd = frsq(ss * (1.0f / 64.0f) + EPS);
    const int t = t0 + tl; bf16* y = WSP(bf16, WS_ACT) + (size_t)t * 1024 + Y_HG + h * 64;
#pragma unroll
    for (int n = 0; n < 4; ++n) { const int e = 16 * n + 4 * fq; const u32x2 g = rg[n]; const f32x4 gn = rn[n]; const f32x4 v = oi[n] * rstd * gn;
        u32x2 o; o.x = pk2(v.x * siluf_(bflo(g.x)), v.y * siluf_(bfhi(g.x))); o.y = pk2(v.z * siluf_(bflo(g.y)), v.w * siluf_(bfhi(g.y))); *(u32x2*)(y + e) = o; }
}

struct PtrS5A { const bf16* proj; const bf16* sp; int g, c0;
    __device__ __forceinline__ const bf16* operator()(int r, int k) const { int c = c0 + r; if (c >= NCH5) c = NCH5 - 1;
        return k < 512 ? proj + (size_t)(c * 32 + (k >> 4)) * NPROJ + C_S5U + g * 16 + (k & 15) : sp + ((size_t)c * 16 + g) * 128 + (k - 512); } };
struct EpiS5Inc { static constexpr bool HAS_PRE = false; float* st; int g, c0;
    __device__ __forceinline__ void operator()(int r, int c, f32x4 v) const { const int ch = c0 + r; if (ch < NCH5) *(f32x4*)(st + ((size_t)ch * 16 + g) * 128 + c) = v; } };
struct EpiS5Out { static constexpr bool HAS_PRE = false; const bf16* proj; bf16* ypre; const float* dsk; int g, c0, n0;
    __device__ __forceinline__ void operator()(int r, int c, f32x4 v) const { const int ch = c0 + r; if (ch >= NCH5) return; const int np = n0 + c, tl = np >> 4, p = np & 15, t = ch * 32 + tl;
        const u32x2 u = *(const u32x2*)(proj + (size_t)t * NPROJ + C_S5U + g * 16 + p); const float* d = dsk + g * 16 + p;
        const float y0 = gelu_tanh(v.x + d[0] * bflo(u.x)), y1 = gelu_tanh(v.y + d[1] * bfhi(u.x)), y2 = gelu_tanh(v.z + d[2] * bflo(u.y)), y3 = gelu_tanh(v.w + d[3] * bfhi(u.y));
        u32x2 o; o.x = pk2(y0, y1); o.y = pk2(y2, y3); *(u32x2*)(ypre + (size_t)t * 256 + g * 16 + p) = o; } };

constexpr int S5_CB = (NCH5 + 127) / 128;
__device__ __forceinline__ void phase_m1(Frame& F, int l) {
    constexpr int U_HG = NCH * 4, U_M2 = NCH * 2, U_RET = NCH * 4, U_S5 = 16 * S5_CB;
    unsigned* ctr = WSP(unsigned, WS_CTL) + CW_Q + 64 * (2 * l) + 32 * F.rep;
    constexpr int U_GG = L / 256;
    constexpr int NC = U_GG + U_HG + U_M2 + U_RET + U_S5 + 256;
    for (int u0 = grab_unit(F, ctr); u0 < NC + CONV_D_UNITS; u0 = grab_unit(F, ctr)) {
        if (u0 >= NC) { conv_d_unit(F, l, u0 - NC); continue; }
        if (u0 < U_GG) { g8::OneUnit S1{u0, NPROJ / 256 - 1, (size_t)256 * 1024 * 2, (size_t)256 * 1024 * 2}; g8::EpiStore E1{WSP(bf16, WS_BIG), NPROJ};
            g8::gemm_phase(F.lds, WSP(bf16, WS_ACT), WSP(bf16, WS_WIN) + (size_t)l * NPROJ * 1024, 1024, S1, E1); continue; }
        const int u = u0 - U_GG;
        if (u >= U_HG + U_M2 + U_RET + U_S5) { s5_prep_b(F, l, u - (U_HG + U_M2 + U_RET + U_S5), 256); continue; }
        if (u < U_HG) { hg_state_unit(F, l, u >> 2, u & 3); continue; }
        int r = u - U_HG;
        if (r < U_M2) { m2_state_unit(F, l, r >> 1, r & 1); continue; } r -= U_M2;
        if (r < U_RET) { ret_state_unit(F, r >> 2, r & 3); continue; } r -= U_RET;
        { const int g = r / S5_CB, cb = r % S5_CB; PtrS5A ap{WSP(bf16, WS_BIG), nullptr, g, cb * 128}; PtrRM bp{WSP(bf16, WS_S5BI) + (size_t)g * 128 * 512, 512, 127};
          EpiS5Inc e{WSP(float, WS_ST_S5), g, cb * 128}; gemm128(F.lds, 512, ap, bp, e); }
    }
}
constexpr int SL = 32;
template <int LEN, class DEC>
__device__ __forceinline__ void seg_scan_real(Frame& F0, float* base, size_t cstride, int chain0, int nchain_total, const DEC& dec) {
    Frame F = F0; LAUNDER(F);
    constexpr int NSEG = (LEN + SL - 1) / SL, CHB = NTHREADS / NSEG;
    lf32* Ts = (lf32*)F.lds; lf32* Qs = Ts + NTHREADS;
    const int ch = chain0 + (F.tid % CHB), sg = F.tid / CHB; const bool act = (F.tid < CHB * NSEG) && ch < nchain_total;
    float v[SL], d[SL]; float s = 0.f, q = 1.f;
    float* p = base + ch;
    __syncthreads();
    if (act) {
#pragma unroll
        for (int j = 0; j < SL; ++j) { const int c = sg * SL + j; const bool ok = c < LEN; v[j] = ok ? p[(size_t)c * cstride] : 0.f; d[j] = ok ? dec(ch, c) : 1.f; }
#pragma unroll
        for (int j = 0; j < SL; ++j) { s = d[j] * s + v[j]; q *= d[j]; }
        Ts[sg * CHB + (F.tid % CHB)] = s; Qs[sg * CHB + (F.tid % CHB)] = q;
    }
    __syncthreads();
    if (act) {
        float c0 = 0.f;
        for (int g = 0; g < sg; ++g) c0 = Qs[g * CHB + (F.tid % CHB)] * c0 + Ts[g * CHB + (F.tid % CHB)];
        s = c0;
#pragma unroll
        for (int j = 0; j < SL; ++j) { const int c = sg * SL + j; if (c < LEN) { p[(size_t)c * cstride] = s; s = d[j] * s + v[j]; } }
    }
}
struct DecConst { float d; __device__ __forceinline__ float operator()(int, int) const { return d; } };
struct DecM2 { const float* dc; __device__ __forceinline__ float operator()(int ch, int c) const { return dc[c * 4 + (ch >> 13)]; } };
struct DecHG { const float* dc; __device__ __forceinline__ float operator()(int ch, int c) const { return dc[(size_t)c * 256 + (ch >> 12) * 64 + (ch & 63)]; } };
template <int LEN>
__device__ __forceinline__ void seg_scan_s5(Frame& F0, int l, int chain0) {
    Frame F = F0; LAUNDER(F);
    constexpr int NSEG = (LEN + SL - 1) / SL, CHB = NTHREADS / NSEG;
    LAS f32x2* Ts = (LAS f32x2*)F.lds; LAS f32x2* Qs = Ts + NTHREADS;
    const int r = chain0 + (F.tid % CHB), sg = F.tid / CHB; const bool act = (F.tid < CHB * NSEG) && r < 1024;
    const float* ap = WSP(float, WS_S5AP) + ((size_t)l * 1024 + (act ? r : 0)) * 68 + 64; const float ar = ap[0], ai = ap[1];
    const f32x2* p = (const f32x2*)(WSP(float, WS_ST_S5) + 2 * r); bf16* qo = WSP(bf16, WS_S5UG) + (size_t)(r >> 6) * NR5 * 640 + 512 + 2 * (r & 63);
    f32x2 v[SL]; float sr = 0.f, si = 0.f, qr = 1.f, qi = 0.f;
    __syncthreads();
    if (act) {
#pragma unroll
        for (int j = 0; j < SL; ++j) { const int c = sg * SL + j; v[j] = (c < LEN) ? p[(size_t)c * 1024] : (f32x2){0.f, 0.f}; }
#pragma unroll
        for (int j = 0; j < SL; ++j) { const int c = sg * SL + j; if (c < LEN) { const float nr = ar * sr - ai * si + v[j].x, ni = ar * si + ai * sr + v[j].y; sr = nr; si = ni; const float tr = ar * qr - ai * qi, ti = ar * qi + ai * qr; qr = tr; qi = ti; } }
        Ts[sg * CHB + (F.tid % CHB)] = (f32x2){sr, si}; Qs[sg * CHB + (F.tid % CHB)] = (f32x2){qr, qi};
    }
    __syncthreads();
    if (act) {
        float cr = 0.f, ci = 0.f;
        for (int g = 0; g < sg; ++g) { const f32x2 Q = Qs[g * CHB + (F.tid % CHB)], T = Ts[g * CHB + (F.tid % CHB)]; const float nr = Q.x * cr - Q.y * ci + T.x, ni = Q.x * ci + Q.y * cr + T.y; cr = nr; ci = ni; }
        sr = cr; si = ci;
#pragma unroll
        for (int j = 0; j < SL; ++j) { const int c = sg * SL + j; if (c < LEN) { *(unsigned*)(qo + (size_t)c * 640) = pk2(sr, si); const float nr = ar * sr - ai * si + v[j].x, ni = ar * si + ai * sr + v[j].y; sr = nr; si = ni; } }
    }
}
__device__ __forceinline__ void phase_m2(Frame& F, int l) {
    constexpr int N_RET = 4 * 4096, N_M2 = 4 * 8192, N_HG = 4 * 4096, N_S5 = 16 * 64;
    constexpr int CB_R = NTHREADS / ((NCH + SL - 1) / SL), CB_H = NTHREADS / ((NCH + SL - 1) / SL), CB_S = NTHREADS / ((NCH5 + SL - 1) / SL);
    constexpr int U_S5 = (N_S5 + CB_S - 1) / CB_S, U_HG = (N_HG + CB_H - 1) / CB_H, U_M2 = (N_M2 + CB_R - 1) / CB_R, U_RET = (N_RET + CB_R - 1) / CB_R;
    unsigned* ctr = WSP(unsigned, WS_CTL) + CW_Q + 64 * (6 + l) + 32 * F.rep;
    for (int u = grab_unit(F, ctr); u < U_S5 + U_HG + U_M2 + U_RET; u = grab_unit(F, ctr)) {
        if (u < U_S5) { seg_scan_s5<NCH5>(F, l, u * CB_S); continue; }
        int r = u - U_S5;
        if (r < U_HG) { DecHG dh{WSP(float, WS_DEC_HG)}; seg_scan_real<NCH>(F, WSP(float, WS_ST_HG), 16384, r * CB_H, N_HG, dh); continue; }
        r -= U_HG;
        if (r < U_M2) { DecM2 dm{WSP(float, WS_DEC_M2)}; seg_scan_real<NCH>(F, WSP(float, WS_ST_M2), 32768, r * CB_R, N_M2, dm); continue; }
        r -= U_M2;
        { const int ch0 = r * CB_R; DecConst dcst{exp2f(128.0f * ret_log2gamma(ch0 >> 12))};
          seg_scan_real<NCH>(F, WSP(float, WS_ST_RET), 16384, ch0, N_RET, dcst); }
    }
}
__device__ __forceinline__ void phase_m3(Frame& F, int l) {
    constexpr int U_HG = NCH * 4, U_M2 = NCH, U_RET = NCH * 4, U_S5 = 16 * (NR5 / 256) * 2;
    unsigned* ctr = WSP(unsigned, WS_CTL) + CW_Q + 64 * (2 * l + 1) + 32 * F.rep;
    constexpr int NC = U_HG + U_M2 + U_RET + U_S5;
    for (int u0 = grab_unit(F, ctr); u0 < NC + CONV_GU_UNITS; u0 = grab_unit(F, ctr)) {
        if (u0 >= U_M2 + U_S5 && u0 < U_M2 + U_S5 + CONV_GU_UNITS) { conv_gu_unit(F, l, u0 - (U_M2 + U_S5)); continue; }
        const int u = u0 < U_M2 + U_S5 ? u0 : u0 - CONV_GU_UNITS;
#ifndef M3SKIP
#define M3SKIP 0
#endif
        if (u < U_M2) { if (!(M3SKIP & 2)) m2_out_unit(F, l, u); continue; }
        int r = u - U_M2;
        if (r >= U_S5) { r -= U_S5;
            if (r < U_HG) { if (!(M3SKIP & 1)) hg_out_unit(F, l, r >> 2, r & 3); continue; } r -= U_HG;
            if (!(M3SKIP & 4)) ret_out_unit(F, r >> 2, r & 3); continue; }
        if (M3SKIP & 8) continue;
        { const int g = r / (2 * (NR5 / 256)), pm = (r >> 1) % (NR5 / 256), pn = r & 1;
          g8::OneUnit S1{pm, pn, (size_t)256 * 640 * 2, (size_t)256 * 640 * 2};
          g8::EpiS5OutG E1{WSP(bf16, WS_BIG), WSP(bf16, WS_YPRE), F.s5_d + l * 256, g, NCH5, C_S5U, NPROJ};
          g8::gemm_phase(F.lds, WSP(bf16, WS_S5UG) + (size_t)g * NR5 * 640, WSP(bf16, WS_S5MT) + (size_t)g * 512 * 640, 640, S1, E1); }
    }
}
struct EpiGlu { static constexpr bool HAS_PRE = true; const bf16* ypre; bf16* y; const float* bias; int r0, c0;
    struct Pre { u32x2 u; f32x4 b; };
    __device__ __forceinline__ Pre load(int r, int c) const { const int t = r0 + r, j = c0 + c; Pre p; p.u = *(const u32x2*)(ypre + (size_t)t * 256 + j); p.b = *(const f32x4*)(bias + j); return p; }
    __device__ __forceinline__ void fin(int r, int c, f32x4 v, const Pre& p) const { const int t = r0 + r, j = c0 + c; const u32x2 u = p.u; const f32x4 b = p.b;
        u32x2 o; o.x = pk2(bflo(u.x) * sigmoidf_(v.x + b.x), bfhi(u.x) * sigmoidf_(v.y + b.y)); o.y = pk2(bflo(u.y) * sigmoidf_(v.z + b.z), bfhi(u.y) * sigmoidf_(v.w + b.w));
        *(u32x2*)(y + (size_t)t * 1024 + Y_S5 + j) = o; } };
__device__ __forceinline__ void phase_m4(Frame& F, int l) {
    constexpr int NM = L / 128;
    for (int u = F.bid; u < NM * 2; u += F.G) { const int pm = u >> 1, pn = u & 1;
        PtrRM ap{WSP(bf16, WS_YPRE) + (size_t)pm * 128 * 256, 256, 127}, bp{WSP(bf16, WS_WGLU) + (size_t)l * 65536 + (size_t)pn * 128 * 256, 256, 127};
        EpiGlu e{WSP(bf16, WS_YPRE), WSP(bf16, WS_ACT), F.s5_b_glu + l * 256, pm * 128, pn * 128}; gemm128(F.lds, 256, ap, bp, e); }
}

__device__ __forceinline__ void phase_g2(Frame& F, int l) {
    g8::GridOrder S{L / 256, 4, (L / 256) * 4, F.G, F.bid, (size_t)256 * 1024 * 2, (size_t)256 * 1024 * 2};
    if (l == 0) { g8::EpiResid<false> E{F.x, WSP(bf16, WS_XRES)}; g8::gemm_phase(F.lds, WSP(bf16, WS_ACT), WSP(bf16, WS_WOUT), 1024, S, E); }
    else { g8::EpiResid<true> E{F.out, WSP(bf16, WS_XRES)}; g8::gemm_phase(F.lds, WSP(bf16, WS_ACT), WSP(bf16, WS_WOUT) + (size_t)1048576, 1024, S, E); }
}

__device__ __forceinline__ void phase_r2(Frame& F, int l) {
    const int RPB = L / F.G;
    LAS f32x4* T = (LAS f32x4*)F.lds;
    li32* e_s = (li32*)(F.lds + 81920); li32* base_s = e_s + 128;
    int* hist = WSP(int, WS_HIST) + l * 256 * 16;
    const float* g2 = F.norm2_g + l * 1024; const float* wg = F.moe_w_group + (size_t)l * 4096; const float* we = F.moe_w_expert + (size_t)l * 16384;
    __syncthreads();
    for (int k = F.tid; k < 1024; k += NTHREADS) { const float g = g2[k]; const int ln = (k >> 2) & 63, a = k & 3, j = k >> 8; const int idx = (j * 4 + a) * 64 + ln;
        T[idx] = g * *(const f32x4*)(wg + (size_t)k * 4);
#pragma unroll
        for (int b = 0; b < 4; ++b) T[(b + 1) * 1024 + idx] = g * *(const f32x4*)(we + (size_t)k * 16 + 4 * b); }
    for (int rb = 0; rb < RPB; rb += 64) {
        __syncthreads();
        u32x2 xq[4];
        if (rb + F.wave * 8 < RPB) { const u32x2* x0 = (const u32x2*)(WSP(bf16, WS_XRES) + (size_t)(F.bid * RPB + rb + F.wave * 8) * D) + F.lane;
#pragma unroll
            for (int j = 0; j < 4; ++j) xq[j] = x0[64 * j]; }
        for (int rr = 0; rr < 8; ++rr) { const int ri = F.wave * 8 + rr; if (rb + ri >= RPB) break; const int t = F.bid * RPB + rb + ri; const int lane = F.lane;
            const u32x2* xr = (const u32x2*)(WSP(bf16, WS_XRES) + (size_t)t * D) + lane; float ss = 0.f; f32x4 v[4];
#pragma unroll
            for (int j = 0; j < 4; ++j) { const u32x2 xb = xq[j]; v[j] = (f32x4){bflo(xb.x), bfhi(xb.x), bflo(xb.y), bfhi(xb.y)}; ss += (v[j].x * v[j].x + v[j].y * v[j].y) + (v[j].z * v[j].z + v[j].w * v[j].w); }
            if (rr + 1 < 8 && rb + ri + 1 < RPB) {
#pragma unroll
                for (int j = 0; j < 4; ++j) xq[j] = xr[256 + 64 * j]; }
            const float rstd = frsq(wave_sum(ss) * (1.0f / D) + EPS);
            float lgg[4] = {0.f, 0.f, 0.f, 0.f};
            u32x2* hb = (u32x2*)(WSP(bf16, WS_ACT) + (size_t)t * D) + lane;
#pragma unroll
            for (int j = 0; j < 4; ++j) { const int k = 4 * lane + 256 * j; const f32x4 h = v[j] * rstd * *(const f32x4*)(g2 + k);
                u32x2 w; w.x = pk2(h.x, h.y); w.y = pk2(h.z, h.w); hb[64 * j] = w;
                const float xv[4] = {v[j].x, v[j].y, v[j].z, v[j].w};
#pragma unroll
                for (int a = 0; a < 4; ++a) { const f32x4 w4 = T[(j * 4 + a) * 64 + lane]; lgg[0] += xv[a] * w4.x; lgg[1] += xv[a] * w4.y; lgg[2] += xv[a] * w4.z; lgg[3] += xv[a] * w4.w; } }
            float gl[4]; float gm = -1e30f; int gi = 0;
#pragma unroll
            for (int q = 0; q < 4; ++q) { gl[q] = wave_sum(lgg[q]) * rstd + F.moe_b_group[l * 4 + q]; if (gl[q] > gm) { gm = gl[q]; gi = q; } }
            gi = __builtin_amdgcn_readfirstlane(gi);
            float lge[4] = {0.f, 0.f, 0.f, 0.f};
            { const LAS f32x4* Te = T + (1 + gi) * 1024;
#pragma unroll
              for (int j = 0; j < 4; ++j) { const float xv[4] = {v[j].x, v[j].y, v[j].z, v[j].w};
#pragma unroll
                for (int a = 0; a < 4; ++a) { const f32x4 w4 = Te[(j * 4 + a) * 64 + lane]; lge[0] += xv[a] * w4.x; lge[1] += xv[a] * w4.y; lge[2] += xv[a] * w4.z; lge[3] += xv[a] * w4.w; } } }
            float el[4];
#pragma unroll
            for (int q = 0; q < 4; ++q) el[q] = wave_sum(lge[q]) * rstd + F.moe_b_expert[l * 16 + gi * 4 + q];
            if (lane == 0) {
                float gs = 0.f;
#pragma unroll
                for (int q = 0; q < 4; ++q) gs += fexp(gl[q] - gm);
                const float pg = 1.0f / gs;
                int i0 = 0; float m0 = el[0];
#pragma unroll
                for (int q = 1; q < 4; ++q) if (el[q] > m0) { m0 = el[q]; i0 = q; }
                int i1 = -1; float m1 = -1e30f;
#pragma unroll
                for (int q = 0; q < 4; ++q) if (q != i0 && el[q] > m1) { m1 = el[q]; i1 = q; }
                if (i1 < 0) { i1 = (i0 + 1) & 3; m1 = m0; }
                const float p1 = fexp(m1 - m0);
                const float w0 = pg / (1.0f + p1), w1 = pg * p1 / (1.0f + p1);
                int* rt = WSP(int, WS_ROUTE) + ((size_t)l * L + t) * 8; float* rtf = (float*)rt;
                rt[0] = gi * 4 + i0; rt[1] = gi * 4 + i1; rtf[4] = w0; rtf[5] = w1;
                e_s[2 * ri] = gi * 4 + i0; e_s[2 * ri + 1] = gi * 4 + i1;
            } }
        __syncthreads();
        const int nrow = (RPB - rb) < 64 ? (RPB - rb) : 64;
        li32* cnt_s = base_s;
        int my_e = -1, my_rank = 0;
        if (F.wave < 2) { const int idx = F.wave * 64 + F.lane; my_e = idx < 2 * nrow ? e_s[idx] : -1;
#pragma unroll
            for (int q = 0; q < 16; ++q) { const unsigned long long m = __ballot(my_e == q); if (my_e == q) my_rank = __builtin_popcountll(m & ((1ull << F.lane) - 1ull)); if (F.lane == 0) cnt_s[F.wave * 16 + q] = __builtin_popcountll(m); } }
        __syncthreads();
        if (F.tid < 16) hist[F.bid * 16 + F.tid] = cnt_s[F.tid] + cnt_s[16 + F.tid];
        if (F.wave < 2 && my_e >= 0) { const int idx = F.wave * 64 + F.lane; const int pos = my_rank + (F.wave == 1 ? cnt_s[my_e] : 0);
            const int t = F.bid * RPB + rb + (idx >> 1); WSP(int, WS_ROUTE)[((size_t)l * L + t) * 8 + 2 + (idx & 1)] = pos; }
    }
}
__device__ __forceinline__ int moe_tables(Frame& F, int l, li32* base_s, li32* pe_s, li32* pref_s) {
    const int* hist = WSP(int, WS_HIST) + l * 256 * 16; const int G = F.G; li32* seg_s = pref_s + 256 * 16;
    const int e = F.tid & 15, sg = F.tid >> 4, per = (G + 31) / 32;
    __syncthreads();
    for (int i = F.tid; i < G * 16; i += NTHREADS) pref_s[i] = hist[i];
    __syncthreads();
    { int run = 0; for (int b = sg * per; b < (sg + 1) * per && b < G; ++b) { const int v = pref_s[b * 16 + e]; pref_s[b * 16 + e] = run; run += v; } seg_s[sg * 16 + e] = run; }
    __syncthreads();
    if (F.tid < 16) { int run = 0; for (int g = 0; g < 32; ++g) { const int v = seg_s[g * 16 + F.tid]; seg_s[g * 16 + F.tid] = run; run += v; } base_s[16 + F.tid] = run; }
    __syncthreads();
    { const int off = seg_s[sg * 16 + e]; for (int b = sg * per; b < (sg + 1) * per && b < G; ++b) pref_s[b * 16 + e] += off; }
    if (F.tid == 0) { int tot[16];
#pragma unroll
        for (int q = 0; q < 16; ++q) tot[q] = base_s[16 + q];
        int b = 0, np = 0;
#pragma unroll
        for (int q = 0; q < 16; ++q) { base_s[q] = b; const int pp = (tot[q] + 255) >> 8; for (int i = 0; i < pp; ++i) pe_s[np++] = q; b += pp * 256; }
        base_s[16] = np; }
    __syncthreads();
    return base_s[16];
}
constexpr size_t WS_MOETAB = WS_LB + 2048;
__device__ __forceinline__ int moe_tables_small(Frame& F, int l, li32* base_s, li32* pe_s) {
    const int* tab = WSP(int, WS_MOETAB) + l * 256;
    __syncthreads();
    if (F.tid < 32) base_s[F.tid] = tab[F.tid];
    if (F.tid >= 32 && F.tid < 32 + 160) pe_s[F.tid - 32] = tab[F.tid];
    __syncthreads();
    return base_s[16];
}
__device__ __forceinline__ void phase_ga(Frame& F, int l) {
    li32* base_s = (li32*)F.lds; li32* pe_s = base_s + 32; li32* pref_s = pe_s + 160;
    moe_tables(F, l, base_s, pe_s, pref_s);
    if (F.bid == 0) { int* tab = WSP(int, WS_MOETAB) + l * 256; if (F.tid < 32) tab[F.tid] = base_s[F.tid]; if (F.tid >= 32 && F.tid < 32 + 160) tab[F.tid] = pe_s[F.tid - 32]; }
    const int RPB = L / F.G;
    const int gw = F.bid * 8 + F.wave, ngw = F.G * 8;
    for (int t = gw; t < L; t += ngw) { int* rt = WSP(int, WS_ROUTE) + ((size_t)l * L + t) * 8;
        const int ob = (t / RPB) * 16; const int s0 = base_s[rt[0]] + pref_s[ob + rt[0]] + rt[2], s1 = base_s[rt[1]] + pref_s[ob + rt[1]] + rt[3];
        if (F.lane == 0) { rt[6] = s0; rt[7] = s1; }
        const u32x4* src = (const u32x4*)(WSP(bf16, WS_ACT) + (size_t)t * 1024) + F.lane; u32x4* d0 = (u32x4*)(WSP(bf16, WS_H2G) + (size_t)s0 * 1024) + F.lane; u32x4* d1 = (u32x4*)(WSP(bf16, WS_H2G) + (size_t)s1 * 1024) + F.lane;
        const u32x4 a = src[0], b = src[64]; d0[0] = a; d0[64] = b; d1[0] = a; d1[64] = b; }
}
__device__ __forceinline__ void phase_g3(Frame& F, int l) {
    li32* base_s = (li32*)(F.lds + g8::STAGE_BYTES); li32* pe_s = base_s + 32;
    const int np = moe_tables_small(F, l, base_s, pe_s);
    g8::MoeOrder S{np, F.G, F.bid, pe_s, (size_t)256 * 1024 * 2, (size_t)1024 * 1024 * 2, (size_t)256 * 1024 * 2};
    g8::EpiGateUp E{WSP(bf16, WS_ACTB), (unsigned)((size_t)NSLOTP * 512 * 2), WSP(unsigned, WS_CTL) + CW_DEP + l * 4096};
    g8::gemm_phase(F.lds, WSP(bf16, WS_H2G), WSP(bf16, WS_WGU), 1024, S, E);
}
__device__ __forceinline__ void phase_g4(Frame& F, int l) {
    li32* base_s = (li32*)(F.lds + g8::STAGE_BYTES); li32* pe_s = base_s + 32;
    const int np = moe_tables_small(F, l, base_s, pe_s);
    const int n3raw = np * 4 - 2 * F.G, n3 = (n3raw >= 0 && n3raw <= F.G / 4) ? n3raw : -1;
    const int rank = n3 < 0 ? (F.bid + F.G / 2) % F.G : (F.bid >= n3 ? F.bid - n3 : F.G - n3 + F.bid);
    g8::MoeOrderDep S{np, F.G, rank, n3, pe_s, (size_t)256 * 512 * 2, (size_t)1024 * 512 * 2, (size_t)256 * 512 * 2, WSP(unsigned, WS_CTL) + CW_DEP + l * 4096, F.wave};
    g8::EpiStore E{WSP(bf16, WS_H2G), 1024};
    g8::gemm_phase(F.lds, WSP(bf16, WS_ACTB), WSP(bf16, WS_WD), 512, S, E);
    if (l == 0) { unsigned* ctr = WSP(unsigned, WS_CTL) + CW_Q + 64 * 5 + 32 * F.rep;
      for (int u = grab_unit(F, ctr); u < 256; u = grab_unit(F, ctr)) s5_prep_a(F, 1, u, 256); }
}
#ifndef ONLY
#define ONLY -1
#endif
#define EN(k) (ONLY < 0 || ONLY == (k))
constexpr int NPHASE = 23;
__global__ void __launch_bounds__(NTHREADS, 2) fwd_kernel(Args a) {
#ifdef EMU
    lu8* lds = emu::ctx->lds;
#else
    __shared__ __attribute__((aligned(16))) unsigned char lds_raw[LDS_BYTES];
    lu8* lds = (lu8*)lds_raw;
#endif
    Frame F;
    F.lds = lds; F.ws = a.ws; F.out = a.out; F.tid = threadIdx.x; F.lane = F.tid & 63; F.wave = __builtin_amdgcn_readfirstlane(F.tid >> 6); F.G = gridDim.x; F.bid = blockIdx.x; F.rep = 0;
    F.x = (const float*)a.in[0]; F.pos = (const int*)a.in[1];
    { LAS unsigned long long* tab = (LAS unsigned long long*)(lds + MISC_OFF + 256); if (F.tid < 32) tab[F.tid] = (unsigned long long)a.in[F.tid]; F.ptab = tab; }
#ifndef EMU
    volatile LAS unsigned* misc = (volatile LAS unsigned*)(lds + MISC_OFF);
    for (int u = F.tid; u < 64; u += NTHREADS) misc[u] = 0u;
#endif
    __syncthreads();
#ifndef EMU
    XcdBarrier bar = xcd_barrier_post(WSP(unsigned, WS_CTL) + CW_BAR, misc + 8);
#endif
    const Frame F00 = F;
    const int lo = a.ph_lo, hi = a.ph_hi;
#ifdef EMU
#define GRID_BAR() ((void)0)
#else
#define GRID_BAR() xcd_barrier(bar)
#endif
#ifndef REPEAT_PH
#define REPEAT_PH -1
#endif
#define PH(k, en, stmt) if (lo <= (k) && (k) < hi) { Frame F = F00; LAUNDER(F); if (EN(en)) { stmt; } if ((k) + 1 < hi && (k) != 9 && (k) != 20) GRID_BAR(); \
        if ((k) == REPEAT_PH) { Frame F = F00; LAUNDER(F); F.rep = 1; stmt; GRID_BAR(); } }
    PH(0, 10, phase_p0(F))
    PH(1, 0, phase_g1(F, 0)) PH(2, 1, phase_m1(F, 0)) PH(3, 2, phase_m2(F, 0)) PH(4, 3, phase_m3(F, 0)) PH(5, 4, phase_m4(F, 0))
    PH(6, 5, phase_g2(F, 0)) PH(7, 6, phase_r2(F, 0)) PH(8, 7, phase_ga(F, 0)) PH(9, 8, phase_g3(F, 0)) PH(10, 9, phase_g4(F, 0))
    PH(11, 12, r1_phase(F, 1, 1))
    PH(12, 0, phase_g1(F, 1)) PH(13, 1, phase_m1(F, 1)) PH(14, 2, phase_m2(F, 1)) PH(15, 3, phase_m3(F, 1)) PH(16, 4, phase_m4(F, 1))
    PH(17, 5, phase_g2(F, 1)) PH(18, 6, phase_r2(F, 1)) PH(19, 7, phase_ga(F, 1)) PH(20, 8, phase_g3(F, 1)) PH(21, 9, phase_g4(F, 1))
    PH(22, 11, r1_phase(F, 2, 0))
#undef PH
}


#ifdef STOP_AFTER
__global__ void __launch_bounds__(512) diag0(unsigned char* ws) { unsigned* flag = (unsigned*)(ws + WS_CTL) + 70000; if (threadIdx.x < 8 && blockIdx.x == 0) flag[threadIdx.x] = threadIdx.x == 1 ? 0x7fffffffu : 0u; }
__global__ void __launch_bounds__(512) diag1(const float* out, unsigned char* ws) {
    const size_t N = (size_t)L * D; const unsigned short* act = (const unsigned short*)(ws + WS_ACT); unsigned* flag = (unsigned*)(ws + WS_CTL) + 70000;
    for (size_t i = (size_t)blockIdx.x * 512 + threadIdx.x; i < N; i += (size_t)gridDim.x * 512) { if ((act[i] & 0x7F80u) == 0x7F80u) { atomicAdd(flag, 1u); atomicMin(flag + 1, (unsigned)(i >> 10)); if (((i >> 8) & 3) == 1) atomicOr(flag + 2, 1u << ((i >> 4) & 3)); } }
}
__global__ void __launch_bounds__(512) diag2(float* out, const unsigned char* ws) {
    const size_t N = (size_t)L * D; const unsigned* flag = (const unsigned*)(ws + WS_CTL) + 70000;
    const float c = DIAG_SEL == 0 ? (float)flag[0] : DIAG_SEL == 1 ? (float)flag[1] + 1.f : DIAG_SEL == 2 ? (float)flag[2] * 10.f : DIAG_SEL == 4 ? (float)flag[16] * 10.f : (float)flag[3];
    for (size_t i = (size_t)blockIdx.x * 512 + threadIdx.x; i < N; i += (size_t)gridDim.x * 512) out[i] = c;
}
#endif
#ifdef EMU
extern "C" int emu_seq() { return L; }
extern "C" size_t emu_ws_bytes() { return WS_END; }
extern "C" void emu_dump_layout(FILE* f) {
#define LO(n) fprintf(f, #n " %zu\n", (size_t)n)
    LO(WS_WIN); LO(WS_WOUT); LO(WS_WGLU); LO(WS_WGU); LO(WS_WD); LO(WS_S5MT); LO(WS_S5BI); LO(WS_S5AP); LO(WS_S5BB); LO(WS_S5KT); LO(WS_ROPE); LO(WS_DTW); LO(WS_LB); LO(WS_ACT); LO(WS_YPRE);
    LO(WS_DTRAW); LO(WS_ROUTE); LO(WS_ST_RET); LO(WS_ST_M2); LO(WS_DEC_M2); LO(WS_ST_HG); LO(WS_DEC_HG); LO(WS_ST_S5); LO(WS_SP_S5); LO(WS_BIG); LO(WS_H2G); LO(WS_ACTB); LO(WS_S5UG); LO(WS_END);
    fprintf(f, "CNT %zu\n", (size_t)CW_CNT * 4);
}
#endif

extern "C" void kernel_launch(void* const* d_in, const int* in_sizes, int n_in, void* d_out, int out_size, void* d_ws, size_t ws_size, hipStream_t stream) {
    static int grid = 0;
    if (grid == 0) {
        if (n_in != 32 || out_size != L * D || ws_size < WS_END) { fprintf(stderr, "kernel_launch: unexpected shapes: n_in %d out %d ws %zu (need %zu)\n", n_in, out_size, ws_size, (size_t)WS_END); grid = -1; return; }
#ifdef EMU
        grid = getenv("EMU_GRID") ? atoi(getenv("EMU_GRID")) : L / 64;
#else
        int dev = 0, cus = 0, per_cu = 0;
        (void)hipGetDevice(&dev);
        (void)hipDeviceGetAttribute(&cus, hipDeviceAttributeMultiprocessorCount, dev);
        (void)hipOccupancyMaxActiveBlocksPerMultiprocessor(&per_cu, (const void*)fwd_kernel, NTHREADS, 0);
        (void)hipGetLastError();
        grid = cus > 0 ? cus : 256;
        if (per_cu < 1) { fprintf(stderr, "kernel_launch: occupancy query says 0 blocks/CU\n"); grid = -1; return; }
        if (L % grid != 0 || L / grid > 64 || grid > 256) { fprintf(stderr, "kernel_launch: grid %d unsupported (need L %% grid == 0, L / grid <= 64, grid <= 256)\n", grid); grid = -1; return; }
#endif
    }
    if (grid < 0) return;
    (void)hipMemsetAsync((char*)d_ws + WS_CTL, 0, CTL_ZERO_BYTES, stream);
    Args a{};
    for (int i = 0; i < 32; ++i) a.in[i] = d_in[i];
    a.out = (float*)d_out; a.ws = (unsigned char*)d_ws;
#ifdef EMU
    const int nph = getenv("EMU_PHASES") ? atoi(getenv("EMU_PHASES")) : NPHASE;
    for (int ph = 0; ph < nph; ++ph) { a.ph_lo = ph; a.ph_hi = ph + 1; Args b = a; fprintf(stderr, "emu: phase %d\n", ph);
        emu::launch(dim3(grid), dim3(NTHREADS), LDS_BYTES, [b]() { fwd_kernel(b); }); }
#else
#if defined(STOP_AFTER)
    for (int ph = 0; ph < STOP_AFTER; ++ph) { a.ph_lo = ph; a.ph_hi = ph + 1; hipLaunchKernelGGL(fwd_kernel, dim3(grid), dim3(NTHREADS), 0, stream, a); }
    hipLaunchKernelGGL(diag0, dim3(1), dim3(512), 0, stream, (unsigned char*)d_ws);
    hipLaunchKernelGGL(diag1, dim3(1024), dim3(512), 0, stream, (const float*)d_out, (unsigned char*)d_ws);
    hipLaunchKernelGGL(diag2, dim3(1024), dim3(512), 0, stream, (float*)d_out, (const unsigned char*)d_ws);
#elif defined(MULTI_LAUNCH)
    for (int ph = 0; ph < NPHASE; ++ph) { a.ph_lo = ph; a.ph_hi = ph + 1; hipLaunchKernelGGL(fwd_kernel, dim3(grid), dim3(NTHREADS), 0, stream, a); }
#else
    a.ph_lo = 0; a.ph_hi = NPHASE;
    void* args[] = {&a};
    hipError_t e = hipLaunchCooperativeKernel((const void*)fwd_kernel, dim3(grid), dim3(NTHREADS), args, 0, stream);
    if (e != hipSuccess) fprintf(stderr, "cooperative launch failed: %s (grid %d)\n", hipGetErrorString(e), grid);
#endif
#endif
}
```

```cpp
#ifndef EMU
#include <hip/hip_runtime.h>
#endif
#include <cstdio>
#include <cstdint>
#include <cmath>
#include <cstdlib>

#ifndef SEQ_LEN
#define SEQ_LEN 16384
#endif


typedef unsigned short bf16;
typedef short bf16x8 __attribute__((ext_vector_type(8)));
typedef float f32x4 __attribute__((ext_vector_type(4)));
typedef float f32x2 __attribute__((ext_vector_type(2)));
typedef unsigned u32x4 __attribute__((ext_vector_type(4)));
typedef unsigned u32x2 __attribute__((ext_vector_type(2)));
#ifdef EMU
#define LAS
#else
#define LAS __attribute__((address_space(3)))
#endif
typedef LAS bf16 lbf; typedef LAS float lf32; typedef LAS int li32; typedef LAS unsigned char lu8;

#ifdef EMU
#define WAVE_SYNC() emu::wave_barrier()
#else
#define WAVE_SYNC() do { __builtin_amdgcn_fence(__ATOMIC_RELEASE, "wavefront"); asm volatile("s_waitcnt lgkmcnt(0)" ::: "memory"); __builtin_amdgcn_wave_barrier(); } while (0)
#endif
constexpr int L = SEQ_LEN, D = 1024, NPROJ = 3328, DIN = 3332;
constexpr int C_S5U = 0, C_RQ = 256, C_RK = 512, C_RV = 768, C_RG = 1024, C_MZ = 1280, C_MX = 1536, C_MB = 1792, C_MC = 2048,
              C_GQ = 2304, C_GF = 2560, C_GI = 2816, C_GG = 3072;
constexpr int Y_S5 = 0, Y_RET = 256, Y_M2 = 512, Y_HG = 768;
constexpr int CH = 128, NCH = L / CH;
constexpr int HSC = 64, NHSC = L / HSC;
constexpr int T5 = 32, NCH5 = L / T5;
constexpr int NEXP = 16, FF = 512;
constexpr int NSLOTP = 2 * L + NEXP * 256;
constexpr float EPS = 1e-6f;
constexpr int NTHREADS = 512;
constexpr int LDS_BYTES = 147456;
constexpr int MISC_OFF = 147456 - 512;

constexpr size_t al(size_t x) { return (x + 4095) & ~(size_t)4095; }
constexpr size_t WS_CTL = 0, CTL_ZERO_BYTES = 1u << 20;
constexpr int CW_BAR = 4096;
constexpr int CW_CNT = 65536;
constexpr size_t WS_WIN = 1u << 20;
constexpr size_t WS_WOUT = WS_WIN + al((size_t)2 * NPROJ * 1024 * 2);
constexpr size_t WS_WGLU = WS_WOUT + al((size_t)2 * 1024 * 1024 * 2);
constexpr size_t WS_WGU = WS_WGLU + al((size_t)2 * 256 * 256 * 2);
constexpr size_t WS_WD = WS_WGU + al((size_t)16 * 1024 * 1024 * 2);
constexpr size_t WS_S5MT = WS_WD + al((size_t)16 * 1024 * 512 * 2);
constexpr size_t WS_S5BI = WS_S5MT + al((size_t)16 * 512 * 640 * 2);
constexpr size_t WS_S5AP = WS_S5BI + al((size_t)16 * 128 * 512 * 2);
constexpr size_t WS_S5BB = WS_S5AP + al((size_t)2 * 16 * 64 * 34 * 2 * 4);
constexpr size_t WS_S5KT = WS_S5BB + al((size_t)2 * 16 * 64 * 16 * 2 * 4);
constexpr size_t WS_ROPE = WS_S5KT + al((size_t)16 * 32 * 256 * 4);
constexpr size_t WS_DTW = WS_ROPE + al((size_t)L * 64 * 4);
constexpr size_t WS_HIST = WS_DTW;
constexpr size_t WS_LB = WS_DTW + al((size_t)2 * 1024 * 4 * 4);
constexpr size_t WS_ACT = WS_LB + al(2 * 256 * 4);
constexpr size_t WS_YPRE = WS_ACT + al((size_t)L * 1024 * 2);
constexpr size_t WS_DTRAW = WS_YPRE + al((size_t)L * 256 * 2);
constexpr size_t WS_ROUTE = WS_DTRAW + al((size_t)L * 4 * 4);
constexpr size_t WS_ST_RET = WS_ROUTE + al((size_t)2 * L * 8 * 4);
constexpr size_t WS_ST_M2 = WS_ST_RET + al((size_t)NCH * 4 * 4096 * 4);
constexpr size_t WS_DEC_M2 = WS_ST_M2 + al((size_t)NCH * 4 * 8192 * 4);
constexpr size_t WS_ST_HG = WS_DEC_M2 + al((size_t)NCH * 4 * 4);
constexpr size_t WS_DEC_HG = WS_ST_HG + al((size_t)NHSC * 4 * 4096 * 4);
constexpr size_t WS_ST_S5 = WS_DEC_HG + al((size_t)NHSC * 4 * 64 * 4);
constexpr size_t WS_SP_S5 = WS_ST_S5 + al((size_t)NCH5 * 16 * 128 * 4);
constexpr size_t WS_BIG = WS_SP_S5 + al((size_t)NCH5 * 16 * 128 * 2);
constexpr size_t BIG_BYTES = ((size_t)L * NPROJ * 2 > (size_t)NSLOTP * 1536 * 2) ? (size_t)L * NPROJ * 2 : (size_t)NSLOTP * 1536 * 2;
constexpr size_t WS_XRES = WS_ST_RET;
static_assert(WS_BIG - WS_ST_RET >= (size_t)L * 1024 * 2, "xres overlay");
#define XBC_PTR(F) ((bf16*)(F).out + (size_t)L * 1024)
static_assert((size_t)L * 768 * 2 <= (size_t)16 * 1024 * 1024 * 2, "xbc overlay");
constexpr size_t WS_H2G = WS_BIG, WS_ACTB = WS_BIG + (size_t)NSLOTP * 1024 * 2;
constexpr int NR5 = ((NCH5 + 255) / 256) * 256;
constexpr size_t WS_S5UG = WS_BIG + al(BIG_BYTES);
constexpr size_t WS_END = WS_S5UG + al((size_t)16 * NR5 * 640 * 2);

#ifdef EMU
__device__ __forceinline__ unsigned f2bf(float f) { unsigned u = __builtin_bit_cast(unsigned, f); return (u + 0x7fffu + ((u >> 16) & 1u)) >> 16; }
__device__ __forceinline__ unsigned pk2(float lo, float hi) { return f2bf(lo) | (f2bf(hi) << 16); }
#else
typedef __bf16 hw_bf16x2 __attribute__((ext_vector_type(2)));
__device__ __forceinline__ unsigned pk2(float lo, float hi) { return __builtin_bit_cast(unsigned, __builtin_convertvector((f32x2){lo, hi}, hw_bf16x2)); }
__device__ __forceinline__ unsigned f2bf(float f) { return pk2(f, 0.f) & 0xffffu; }
#endif
__device__ __forceinline__ float bf2f(unsigned short b) { return __builtin_bit_cast(float, ((unsigned)b) << 16); }
__device__ __forceinline__ float bflo(unsigned w) { return __builtin_bit_cast(float, w << 16); }
__device__ __forceinline__ float bfhi(unsigned w) { return __builtin_bit_cast(float, w & 0xffff0000u); }
#ifdef EMU
__device__ __forceinline__ float fexp(float x) { return expf(x); }
__device__ __forceinline__ float frcp(float x) { return 1.0f / x; }
__device__ __forceinline__ float frsq(float x) { return 1.0f / sqrtf(x); }
__device__ __forceinline__ float fexp2(float x) { return exp2f(x); }
__device__ __forceinline__ float flog(float x) { return logf(x); }
#else
__device__ __forceinline__ float fexp(float x) { return __builtin_amdgcn_exp2f(x * 1.4426950408889634f); }
__device__ __forceinline__ float frcp(float x) { return __builtin_amdgcn_rcpf(x); }
__device__ __forceinline__ float frsq(float x) { return __builtin_amdgcn_rsqf(x); }
__device__ __forceinline__ float fexp2(float x) { return __builtin_amdgcn_exp2f(x); }
__device__ __forceinline__ float flog(float x) { return __builtin_amdgcn_logf(x) * 0.6931471805599453f; }
#endif
__device__ __forceinline__ float sigmoidf_(float x) { return frcp(1.0f + fexp(-x)); }
__device__ __forceinline__ float siluf_(float x) { return x * frcp(1.0f + fexp(-x)); }
__device__ __forceinline__ float gelu_tanh(float x) { const float u = 0.7978845608028654f * (x + 0.044715f * x * x * x); return x * (1.0f - frcp(1.0f + fexp(2.0f * u))); }
#ifdef EMU
__device__ __forceinline__ float wave_sum(float v) {
#pragma unroll
    for (int o = 1; o < 64; o <<= 1) v += __shfl_xor(v, o);
    return v;
}
#else
__device__ __forceinline__ float wave_sum(float v) {
    v += __builtin_bit_cast(float, __builtin_amdgcn_update_dpp(0, __builtin_bit_cast(int, v), 0xB1, 0xF, 0xF, true));
    v += __builtin_bit_cast(float, __builtin_amdgcn_update_dpp(0, __builtin_bit_cast(int, v), 0x4E, 0xF, 0xF, true));
    v += __builtin_bit_cast(float, __builtin_amdgcn_update_dpp(0, __builtin_bit_cast(int, v), 0x141, 0xF, 0xF, true));
    v += __builtin_bit_cast(float, __builtin_amdgcn_update_dpp(0, __builtin_bit_cast(int, v), 0x140, 0xF, 0xF, true));
    const int iv = __builtin_bit_cast(int, v);
    return (__builtin_bit_cast(float, __builtin_amdgcn_readlane(iv, 0)) + __builtin_bit_cast(float, __builtin_amdgcn_readlane(iv, 16))) +
           (__builtin_bit_cast(float, __builtin_amdgcn_readlane(iv, 32)) + __builtin_bit_cast(float, __builtin_amdgcn_readlane(iv, 48)));
}
#endif
__device__ __forceinline__ void dsincos(double a, double& s, double& c) {
    const double k = __builtin_rint(a * 0.15915494309189535);
    const double r = __builtin_fma(-k, 6.283185307179586, a) - k * 2.4492935982947064e-16;
    const double r2 = r * r;
    double ps = 1.0 / 51090942171709440000.0;
    ps = ps * r2 - 1.0 / 121645100408832000.0; ps = ps * r2 + 1.0 / 355687428096000.0; ps = ps * r2 - 1.0 / 1307674368000.0; ps = ps * r2 + 1.0 / 6227020800.0;
    ps = ps * r2 - 1.0 / 39916800.0; ps = ps * r2 + 1.0 / 362880.0; ps = ps * r2 - 1.0 / 5040.0; ps = ps * r2 + 1.0 / 120.0; ps = ps * r2 - 1.0 / 6.0; ps = ps * r2 + 1.0;
    s = ps * r;
    double pc = -1.0 / 1124000727777607680000.0;
    pc = pc * r2 + 1.0 / 2432902008176640000.0; pc = pc * r2 - 1.0 / 6402373705728000.0; pc = pc * r2 + 1.0 / 20922789888000.0; pc = pc * r2 - 1.0 / 87178291200.0;
    pc = pc * r2 + 1.0 / 479001600.0; pc = pc * r2 - 1.0 / 3628800.0; pc = pc * r2 + 1.0 / 40320.0; pc = pc * r2 - 1.0 / 720.0; pc = pc * r2 + 1.0 / 24.0; pc = pc * r2 - 0.5; pc = pc * r2 + 1.0;
    c = pc;
}

#ifdef EMU
__device__ __forceinline__ unsigned ld_agent(const unsigned* p) { return __atomic_load_n(p, __ATOMIC_RELAXED); }
#else
__device__ __forceinline__ unsigned ld_agent(const unsigned* p) { return __hip_atomic_load(p, __ATOMIC_RELAXED, __HIP_MEMORY_SCOPE_AGENT); }
#endif
struct Args { const void* in[32]; float* out; unsigned char* ws; int ph_lo, ph_hi; };
struct Frame {
    lu8* lds; unsigned char* ws; float* out;
    int tid, lane, wave, G, bid, rep;
    const float* x; const int* pos;
    const LAS unsigned long long* ptab;
    __device__ __forceinline__ const float* inp(int i) const { const unsigned long long v = ptab[i];
        const unsigned lo = (unsigned)__builtin_amdgcn_readfirstlane((int)(unsigned)v), hi = (unsigned)__builtin_amdgcn_readfirstlane((int)(unsigned)(v >> 32));
#ifdef EMU
        return (const float*)(((unsigned long long)hi << 32) | lo); }
#else
        return (const float*)(const __attribute__((address_space(1))) float*)(((unsigned long long)hi << 32) | lo); }
#endif
};

#define norm1_g inp(2)
#define w_in inp(3)
#define w_out inp(4)
#define s5_a_re inp(5)
#define s5_a_im inp(6)
#define s5_log_dt inp(7)
#define s5_b_re inp(8)
#define s5_b_im inp(9)
#define s5_c_re inp(10)
#define s5_c_im inp(11)
#define s5_d inp(12)
#define s5_w_glu inp(13)
#define s5_b_glu inp(14)
#define m2_conv_w inp(15)
#define m2_conv_b inp(16)
#define m2_dt_bias inp(17)
#define m2_a_log inp(18)
#define m2_d inp(19)
#define m2_norm_g inp(20)
#define hg_lb_logits inp(21)
#define hg_norm_g inp(22)
#define norm2_g inp(23)
#define moe_w_group inp(24)
#define moe_b_group inp(25)
#define moe_w_expert inp(26)
#define moe_b_expert inp(27)
#define moe_w_gate inp(28)
#define moe_w_up inp(29)
#define moe_w_down inp(30)
#define final_norm_g inp(31)
#define WSP(T, off) ((T*)(F.ws + (off)))
#ifdef EMU
#define CFENCE() ((void)0)
#else
#define CFENCE() asm volatile("" ::: "memory")
#endif
#ifdef EMU
#define LAUNDER(F) ((void)0)
#define LAUNDER_I(x) ((void)0)
#else
#define LAUNDER(F) do { size_t z_ = 0; asm volatile("" : "+v"((F).tid), "+v"((F).lane), "+s"((F).wave), "+s"(z_)); (F).ws = (F).ws + z_; } while (0)
#define LAUNDER_I(x) asm volatile("" : "+v"(x))
#endif

#ifndef EMU
#define XB_TMO      128
#define XB_XCNT(j)  (256  + 64 * (j))
#define XB_XSUB(j)  (1280 + 64 * (j))
#define XB_XGEN(j)  (2304 + 64 * (j))
#define XB_TOP      3328
#define XB_TOPGEN   3392
#define XCD_BAR_WORDS 3456
#define XB_SPIN_CAP (1u << 20)
__device__ __forceinline__ unsigned xb_ld(unsigned* p)              { return __hip_atomic_load(p, __ATOMIC_RELAXED, __HIP_MEMORY_SCOPE_AGENT); }
__device__ __forceinline__ unsigned xb_add(unsigned* p, unsigned v) { return __hip_atomic_fetch_add(p, v, __ATOMIC_RELAXED, __HIP_MEMORY_SCOPE_AGENT); }
__device__ __forceinline__ unsigned xb_xcc_id() { return (unsigned)__builtin_amdgcn_s_getreg((3 << 11) | 20) & 0xFu; }
#define XB_SPIN(cond, bar) do { unsigned _sp = 0; while (cond) { __builtin_amdgcn_s_sleep(1); \
    if ((++_sp & 255u) == 0u) { if (xb_ld(&(bar)[XB_TMO])) break; if (_sp > XB_SPIN_CAP) { atomicAdd(&(bar)[XB_TMO], 1u); break; } } } } while (0)
struct XcdBarrier { unsigned* bar; unsigned x; volatile LAS unsigned* st; };
__device__ __forceinline__ XcdBarrier xcd_barrier_post(unsigned* bar, volatile LAS unsigned* st) {
    XcdBarrier b; b.bar = bar; b.x = xb_xcc_id(); b.st = st;
    if (threadIdx.x == 0) (void)xb_add(&bar[XB_XCNT(b.x)], 1u);
    return b;
}
__device__ __forceinline__ void xcd_barrier_complete(unsigned* bar, unsigned x, unsigned& nloc, unsigned& nx) {
    const unsigned G = gridDim.x * gridDim.y * gridDim.z;
    unsigned sum, cnt, mine, sp = 0u;
    for (;;) {
        sum = 0u; cnt = 0u; mine = 0u;
#pragma unroll
        for (unsigned j = 0; j < 16; ++j) { const unsigned c = xb_ld(&bar[XB_XCNT(j)]); sum += c; cnt += (c > 0u) ? 1u : 0u; mine = (j == x) ? c : mine; }
        if (sum == G) break;
        __builtin_amdgcn_s_sleep(1);
        if ((++sp & 255u) == 0u) { if (xb_ld(&bar[XB_TMO])) break; if (sp > XB_SPIN_CAP) { atomicAdd(&bar[XB_TMO], 1u); break; } }
    }
    nloc = mine > 0u ? mine : 1u; nx = cnt > 0u ? cnt : 1u;
}
__device__ __forceinline__ void xcd_barrier(const XcdBarrier& b) {
    asm volatile("s_waitcnt vmcnt(0)" ::: "memory");
    __syncthreads();
    if (threadIdx.x == 0) {
        unsigned* bar = b.bar;
        __builtin_amdgcn_s_waitcnt(0);
        unsigned nloc = b.st[0], nx = b.st[1];
        if (nloc == 0u) { xcd_barrier_complete(bar, b.x, nloc, nx); b.st[0] = nloc; b.st[1] = nx; }
        const unsigned old = xb_add(&bar[XB_XSUB(b.x)], 1u);
        const unsigned gen = old / nloc;
        if (old + 1u == (gen + 1u) * nloc) {
            __builtin_amdgcn_fence(__ATOMIC_RELEASE, "agent");
            asm volatile("s_waitcnt vmcnt(0)" ::: "memory");
            const unsigned og = xb_add(&bar[XB_TOP], 1u);
            const unsigned tg = og / nx;
            if (og + 1u == (tg + 1u) * nx) xb_add(&bar[XB_TOPGEN], 1u);
            else XB_SPIN(xb_ld(&bar[XB_TOPGEN]) == tg, bar);
            __builtin_amdgcn_fence(__ATOMIC_ACQUIRE, "agent");
            xb_add(&bar[XB_XGEN(b.x)], 1u);
            asm volatile("s_waitcnt vmcnt(0)" ::: "memory");
        } else {
            XB_SPIN(xb_ld(&bar[XB_XGEN(b.x)]) == gen, bar);
            __builtin_amdgcn_fence(__ATOMIC_ACQUIRE, "agent");
            asm volatile("s_waitcnt vmcnt(0)" ::: "memory");
        }
    }
    __syncthreads();
}
#endif

constexpr int GT_BK = 128, GT_LD = GT_BK + 8;
constexpr int GT_BYTES = 2 * 128 * GT_LD * 2;
template <class AP, class BP, class EPI>
__device__ __forceinline__ void gemm128(lu8* lds, int K, const AP& ap, const BP& bp, const EPI& epi) {
    int tid = threadIdx.x; LAUNDER_I(tid);
    const int lane = tid & 63, wid = tid >> 6, wr = wid >> 1, wc = wid & 1, fr = lane & 15, fq = lane >> 4;
    lbf* As = (lbf*)lds; lbf* Bs = (lbf*)(lds + 128 * GT_LD * 2);
    f32x4 acc[2][4];
#pragma unroll
    for (int m = 0; m < 2; ++m)
#pragma unroll
        for (int n = 0; n < 4; ++n) acc[m][n] = (f32x4){0.f, 0.f, 0.f, 0.f};
    u32x4 ra[2][4], rb[2][4];
    const int nk = K / GT_BK;
#define GT_LOAD(slot, k0) do { _Pragma("unroll") for (int i = 0; i < 4; ++i) { const int p = tid + 512 * i, r = p >> 4, kc = p & 15; ra[slot][i] = *(const u32x4*)ap(r, (k0) + kc * 8); rb[slot][i] = *(const u32x4*)bp(r, (k0) + kc * 8); } } while (0)
    GT_LOAD(0, 0);
    if (nk > 1) GT_LOAD(1, GT_BK);
    for (int kt = 0; kt < nk; kt += 2) {
#pragma unroll
        for (int half = 0; half < 2; ++half) {
            if (kt + half < nk) {
                __syncthreads();
#pragma unroll
                for (int i = 0; i < 4; ++i) { const int p = tid + 512 * i, r = p >> 4, kc = p & 15; *(LAS u32x4*)(As + r * GT_LD + kc * 8) = ra[half][i]; *(LAS u32x4*)(Bs + r * GT_LD + kc * 8) = rb[half][i]; }
                __syncthreads();
                if (kt + half + 2 < nk) GT_LOAD(half, (kt + half + 2) * GT_BK);
#pragma unroll
                for (int ks = 0; ks < 4; ++ks) {
                    bf16x8 a[2], b[4];
#pragma unroll
                    for (int m = 0; m < 2; ++m) a[m] = *(const LAS bf16x8*)(As + (wr * 32 + m * 16 + fr) * GT_LD + ks * 32 + fq * 8);
#pragma unroll
                    for (int n = 0; n < 4; ++n) b[n] = *(const LAS bf16x8*)(Bs + (wc * 64 + n * 16 + fr) * GT_LD + ks * 32 + fq * 8);
#pragma unroll
                    for (int m = 0; m < 2; ++m)
#pragma unroll
                        for (int n = 0; n < 4; ++n) acc[m][n] = __builtin_amdgcn_mfma_f32_16x16x32_bf16(b[n], a[m], acc[m][n], 0, 0, 0);
                }
            }
        }
    }
#undef GT_LOAD
    if constexpr (EPI::HAS_PRE) {
        typename EPI::Pre pre[2][4];
#pragma unroll
        for (int m = 0; m < 2; ++m)
#pragma unroll
            for (int n = 0; n < 4; ++n) pre[m][n] = epi.load(wr * 32 + m * 16 + fr, wc * 64 + n * 16 + 4 * fq);
#pragma unroll
        for (int m = 0; m < 2; ++m)
#pragma unroll
            for (int n = 0; n < 4; ++n) epi.fin(wr * 32 + m * 16 + fr, wc * 64 + n * 16 + 4 * fq, acc[m][n], pre[m][n]);
    } else {
#pragma unroll
    for (int m = 0; m < 2; ++m)
#pragma unroll
        for (int n = 0; n < 4; ++n) epi(wr * 32 + m * 16 + fr, wc * 64 + n * 16 + 4 * fq, acc[m][n]);
    }
}
struct PtrRM { const bf16* base; size_t ld; int rmax;
    __device__ __forceinline__ const bf16* operator()(int r, int k) const { return base + (size_t)(r < rmax ? r : rmax) * ld + k; } };

template <int NT, int KS>
__device__ __forceinline__ void wave_mma(f32x4 (&acc)[NT], const lbf* A, int lda, const lbf* B, int ldb, int lane) {
    const int fr = lane & 15, fq = lane >> 4;
#pragma unroll
    for (int ks = 0; ks < KS; ++ks) {
        const bf16x8 a = *(const LAS bf16x8*)(A + fr * lda + ks * 32 + fq * 8);
#pragma unroll
        for (int n = 0; n < NT; ++n) { const bf16x8 b = *(const LAS bf16x8*)(B + (n * 16 + fr) * ldb + ks * 32 + fq * 8); acc[n] = __builtin_amdgcn_mfma_f32_16x16x32_bf16(b, a, acc[n], 0, 0, 0); }
    }
}


namespace g8 {
constexpr int BM = 256, BK = 64, HALF = 128, HTB = HALF * BK * 2, STAGE_BYTES = 8 * HTB;
__host__ __device__ __forceinline__ int lds_byte(int r, int c) { const int st = (r >> 4) * 2 + (c >> 5), rr = r & 15, cc = c & 31, ob = rr * 64 + cc * 2; return st * 1024 + (ob ^ (((ob >> 9) & 1) << 5)); }
__host__ __device__ __forceinline__ void stage_rc(int b, int& R, int& C) { const int st = b / 1024, sb = b % 1024, swz = sb ^ (((sb >> 9) & 1) << 5); R = (st >> 1) * 16 + swz / 64; C = (st & 1) * 32 + (swz % 64) / 2; }
__host__ __device__ __forceinline__ int perm32(int rho) { const int n = rho >> 4, i = rho & 15; return 8 * (i >> 2) + 4 * n + (i & 3); }
struct Unit { size_t aoff, boff; int pm, pn; };
#ifdef EMU
#define G8_WAIT_V(n) ((void)0)
#define G8_WAIT_L(n) ((void)0)
#else
#define G8_WAIT_V(n) asm volatile("s_waitcnt vmcnt(" #n ")" ::: "memory")
#define G8_WAIT_L(n) asm volatile("s_waitcnt lgkmcnt(" #n ")" ::: "memory")
#endif
template <class Epi, class Sched, bool ALIGN_EPI = true, bool SP2 = true>
__device__ __forceinline__ void gemm_phase(lu8* lds, const bf16* Abase, const bf16* Bbase, const int K, const Sched& S, const Epi& E) {
    const int tid = threadIdx.x, wid = __builtin_amdgcn_readfirstlane(tid >> 6), lane = tid & 63, wr = wid >> 2, wc = wid & 3, fr = lane & 15, fq = lane >> 4;
    const int nt = K / BK;
    unsigned voffA[2], voffB[2];
#pragma unroll
    for (int i = 0; i < 2; ++i) { int R, C; stage_rc(tid * 16 + i * 8192, R, C); const int Rb = Epi::PERM ? ((R & ~31) + perm32(R & 31)) : R;
        voffA[i] = (unsigned)(R * K + C) * 2u; voffB[i] = (unsigned)(Rb * K + C) * 2u; }
    const size_t kstep = (size_t)(BK * 2), hstep = (size_t)HALF * K * 2;
    const unsigned ldsw = (unsigned)wid * 1024u;
    const int aoff = lds_byte(wr * 64 + fr, fq * 8), boff = lds_byte(wc * 32 + fr, fq * 8);
#define G8_SA(b, h) (((b) * 2 + (h)) * HTB)
#define G8_SB(b, h) ((4 + (b) * 2 + (h)) * HTB)
#define G8_STAGE(bufoff, gbase, voff) do { _Pragma("unroll") for (int _i = 0; _i < 2; ++_i) \
        __builtin_amdgcn_global_load_lds((const unsigned*)((const char*)(gbase) + (voff)[_i]), (LAS unsigned*)(lds + (bufoff) + ldsw + _i * 8192), 16, 0, 0); } while (0)
#define G8_STAGEA(bufoff, gbase, voff) do { _Pragma("unroll") for (int _i = 0; _i < 2; ++_i) \
        __builtin_amdgcn_global_load_lds((const unsigned*)((const char*)(gbase) + (voff)[_i]), (LAS unsigned*)(lds + (bufoff) + ldsw + _i * 8192), 16, 0, Sched::A_AUX); } while (0)
#define G8_LDA(dst, b, h) do { _Pragma("unroll") for (int m = 0; m < 4; ++m) _Pragma("unroll") for (int k = 0; k < 2; ++k) dst[m][k] = *(const LAS bf16x8*)(lds + G8_SA(b, h) + aoff + m * 2048 + k * 1024); } while (0)
#define G8_LDB(dst, b, h) do { _Pragma("unroll") for (int n = 0; n < 2; ++n) _Pragma("unroll") for (int k = 0; k < 2; ++k) dst[n][k] = *(const LAS bf16x8*)(lds + G8_SB(b, h) + boff + n * 2048 + k * 1024); } while (0)
#define G8_MMA(ai, bj, At, Bt) do { __builtin_amdgcn_s_setprio(1); _Pragma("unroll") for (int m = 0; m < 4; ++m) _Pragma("unroll") for (int n = 0; n < 2; ++n) _Pragma("unroll") for (int k = 0; k < 2; ++k) \
        acc[ai][bj][m][n] = __builtin_amdgcn_mfma_f32_16x16x32_bf16(Bt[n][k], At[m][k], acc[ai][bj][m][n], 0, 0, 0); __builtin_amdgcn_s_setprio(0); } while (0)
#define G8_BAR __builtin_amdgcn_s_barrier()
#define G8_SCHED __builtin_amdgcn_sched_barrier(0)
    Unit cur, nxt; int ui = 0; int pend = -1;
    if (!S.next(0, cur)) return;
    f32x4 acc[2][2][4][2];
    bool pre = false;
    if constexpr (Epi::INIT_ACC) pre = E.want_pre(cur);
    if (pre) { if constexpr (Epi::INIT_ACC) E.init(acc, cur, wr, wc, fr, fq); }
    else {
#pragma unroll
    for (int a = 0; a < 2; ++a)
#pragma unroll
        for (int b = 0; b < 2; ++b)
#pragma unroll
            for (int m = 0; m < 4; ++m)
#pragma unroll
                for (int n = 0; n < 2; ++n) acc[a][b][m][n] = (f32x4){0.f, 0.f, 0.f, 0.f};
    }
    bf16x8 At[4][2], B0[2][2], B1[2][2];
    const char* cA = (const char*)Abase + cur.aoff; const char* cB = (const char*)Bbase + cur.boff;
    if constexpr (SP2) {
        G8_STAGE(G8_SB(0, 0), cB, voffB); G8_STAGE(G8_SB(0, 1), cB + hstep, voffB); G8_STAGEA(G8_SA(0, 0), cA, voffA); G8_STAGEA(G8_SA(0, 1), cA + hstep, voffA);
        if (wr == 1) G8_BAR;
        G8_WAIT_V(2); G8_BAR;
        G8_STAGE(G8_SB(1, 0), cB + kstep, voffB); G8_STAGEA(G8_SA(1, 0), cA + kstep, voffA); G8_STAGE(G8_SB(1, 1), cB + hstep + kstep, voffB);
        G8_WAIT_V(6); G8_BAR;
    } else {
        G8_STAGE(G8_SB(0, 0), cB, voffB); G8_STAGEA(G8_SA(0, 0), cA, voffA); G8_STAGE(G8_SB(0, 1), cB + hstep, voffB); G8_STAGEA(G8_SA(0, 1), cA + hstep, voffA);
        if (wr == 1) G8_BAR;
        G8_WAIT_V(4); G8_BAR;
        G8_STAGE(G8_SB(1, 0), cB + kstep, voffB); G8_STAGEA(G8_SA(1, 0), cA + kstep, voffA); G8_STAGE(G8_SB(1, 1), cB + hstep + kstep, voffB);
        G8_WAIT_V(6); G8_BAR;
    }
    for (;;) {
        const bool has_next = S.next(ui + 1, nxt);
        const char* nA = has_next ? (const char*)Abase + nxt.aoff : cA; const char* nB = has_next ? (const char*)Bbase + nxt.boff : cB;
        for (int t = 0; t < nt; t += 2) {
            const bool last = (t == nt - 2);
            if constexpr (Epi::DEFER_PUB) { if (t == 2 && pend >= 0) { E.publish(pend, lane == 0); pend = -1; } }
            const char* a1 = cA + (size_t)(t + 1) * kstep;
            const char* a2 = last ? nA : cA + (size_t)(t + 2) * kstep; const char* b2 = last ? nB : cB + (size_t)(t + 2) * kstep;
            const char* a3 = a2 + kstep; const char* b3 = b2 + kstep;
            if constexpr (SP2) {
            G8_LDB(B0, 0, 0); G8_LDB(B1, 0, 1); G8_SCHED; G8_LDA(At, 0, 0); G8_STAGEA(G8_SA(1, 1), a1 + hstep, voffA);
            G8_WAIT_V(8); G8_WAIT_L(0); G8_BAR; G8_MMA(0, 0, At, B0); G8_MMA(0, 1, At, B1); G8_BAR; G8_SCHED;
            G8_LDA(At, 0, 1); G8_STAGE(G8_SB(0, 0), b2, voffB); G8_STAGE(G8_SB(0, 1), b2 + hstep, voffB); G8_STAGEA(G8_SA(0, 0), a2, voffA);
            G8_WAIT_V(8); G8_WAIT_L(0); G8_BAR; G8_MMA(1, 0, At, B0); G8_MMA(1, 1, At, B1); G8_BAR; G8_SCHED;
            G8_LDB(B0, 1, 0); G8_LDB(B1, 1, 1); G8_SCHED; G8_LDA(At, 1, 0); G8_STAGEA(G8_SA(0, 1), a2 + hstep, voffA);
            G8_WAIT_V(8); G8_WAIT_L(0); G8_BAR; G8_MMA(0, 0, At, B0); G8_MMA(0, 1, At, B1); G8_BAR; G8_SCHED;
            G8_LDA(At, 1, 1); G8_STAGE(G8_SB(1, 0), b3, voffB); G8_STAGE(G8_SB(1, 1), b3 + hstep, voffB); G8_STAGEA(G8_SA(1, 0), a3, voffA);
            G8_WAIT_V(8); G8_WAIT_L(0); G8_BAR; G8_MMA(1, 0, At, B0); G8_MMA(1, 1, At, B1); G8_BAR; G8_SCHED;
            } else {
            G8_LDB(B0, 0, 0); G8_SCHED; G8_LDA(At, 0, 0); G8_STAGEA(G8_SA(1, 1), a1 + hstep, voffA);
            G8_WAIT_L(8); G8_BAR; G8_WAIT_L(0); G8_MMA(0, 0, At, B0); G8_BAR; G8_SCHED;
            G8_LDB(B1, 0, 1); G8_STAGE(G8_SB(0, 0), b2, voffB);
            G8_BAR; G8_WAIT_L(0); G8_MMA(0, 1, At, B1); G8_BAR;
            G8_LDA(At, 0, 1); G8_STAGEA(G8_SA(0, 0), a2, voffA);
            G8_BAR; G8_WAIT_L(0); G8_MMA(1, 0, At, B0); G8_BAR; G8_SCHED;
            G8_STAGE(G8_SB(0, 1), b2 + hstep, voffB);
            G8_WAIT_V(6); G8_BAR; G8_MMA(1, 1, At, B1); G8_BAR;
            G8_LDB(B0, 1, 0); G8_SCHED; G8_LDA(At, 1, 0); G8_STAGEA(G8_SA(0, 1), a2 + hstep, voffA);
            G8_WAIT_L(8); G8_BAR; G8_WAIT_L(0); G8_MMA(0, 0, At, B0); G8_BAR; G8_SCHED;
            G8_LDB(B1, 1, 1); G8_STAGE(G8_SB(1, 0), b3, voffB);
            G8_BAR; G8_WAIT_L(0); G8_MMA(0, 1, At, B1); G8_BAR;
            G8_LDA(At, 1, 1); G8_STAGEA(G8_SA(1, 0), a3, voffA);
            G8_BAR; G8_WAIT_L(0); G8_MMA(1, 0, At, B0); G8_BAR; G8_SCHED;
            G8_STAGE(G8_SB(1, 1), b3 + hstep, voffB);
            G8_WAIT_V(6); G8_BAR; G8_MMA(1, 1, At, B1); G8_BAR;
            }
        }
        if constexpr (ALIGN_EPI) { if (wr == 0) G8_BAR; }
        if constexpr (Epi::INIT_ACC) { E.ep(acc, cur, wr, wc, fr, fq, pre); pre = false; } else E(acc, cur, wr, wc, fr, fq);
        if constexpr (Epi::DEFER_PUB) pend = cur.pm;
        if (!has_next) break;
#pragma unroll
        for (int a = 0; a < 2; ++a)
#pragma unroll
            for (int b = 0; b < 2; ++b)
#pragma unroll
                for (int m = 0; m < 4; ++m)
#pragma unroll
                    for (int n = 0; n < 2; ++n) acc[a][b][m][n] = (f32x4){0.f, 0.f, 0.f, 0.f};
        cur = nxt; cA = nA; cB = nB; ++ui;
        if constexpr (ALIGN_EPI) { if (wr == 1) G8_BAR; }
    }
    G8_WAIT_V(0);
    if constexpr (Epi::DEFER_PUB) { if (pend >= 0) E.publish(pend, lane == 0); }
    if constexpr (!ALIGN_EPI) { if (wr == 0) G8_BAR; }
    G8_BAR;
#undef G8_SA
#undef G8_SB
#undef G8_STAGE
#undef G8_STAGEA
#undef G8_LDA
#undef G8_LDB
#undef G8_MMA
#undef G8_BAR
#undef G8_SCHED
}
struct GridOrder { static constexpr int A_AUX = 0; int nM, nN, nwg, G, c; size_t astep, bstep;
    __device__ __forceinline__ bool next(int i, Unit& u) const {
        const long Lx = (long)i * G + c; if (Lx >= nwg) return false;
        int wgid = (int)Lx; { const int q = nwg / 8, r = nwg % 8, xcd = wgid % 8, off = wgid / 8; wgid = (xcd < r ? xcd * (q + 1) : r * (q + 1) + (xcd - r) * q) + off; }
        const int nig = 8 * nN, gid = wgid / nig, fm = gid * 8, gsz = (nM - fm) < 8 ? (nM - fm) : 8;
        u.pm = fm + ((wgid % nig) % gsz); u.pn = (wgid % nig) / gsz; u.aoff = (size_t)u.pm * astep; u.boff = (size_t)u.pn * bstep; return true; } };
struct OneUnit { static constexpr int A_AUX = 0; int pm, pn; size_t astep, bstep;
    __device__ __forceinline__ bool next(int i, Unit& u) const { if (i != 0) return false; u.pm = pm; u.pn = pn; u.aoff = (size_t)pm * astep; u.boff = (size_t)pn * bstep; return true; } };
struct MoeOrder { static constexpr int A_AUX = 0; int np, G, c; const li32* pe; size_t astep, estep, bstep;
    __device__ __forceinline__ bool next(int i, Unit& u) const {
        int Lx = i * G + c; const int nwg = np * 4; if (Lx >= nwg) return false;
        { const int q = nwg / 8, r = nwg % 8, xcd = Lx % 8, off = Lx / 8; Lx = (xcd < r ? xcd * (q + 1) : r * (q + 1) + (xcd - r) * q) + off; }
        u.pm = Lx >> 2; u.pn = Lx & 3; u.aoff = (size_t)u.pm * astep; const int e = __builtin_amdgcn_readfirstlane(pe[u.pm]); u.boff = (size_t)e * estep + (size_t)u.pn * bstep; return true; } };
struct EpiStore {
    static constexpr bool PERM = true, DEFER_PUB = false, INIT_ACC = false;
    bf16* O; int ldc;
    __device__ __forceinline__ void operator()(const f32x4 (&acc)[2][2][4][2], const Unit& u, int wr, int wc, int fr, int fq) const {
        const int row0 = u.pm * BM + wr * 64 + fr, col0 = u.pn * BM + wc * 32 + 8 * fq;
#pragma unroll
        for (int ai = 0; ai < 2; ++ai)
#pragma unroll
            for (int m = 0; m < 4; ++m) { bf16* rowp = O + (size_t)(row0 + ai * HALF + m * 16) * ldc + col0;
#pragma unroll
                for (int bj = 0; bj < 2; ++bj) { const f32x4 v0 = acc[ai][bj][m][0], v1 = acc[ai][bj][m][1];
                    u32x4 w; w.x = pk2(v0.x, v0.y); w.y = pk2(v0.z, v0.w); w.z = pk2(v1.x, v1.y); w.w = pk2(v1.z, v1.w); *(u32x4*)(rowp + bj * HALF) = w; } }
    } };
template <bool XBF>
struct EpiResid {
    static constexpr bool PERM = true, DEFER_PUB = false, INIT_ACC = true;
    const void* xin; bf16* out;
    __device__ __forceinline__ bool want_pre(const Unit& u) const { return (u.pm & 1) != 0; }
    __device__ __forceinline__ void init(f32x4 (&acc)[2][2][4][2], const Unit& u, int wr, int wc, int fr, int fq) const {
        const int row0 = u.pm * BM + wr * 64 + fr, col0 = u.pn * BM + wc * 32 + 8 * fq;
#pragma unroll
        for (int ai = 0; ai < 2; ++ai)
#pragma unroll
            for (int m = 0; m < 4; ++m)
#pragma unroll
                for (int bj = 0; bj < 2; ++bj) { const size_t o = (size_t)(row0 + ai * HALF + m * 16) * D + col0 + bj * HALF;
                    if (XBF) { const u32x4 xb = *(const u32x4*)((const bf16*)xin + o); acc[ai][bj][m][0] = (f32x4){bflo(xb.x), bfhi(xb.x), bflo(xb.y), bfhi(xb.y)}; acc[ai][bj][m][1] = (f32x4){bflo(xb.z), bfhi(xb.z), bflo(xb.w), bfhi(xb.w)}; }
                    else { acc[ai][bj][m][0] = *(const f32x4*)((const float*)xin + o); acc[ai][bj][m][1] = *(const f32x4*)((const float*)xin + o + 4); } }
    }
    __device__ __forceinline__ void ep(const f32x4 (&acc)[2][2][4][2], const Unit& u, int wr, int wc, int fr, int fq, bool pre) const {
        const int row0 = u.pm * BM + wr * 64 + fr, col0 = u.pn * BM + wc * 32 + 8 * fq;
        if (pre) {
#pragma unroll
            for (int ai = 0; ai < 2; ++ai)
#pragma unroll
                for (int m = 0; m < 4; ++m)
#pragma unroll
                    for (int bj = 0; bj < 2; ++bj) { const size_t o = (size_t)(row0 + ai * HALF + m * 16) * D + col0 + bj * HALF; const f32x4 v0 = acc[ai][bj][m][0], v1 = acc[ai][bj][m][1];
                        u32x4 w; w.x = pk2(v0.x, v0.y); w.y = pk2(v0.z, v0.w); w.z = pk2(v1.x, v1.y); w.w = pk2(v1.z, v1.w); *(u32x4*)(out + o) = w; }
            return;
        }
#pragma unroll
        for (int ai = 0; ai < 2; ++ai) {
            f32x4 x0[4][2], x1[4][2];
#pragma unroll
            for (int m = 0; m < 4; ++m)
#pragma unroll
                for (int bj = 0; bj < 2; ++bj) { const size_t o = (size_t)(row0 + ai * HALF + m * 16) * D + col0 + bj * HALF;
                    if (XBF) { const u32x4 xb = *(const u32x4*)((const bf16*)xin + o); x0[m][bj] = (f32x4){bflo(xb.x), bfhi(xb.x), bflo(xb.y), bfhi(xb.y)}; x1[m][bj] = (f32x4){bflo(xb.z), bfhi(xb.z), bflo(xb.w), bfhi(xb.w)}; }
                    else { x0[m][bj] = *(const f32x4*)((const float*)xin + o); x1[m][bj] = *(const f32x4*)((const float*)xin + o + 4); } }
#pragma unroll
            for (int m = 0; m < 4; ++m)
#pragma unroll
                for (int bj = 0; bj < 2; ++bj) { const size_t o = (size_t)(row0 + ai * HALF + m * 16) * D + col0 + bj * HALF;
                    const f32x4 v0 = x0[m][bj] + acc[ai][bj][m][0], v1 = x1[m][bj] + acc[ai][bj][m][1];
                    u32x4 w; w.x = pk2(v0.x, v0.y); w.y = pk2(v0.z, v0.w); w.z = pk2(v1.x, v1.y); w.w = pk2(v1.z, v1.w); *(u32x4*)(out + o) = w; }
        }
    } };
struct EpiStoreU {
    static constexpr bool PERM = true, DEFER_PUB = false, INIT_ACC = false;
    bf16* O; int ldc; bf16* ug;
    __device__ __forceinline__ void operator()(const f32x4 (&acc)[2][2][4][2], const Unit& u, int wr, int wc, int fr, int fq) const {
        const int row0 = u.pm * BM + wr * 64 + fr, col0 = u.pn * BM + wc * 32 + 8 * fq;
#pragma unroll
        for (int ai = 0; ai < 2; ++ai)
#pragma unroll
            for (int m = 0; m < 4; ++m) { const int t = row0 + ai * HALF + m * 16; bf16* rowp = O + (size_t)t * ldc + col0;
#pragma unroll
                for (int bj = 0; bj < 2; ++bj) { const f32x4 v0 = acc[ai][bj][m][0], v1 = acc[ai][bj][m][1];
                    u32x4 w; w.x = pk2(v0.x, v0.y); w.y = pk2(v0.z, v0.w); w.z = pk2(v1.x, v1.y); w.w = pk2(v1.z, v1.w); *(u32x4*)(rowp + bj * HALF) = w;
                    if (u.pn == 0) { const int g = 8 * bj + 2 * wc + (fq >> 1); *(u32x4*)(ug + ((size_t)g * NR5 + (t >> 5)) * 640 + (t & 31) * 16 + 8 * (fq & 1)) = w; } } }
    } };
struct EpiS5OutG {
    static constexpr bool PERM = false, DEFER_PUB = false, INIT_ACC = false;
    const bf16* proj; bf16* ypre; const float* dsk; int g; int nch5, c_s5u, nproj;
    __device__ __forceinline__ void operator()(const f32x4 (&acc)[2][2][4][2], const Unit& u, int wr, int wc, int fr, int fq) const {
        const f32x4 d = *(const f32x4*)(dsk + g * 16 + 4 * fq);
#pragma unroll
        for (int ai = 0; ai < 2; ++ai) {
            u32x2 uu[4][2][2];
#pragma unroll
            for (int m = 0; m < 4; ++m) { const int ch = u.pm * BM + ai * HALF + wr * 64 + m * 16 + fr;
#pragma unroll
                for (int bj = 0; bj < 2; ++bj)
#pragma unroll
                    for (int n = 0; n < 2; ++n) { const int tl = u.pn * 16 + bj * 8 + wc * 2 + n; const size_t t = (size_t)(ch < nch5 ? ch : 0) * 32 + tl;
                        uu[m][bj][n] = *(const u32x2*)(proj + t * nproj + c_s5u + g * 16 + 4 * fq); } }
#pragma unroll
            for (int m = 0; m < 4; ++m) { const int ch = u.pm * BM + ai * HALF + wr * 64 + m * 16 + fr;
#pragma unroll
                for (int bj = 0; bj < 2; ++bj)
#pragma unroll
                    for (int n = 0; n < 2; ++n) { const int tl = u.pn * 16 + bj * 8 + wc * 2 + n; const size_t t = (size_t)ch * 32 + tl; const f32x4 v = acc[ai][bj][m][n]; const u32x2 x = uu[m][bj][n];
                        const float y0 = gelu_tanh(v.x + d.x * bflo(x.x)), y1 = gelu_tanh(v.y + d.y * bfhi(x.x)), y2 = gelu_tanh(v.z + d.z * bflo(x.y)), y3 = gelu_tanh(v.w + d.w * bfhi(x.y));
                        u32x2 o; o.x = pk2(y0, y1); o.y = pk2(y2, y3); if (ch < nch5) *(u32x2*)(ypre + t * 256 + g * 16 + 4 * fq) = o; } }
        }
    } };
struct EpiGateUp {
    static constexpr bool PERM = true, DEFER_PUB = false, INIT_ACC = false;
    bf16* act; unsigned act_bytes; unsigned* cnt;
    __device__ __forceinline__ void operator()(const f32x4 (&acc)[2][2][4][2], const Unit& u, int wr, int wc, int fr, int fq) const {
        const int row0 = u.pm * BM + wr * 64 + fr, col0 = u.pn * HALF + wc * 32 + 8 * fq;
#ifndef EMU
        const __amdgpu_buffer_rsrc_t rs = __builtin_amdgcn_make_buffer_rsrc(act, 0, (int)act_bytes, 0x00020000);
#endif
#pragma unroll
        for (int ai = 0; ai < 2; ++ai)
#pragma unroll
            for (int m = 0; m < 4; ++m) { const f32x4 g0 = acc[ai][0][m][0], g1 = acc[ai][0][m][1], u0 = acc[ai][1][m][0], u1 = acc[ai][1][m][1];
                u32x4 w; w.x = pk2(siluf_(g0.x) * u0.x, siluf_(g0.y) * u0.y); w.y = pk2(siluf_(g0.z) * u0.z, siluf_(g0.w) * u0.w);
                w.z = pk2(siluf_(g1.x) * u1.x, siluf_(g1.y) * u1.y); w.w = pk2(siluf_(g1.z) * u1.z, siluf_(g1.w) * u1.w);
                const size_t o = (size_t)(row0 + ai * HALF + m * 16) * 512 + col0;
#ifdef EMU
                *(u32x4*)(act + o) = w;
#else
                __builtin_amdgcn_raw_buffer_store_b128(w, rs, (unsigned)(o * 2), 0, 16);
#endif
            }
        G8_WAIT_V(0); publish(u.pm, fr == 0 && fq == 0);
    }
    __device__ __forceinline__ void publish(int pm, bool leader) const { if (leader) atomicAdd(cnt + pm * 16, 1u); } };
struct MoeOrderDep { static constexpr int A_AUX = 16; int np, G, rank, n3; const li32* pe; size_t astep, estep, bstep; const unsigned* cnt; int wid;
    __device__ __forceinline__ bool next(int i, Unit& u) const {
        const int nwg = np * 4; int Lx;
        if (n3 >= 0) { if (i == 0) Lx = rank; else if (i == 1) { if (rank >= G - n3) return false; Lx = G + rank; } else if (i == 2) { if (rank >= 2 * n3) return false; Lx = 2 * G - n3 + rank; } else return false; }
        else Lx = i * G + rank;
        if (Lx >= nwg) return false;
        { const int q = nwg / 8, r = nwg % 8, xcd = Lx % 8, off = Lx / 8; Lx = (xcd < r ? xcd * (q + 1) : r * (q + 1) + (xcd - r) * q) + off; }
        u.pm = Lx >> 2; u.pn = Lx & 3; u.aoff = (size_t)u.pm * astep; const int e = __builtin_amdgcn_readfirstlane(pe[u.pm]); u.boff = (size_t)e * estep + (size_t)u.pn * bstep;
        if (wid == 0) { unsigned spins = 0; while (ld_agent(cnt + u.pm * 16) < 32u && ++spins < (1u << 22)) __builtin_amdgcn_s_sleep(1); }
        if (i == 0) __syncthreads();
        return true; } };
}

constexpr int CW_DEP = 196608;
constexpr int CW_Q = 131072;
__device__ __forceinline__ int grab_unit(Frame& F, unsigned* ctr) {
    li32* slot = (li32*)(F.lds + MISC_OFF + 128);
    __syncthreads();
    if (F.tid == 0) *slot = (int)atomicAdd(ctr, 1u);
    __syncthreads();
    return *slot;
}
__device__ __forceinline__ void transpose_item(const float* src, int ldsrc, int scol0, int k0, bf16* dst, int K, int drow0, const float* scale, int lane) {
    const int kq = lane >> 3, n2 = lane & 7;
    const float* sp = src + (size_t)(k0 + 8 * kq) * ldsrc + scol0 + 4 * n2;
    f32x4 v[8];
#pragma unroll
    for (int i = 0; i < 8; ++i) v[i] = *(const f32x4*)(sp + (size_t)i * ldsrc);
    if (scale) { const f32x4 s0 = *(const f32x4*)(scale + k0 + 8 * kq), s1 = *(const f32x4*)(scale + k0 + 8 * kq + 4);
        v[0] *= s0.x; v[1] *= s0.y; v[2] *= s0.z; v[3] *= s0.w; v[4] *= s1.x; v[5] *= s1.y; v[6] *= s1.z; v[7] *= s1.w; }
    bf16* dp = dst + (size_t)(drow0 + 4 * n2) * K + k0 + 8 * kq;
#pragma unroll
    for (int j = 0; j < 4; ++j) { u32x4 o; o.x = pk2(v[0][j], v[1][j]); o.y = pk2(v[2][j], v[3][j]); o.z = pk2(v[4][j], v[5][j]); o.w = pk2(v[6][j], v[7][j]);
        *(u32x4*)(dp + (size_t)j * K) = o; }
}
constexpr int CONV_GU_UNITS = 16 * 2 * 256 / 32, CONV_D_UNITS = 16 * 256 / 32;
template <int NI>
__device__ __forceinline__ void transpose_items(const float* src, int ldsrc, int scol0, int k0, bf16* dst, int K, int drow0, int lane) {
    const int kq = lane >> 3, n2 = lane & 7;
    const float* sp = src + (size_t)(k0 + 8 * kq) * ldsrc + scol0 + 4 * n2;
    f32x4 v[NI][8];
#pragma unroll
    for (int i = 0; i < 8; ++i)
#pragma unroll
        for (int q = 0; q < NI; ++q) v[q][i] = *(const f32x4*)(sp + (size_t)i * ldsrc + 32 * q);
    bf16* dp = dst + (size_t)(drow0 + 4 * n2) * K + k0 + 8 * kq;
#pragma unroll
    for (int q = 0; q < NI; ++q)
#pragma unroll
        for (int j = 0; j < 4; ++j) { u32x4 o; o.x = pk2(v[q][0][j], v[q][1][j]); o.y = pk2(v[q][2][j], v[q][3][j]); o.z = pk2(v[q][4][j], v[q][5][j]); o.w = pk2(v[q][6][j], v[q][7][j]);
            *(u32x4*)(dp + (size_t)(32 * q + j) * K) = o; }
}
__device__ __forceinline__ void conv_gu_unit(Frame& F0, int l, int cu) {
    Frame F = F0; LAUNDER(F);
    const int it0 = cu * 32 + F.wave * 4, e = it0 >> 9, up = (it0 >> 8) & 1, r = it0 & 255, kb = r >> 4, nb0 = r & 15;
    const float* src = (up ? F.moe_w_up : F.moe_w_gate) + ((size_t)l * 16 + e) * 1024 * 512;
    const int ff0 = 32 * nb0, drow0 = (ff0 >> 7) * 256 + up * 128;
    transpose_items<4>(src, 512, ff0, 64 * kb, WSP(bf16, WS_WGU) + (size_t)e * 1024 * 1024, 1024, drow0, F.lane);
}
__device__ __forceinline__ void conv_d_unit(Frame& F0, int l, int cu) {
    Frame F = F0; LAUNDER(F);
    const int it0 = cu * 32 + F.wave * 4, e = it0 >> 8, r = it0 & 255, kb = r >> 5, nb0 = r & 31;
    transpose_items<4>(F.moe_w_down + ((size_t)l * 16 + e) * 512 * 1024, 1024, 32 * nb0, 64 * kb, WSP(bf16, WS_WD) + (size_t)e * 1024 * 512, 512, 32 * nb0, F.lane);
}
__device__ __forceinline__ void r1_row(Frame& F, int t, int mode, const LAS f32x4* dw) {
    const int lane = F.lane;
    f32x4 v[4];
    if (mode == 0) { const f32x4* xr = (const f32x4*)(F.x + (size_t)t * D) + lane;
#pragma unroll
        for (int j = 0; j < 4; ++j) v[j] = xr[64 * j]; }
    else { const u32x2* xr = (const u32x2*)(WSP(bf16, WS_XRES) + (size_t)t * D) + lane;
#pragma unroll
        for (int j = 0; j < 4; ++j) { const u32x2 xb = xr[64 * j]; v[j] = (f32x4){bflo(xb.x), bfhi(xb.x), bflo(xb.y), bfhi(xb.y)}; } }
    if (mode != 0) {
        const int* rt = WSP(int, WS_ROUTE) + ((size_t)(mode == 2 ? L : 0) + t) * 8; const float* rtf = (const float*)rt;
        const bf16* ym = WSP(bf16, WS_H2G);
#pragma unroll
        for (int k = 0; k < 2; ++k) { const int slot = rt[6 + k]; const float w = rtf[4 + k];
            const u32x2* yr = (const u32x2*)(ym + (size_t)slot * 1024) + lane;
#pragma unroll
            for (int j = 0; j < 4; ++j) { const u32x2 y = yr[64 * j]; v[j].x += w * bflo(y.x); v[j].y += w * bfhi(y.x); v[j].z += w * bflo(y.y); v[j].w += w * bfhi(y.y); } }
    }
    float ss = 0.f;
#pragma unroll
    for (int j = 0; j < 4; ++j) ss += (v[j].x * v[j].x + v[j].y * v[j].y) + (v[j].z * v[j].z + v[j].w * v[j].w);
    const float rstd = frsq(wave_sum(ss) * (1.0f / D) + EPS);
    if (mode == 2) {
        f32x4* o = (f32x4*)(F.out + (size_t)t * D) + lane; const f32x4* g = (const f32x4*)F.final_norm_g + lane;
#pragma unroll
        for (int j = 0; j < 4; ++j) o[64 * j] = v[j] * rstd * g[64 * j];
        return;
    }
    if (mode == 1) { u32x2* o = (u32x2*)((bf16*)F.out + (size_t)t * D) + lane;
#pragma unroll
        for (int j = 0; j < 4; ++j) { u32x2 w; w.x = pk2(v[j].x, v[j].y); w.y = pk2(v[j].z, v[j].w); o[64 * j] = w; } }
    u32x2* hb = (u32x2*)(WSP(bf16, WS_ACT) + (size_t)t * D) + lane;
    f32x4 da = (f32x4){0.f, 0.f, 0.f, 0.f};
#pragma unroll
    for (int j = 0; j < 4; ++j) { const f32x4 h = v[j] * rstd; u32x2 w; w.x = pk2(h.x, h.y); w.y = pk2(h.z, h.w); hb[64 * j] = w;
        const int k = 4 * lane + 256 * j; da += h.x * dw[k] + h.y * dw[k + 1] + h.z * dw[k + 2] + h.w * dw[k + 3]; }
    da.x = wave_sum(da.x); da.y = wave_sum(da.y); da.z = wave_sum(da.z); da.w = wave_sum(da.w);
    if (lane == 0) *(f32x4*)(WSP(float, WS_DTRAW) + (size_t)t * 4) = da;
}

__device__ __forceinline__ void r1_phase(Frame& F, int mode, int l) {
    LAS f32x4* dw = (LAS f32x4*)F.lds;
    if (mode != 2) { for (int k = F.tid; k < 1024; k += NTHREADS) { const float g = F.norm1_g[l * 1024 + k]; dw[k] = g * *(const f32x4*)(F.w_in + ((size_t)l * 1024 + k) * DIN + 2304); } }
    __syncthreads();
    const int gw = F.bid * 8 + F.wave, ngw = F.G * 8;
    for (int t = gw; t < L; t += ngw) r1_row(F, t, mode, dw);
}

__device__ __forceinline__ void phase_p0(Frame& F) {
    const int gw = F.bid * 8 + F.wave, ngw = F.G * 8, gt = F.bid * NTHREADS + F.tid, ngt = F.G * NTHREADS;
    {
        constexpr int I_IN = (1024 / 64) * (NPROJ / 32), I_OUT = (1024 / 64) * (1024 / 32), I_GLU = (256 / 64) * (256 / 32);
        constexpr int NIT = 2 * (I_IN + I_OUT + I_GLU);
        for (int it = gw; it < NIT; it += ngw) {
            const int l = it / (I_IN + I_OUT + I_GLU); int r = it % (I_IN + I_OUT + I_GLU);
            if (r < I_IN) { const int kb = r / (NPROJ / 32), nb = r % (NPROJ / 32); const int n0 = 32 * nb, sc0 = n0 < 2304 ? n0 : n0 + 4;
                transpose_item(F.w_in + (size_t)l * 1024 * DIN, DIN, sc0, 64 * kb, WSP(bf16, WS_WIN) + (size_t)l * NPROJ * 1024, 1024, n0, F.norm1_g + l * 1024, F.lane); }
            else if (r < I_IN + I_OUT) { r -= I_IN; const int kb = r / 32, nb = r % 32;
                transpose_item(F.w_out + (size_t)l * 1024 * 1024, 1024, 32 * nb, 64 * kb, WSP(bf16, WS_WOUT) + (size_t)l * 1024 * 1024, 1024, 32 * nb, nullptr, F.lane); }
            else { r -= I_IN + I_OUT; const int kb = r / 8, nb = r % 8;
                transpose_item(F.s5_w_glu + (size_t)l * 65536, 256, 32 * nb, 64 * kb, WSP(bf16, WS_WGLU) + (size_t)l * 65536, 256, 32 * nb, nullptr, F.lane); }
        }
    }
    for (int i = gt; i < 256; i += ngt) {
        const float a = F.hg_lb_logits[i], b = F.hg_lb_logits[256 + i], m = fmaxf(a, b), ea = fexp(a - m), eb = fexp(b - m);
        WSP(float, WS_LB)[i] = 0.f; WSP(float, WS_LB)[256 + i] = eb / (ea + eb); }
    for (int i = gt; i < L * 32; i += ngt) { const int t = i >> 5, j = i & 31;
        const float inv = powf(10000.0f, -(float)j / 32.0f); const float ang = (float)F.pos[t] * inv; double s, c; dsincos((double)ang, s, c);
        *(f32x2*)(WSP(float, WS_ROPE) + (size_t)i * 2) = (f32x2){(float)c, (float)s}; }
    for (int i = gt; i < 2 * 16 * 64 * 34; i += ngt) { const int e = i / 34, d = i % 34, l = e >> 10, g = (e >> 6) & 15;
        const double dt = exp((double)F.s5_log_dt[l * 16 + g]); const double are = fmin((double)F.s5_a_re[e], -1e-4), aim = (double)F.s5_a_im[e];
        const double mag = exp(are * dt * d); double sn, cs; dsincos(aim * dt * d, sn, cs);
        *(f32x2*)(WSP(float, WS_S5AP) + (size_t)e * 68 + 2 * d) = (f32x2){(float)(mag * cs), (float)(mag * sn)}; }
    for (int i = gt; i < 2 * 16 * 64; i += ngt) {
        const int l = i >> 10, g = (i >> 6) & 15;
        const double dt = exp((double)F.s5_log_dt[l * 16 + g]); const double are = fmin((double)F.s5_a_re[i], -1e-4), aim = (double)F.s5_a_im[i];
        const double mag = exp(are * dt); double sn, cs; dsincos(aim * dt, sn, cs); const double abr = mag * cs, abi = mag * sn;
        const double den = are * are + aim * aim;
        const double kre = ((abr - 1.0) * are + abi * aim) / den, kim = (abi * are - (abr - 1.0) * aim) / den;
        float* bb = WSP(float, WS_S5BB) + (size_t)i * 32;
        for (int q = 0; q < 16; ++q) { const double br = F.s5_b_re[(size_t)i * 16 + q], bi = F.s5_b_im[(size_t)i * 16 + q]; bb[2 * q] = (float)(kre * br - kim * bi); bb[2 * q + 1] = (float)(kre * bi + kim * br); }
    }
    __syncthreads();
    r1_phase(F, 0, 0);
}

__device__ __forceinline__ void s5_prep_a(Frame& F, int l, int chunk, int nchunk) {
    const float* AP = WSP(float, WS_S5AP) + (size_t)l * 16 * 64 * 68; const float* BB = WSP(float, WS_S5BB) + (size_t)l * 16 * 64 * 32;
    constexpr int N1 = 16 * 32 * 256, N2 = 16 * 128 * 512;
    if (nchunk == 256 && NTHREADS == 512) {
        const int lo = chunk * 512, g = lo >> 13, d0 = (lo >> 8) & 31;
        LAS f32x2* Cs = (LAS f32x2*)F.lds; LAS f32x2* Bs = Cs + 16 * 65; LAS f32x2* As = Bs + 1024;
        __syncthreads();
#pragma unroll
        for (int k = 0; k < 2; ++k) { const int idx = F.tid + 512 * k; const size_t ci = ((size_t)l * 16 + g) * 1024 + idx;
            Cs[(idx >> 6) * 65 + (idx & 63)] = (f32x2){F.s5_c_re[ci], F.s5_c_im[ci]}; Bs[idx] = *(const f32x2*)(BB + (size_t)g * 64 * 32 + 2 * idx); }
        if (F.tid < 128) As[F.tid] = *(const f32x2*)(AP + ((size_t)g * 64 + (F.tid & 63)) * 68 + 2 * (d0 + (F.tid >> 6)));
        __syncthreads();
        { const int i = lo + F.tid, dd = (F.tid >> 8) & 1, p = (F.tid >> 4) & 15, q = F.tid & 15; float s = 0.f;
#pragma unroll 8
          for (int n = 0; n < 64; ++n) { const f32x2 a = As[dd * 64 + n], b = Bs[n * 16 + q], c = Cs[p * 65 + n];
              const float tr = a.x * b.x - a.y * b.y, ti = a.x * b.y + a.y * b.x; s += c.x * tr - c.y * ti; }
          WSP(float, WS_S5KT)[i] = s; }
        __syncthreads();
    } else
    { const int per = (N1 + nchunk - 1) / nchunk, lo = chunk * per, hi = lo + per < N1 ? lo + per : N1;
      for (int i = lo + F.tid; i < hi; i += NTHREADS) { const int g = i >> 13, d = (i >> 8) & 31, p = (i >> 4) & 15, q = i & 15;
        float s = 0.f;
        for (int n = 0; n < 64; ++n) { const size_t gn = (size_t)g * 64 + n; const float cr = F.s5_c_re[((size_t)l * 16 + g) * 1024 + p * 64 + n], ci = F.s5_c_im[((size_t)l * 16 + g) * 1024 + p * 64 + n];
            const float ar = AP[gn * 68 + 2 * d], ai = AP[gn * 68 + 2 * d + 1], br = BB[gn * 32 + 2 * q], bi = BB[gn * 32 + 2 * q + 1];
            const float tr = ar * br - ai * bi, ti = ar * bi + ai * br; s += cr * tr - ci * ti; }
        WSP(float, WS_S5KT)[i] = s; } }
    if (nchunk == 256 && NTHREADS == 512) {
        const int i0 = chunk * 4096 + 8 * F.tid, g = i0 >> 16, m = (i0 >> 9) & 127, k0 = i0 & 511, n = m >> 1, j = k0 >> 4, q0 = k0 & 15; const size_t gn = (size_t)g * 64 + n;
        const f32x2 a = *(const f32x2*)(AP + gn * 68 + 2 * (31 - j)); const f32x4* bp = (const f32x4*)(BB + gn * 32 + 2 * q0);
        const f32x4 b0 = bp[0], b1 = bp[1], b2 = bp[2], b3 = bp[3]; const bool im = m & 1;
#define BINC_V(br, bi) (im ? (a.x * (bi) + a.y * (br)) : (a.x * (br) - a.y * (bi)))
        u32x4 o; o.x = pk2(BINC_V(b0.x, b0.y), BINC_V(b0.z, b0.w)); o.y = pk2(BINC_V(b1.x, b1.y), BINC_V(b1.z, b1.w)); o.z = pk2(BINC_V(b2.x, b2.y), BINC_V(b2.z, b2.w)); o.w = pk2(BINC_V(b3.x, b3.y), BINC_V(b3.z, b3.w));
#undef BINC_V
        *(u32x4*)(WSP(bf16, WS_S5BI) + i0) = o;
    } else
    { const int per = (N2 + nchunk - 1) / nchunk, lo = chunk * per, hi = lo + per < N2 ? lo + per : N2;
      for (int i = lo + F.tid; i < hi; i += NTHREADS) { const int g = i >> 16, m = (i >> 9) & 127, k = i & 511, n = m >> 1, j = k >> 4, q = k & 15; const size_t gn = (size_t)g * 64 + n;
        const float ar = AP[gn * 68 + 2 * (31 - j)], ai = AP[gn * 68 + 2 * (31 - j) + 1], br = BB[gn * 32 + 2 * q], bi = BB[gn * 32 + 2 * q + 1];
        WSP(bf16, WS_S5BI)[i] = (bf16)f2bf((m & 1) ? (ar * bi + ai * br) : (ar * br - ai * bi)); } }
}
__device__ __forceinline__ void s5_prep_b(Frame& F, int l, int chunk, int nchunk) {
    const float* AP = WSP(float, WS_S5AP) + (size_t)l * 16 * 64 * 68; const float* KT = WSP(float, WS_S5KT);
    constexpr int N = 16 * 512 * 640; const int per = (N + nchunk - 1) / nchunk, lo = chunk * per, hi = lo + per < N ? lo + per : N;
    if (nchunk == 256 && NTHREADS == 512) {
#pragma unroll 1
        for (int it = 0; it < 5; ++it) { const int i0 = chunk * 20480 + 8 * (F.tid + 512 * it);
            const int g = i0 / (512 * 640), r = i0 % (512 * 640), np = r / 640, k0 = r % 640, tl = np >> 4, p = np & 15;
            u32x4 o = (u32x4){0u, 0u, 0u, 0u};
            if (k0 < 512) { const int j = k0 >> 4, q0 = k0 & 15;
                if (tl >= j) { const f32x4* kp = (const f32x4*)(KT + (((size_t)g * 32 + (tl - j)) * 16 + p) * 16 + q0); const f32x4 x0 = kp[0], x1 = kp[1];
                    o.x = pk2(x0.x, x0.y); o.y = pk2(x0.z, x0.w); o.z = pk2(x1.x, x1.y); o.w = pk2(x1.z, x1.w); } }
            else { const int n0 = (k0 - 512) >> 1; const size_t cb = ((size_t)l * 16 + g) * 1024 + p * 64 + n0;
                const f32x4 cr = *(const f32x4*)(F.s5_c_re + cb), ci = *(const f32x4*)(F.s5_c_im + cb); const float* ap = AP + ((size_t)g * 64 + n0) * 68 + 2 * (tl + 1);
                const f32x2 a0 = *(const f32x2*)ap, a1 = *(const f32x2*)(ap + 68), a2 = *(const f32x2*)(ap + 136), a3 = *(const f32x2*)(ap + 204);
                o.x = pk2(cr.x * a0.x - ci.x * a0.y, -(cr.x * a0.y + ci.x * a0.x)); o.y = pk2(cr.y * a1.x - ci.y * a1.y, -(cr.y * a1.y + ci.y * a1.x));
                o.z = pk2(cr.z * a2.x - ci.z * a2.y, -(cr.z * a2.y + ci.z * a2.x)); o.w = pk2(cr.w * a3.x - ci.w * a3.y, -(cr.w * a3.y + ci.w * a3.x)); }
            *(u32x4*)(WSP(bf16, WS_S5MT) + i0) = o; }
        return;
    }
    for (int i = lo + F.tid; i < hi; i += NTHREADS) { const int g = i / (512 * 640), r = i % (512 * 640), np = r / 640, k = r % 640, tl = np >> 4, p = np & 15;
        float v;
        if (k < 512) { const int j = k >> 4, q = k & 15; v = tl >= j ? KT[(((size_t)g * 32 + (tl - j)) * 16 + p) * 16 + q] : 0.f; }
        else { const int n = (k - 512) >> 1; const size_t gn = (size_t)g * 64 + n; const float cr = F.s5_c_re[((size_t)l * 16 + g) * 1024 + p * 64 + n], ci = F.s5_c_im[((size_t)l * 16 + g) * 1024 + p * 64 + n];
            const float ar = AP[gn * 68 + 2 * (tl + 1)], ai = AP[gn * 68 + 2 * (tl + 1) + 1]; v = (k & 1) ? -(cr * ai + ci * ar) : (cr * ar - ci * ai); }
        WSP(bf16, WS_S5MT)[i] = (bf16)f2bf(v); }
}

struct EpiBf16Store { static constexpr bool HAS_PRE = false; bf16* O; size_t ld; int r0, c0;
    __device__ __forceinline__ void operator()(int r, int c, f32x4 v) const { u32x2 w; w.x = pk2(v.x, v.y); w.y = pk2(v.z, v.w); *(u32x2*)(O + (size_t)(r0 + r) * ld + c0 + c) = w; } };
__device__ __forceinline__ void phase_g1(Frame& F, int l) {
    g8::GridOrder S{L / 256, NPROJ / 256 - 1, (L / 256) * (NPROJ / 256 - 1), F.G, F.bid, (size_t)256 * 1024 * 2, (size_t)256 * 1024 * 2};
    g8::EpiStoreU E{WSP(bf16, WS_BIG), NPROJ, WSP(bf16, WS_S5UG)};
    g8::gemm_phase(F.lds, WSP(bf16, WS_ACT), WSP(bf16, WS_WIN) + (size_t)l * NPROJ * 1024, 1024, S, E);
    if (l == 0) { unsigned* ctr = WSP(unsigned, WS_CTL) + CW_Q + 64 * 4 + 32 * F.rep;
      for (int u = grab_unit(F, ctr); u < 256; u = grab_unit(F, ctr)) s5_prep_a(F, 0, u, 256); }
}

constexpr int LD64 = 72, LD128 = 136;
template <bool HAS_DST, bool HAS_DSTT>
__device__ __forceinline__ void stage_rot(Frame& F, const bf16* proj, int t0, int col0, float scale, lbf* dst  , lbf* dstT  , const lf32* tscale  ) {
    const int t = F.tid >> 2, ib = (F.tid & 3) * 8;
    const bf16* row = proj + (size_t)(t0 + t) * NPROJ + col0;
    const u32x4 a = *(const u32x4*)(row + ib), b = *(const u32x4*)(row + 32 + ib);
    const f32x4* cs4 = (const f32x4*)(WSP(float, WS_ROPE) + ((size_t)(t0 + t) * 32 + ib) * 2);
    const f32x4 r0 = cs4[0], r1 = cs4[1], r2 = cs4[2], r3 = cs4[3];
    const float cs[16] = {r0.x, r0.y, r0.z, r0.w, r1.x, r1.y, r1.z, r1.w, r2.x, r2.y, r2.z, r2.w, r3.x, r3.y, r3.z, r3.w};
    float o1[8], o2[8];
    const unsigned aw[4] = {a.x, a.y, a.z, a.w}, bw[4] = {b.x, b.y, b.z, b.w};
#pragma unroll
    for (int j = 0; j < 8; ++j) { const float q1 = (j & 1) ? bfhi(aw[j >> 1]) : bflo(aw[j >> 1]), q2 = (j & 1) ? bfhi(bw[j >> 1]) : bflo(bw[j >> 1]); const float c = cs[2 * j], s = cs[2 * j + 1];
        o1[j] = (q1 * c - q2 * s) * scale; o2[j] = (q2 * c + q1 * s) * scale;
        }
    if (HAS_DST) { u32x4 w1, w2; w1.x = pk2(o1[0], o1[1]); w1.y = pk2(o1[2], o1[3]); w1.z = pk2(o1[4], o1[5]); w1.w = pk2(o1[6], o1[7]); w2.x = pk2(o2[0], o2[1]); w2.y = pk2(o2[2], o2[3]); w2.z = pk2(o2[4], o2[5]); w2.w = pk2(o2[6], o2[7]);
        *(LAS u32x4*)(dst + t * LD64 + ib) = w1; *(LAS u32x4*)(dst + t * LD64 + 32 + ib) = w2; }
    if (HAS_DSTT) { const float ts = tscale[t];
#pragma unroll
        for (int j = 0; j < 8; ++j) { dstT[(ib + j) * LD128 + t] = (bf16)f2bf(o1[j] * ts); dstT[(32 + ib + j) * LD128 + t] = (bf16)f2bf(o2[j] * ts); } }
}
__device__ __forceinline__ void hg_logf_cumsum_r(Frame& F, const u32x4 (&rf)[2], const float (&lb)[16], lf32* bL, lf32* tot) {
    { const int t = F.tid >> 2, dq = (F.tid & 3) * 16;
#pragma unroll
      for (int hh = 0; hh < 2; ++hh) { const unsigned aw[4] = {rf[hh].x, rf[hh].y, rf[hh].z, rf[hh].w}; float lf[8];
#pragma unroll
          for (int j = 0; j < 8; ++j) { const float x = (j & 1) ? bfhi(aw[j >> 1]) : bflo(aw[j >> 1]); const float b = lb[8 * hh + j]; lf[j] = flog(b + (1.0f - b) * sigmoidf_(x)); }
          *(LAS f32x4*)(bL + t * 64 + dq + 8 * hh) = (f32x4){lf[0], lf[1], lf[2], lf[3]}; *(LAS f32x4*)(bL + t * 64 + dq + 8 * hh + 4) = (f32x4){lf[4], lf[5], lf[6], lf[7]}; } }
    __syncthreads();
    const int d = F.tid & 63, sg = F.tid >> 6;
    { float run = 0.f;
#pragma unroll
      for (int j = 0; j < 16; ++j) { run += bL[(sg * 16 + j) * 64 + d]; bL[(sg * 16 + j) * 64 + d] = run; }
      tot[sg * 64 + d] = run; }
    __syncthreads();
    { float off = 0.f; for (int g = 0; g < sg; ++g) off += tot[g * 64 + d];
#pragma unroll
      for (int j = 0; j < 16; ++j) bL[(sg * 16 + j) * 64 + d] += off; }
    __syncthreads();
}
__device__ __forceinline__ void stage_T64(Frame& F, const bf16* proj, int t0, int col0, lbf* dstT) {
#pragma unroll
    for (int i = 0; i < 2; ++i) { const int p = F.tid + 512 * i, s = p >> 3, eb = (p & 7) * 8;
        const u32x4 a = *(const u32x4*)(proj + (size_t)(t0 + s) * NPROJ + col0 + eb); const unsigned aw[4] = {a.x, a.y, a.z, a.w};
#pragma unroll
        for (int j = 0; j < 8; ++j) dstT[(eb + j) * LD128 + s] = (bf16)((j & 1) ? (aw[j >> 1] >> 16) : (aw[j >> 1] & 0xffffu)); }
}

__device__ __forceinline__ float ret_log2gamma(int h) { return log2f(1.0f - exp2f(-5.0f - (float)h)); }
__device__ __forceinline__ void ret_state_unit(Frame& F0, int c, int h) {
    Frame F = F0; LAUNDER(F);
    lbf* VT = (lbf*)F.lds; lbf* KT = VT + 64 * LD128; lf32* zeta = (lf32*)(KT + 64 * LD128);
    const bf16* proj = WSP(bf16, WS_BIG); const int t0 = c * CH; const float lg = ret_log2gamma(h);
    __syncthreads();
    if (F.tid < 128) zeta[F.tid] = fexp2((float)(CH - 1 - F.tid) * lg);
    __syncthreads();
    stage_T64(F, proj, t0, C_RV + h * 64, VT);
    stage_rot<false, true>(F, proj, t0, C_RK + h * 64, 0.125f, KT, KT, zeta);
    __syncthreads();
    f32x4 acc[2] = {(f32x4){0, 0, 0, 0}, (f32x4){0, 0, 0, 0}};
    const int w = F.wave;
    wave_mma<2, 4>(acc, VT + 16 * (w >> 1) * LD128, LD128, KT + 32 * (w & 1) * LD128, LD128, F.lane);
    float* st = WSP(float, WS_ST_RET) + ((size_t)c * 4 + h) * 4096;
    const int e = 16 * (w >> 1) + (F.lane & 15);
#pragma unroll
    for (int n = 0; n < 2; ++n) *(f32x4*)(st + e * 64 + 32 * (w & 1) + 16 * n + 4 * (F.lane >> 4)) = acc[n];
}
__device__ __forceinline__ void ret_out_unit(Frame& F0, int c, int h) {
    Frame F = F0; LAUNDER(F);
    lbf* Q = (lbf*)F.lds; lbf* K = Q + 128 * LD64; lbf* VT = K + 128 * LD64; lbf* RT = VT + 64 * LD128; lbf* P = RT + 64 * LD64;
    const bf16* proj = WSP(bf16, WS_BIG); const int t0 = c * CH; const float lg = ret_log2gamma(h);
    const int w = F.wave, lane = F.lane, fr = lane & 15, fq = lane >> 4;
    __syncthreads();
    stage_rot<true, false>(F, proj, t0, C_RQ + h * 64, 1.0f, Q, Q, (const lf32*)Q);
    stage_rot<true, false>(F, proj, t0, C_RK + h * 64, 0.125f, K, K, (const lf32*)K);
    stage_T64(F, proj, t0, C_RV + h * 64, VT);
    { const float* st = WSP(float, WS_ST_RET) + ((size_t)c * 4 + h) * 4096 + F.tid * 8; const f32x4 a = *(const f32x4*)st, b = *(const f32x4*)(st + 4);
      u32x4 o; o.x = pk2(a.x, a.y); o.y = pk2(a.z, a.w); o.z = pk2(b.x, b.y); o.w = pk2(b.z, b.w); *(LAS u32x4*)(RT + (F.tid >> 3) * LD64 + (F.tid & 7) * 8) = o; }
    __syncthreads();
    f32x4 sc[8];
#pragma unroll
    for (int n = 0; n < 8; ++n) sc[n] = (f32x4){0, 0, 0, 0};
    wave_mma<8, 2>(sc, Q + 16 * w * LD64, LD64, K, LD64, lane);
    lbf* Pw = P + w * 16 * LD128;
    const int tl = 16 * w + fr;
#pragma unroll
    for (int n = 0; n < 8; ++n) { float pv[4];
#pragma unroll
        for (int j = 0; j < 4; ++j) { const int s = 16 * n + 4 * fq + j; pv[j] = (s <= tl) ? sc[n][j] * fexp2((float)(tl - s) * lg) : 0.f; }
        u32x2 o; o.x = pk2(pv[0], pv[1]); o.y = pk2(pv[2], pv[3]); *(LAS u32x2*)(Pw + fr * LD128 + 16 * n + 4 * fq) = o; }
    __syncthreads();
    f32x4 oi[4], ox[4];
#pragma unroll
    for (int n = 0; n < 4; ++n) { oi[n] = (f32x4){0, 0, 0, 0}; ox[n] = (f32x4){0, 0, 0, 0}; }
    wave_mma<4, 4>(oi, Pw, LD128, VT, LD128, lane);
    wave_mma<4, 2>(ox, Q + 16 * w * LD64, LD64, RT, LD64, lane);
    const float xi = fexp2((float)(tl + 1) * lg);
    float s1 = 0.f;
#pragma unroll
    for (int n = 0; n < 4; ++n) {
        oi[n] = oi[n] + xi * ox[n];
        s1 += (oi[n].x + oi[n].y) + (oi[n].z + oi[n].w); }
    s1 += __shfl_xor(s1, 16); s1 += __shfl_xor(s1, 32);
    const float mean = s1 * (1.0f / 64.0f); float s2 = 0.f;
#pragma unroll
    for (int n = 0; n < 4; ++n) { oi[n] = oi[n] - mean; s2 += (oi[n].x * oi[n].x + oi[n].y * oi[n].y) + (oi[n].z * oi[n].z + oi[n].w * oi[n].w); }
    s2 += __shfl_xor(s2, 16); s2 += __shfl_xor(s2, 32);
    const float rstd = frsq(s2 * (1.0f / 64.0f) + EPS);
    const int t = t0 + tl; bf16* y = WSP(bf16, WS_ACT) + (size_t)t * 1024 + Y_RET + h * 64;
    const bf16* gp = proj + (size_t)t * NPROJ + C_RG + h * 64;
#pragma unroll
    for (int n = 0; n < 4; ++n) { const int e = 16 * n + 4 * fq; const u32x2 g = *(const u32x2*)(gp + e);
        const f32x4 v = oi[n] * rstd; u32x2 o; o.x = pk2(v.x * siluf_(bflo(g.x)), v.y * siluf_(bfhi(g.x))); o.y = pk2(v.z * siluf_(bflo(g.y)), v.w * siluf_(bfhi(g.y))); *(u32x2*)(y + e) = o; }
}

__device__ __forceinline__ void m2_conv8(Frame& F, int l, const bf16* proj, int t, int cc  , float (&o)[8]) {
    const float* cw = F.m2_conv_w + (size_t)l * 4 * 768 + cc; const float* cb = F.m2_conv_b + (size_t)l * 768 + cc;
#pragma unroll
    for (int j = 0; j < 8; ++j) o[j] = cb[j];
#pragma unroll
    for (int q = 0; q < 4; ++q) { const int ts = t - 3 + q; if (ts >= 0) { const u32x4 a = *(const u32x4*)(proj + (size_t)ts * NPROJ + C_MX + cc); const unsigned aw[4] = {a.x, a.y, a.z, a.w};
#pragma unroll
        for (int j = 0; j < 8; ++j) o[j] += cw[q * 768 + j] * ((j & 1) ? bfhi(aw[j >> 1]) : bflo(aw[j >> 1])); } }
#pragma unroll
    for (int j = 0; j < 8; ++j) o[j] = siluf_(o[j]);
}
__device__ __forceinline__ void m2_dt_acum(Frame& F, int l, int c, lf32* dts, lf32* acs) {
    const int h = F.tid >> 7, t = F.tid & 127, lane = F.lane; const float x = WSP(float, WS_DTRAW)[(size_t)(c * CH + t) * 4 + h] + F.m2_dt_bias[l * 4 + h];
    const float dt = x > 20.f ? x : log1pf(fexp(x)); dts[h * 128 + t] = dt;
    float a = -fexp(F.m2_a_log[l * 4 + h]) * dt;
#pragma unroll
    for (int off = 1; off < 64; off <<= 1) { const float o = __shfl(a, lane - off); if (lane >= off) a += o; }
    acs[h * 128 + t] = a;
    __syncthreads();
    if (t >= 64) acs[h * 128 + t] = a + acs[h * 128 + 63];
    __syncthreads();
}
__device__ __forceinline__ void m2_conv8_r(const u32x4 (&raw)[4], const f32x4 (&w)[4][2], const f32x4 (&bs)[2], int t, float (&o)[8]) {
    o[0] = bs[0].x; o[1] = bs[0].y; o[2] = bs[0].z; o[3] = bs[0].w; o[4] = bs[1].x; o[5] = bs[1].y; o[6] = bs[1].z; o[7] = bs[1].w;
#pragma unroll
    for (int q = 0; q < 4; ++q) { if (t - 3 + q >= 0) { const unsigned aw[4] = {raw[q].x, raw[q].y, raw[q].z, raw[q].w}; const float wq[8] = {w[q][0].x, w[q][0].y, w[q][0].z, w[q][0].w, w[q][1].x, w[q][1].y, w[q][1].z, w[q][1].w};
#pragma unroll
        for (int j = 0; j < 8; ++j) o[j] += wq[j] * ((j & 1) ? bfhi(aw[j >> 1]) : bflo(aw[j >> 1])); } }
#pragma unroll
    for (int j = 0; j < 8; ++j) o[j] = siluf_(o[j]);
}
#define M2S_LDW(w_, b_, cc_) do { const float* cw_ = F.m2_conv_w + (size_t)l * 4 * 768 + (cc_); const float* cb_ = F.m2_conv_b + (size_t)l * 768 + (cc_); \
        _Pragma("unroll") for (int q = 0; q < 4; ++q) { w_[q][0] = *(const f32x4*)(cw_ + q * 768); w_[q][1] = *(const f32x4*)(cw_ + q * 768 + 4); } b_[0] = *(const f32x4*)cb_; b_[1] = *(const f32x4*)(cb_ + 4); } while (0)
#define M2S_LDR(raw_, t_, cc_) do { _Pragma("unroll") for (int q = 0; q < 4; ++q) { const int ts_ = (t_) - 3 + q; raw_[q] = *(const u32x4*)(proj + (size_t)(ts_ < 0 ? 0 : ts_) * NPROJ + C_MX + (cc_)); } } while (0)
__device__ __forceinline__ void m2_state_unit(Frame& F0, int l, int c, int g) {
    Frame F = F0; LAUNDER(F);
    lbf* XT = (lbf*)F.lds; lbf* BT = XT + 64 * LD128; lf32* dts = (lf32*)(BT + 128 * LD128); lf32* acs = dts + 512;
    const bf16* proj = WSP(bf16, WS_BIG); bf16* xbc = XBC_PTR(F); const int t0 = c * CH;
    __syncthreads();
    const int nb = (F.tid & 15) * 8, sb = F.tid >> 4;
    f32x4 wB[4][2], bB[2], wC[4][2], bC[2]; u32x4 rB[4], rC[4], nB[4];
    M2S_LDW(wB, bB, 256 + g * 128 + nb); M2S_LDW(wC, bC, 512 + g * 128 + nb);
    M2S_LDR(rB, t0 + sb, 256 + g * 128 + nb);
    m2_dt_acum(F, l, c, dts, acs);
#pragma unroll 1
    for (int i = 0; i < 4; ++i) { const int s = sb + 32 * i; float o[8], o2[8];
        M2S_LDR(rC, t0 + s, 512 + g * 128 + nb);
        if (i < 3) { M2S_LDR(nB, t0 + s + 32, 256 + g * 128 + nb); }
        { const float* cbp = F.m2_conv_b + (size_t)l * 768 + g * 128 + nb; bB[0] = *(const f32x4*)(cbp + 256); bB[1] = *(const f32x4*)(cbp + 260); bC[0] = *(const f32x4*)(cbp + 512); bC[1] = *(const f32x4*)(cbp + 516); }
        m2_conv8_r(rB, wB, bB, t0 + s, o); m2_conv8_r(rC, wC, bC, t0 + s, o2);
        u32x4 wv; wv.x = pk2(o[0], o[1]); wv.y = pk2(o[2], o[3]); wv.z = pk2(o[4], o[5]); wv.w = pk2(o[6], o[7]); *(u32x4*)(xbc + (size_t)(t0 + s) * 768 + 256 + g * 128 + nb) = wv;
#pragma unroll
        for (int j = 0; j < 8; ++j) BT[(nb + j) * LD128 + s] = (bf16)f2bf(o[j]);
        wv.x = pk2(o2[0], o2[1]); wv.y = pk2(o2[2], o2[3]); wv.z = pk2(o2[4], o2[5]); wv.w = pk2(o2[6], o2[7]); *(u32x4*)(xbc + (size_t)(t0 + s) * 768 + 512 + g * 128 + nb) = wv;
#pragma unroll
        for (int q = 0; q < 4; ++q) rB[q] = nB[q]; }
#pragma unroll 1
    for (int hh = 0; hh < 2; ++hh) { const int h = 2 * g + hh;
        const float alast = acs[h * 128 + 127];
        { const int s0 = F.tid >> 3, eb = (F.tid & 7) * 8, s1 = s0 + 64; float o[8], o2[8];
          M2S_LDW(wB, bB, h * 64 + eb); M2S_LDR(rB, t0 + s0, h * 64 + eb); M2S_LDR(rC, t0 + s1, h * 64 + eb);
          m2_conv8_r(rB, wB, bB, t0 + s0, o); m2_conv8_r(rC, wB, bB, t0 + s1, o2);
          u32x4 wv; wv.x = pk2(o[0], o[1]); wv.y = pk2(o[2], o[3]); wv.z = pk2(o[4], o[5]); wv.w = pk2(o[6], o[7]); *(u32x4*)(xbc + (size_t)(t0 + s0) * 768 + h * 64 + eb) = wv;
          wv.x = pk2(o2[0], o2[1]); wv.y = pk2(o2[2], o2[3]); wv.z = pk2(o2[4], o2[5]); wv.w = pk2(o2[6], o2[7]); *(u32x4*)(xbc + (size_t)(t0 + s1) * 768 + h * 64 + eb) = wv;
          const float sc0 = dts[h * 128 + s0] * fexp(alast - acs[h * 128 + s0]), sc1 = dts[h * 128 + s1] * fexp(alast - acs[h * 128 + s1]);
#pragma unroll
          for (int j = 0; j < 8; ++j) { XT[(eb + j) * LD128 + s0] = (bf16)f2bf(o[j] * sc0); XT[(eb + j) * LD128 + s1] = (bf16)f2bf(o2[j] * sc1); } }
        __syncthreads();
        f32x4 acc[4];
#pragma unroll
        for (int n = 0; n < 4; ++n) acc[n] = (f32x4){0, 0, 0, 0};
        const int w = F.wave;
        wave_mma<4, 4>(acc, XT + 16 * (w >> 1) * LD128, LD128, BT + 64 * (w & 1) * LD128, LD128, F.lane);
        float* st = WSP(float, WS_ST_M2) + ((size_t)c * 4 + h) * 8192; const int pr = 16 * (w >> 1) + (F.lane & 15);
#pragma unroll
        for (int n = 0; n < 4; ++n) *(f32x4*)(st + pr * 128 + 64 * (w & 1) + 16 * n + 4 * (F.lane >> 4)) = acc[n];
        if (F.tid == 0) WSP(float, WS_DEC_M2)[c * 4 + h] = fexp(alast);
        __syncthreads();
    }
}
#undef M2S_LDW
#undef M2S_LDR
__device__ __forceinline__ void m2_out_unit(Frame& F0, int l, int c) {
    Frame F = F0; LAUNDER(F);
    lbf* Cm = (lbf*)F.lds; lbf* Bm = Cm + 128 * LD128; lbf* XT = Bm + 128 * LD128; lbf* ST = XT + 64 * LD128; lf32* dts = (lf32*)(ST + 64 * LD128); lf32* acs = dts + 512;
    lbf* P = Bm;
    const bf16* proj = WSP(bf16, WS_BIG); const bf16* xbc = XBC_PTR(F); const int t0 = c * CH;
    const int w = F.wave, lane = F.lane, fr = lane & 15, fq = lane >> 4, tl = 16 * w + fr;
    u32x4 rC[4], rB[4], rX[2]; f32x4 rSa[2], rSb[2];
#define M2O_LD_CB(g_) do { _Pragma("unroll") for (int i = 0; i < 4; ++i) { const int p = F.tid + 512 * i, s = p >> 4, nb = (p & 15) * 8; const bf16* xr = xbc + (size_t)(t0 + s) * 768 + (g_) * 128 + nb; \
        rC[i] = *(const u32x4*)(xr + 512); rB[i] = *(const u32x4*)(xr + 256); } } while (0)
#define M2O_LD_XS(h_) do { const float* st_ = WSP(float, WS_ST_M2) + ((size_t)c * 4 + (h_)) * 8192; _Pragma("unroll") for (int i = 0; i < 2; ++i) { const int p = F.tid + 512 * i, s = p >> 3, eb = (p & 7) * 8; \
        rX[i] = *(const u32x4*)(xbc + (size_t)(t0 + s) * 768 + (h_) * 64 + eb); rSa[i] = *(const f32x4*)(st_ + p * 8); rSb[i] = *(const f32x4*)(st_ + p * 8 + 4); } } while (0)
    __syncthreads();
    M2O_LD_CB(0);
    m2_dt_acum(F, l, c, dts, acs);
    float ss = 0.f;
    bf16* yrow = WSP(bf16, WS_ACT) + (size_t)(t0 + tl) * 1024 + Y_M2;
#pragma unroll 1
    for (int g = 0; g < 2; ++g) {
        __syncthreads();
#pragma unroll
        for (int i = 0; i < 4; ++i) { const int p = F.tid + 512 * i, s = p >> 4, nb = (p & 15) * 8; *(LAS u32x4*)(Cm + s * LD128 + nb) = rC[i]; *(LAS u32x4*)(Bm + s * LD128 + nb) = rB[i]; }
        M2O_LD_XS(2 * g);
        __syncthreads();
        f32x4 sc[8];
#pragma unroll
        for (int n = 0; n < 8; ++n) sc[n] = (f32x4){0, 0, 0, 0};
        wave_mma<8, 4>(sc, Cm + 16 * w * LD128, LD128, Bm, LD128, lane);
#pragma unroll 1
        for (int hh = 0; hh < 2; ++hh) { const int h = 2 * g + hh;
            __syncthreads();
#pragma unroll
            for (int i = 0; i < 2; ++i) { const int p = F.tid + 512 * i, s = p >> 3, eb = (p & 7) * 8; const unsigned aw[4] = {rX[i].x, rX[i].y, rX[i].z, rX[i].w};
#pragma unroll
                for (int j = 0; j < 8; ++j) XT[(eb + j) * LD128 + s] = (bf16)((j & 1) ? (aw[j >> 1] >> 16) : (aw[j >> 1] & 0xffffu));
                u32x4 o; o.x = pk2(rSa[i].x, rSa[i].y); o.y = pk2(rSa[i].z, rSa[i].w); o.z = pk2(rSb[i].x, rSb[i].y); o.w = pk2(rSb[i].z, rSb[i].w); *(LAS u32x4*)(ST + (p >> 4) * LD128 + (p & 15) * 8) = o; }
            const bf16* zp = proj + (size_t)(t0 + tl) * NPROJ + C_MZ + h * 64;
            u32x2 zr[4];
#pragma unroll
            for (int n = 0; n < 4; ++n) zr[n] = *(const u32x2*)(zp + 16 * n + 4 * fq);
            if (hh == 0) M2O_LD_XS(h + 1); else if (g == 0) M2O_LD_CB(1);
            const float at = acs[h * 128 + tl];
            lbf* Pw = P + w * 16 * LD128;
#pragma unroll
            for (int n = 0; n < 8; ++n) { float pv[4];
#pragma unroll
                for (int j = 0; j < 4; ++j) { const int s = 16 * n + 4 * fq + j; pv[j] = (s <= tl) ? sc[n][j] * fexp(at - acs[h * 128 + s]) * dts[h * 128 + s] : 0.f; }
                u32x2 o; o.x = pk2(pv[0], pv[1]); o.y = pk2(pv[2], pv[3]); *(LAS u32x2*)(Pw + fr * LD128 + 16 * n + 4 * fq) = o; CFENCE(); }
            __syncthreads();
            f32x4 yi[4], yx[4];
#pragma unroll
            for (int n = 0; n < 4; ++n) { yi[n] = (f32x4){0, 0, 0, 0}; yx[n] = (f32x4){0, 0, 0, 0}; }
            wave_mma<4, 4>(yi, Pw, LD128, XT, LD128, lane);
            wave_mma<4, 4>(yx, Cm + 16 * w * LD128, LD128, ST, LD128, lane);
            const float ea = fexp(at), dsk = F.m2_d[l * 4 + h];
#pragma unroll
            for (int n = 0; n < 4; ++n) { const int p0 = 16 * n + 4 * fq; const u32x2 z = zr[n];
                f32x4 v = yi[n] + ea * yx[n];
                v.x += dsk * bf2f(XT[(p0 + 0) * LD128 + tl]); v.y += dsk * bf2f(XT[(p0 + 1) * LD128 + tl]); v.z += dsk * bf2f(XT[(p0 + 2) * LD128 + tl]); v.w += dsk * bf2f(XT[(p0 + 3) * LD128 + tl]);
                v.x *= siluf_(bflo(z.x)); v.y *= siluf_(bfhi(z.x)); v.z *= siluf_(bflo(z.y)); v.w *= siluf_(bfhi(z.y));
                ss += (v.x * v.x + v.y * v.y) + (v.z * v.z + v.w * v.w);
                u32x2 o; o.x = pk2(v.x, v.y); o.y = pk2(v.z, v.w); *(u32x2*)(yrow + h * 64 + p0) = o; CFENCE(); }
        }
    }
#undef M2O_LD_CB
#undef M2O_LD_XS
    ss += __shfl_xor(ss, 16); ss += __shfl_xor(ss, 32);
    const float rstd = frsq(ss * (1.0f / 256.0f) + EPS);
    const float* ng = F.m2_norm_g + l * 256;
#ifndef EMU
    asm volatile("s_waitcnt vmcnt(0)" ::: "memory");
#endif
#pragma unroll
    for (int qh = 0; qh < 2; ++qh) {
        f32x4 gv[8]; u32x2 yv[8];
#pragma unroll
        for (int q = 0; q < 8; ++q) { const int cc = (2 * qh + (q >> 2)) * 64 + 16 * (q & 3) + 4 * fq; gv[q] = *(const f32x4*)(ng + cc); yv[q] = *(const u32x2*)(yrow + cc); }
#pragma unroll
        for (int q = 0; q < 8; ++q) { const int cc = (2 * qh + (q >> 2)) * 64 + 16 * (q & 3) + 4 * fq;
            u32x2 o; o.x = pk2(bflo(yv[q].x) * rstd * gv[q].x, bfhi(yv[q].x) * rstd * gv[q].y); o.y = pk2(bflo(yv[q].y) * rstd * gv[q].z, bfhi(yv[q].y) * rstd * gv[q].w); *(u32x2*)(yrow + cc) = o; } }
}

template <bool OUT>
__device__ __forceinline__ void hg_wave_unit(Frame& F0, int l, int sc, int h) {
    Frame F = F0; LAUNDER(F);
    constexpr int TB = 16;
    lf32* Fb = (lf32*)(F.lds + F.wave * 16384); lf32* Vb = Fb + 1024; lf32* Qb = Vb + 1024; lf32* Gb = Qb + 1024;
    const bf16* proj = WSP(bf16, WS_BIG); const int lane = F.lane, t0 = sc * HSC;
    const float lb = WSP(float, WS_LB)[l * 256 + h * 64 + lane];
    float S[64];
    if (OUT) { const float* sp = WSP(float, WS_ST_HG) + ((size_t)sc * 4 + h) * 4096 + lane;
#pragma unroll
        for (int d = 0; d < 64; ++d) S[d] = sp[d * 64]; }
    else {
#pragma unroll
        for (int d = 0; d < 64; ++d) S[d] = 0.f; }
    float lam = 1.0f;
    const float ng = OUT ? F.hg_norm_g[l * 256 + h * 64 + lane] : 0.f;
    bf16 rf[TB], rq[TB], rv[TB], rg[TB];
    const bf16* pb = proj + (size_t)t0 * NPROJ + h * 64 + lane;
#pragma unroll
    for (int tt = 0; tt < TB; ++tt) { const bf16* pr = pb + (size_t)tt * NPROJ; rf[tt] = pr[C_GF]; rv[tt] = pr[C_GI]; if (OUT) { rq[tt] = pr[C_GQ]; rg[tt] = pr[C_GG]; } }
#pragma unroll 1
    for (int tb = 0; tb < HSC; tb += TB) {
#pragma unroll
        for (int tt = 0; tt < TB; ++tt) {
            const float f = lb + (1.0f - lb) * sigmoidf_(bf2f(rf[tt])); Fb[tt * 64 + lane] = f; lam *= f; Vb[tt * 64 + lane] = bf2f(rv[tt]);
            if (OUT) { Qb[tt * 64 + lane] = siluf_(bf2f(rq[tt])); Gb[tt * 64 + lane] = siluf_(bf2f(rg[tt])) * ng; } }
        WAVE_SYNC();
        if (tb + TB < HSC) { const bf16* pn = pb + (size_t)(tb + TB) * NPROJ;
#pragma unroll
            for (int tt = 0; tt < TB; ++tt) { const bf16* pr = pn + (size_t)tt * NPROJ; rf[tt] = pr[C_GF]; rv[tt] = pr[C_GI]; if (OUT) { rq[tt] = pr[C_GQ]; rg[tt] = pr[C_GG]; } } }
#pragma unroll 2
        for (int tt = 0; tt < TB; ++tt) {
            const float v = Vb[tt * 64 + lane];
            float o0 = 0.f, o1 = 0.f, o2 = 0.f, o3 = 0.f;
#pragma unroll
            for (int d4 = 0; d4 < 16; ++d4) { const f32x4 f4 = *(const LAS f32x4*)(Fb + tt * 64 + 4 * d4);
                S[4 * d4 + 0] = f4.x * (S[4 * d4 + 0] - v) + v; S[4 * d4 + 1] = f4.y * (S[4 * d4 + 1] - v) + v; S[4 * d4 + 2] = f4.z * (S[4 * d4 + 2] - v) + v; S[4 * d4 + 3] = f4.w * (S[4 * d4 + 3] - v) + v;
                if (OUT) { const f32x4 q4 = *(const LAS f32x4*)(Qb + tt * 64 + 4 * d4); o0 += q4.x * S[4 * d4 + 0]; o1 += q4.y * S[4 * d4 + 1]; o2 += q4.z * S[4 * d4 + 2]; o3 += q4.w * S[4 * d4 + 3]; } }
            if (OUT) { const float o = (o0 + o1) + (o2 + o3); const float ssq = wave_sum(o * o); const float rstd = frsq(ssq * (1.0f / 64.0f) + EPS);
                WSP(bf16, WS_ACT)[(size_t)(t0 + tb + tt) * 1024 + Y_HG + h * 64 + lane] = (bf16)f2bf(o * rstd * Gb[tt * 64 + lane]); } }
        WAVE_SYNC();
    }
    if (!OUT) { float* sp = WSP(float, WS_ST_HG) + ((size_t)sc * 4 + h) * 4096 + lane;
#pragma unroll
        for (int d = 0; d < 64; ++d) sp[d * 64] = S[d];
        WSP(float, WS_DEC_HG)[((size_t)sc * 4 + h) * 64 + lane] = lam; }
}


__device__ __forceinline__ bf16x8 pack8(const float (&x)[8]) {
    u32x4 w; w.x = pk2(x[0], x[1]); w.y = pk2(x[2], x[3]); w.z = pk2(x[4], x[5]); w.w = pk2(x[6], x[7]); return __builtin_bit_cast(bf16x8, w); }
__device__ __forceinline__ void ld8f(const lf32* p, float (&x)[8]) { const f32x4 a = *(const LAS f32x4*)p, b = *(const LAS f32x4*)(p + 4); x[0] = a.x; x[1] = a.y; x[2] = a.z; x[3] = a.w; x[4] = b.x; x[5] = b.y; x[6] = b.z; x[7] = b.w; }
__device__ __forceinline__ void ld8b(const lbf* p, float (&x)[8]) { const u32x4 a = *(const LAS u32x4*)p; x[0] = bflo(a.x); x[1] = bfhi(a.x); x[2] = bflo(a.y); x[3] = bfhi(a.y); x[4] = bflo(a.z); x[5] = bfhi(a.z); x[6] = bflo(a.w); x[7] = bfhi(a.w); }
__device__ __forceinline__ void hg_logf_cumsum(Frame& F, int l, const bf16* proj, int t0, int h, lf32* bL, lf32* tot) {
    { const int t = F.tid >> 2, dq = (F.tid & 3) * 16; const bf16* pr = proj + (size_t)(t0 + t) * NPROJ + C_GF + h * 64 + dq; const float* lbp = WSP(float, WS_LB) + l * 256 + h * 64 + dq;
#pragma unroll
      for (int hh = 0; hh < 2; ++hh) { const u32x4 a = *(const u32x4*)(pr + 8 * hh); const unsigned aw[4] = {a.x, a.y, a.z, a.w}; float lf[8];
#pragma unroll
          for (int j = 0; j < 8; ++j) { const float x = (j & 1) ? bfhi(aw[j >> 1]) : bflo(aw[j >> 1]); const float lb = lbp[8 * hh + j]; lf[j] = flog(lb + (1.0f - lb) * sigmoidf_(x)); }
          *(LAS f32x4*)(bL + t * 64 + dq + 8 * hh) = (f32x4){lf[0], lf[1], lf[2], lf[3]}; *(LAS f32x4*)(bL + t * 64 + dq + 8 * hh + 4) = (f32x4){lf[4], lf[5], lf[6], lf[7]}; } }
    __syncthreads();
    const int d = F.tid & 63, sg = F.tid >> 6;
    { float run = 0.f;
#pragma unroll
      for (int j = 0; j < 16; ++j) { run += bL[(sg * 16 + j) * 64 + d]; bL[(sg * 16 + j) * 64 + d] = run; }
      tot[sg * 64 + d] = run; }
    __syncthreads();
    { float off = 0.f; for (int g = 0; g < sg; ++g) off += tot[g * 64 + d];
#pragma unroll
      for (int j = 0; j < 16; ++j) bL[(sg * 16 + j) * 64 + d] += off; }
    __syncthreads();
}
__device__ __forceinline__ void hg_state_unit(Frame& F0, int l, int c, int h) {
    Frame F = F0; LAUNDER(F);
    lf32* bL = (lf32*)F.lds; lf32* tot = bL + 128 * 64; lbf* VT = (lbf*)(tot + 512); lbf* KT = VT + 64 * LD128;
    const bf16* proj = WSP(bf16, WS_BIG); const int t0 = c * CH;
    __syncthreads();
    hg_logf_cumsum(F, l, proj, t0, h, bL, tot);
    stage_T64(F, proj, t0, C_GI + h * 64, VT);
    { const int s = F.tid >> 2, dq = (F.tid & 3) * 16; const bf16* pr = proj + (size_t)(t0 + s) * NPROJ + C_GF + h * 64 + dq; const float* lbp = WSP(float, WS_LB) + l * 256 + h * 64 + dq;
#pragma unroll
      for (int hh = 0; hh < 2; ++hh) { const u32x4 a = *(const u32x4*)(pr + 8 * hh); const unsigned aw[4] = {a.x, a.y, a.z, a.w};
#pragma unroll
          for (int j = 0; j < 8; ++j) { const int d = dq + 8 * hh + j; const float x = (j & 1) ? bfhi(aw[j >> 1]) : bflo(aw[j >> 1]); const float lb = lbp[8 * hh + j];
              const float k = 1.0f - (lb + (1.0f - lb) * sigmoidf_(x)); KT[d * LD128 + s] = (bf16)f2bf(k * fexp(bL[127 * 64 + d] - bL[s * 64 + d])); } } }
    __syncthreads();
    f32x4 acc[2] = {(f32x4){0, 0, 0, 0}, (f32x4){0, 0, 0, 0}};
    const int w = F.wave;
    wave_mma<2, 4>(acc, VT + 16 * (w >> 1) * LD128, LD128, KT + 32 * (w & 1) * LD128, LD128, F.lane);
    float* st = WSP(float, WS_ST_HG) + ((size_t)c * 4 + h) * 4096; const int e = 16 * (w >> 1) + (F.lane & 15);
#pragma unroll
    for (int n = 0; n < 2; ++n) *(f32x4*)(st + e * 64 + 32 * (w & 1) + 16 * n + 4 * (F.lane >> 4)) = acc[n];
    if (F.tid < 64) WSP(float, WS_DEC_HG)[((size_t)c * 4 + h) * 64 + F.tid] = fexp(bL[127 * 64 + F.tid]);
}
__device__ __forceinline__ void hg_out_unit(Frame& F0, int l, int c, int h) {
    Frame F = F0; LAUNDER(F);
    lf32* bL = (lf32*)F.lds; lf32* tot = bL + 128 * 64; lbf* Qr = (lbf*)(tot + 512); lbf* Kh = Qr + 128 * LD64; lbf* VT = Kh + 128 * LD64; lbf* ST = VT + 64 * LD128; lbf* P = ST + 64 * LD64;
    const bf16* proj = WSP(bf16, WS_BIG); const int t0 = c * CH;
    const int w = F.wave, lane = F.lane, fr = lane & 15, fq = lane >> 4, tl = 16 * w + fr;
    __syncthreads();
    u32x4 rq[2], rf[2], rv[2]; f32x4 rsa, rsb; u32x2 rg[4]; f32x4 rn[4]; float lb[16];
    { const int t = F.tid >> 2, dq = (F.tid & 3) * 16; const bf16* pq = proj + (size_t)(t0 + t) * NPROJ + C_GQ + h * 64 + dq; const bf16* pf = proj + (size_t)(t0 + t) * NPROJ + C_GF + h * 64 + dq;
      const f32x4* lbp = (const f32x4*)(WSP(float, WS_LB) + l * 256 + h * 64 + dq);
#pragma unroll
      for (int hh = 0; hh < 2; ++hh) { rq[hh] = *(const u32x4*)(pq + 8 * hh); rf[hh] = *(const u32x4*)(pf + 8 * hh); }
#pragma unroll
      for (int i = 0; i < 4; ++i) { const f32x4 x = lbp[i]; lb[4 * i] = x.x; lb[4 * i + 1] = x.y; lb[4 * i + 2] = x.z; lb[4 * i + 3] = x.w; }
#pragma unroll
      for (int i = 0; i < 2; ++i) { const int p = F.tid + 512 * i, s = p >> 3, eb = (p & 7) * 8; rv[i] = *(const u32x4*)(proj + (size_t)(t0 + s) * NPROJ + C_GI + h * 64 + eb); }
      const float* st = WSP(float, WS_ST_HG) + ((size_t)c * 4 + h) * 4096 + F.tid * 8; rsa = *(const f32x4*)st; rsb = *(const f32x4*)(st + 4);
      const bf16* gp0 = proj + (size_t)(t0 + tl) * NPROJ + C_GG + h * 64; const float* ng0 = F.hg_norm_g + l * 256 + h * 64;
#pragma unroll
      for (int n = 0; n < 4; ++n) { rg[n] = *(const u32x2*)(gp0 + 16 * n + 4 * fq); rn[n] = *(const f32x4*)(ng0 + 16 * n + 4 * fq); } }
    hg_logf_cumsum_r(F, rf, lb, bL, tot);
    { const int t = F.tid >> 2, dq = (F.tid & 3) * 16, te = (t | 15);
#pragma unroll
      for (int hh = 0; hh < 2; ++hh) { const unsigned aw[4] = {rq[hh].x, rq[hh].y, rq[hh].z, rq[hh].w}, bw[4] = {rf[hh].x, rf[hh].y, rf[hh].z, rf[hh].w}; float qo[8], ko[8];
#pragma unroll
          for (int j = 0; j < 8; ++j) { const int d = dq + 8 * hh + j; const float xq = (j & 1) ? bfhi(aw[j >> 1]) : bflo(aw[j >> 1]), xf = (j & 1) ? bfhi(bw[j >> 1]) : bflo(bw[j >> 1]); const float lbv = lb[8 * hh + j];
              qo[j] = siluf_(xq); ko[j] = (1.0f - (lbv + (1.0f - lbv) * sigmoidf_(xf))) * fexp(bL[te * 64 + d] - bL[t * 64 + d]); }
          *(LAS bf16x8*)(Qr + t * LD64 + dq + 8 * hh) = pack8(qo); *(LAS bf16x8*)(Kh + t * LD64 + dq + 8 * hh) = pack8(ko); } }
#pragma unroll
    for (int i = 0; i < 2; ++i) { const int p = F.tid + 512 * i, s = p >> 3, eb = (p & 7) * 8; const unsigned aw[4] = {rv[i].x, rv[i].y, rv[i].z, rv[i].w};
#pragma unroll
        for (int j = 0; j < 8; ++j) VT[(eb + j) * LD128 + s] = (bf16)((j & 1) ? (aw[j >> 1] >> 16) : (aw[j >> 1] & 0xffffu)); }
    { u32x4 o; o.x = pk2(rsa.x, rsa.y); o.y = pk2(rsa.z, rsa.w); o.z = pk2(rsb.x, rsb.y); o.w = pk2(rsb.z, rsb.w); *(LAS u32x4*)(ST + (F.tid >> 3) * LD64 + (F.tid & 7) * 8) = o; }
    __syncthreads();
    float qv[2][8], bt[2][8];
#pragma unroll
    for (int ks = 0; ks < 2; ++ks) { ld8b(Qr + tl * LD64 + ks * 32 + fq * 8, qv[ks]); ld8f(bL + tl * 64 + ks * 32 + fq * 8, bt[ks]); }
    lbf* Pw = P + w * 16 * LD128;
    f32x4 ox[4];
#pragma unroll
    for (int n = 0; n < 4; ++n) ox[n] = (f32x4){0, 0, 0, 0};
#pragma unroll
    for (int ks = 0; ks < 2; ++ks) { float x[8];
#pragma unroll
        for (int j = 0; j < 8; ++j) x[j] = qv[ks][j] * fexp(bt[ks][j]);
        const bf16x8 a = pack8(x);
#pragma unroll
        for (int n = 0; n < 4; ++n) { const bf16x8 b = *(const LAS bf16x8*)(ST + (n * 16 + fr) * LD64 + ks * 32 + fq * 8); ox[n] = __builtin_amdgcn_mfma_f32_16x16x32_bf16(b, a, ox[n], 0, 0, 0); } }
    for (int j = 0; j < w; ++j) { f32x4 sc = (f32x4){0, 0, 0, 0};
#pragma unroll
        for (int ks = 0; ks < 2; ++ks) { float be[8], x[8]; ld8f(bL + (16 * j + 15) * 64 + ks * 32 + fq * 8, be);
#pragma unroll
            for (int q = 0; q < 8; ++q) x[q] = qv[ks][q] * fexp(bt[ks][q] - be[q]);
            const bf16x8 a = pack8(x); const bf16x8 b = *(const LAS bf16x8*)(Kh + (16 * j + fr) * LD64 + ks * 32 + fq * 8);
            sc = __builtin_amdgcn_mfma_f32_16x16x32_bf16(b, a, sc, 0, 0, 0); }
        u32x2 o; o.x = pk2(sc.x, sc.y); o.y = pk2(sc.z, sc.w); *(LAS u32x2*)(Pw + fr * LD128 + 16 * j + 4 * fq) = o; }
    { f32x4 sc = (f32x4){0, 0, 0, 0};
#pragma unroll
      for (int ks = 0; ks < 2; ++ks) { float br[8], bee[8], kk[8], x[8], y[8]; ld8f(bL + (16 * w + 7) * 64 + ks * 32 + fq * 8, br); ld8f(bL + (16 * w + 15) * 64 + ks * 32 + fq * 8, bee); ld8b(Kh + tl * LD64 + ks * 32 + fq * 8, kk);
#pragma unroll
          for (int q = 0; q < 8; ++q) { x[q] = qv[ks][q] * fexp(bt[ks][q] - br[q]); y[q] = kk[q] * fexp(br[q] - bee[q]); }
          sc = __builtin_amdgcn_mfma_f32_16x16x32_bf16(pack8(y), pack8(x), sc, 0, 0, 0); }
      float pv[4];
#pragma unroll
      for (int q = 0; q < 4; ++q) pv[q] = (4 * fq + q <= fr) ? sc[q] : 0.f;
      u32x2 o; o.x = pk2(pv[0], pv[1]); o.y = pk2(pv[2], pv[3]); *(LAS u32x2*)(Pw + fr * LD128 + 16 * w + 4 * fq) = o; }
    for (int j = w + 1; j < 8; ++j) *(LAS u32x2*)(Pw + fr * LD128 + 16 * j + 4 * fq) = (u32x2){0u, 0u};
    WAVE_SYNC();
    f32x4 oi[4];
#pragma unroll
    for (int n = 0; n < 4; ++n) oi[n] = (f32x4){0, 0, 0, 0};
    wave_mma<4, 4>(oi, Pw, LD128, VT, LD128, lane);
    float ss = 0.f;
#pragma unroll
    for (int n = 0; n < 4; ++n) { oi[n] = oi[n] + ox[n]; ss += (oi[n].x * oi[n].x + oi[n].y * oi[n].y) + (oi[n].z * oi[n].z + oi[n].w * oi[n].w); }
    ss += __shfl_xor(ss, 16); ss += __shfl_xor(ss, 32);
    const float rstd = frsq(ss * (1.0f / 64.0f) + EPS);
    const int t = t0 + tl; bf16* y = WSP(bf16, WS_ACT) + (size_t)t * 1024 + Y_HG + h * 64;
#pragma unroll
    for (int n = 0; n < 4; ++n) { const int e = 16 * n + 4 * fq; const u32x2 g = rg[n]; const f32x4 gn = rn[n]; const f32x4 v = oi[n] * rstd * gn;
        u32x2 o; o.x = pk2(v.x * siluf_(bflo(g.x)), v.y * siluf_(bfhi(g.x))); o.y = pk2(v.z * siluf_(bflo(g.y)), v.w * siluf_(bfhi(g.y))); *(u32x2*)(y + e) = o; }
}

struct PtrS5A { const bf16* proj; const bf16* sp; int g, c0;
    __device__ __forceinline__ const bf16* operator()(int r, int k) const { int c = c0 + r; if (c >= NCH5) c = NCH5 - 1;
        return k < 512 ? proj + (size_t)(c * 32 + (k >> 4)) * NPROJ + C_S5U + g * 16 + (k & 15) : sp + ((size_t)c * 16 + g) * 128 + (k - 512); } };
struct EpiS5Inc { static constexpr bool HAS_PRE = false; float* st; int g, c0;
    __device__ __forceinline__ void operator()(int r, int c, f32x4 v) const { const int ch = c0 + r; if (ch < NCH5) *(f32x4*)(st + ((size_t)ch * 16 + g) * 128 + c) = v; } };
struct EpiS5Out { static constexpr bool HAS_PRE = false; const bf16* proj; bf16* ypre; const float* dsk; int g, c0, n0;
    __device__ __forceinline__ void operator()(int r, int c, f32x4 v) const { const int ch = c0 + r; if (ch >= NCH5) return; const int np = n0 + c, tl = np >> 4, p = np & 15, t = ch * 32 + tl;
        const u32x2 u = *(const u32x2*)(proj + (size_t)t * NPROJ + C_S5U + g * 16 + p); const float* d = dsk + g * 16 + p;
        const float y0 = gelu_tanh(v.x + d[0] * bflo(u.x)), y1 = gelu_tanh(v.y + d[1] * bfhi(u.x)), y2 = gelu_tanh(v.z + d[2] * bflo(u.y)), y3 = gelu_tanh(v.w + d[3] * bfhi(u.y));
        u32x2 o; o.x = pk2(y0, y1); o.y = pk2(y2, y3); *(u32x2*)(ypre + (size_t)t * 256 + g * 16 + p) = o; } };

constexpr int S5_CB = (NCH5 + 127) / 128;
__device__ __forceinline__ void phase_m1(Frame& F, int l) {
    constexpr int U_HG = NCH * 4, U_M2 = NCH * 2, U_RET = NCH * 4, U_S5 = 16 * S5_CB;
    unsigned* ctr = WSP(unsigned, WS_CTL) + CW_Q + 64 * (2 * l) + 32 * F.rep;
    constexpr int U_GG = L / 256;
    constexpr int NC = U_GG + U_HG + U_M2 + U_RET + U_S5 + 256;
    for (int u0 = grab_unit(F, ctr); u0 < NC + CONV_D_UNITS; u0 = grab_unit(F, ctr)) {
        if (u0 >= NC) { conv_d_unit(F, l, u0 - NC); continue; }
        if (u0 < U_GG) { g8::OneUnit S1{u0, NPROJ / 256 - 1, (size_t)256 * 1024 * 2, (size_t)256 * 1024 * 2}; g8::EpiStore E1{WSP(bf16, WS_BIG), NPROJ};
            g8::gemm_phase(F.lds, WSP(bf16, WS_ACT), WSP(bf16, WS_WIN) + (size_t)l * NPROJ * 1024, 1024, S1, E1); continue; }
        const int u = u0 - U_GG;
        if (u >= U_HG + U_M2 + U_RET + U_S5) { s5_prep_b(F, l, u - (U_HG + U_M2 + U_RET + U_S5), 256); continue; }
        if (u < U_HG) { hg_state_unit(F, l, u >> 2, u & 3); continue; }
        int r = u - U_HG;
        if (r < U_M2) { m2_state_unit(F, l, r >> 1, r & 1); continue; } r -= U_M2;
        if (r < U_RET) { ret_state_unit(F, r >> 2, r & 3); continue; } r -= U_RET;
        { const int g = r / S5_CB, cb = r % S5_CB; PtrS5A ap{WSP(bf16, WS_BIG), nullptr, g, cb * 128}; PtrRM bp{WSP(bf16, WS_S5BI) + (size_t)g * 128 * 512, 512, 127};
          EpiS5Inc e{WSP(float, WS_ST_S5), g, cb * 128}; gemm128(F.lds, 512, ap, bp, e); }
    }
}
constexpr int SL = 32;
template <int LEN, class DEC>
__device__ __forceinline__ void seg_scan_real(Frame& F0, float* base, size_t cstride, int chain0, int nchain_total, const DEC& dec) {
    Frame F = F0; LAUNDER(F);
    constexpr int NSEG = (LEN + SL - 1) / SL, CHB = NTHREADS / NSEG;
    lf32* Ts = (lf32*)F.lds; lf32* Qs = Ts + NTHREADS;
    const int ch = chain0 + (F.tid % CHB), sg = F.tid / CHB; const bool act = (F.tid < CHB * NSEG) && ch < nchain_total;
    float v[SL], d[SL]; float s = 0.f, q = 1.f;
    float* p = base + ch;
    __syncthreads();
    if (act) {
#pragma unroll
        for (int j = 0; j < SL; ++j) { const int c = sg * SL + j; const bool ok = c < LEN; v[j] = ok ? p[(size_t)c * cstride] : 0.f; d[j] = ok ? dec(ch, c) : 1.f; }
#pragma unroll
        for (int j = 0; j < SL; ++j) { s = d[j] * s + v[j]; q *= d[j]; }
        Ts[sg * CHB + (F.tid % CHB)] = s; Qs[sg * CHB + (F.tid % CHB)] = q;
    }
    __syncthreads();
    if (act) {
        float c0 = 0.f;
        for (int g = 0; g < sg; ++g) c0 = Qs[g * CHB + (F.tid % CHB)] * c0 + Ts[g * CHB + (F.tid % CHB)];
        s = c0;
#pragma unroll
        for (int j = 0; j < SL; ++j) { const int c = sg * SL + j; if (c < LEN) { p[(size_t)c * cstride] = s; s = d[j] * s + v[j]; } }
    }
}
struct DecConst { float d; __device__ __forceinline__ float operator()(int, int) const { return d; } };
struct DecM2 { const float* dc; __device__ __forceinline__ float operator()(int ch, int c) const { return dc[c * 4 + (ch >> 13)]; } };
struct DecHG { const float* dc; __device__ __forceinline__ float operator()(int ch, int c) const { return dc[(size_t)c * 256 + (ch >> 12) * 64 + (ch & 63)]; } };
template <int LEN>
__device__ __forceinline__ void seg_scan_s5(Frame& F0, int l, int chain0) {
    Frame F = F0; LAUNDER(F);
    constexpr int NSEG = (LEN + SL - 1) / SL, CHB = NTHREADS / NSEG;
    LAS f32x2* Ts = (LAS f32x2*)F.lds; LAS f32x2* Qs = Ts + NTHREADS;
    const int r = chain0 + (F.tid % CHB), sg = F.tid / CHB; const bool act = (F.tid < CHB * NSEG) && r < 1024;
    const float* ap = WSP(float, WS_S5AP) + ((size_t)l * 1024 + (act ? r : 0)) * 68 + 64; const float ar = ap[0], ai = ap[1];
    const f32x2* p = (const f32x2*)(WSP(float, WS_ST_S5) + 2 * r); bf16* qo = WSP(bf16, WS_S5UG) + (size_t)(r >> 6) * NR5 * 640 + 512 + 2 * (r & 63);
    f32x2 v[SL]; float sr = 0.f, si = 0.f, qr = 1.f, qi = 0.f;
    __syncthreads();
    if (act) {
#pragma unroll
        for (int j = 0; j < SL; ++j) { const int c = sg * SL + j; v[j] = (c < LEN) ? p[(size_t)c * 1024] : (f32x2){0.f, 0.f}; }
#pragma unroll
        for (int j = 0; j < SL; ++j) { const int c = sg * SL + j; if (c < LEN) { const float nr = ar * sr - ai * si + v[j].x, ni = ar * si + ai * sr + v[j].y; sr = nr; si = ni; const float tr = ar * qr - ai * qi, ti = ar * qi + ai * qr; qr = tr; qi = ti; } }
        Ts[sg * CHB + (F.tid % CHB)] = (f32x2){sr, si}; Qs[sg * CHB + (F.tid % CHB)] = (f32x2){qr, qi};
    }
    __syncthreads();
    if (act) {
        float cr = 0.f, ci = 0.f;
        for (int g = 0; g < sg; ++g) { const f32x2 Q = Qs[g * CHB + (F.tid % CHB)], T = Ts[g * CHB + (F.tid % CHB)]; const float nr = Q.x * cr - Q.y * ci + T.x, ni = Q.x * ci + Q.y * cr + T.y; cr = nr; ci = ni; }
        sr = cr; si = ci;
#pragma unroll
        for (int j = 0; j < SL; ++j) { const int c = sg * SL + j; if (c < LEN) { *(unsigned*)(qo + (size_t)c * 640) = pk2(sr, si); const float nr = ar * sr - ai * si + v[j].x, ni = ar * si + ai * sr + v[j].y; sr = nr; si = ni; } }
    }
}
__device__ __forceinline__ void phase_m2(Frame& F, int l) {
    constexpr int N_RET = 4 * 4096, N_M2 = 4 * 8192, N_HG = 4 * 4096, N_S5 = 16 * 64;
    constexpr int CB_R = NTHREADS / ((NCH + SL - 1) / SL), CB_H = NTHREADS / ((NCH + SL - 1) / SL), CB_S = NTHREADS / ((NCH5 + SL - 1) / SL);
    constexpr int U_S5 = (N_S5 + CB_S - 1) / CB_S, U_HG = (N_HG + CB_H - 1) / CB_H, U_M2 = (N_M2 + CB_R - 1) / CB_R, U_RET = (N_RET + CB_R - 1) / CB_R;
    unsigned* ctr = WSP(unsigned, WS_CTL) + CW_Q + 64 * (6 + l) + 32 * F.rep;
    for (int u = grab_unit(F, ctr); u < U_S5 + U_HG + U_M2 + U_RET; u = grab_unit(F, ctr)) {
        if (u < U_S5) { seg_scan_s5<NCH5>(F, l, u * CB_S); continue; }
        int r = u - U_S5;
        if (r < U_HG) { DecHG dh{WSP(float, WS_DEC_HG)}; seg_scan_real<NCH>(F, WSP(float, WS_ST_HG), 16384, r * CB_H, N_HG, dh); continue; }
        r -= U_HG;
        if (r < U_M2) { DecM2 dm{WSP(float, WS_DEC_M2)}; seg_scan_real<NCH>(F, WSP(float, WS_ST_M2), 32768, r * CB_R, N_M2, dm); continue; }
        r -= U_M2;
        { const int ch0 = r * CB_R; DecConst dcst{exp2f(128.0f * ret_log2gamma(ch0 >> 12))};
          seg_scan_real<NCH>(F, WSP(float, WS_ST_RET), 16384, ch0, N_RET, dcst); }
    }
}
__device__ __forceinline__ void phase_m3(Frame& F, int l) {
    constexpr int U_HG = NCH * 4, U_M2 = NCH, U_RET = NCH * 4, U_S5 = 16 * (NR5 / 256) * 2;
    unsigned* ctr = WSP(unsigned, WS_CTL) + CW_Q + 64 * (2 * l + 1) + 32 * F.rep;
    constexpr int NC = U_HG + U_M2 + U_RET + U_S5;
    for (int u0 = grab_unit(F, ctr); u0 < NC + CONV_GU_UNITS; u0 = grab_unit(F, ctr)) {
        if (u0 >= U_M2 + U_S5 && u0 < U_M2 + U_S5 + CONV_GU_UNITS) { conv_gu_unit(F, l, u0 - (U_M2 + U_S5)); continue; }
        const int u = u0 < U_M2 + U_S5 ? u0 : u0 - CONV_GU_UNITS;
#ifndef M3SKIP
#define M3SKIP 0
#endif
        if (u < U_M2) { if (!(M3SKIP & 2)) m2_out_unit(F, l, u); continue; }
        int r = u - U_M2;
        if (r >= U_S5) { r -= U_S5;
            if (r < U_HG) { if (!(M3SKIP & 1)) hg_out_unit(F, l, r >> 2, r & 3); continue; } r -= U_HG;
            if (!(M3SKIP & 4)) ret_out_unit(F, r >> 2, r & 3); continue; }
        if (M3SKIP & 8) continue;
        { const int g = r / (2 * (NR5 / 256)), pm = (r >> 1) % (NR5 / 256), pn = r & 1;
          g8::OneUnit S1{pm, pn, (size_t)256 * 640 * 2, (size_t)256 * 640 * 2};
          g8::EpiS5OutG E1{WSP(bf16, WS_BIG), WSP(bf16, WS_YPRE), F.s5_d + l * 256, g, NCH5, C_S5U, NPROJ};
          g8::gemm_phase(F.lds, WSP(bf16, WS_S5UG) + (size_t)g * NR5 * 640, WSP(bf16, WS_S5MT) + (size_t)g * 512 * 640, 640, S1, E1); }
    }
}
struct EpiGlu { static constexpr bool HAS_PRE = true; const bf16* ypre; bf16* y; const float* bias; int r0, c0;
    struct Pre { u32x2 u; f32x4 b; };
    __device__ __forceinline__ Pre load(int r, int c) const { const int t = r0 + r, j = c0 + c; Pre p; p.u = *(const u32x2*)(ypre + (size_t)t * 256 + j); p.b = *(const f32x4*)(bias + j); return p; }
    __device__ __forceinline__ void fin(int r, int c, f32x4 v, const Pre& p) const { const int t = r0 + r, j = c0 + c; const u32x2 u = p.u; const f32x4 b = p.b;
        u32x2 o; o.x = pk2(bflo(u.x) * sigmoidf_(v.x + b.x), bfhi(u.x) * sigmoidf_(v.y + b.y)); o.y = pk2(bflo(u.y) * sigmoidf_(v.z + b.z), bfhi(u.y) * sigmoidf_(v.w + b.w));
        *(u32x2*)(y + (size_t)t * 1024 + Y_S5 + j) = o; } };
__device__ __forceinline__ void phase_m4(Frame& F, int l) {
    constexpr int NM = L / 128;
    for (int u = F.bid; u < NM * 2; u += F.G) { const int pm = u >> 1, pn = u & 1;
        PtrRM ap{WSP(bf16, WS_YPRE) + (size_t)pm * 128 * 256, 256, 127}, bp{WSP(bf16, WS_WGLU) + (size_t)l * 65536 + (size_t)pn * 128 * 256, 256, 127};
        EpiGlu e{WSP(bf16, WS_YPRE), WSP(bf16, WS_ACT), F.s5_b_glu + l * 256, pm * 128, pn * 128}; gemm128(F.lds, 256, ap, bp, e); }
}

__device__ __forceinline__ void phase_g2(Frame& F, int l) {
    g8::GridOrder S{L / 256, 4, (L / 256) * 4, F.G, F.bid, (size_t)256 * 1024 * 2, (size_t)256 * 1024 * 2};
    if (l == 0) { g8::EpiResid<false> E{F.x, WSP(bf16, WS_XRES)}; g8::gemm_phase(F.lds, WSP(bf16, WS_ACT), WSP(bf16, WS_WOUT), 1024, S, E); }
    else { g8::EpiResid<true> E{F.out, WSP(bf16, WS_XRES)}; g8::gemm_phase(F.lds, WSP(bf16, WS_ACT), WSP(bf16, WS_WOUT) + (size_t)1048576, 1024, S, E); }
}

__device__ __forceinline__ void phase_r2(Frame& F, int l) {
    const int RPB = L / F.G;
    LAS f32x4* T = (LAS f32x4*)F.lds;
    li32* e_s = (li32*)(F.lds + 81920); li32* base_s = e_s + 128;
    int* hist = WSP(int, WS_HIST) + l * 256 * 16;
    const float* g2 = F.norm2_g + l * 1024; const float* wg = F.moe_w_group + (size_t)l * 4096; const float* we = F.moe_w_expert + (size_t)l * 16384;
    __syncthreads();
    for (int k = F.tid; k < 1024; k += NTHREADS) { const float g = g2[k]; const int ln = (k >> 2) & 63, a = k & 3, j = k >> 8; const int idx = (j * 4 + a) * 64 + ln;
        T[idx] = g * *(const f32x4*)(wg + (size_t)k * 4);
#pragma unroll
        for (int b = 0; b < 4; ++b) T[(b + 1) * 1024 + idx] = g * *(const f32x4*)(we + (size_t)k * 16 + 4 * b); }
    for (int rb = 0; rb < RPB; rb += 64) {
        __syncthreads();
        u32x2 xq[4];
        if (rb + F.wave * 8 < RPB) { const u32x2* x0 = (const u32x2*)(WSP(bf16, WS_XRES) + (size_t)(F.bid * RPB + rb + F.wave * 8) * D) + F.lane;
#pragma unroll
            for (int j = 0; j < 4; ++j) xq[j] = x0[64 * j]; }
        for (int rr = 0; rr < 8; ++rr) { const int ri = F.wave * 8 + rr; if (rb + ri >= RPB) break; const int t = F.bid * RPB + rb + ri; const int lane = F.lane;
            const u32x2* xr = (const u32x2*)(WSP(bf16, WS_XRES) + (size_t)t * D) + lane; float ss = 0.f; f32x4 v[4];
#pragma unroll
            for (int j = 0; j < 4; ++j) { const u32x2 xb = xq[j]; v[j] = (f32x4){bflo(xb.x), bfhi(xb.x), bflo(xb.y), bfhi(xb.y)}; ss += (v[j].x * v[j].x + v[j].y * v[j].y) + (v[j].z * v[j].z + v[j].w * v[j].w); }
            if (rr + 1 < 8 && rb + ri + 1 < RPB) {
#pragma unroll
                for (int j = 0; j < 4; ++j) xq[j] = xr[256 + 64 * j]; }
            const float rstd = frsq(wave_sum(ss) * (1.0f / D) + EPS);
            float lgg[4] = {0.f, 0.f, 0.f, 0.f};
            u32x2* hb = (u32x2*)(WSP(bf16, WS_ACT) + (size_t)t * D) + lane;
#pragma unroll
            for (int j = 0; j < 4; ++j) { const int k = 4 * lane + 256 * j; const f32x4 h = v[j] * rstd * *(const f32x4*)(g2 + k);
                u32x2 w; w.x = pk2(h.x, h.y); w.y = pk2(h.z, h.w); hb[64 * j] = w;
                const float xv[4] = {v[j].x, v[j].y, v[j].z, v[j].w};
#pragma unroll
                for (int a = 0; a < 4; ++a) { const f32x4 w4 = T[(j * 4 + a) * 64 + lane]; lgg[0] += xv[a] * w4.x; lgg[1] += xv[a] * w4.y; lgg[2] += xv[a] * w4.z; lgg[3] += xv[a] * w4.w; } }
            float gl[4]; float gm = -1e30f; int gi = 0;
#pragma unroll
            for (int q = 0; q < 4; ++q) { gl[q] = wave_sum(lgg[q]) * rstd + F.moe_b_group[l * 4 + q]; if (gl[q] > gm) { gm = gl[q]; gi = q; } }
            gi = __builtin_amdgcn_readfirstlane(gi);
            float lge[4] = {0.f, 0.f, 0.f, 0.f};
            { const LAS f32x4* Te = T + (1 + gi) * 1024;
#pragma unroll
              for (int j = 0; j < 4; ++j) { const float xv[4] = {v[j].x, v[j].y, v[j].z, v[j].w};
#pragma unroll
                for (int a = 0; a < 4; ++a) { const f32x4 w4 = Te[(j * 4 + a) * 64 + lane]; lge[0] += xv[a] * w4.x; lge[1] += xv[a] * w4.y; lge[2] += xv[a] * w4.z; lge[3] += xv[a] * w4.w; } } }
            float el[4];
#pragma unroll
            for (int q = 0; q < 4; ++q) el[q] = wave_sum(lge[q]) * rstd + F.moe_b_expert[l * 16 + gi * 4 + q];
            if (lane == 0) {
                float gs = 0.f;
#pragma unroll
                for (int q = 0; q < 4; ++q) gs += fexp(gl[q] - gm);
                const float pg = 1.0f / gs;
                int i0 = 0; float m0 = el[0];
#pragma unroll
                for (int q = 1; q < 4; ++q) if (el[q] > m0) { m0 = el[q]; i0 = q; }
                int i1 = -1; float m1 = -1e30f;
#pragma unroll
                for (int q = 0; q < 4; ++q) if (q != i0 && el[q] > m1) { m1 = el[q]; i1 = q; }
                if (i1 < 0) { i1 = (i0 + 1) & 3; m1 = m0; }
                const float p1 = fexp(m1 - m0);
                const float w0 = pg / (1.0f + p1), w1 = pg * p1 / (1.0f + p1);
                int* rt = WSP(int, WS_ROUTE) + ((size_t)l * L + t) * 8; float* rtf = (float*)rt;
                rt[0] = gi * 4 + i0; rt[1] = gi * 4 + i1; rtf[4] = w0; rtf[5] = w1;
                e_s[2 * ri] = gi * 4 + i0; e_s[2 * ri + 1] = gi * 4 + i1;
            } }
        __syncthreads();
        const int nrow = (RPB - rb) < 64 ? (RPB - rb) : 64;
        li32* cnt_s = base_s;
        int my_e = -1, my_rank = 0;
        if (F.wave < 2) { const int idx = F.wave * 64 + F.lane; my_e = idx < 2 * nrow ? e_s[idx] : -1;
#pragma unroll
            for (int q = 0; q < 16; ++q) { const unsigned long long m = __ballot(my_e == q); if (my_e == q) my_rank = __builtin_popcountll(m & ((1ull << F.lane) - 1ull)); if (F.lane == 0) cnt_s[F.wave * 16 + q] = __builtin_popcountll(m); } }
        __syncthreads();
        if (F.tid < 16) hist[F.bid * 16 + F.tid] = cnt_s[F.tid] + cnt_s[16 + F.tid];
        if (F.wave < 2 && my_e >= 0) { const int idx = F.wave * 64 + F.lane; const int pos = my_rank + (F.wave == 1 ? cnt_s[my_e] : 0);
            const int t = F.bid * RPB + rb + (idx >> 1); WSP(int, WS_ROUTE)[((size_t)l * L + t) * 8 + 2 + (idx & 1)] = pos; }
    }
}
__device__ __forceinline__ int moe_tables(Frame& F, int l, li32* base_s, li32* pe_s, li32* pref_s) {
    const int* hist = WSP(int, WS_HIST) + l * 256 * 16; const int G = F.G; li32* seg_s = pref_s + 256 * 16;
    const int e = F.tid & 15, sg = F.tid >> 4, per = (G + 31) / 32;
    __syncthreads();
    for (int i = F.tid; i < G * 16; i += NTHREADS) pref_s[i] = hist[i];
    __syncthreads();
    { int run = 0; for (int b = sg * per; b < (sg + 1) * per && b < G; ++b) { const int v = pref_s[b * 16 + e]; pref_s[b * 16 + e] = run; run += v; } seg_s[sg * 16 + e] = run; }
    __syncthreads();
    if (F.tid < 16) { int run = 0; for (int g = 0; g < 32; ++g) { const int v = seg_s[g * 16 + F.tid]; seg_s[g * 16 + F.tid] = run; run += v; } base_s[16 + F.tid] = run; }
    __syncthreads();
    { const int off = seg_s[sg * 16 + e]; for (int b = sg * per; b < (sg + 1) * per && b < G; ++b) pref_s[b * 16 + e] += off; }
    if (F.tid == 0) { int tot[16];
#pragma unroll
        for (int q = 0; q < 16; ++q) tot[q] = base_s[16 + q];
        int b = 0, np = 0;
#pragma unroll
        for (int q = 0; q < 16; ++q) { base_s[q] = b; const int pp = (tot[q] + 255) >> 8; for (int i = 0; i < pp; ++i) pe_s[np++] = q; b += pp * 256; }
        base_s[16] = np; }
    __syncthreads();
    return base_s[16];
}
constexpr size_t WS_MOETAB = WS_LB + 2048;
__device__ __forceinline__ int moe_tables_small(Frame& F, int l, li32* base_s, li32* pe_s) {
    const int* tab = WSP(int, WS_MOETAB) + l * 256;
    __syncthreads();
    if (F.tid < 32) base_s[F.tid] = tab[F.tid];
    if (F.tid >= 32 && F.tid < 32 + 160) pe_s[F.tid - 32] = tab[F.tid];
    __syncthreads();
    return base_s[16];
}
__device__ __forceinline__ void phase_ga(Frame& F, int l) {
    li32* base_s = (li32*)F.lds; li32* pe_s = base_s + 32; li32* pref_s = pe_s + 160;
    moe_tables(F, l, base_s, pe_s, pref_s);
    if (F.bid == 0) { int* tab = WSP(int, WS_MOETAB) + l * 256; if (F.tid < 32) tab[F.tid] = base_s[F.tid]; if (F.tid >= 32 && F.tid < 32 + 160) tab[F.tid] = pe_s[F.tid - 32]; }
    const int RPB = L / F.G;
    const int gw = F.bid * 8 + F.wave, ngw = F.G * 8;
    for (int t = gw; t < L; t += ngw) { int* rt = WSP(int, WS_ROUTE) + ((size_t)l * L + t) * 8;
        const int ob = (t / RPB) * 16; const int s0 = base_s[rt[0]] + pref_s[ob + rt[0]] + rt[2], s1 = base_s[rt[1]] + pref_s[ob + rt[1]] + rt[3];
        if (F.lane == 0) { rt[6] = s0; rt[7] = s1; }
        const u32x4* src = (const u32x4*)(WSP(bf16, WS_ACT) + (size_t)t * 1024) + F.lane; u32x4* d0 = (u32x4*)(WSP(bf16, WS_H2G) + (size_t)s0 * 1024) + F.lane; u32x4* d1 = (u32x4*)(WSP(bf16, WS_H2G) + (size_t)s1 * 1024) + F.lane;
        const u32x4 a = src[0], b = src[64]; d0[0] = a; d0[64] = b; d1[0] = a; d1[64] = b; }
}
__device__ __forceinline__ void phase_g3(Frame& F, int l) {
    li32* base_s = (li32*)(F.lds + g8::STAGE_BYTES); li32* pe_s = base_s + 32;
    const int np = moe_tables_small(F, l, base_s, pe_s);
    g8::MoeOrder S{np, F.G, F.bid, pe_s, (size_t)256 * 1024 * 2, (size_t)1024 * 1024 * 2, (size_t)256 * 1024 * 2};
    g8::EpiGateUp E{WSP(bf16, WS_ACTB), (unsigned)((size_t)NSLOTP * 512 * 2), WSP(unsigned, WS_CTL) + CW_DEP + l * 4096};
    g8::gemm_phase(F.lds, WSP(bf16, WS_H2G), WSP(bf16, WS_WGU), 1024, S, E);
}
__device__ __forceinline__ void phase_g4(Frame& F, int l) {
    li32* base_s = (li32*)(F.lds + g8::STAGE_BYTES); li32* pe_s = base_s + 32;
    const int np = moe_tables_small(F, l, base_s, pe_s);
    const int n3raw = np * 4 - 2 * F.G, n3 = (n3raw >= 0 && n3raw <= F.G / 4) ? n3raw : -1;
    const int rank = n3 < 0 ? (F.bid + F.G / 2) % F.G : (F.bid >= n3 ? F.bid - n3 : F.G - n3 + F.bid);
    g8::MoeOrderDep S{np, F.G, rank, n3, pe_s, (size_t)256 * 512 * 2, (size_t)1024 * 512 * 2, (size_t)256 * 512 * 2, WSP(unsigned, WS_CTL) + CW_DEP + l * 4096, F.wave};
    g8::EpiStore E{WSP(bf16, WS_H2G), 1024};
    g8::gemm_phase(F.lds, WSP(bf16, WS_ACTB), WSP(bf16, WS_WD), 512, S, E);
    if (l == 0) { unsigned* ctr = WSP(unsigned, WS_CTL) + CW_Q + 64 * 5 + 32 * F.rep;
      for (int u = grab_unit(F, ctr); u < 256; u = grab_unit(F, ctr)) s5_prep_a(F, 1, u, 256); }
}
#ifndef ONLY
#define ONLY -1
#endif
#define EN(k) (ONLY < 0 || ONLY == (k))
constexpr int NPHASE = 23;
__global__ void __launch_bounds__(NTHREADS, 2) fwd_kernel(Args a) {
#ifdef EMU
    lu8* lds = emu::ctx->lds;
#else
    __shared__ __attribute__((aligned(16))) unsigned char lds_raw[LDS_BYTES];
    lu8* lds = (lu8*)lds_raw;
#endif
    Frame F;
    F.lds = lds; F.ws = a.ws; F.out = a.out; F.tid = threadIdx.x; F.lane = F.tid & 63; F.wave = __builtin_amdgcn_readfirstlane(F.tid >> 6); F.G = gridDim.x; F.bid = blockIdx.x; F.rep = 0;
    F.x = (const float*)a.in[0]; F.pos = (const int*)a.in[1];
    { LAS unsigned long long* tab = (LAS unsigned long long*)(lds + MISC_OFF + 256); if (F.tid < 32) tab[F.tid] = (unsigned long long)a.in[F.tid]; F.ptab = tab; }
#ifndef EMU
    volatile LAS unsigned* misc = (volatile LAS unsigned*)(lds + MISC_OFF);
    for (int u = F.tid; u < 64; u += NTHREADS) misc[u] = 0u;
#endif
    __syncthreads();
#ifndef EMU
    XcdBarrier bar = xcd_barrier_post(WSP(unsigned, WS_CTL) + CW_BAR, misc + 8);
#endif
    const Frame F00 = F;
    const int lo = a.ph_lo, hi = a.ph_hi;
#ifdef EMU
#define GRID_BAR() ((void)0)
#else
#define GRID_BAR() xcd_barrier(bar)
#endif
#ifndef REPEAT_PH
#define REPEAT_PH -1
#endif
#define PH(k, en, stmt) if (lo <= (k) && (k) < hi) { Frame F = F00; LAUNDER(F); if (EN(en)) { stmt; } if ((k) + 1 < hi && (k) != 9 && (k) != 20) GRID_BAR(); \
        if ((k) == REPEAT_PH) { Frame F = F00; LAUNDER(F); F.rep = 1; stmt; GRID_BAR(); } }
    PH(0, 10, phase_p0(F))
    PH(1, 0, phase_g1(F, 0)) PH(2, 1, phase_m1(F, 0)) PH(3, 2, phase_m2(F, 0)) PH(4, 3, phase_m3(F, 0)) PH(5, 4, phase_m4(F, 0))
    PH(6, 5, phase_g2(F, 0)) PH(7, 6, phase_r2(F, 0)) PH(8, 7, phase_ga(F, 0)) PH(9, 8, phase_g3(F, 0)) PH(10, 9, phase_g4(F, 0))
    PH(11, 12, r1_phase(F, 1, 1))
    PH(12, 0, phase_g1(F, 1)) PH(13, 1, phase_m1(F, 1)) PH(14, 2, phase_m2(F, 1)) PH(15, 3, phase_m3(F, 1)) PH(16, 4, phase_m4(F, 1))
    PH(17, 5, phase_g2(F, 1)) PH(18, 6, phase_r2(F, 1)) PH(19, 7, phase_ga(F, 1)) PH(20, 8, phase_g3(F, 1)) PH(21, 9, phase_g4(F, 1))
    PH(22, 11, r1_phase(F, 2, 0))
#undef PH
}


#ifdef STOP_AFTER
__global__ void __launch_bounds__(512) diag0(unsigned char* ws) { unsigned* flag = (unsigned*)(ws + WS_CTL) + 70000; if (threadIdx.x < 8 && blockIdx.x == 0) flag[threadIdx.x] = threadIdx.x == 1 ? 0x7fffffffu : 0u; }
__global__ void __launch_bounds__(512) diag1(const float* out, unsigned char* ws) {
    const size_t N = (size_t)L * D; const unsigned short* act = (const unsigned short*)(ws + WS_ACT); unsigned* flag = (unsigned*)(ws + WS_CTL) + 70000;
    for (size_t i = (size_t)blockIdx.x * 512 + threadIdx.x; i < N; i += (size_t)gridDim.x * 512) { if ((act[i] & 0x7F80u) == 0x7F80u) { atomicAdd(flag, 1u); atomicMin(flag + 1, (unsigned)(i >> 10)); if (((i >> 8) & 3) == 1) atomicOr(flag + 2, 1u << ((i >> 4) & 3)); } }
}
__global__ void __launch_bounds__(512) diag2(float* out, const unsigned char* ws) {
    const size_t N = (size_t)L * D; const unsigned* flag = (const unsigned*)(ws + WS_CTL) + 70000;
    const float c = DIAG_SEL == 0 ? (float)flag[0] : DIAG_SEL == 1 ? (float)flag[1] + 1.f : DIAG_SEL == 2 ? (float)flag[2] * 10.f : DIAG_SEL == 4 ? (float)flag[16] * 10.f : (float)flag[3];
    for (size_t i = (size_t)blockIdx.x * 512 + threadIdx.x; i < N; i += (size_t)gridDim.x * 512) out[i] = c;
}
#endif
#ifdef EMU
extern "C" int emu_seq() { return L; }
extern "C" size_t emu_ws_bytes() { return WS_END; }
extern "C" void emu_dump_layout(FILE* f) {
#define LO(n) fprintf(f, #n " %zu\n", (size_t)n)
    LO(WS_WIN); LO(WS_WOUT); LO(WS_WGLU); LO(WS_WGU); LO(WS_WD); LO(WS_S5MT); LO(WS_S5BI); LO(WS_S5AP); LO(WS_S5BB); LO(WS_S5KT); LO(WS_ROPE); LO(WS_DTW); LO(WS_LB); LO(WS_ACT); LO(WS_YPRE);
    LO(WS_DTRAW); LO(WS_ROUTE); LO(WS_ST_RET); LO(WS_ST_M2); LO(WS_DEC_M2); LO(WS_ST_HG); LO(WS_DEC_HG); LO(WS_ST_S5); LO(WS_SP_S5); LO(WS_BIG); LO(WS_H2G); LO(WS_ACTB); LO(WS_S5UG); LO(WS_END);
    fprintf(f, "CNT %zu\n", (size_t)CW_CNT * 4);
}
#endif

extern "C" void kernel_launch(void* const* d_in, const int* in_sizes, int n_in, void* d_out, int out_size, void* d_ws, size_t ws_size, hipStream_t stream) {
    static int grid = 0;
    if (grid == 0) {
        if (n_in != 32 || out_size != L * D || ws_size < WS_END) { fprintf(stderr, "kernel_launch: unexpected shapes: n_in %d out %d ws %zu (need %zu)\n", n_in, out_size, ws_size, (size_t)WS_END); grid = -1; return; }
#ifdef EMU
        grid = getenv("EMU_GRID") ? atoi(getenv("EMU_GRID")) : L / 64;
#else
        int dev = 0, cus = 0, per_cu = 0;
        (void)hipGetDevice(&dev);
        (void)hipDeviceGetAttribute(&cus, hipDeviceAttributeMultiprocessorCount, dev);
        (void)hipOccupancyMaxActiveBlocksPerMultiprocessor(&per_cu, (const void*)fwd_kernel, NTHREADS, 0);
        (void)hipGetLastError();
        grid = cus > 0 ? cus : 256;
        if (per_cu < 1) { fprintf(stderr, "kernel_launch: occupancy query says 0 blocks/CU\n"); grid = -1; return; }
        if (L % grid != 0 || L / grid > 64 || grid > 256) { fprintf(stderr, "kernel_launch: grid %d unsupported (need L %% grid == 0, L / grid <= 64, grid <= 256)\n", grid); grid = -1; return; }
#endif
    }
    if (grid < 0) return;
    (void)hipMemsetAsync((char*)d_ws + WS_CTL, 0, CTL_ZERO_BYTES, stream);
    Args a{};
    for (int i = 0; i < 32; ++i) a.in[i] = d_in[i];
    a.out = (float*)d_out; a.ws = (unsigned char*)d_ws;
#ifdef EMU
    const int nph = getenv("EMU_PHASES") ? atoi(getenv("EMU_PHASES")) : NPHASE;
    for (int ph = 0; ph < nph; ++ph) { a.ph_lo = ph; a.ph_hi = ph + 1; Args b = a; fprintf(stderr, "emu: phase %d\n", ph);
        emu::launch(dim3(grid), dim3(NTHREADS), LDS_BYTES, [b]() { fwd_kernel(b); }); }
#else
#if defined(STOP_AFTER)
    for (int ph = 0; ph < STOP_AFTER; ++ph) { a.ph_lo = ph; a.ph_hi = ph + 1; hipLaunchKernelGGL(fwd_kernel, dim3(grid), dim3(NTHREADS), 0, stream, a); }
    hipLaunchKernelGGL(diag0, dim3(1), dim3(512), 0, stream, (unsigned char*)d_ws);
    hipLaunchKernelGGL(diag1, dim3(1024), dim3(512), 0, stream, (const float*)d_out, (unsigned char*)d_ws);
    hipLaunchKernelGGL(diag2, dim3(1024), dim3(512), 0, stream, (float*)d_out, (const unsigned char*)d_ws);
#elif defined(MULTI_LAUNCH)
    for (int ph = 0; ph < NPHASE; ++ph) { a.ph_lo = ph; a.ph_hi = ph + 1; hipLaunchKernelGGL(fwd_kernel, dim3(grid), dim3(NTHREADS), 0, stream, a); }
#else
    a.ph_lo = 0; a.ph_hi = NPHASE;
    void* args[] = {&a};
    hipError_t e = hipLaunchCooperativeKernel((const void*)fwd_kernel, dim3(grid), dim3(NTHREADS), args, 0, stream);
    if (e != hipSuccess) fprintf(stderr, "cooperative launch failed: %s (grid %d)\n", hipGetErrorString(e), grid);
#endif
#endif
}
```

```cpp
#ifndef EMU
#include <hip/hip_runtime.h>
#endif
#include <cstdio>
#include <cstdint>
#include <cmath>
#include <cstdlib>

#ifndef SEQ_LEN
#define SEQ_LEN 16384
#endif


typedef unsigned short bf16;
typedef short bf16x8 __attribute__((ext_vector_type(8)));
typedef float f32x4 __attribute__((ext_vector_type(4)));
typedef float f32x2 __attribute__((ext_vector_type(2)));
typedef unsigned u32x4 __attribute__((ext_vector_type(4)));
typedef unsigned u32x2 __attribute__((ext_vector_type(2)));
#ifdef EMU
#define LAS
#else
#define LAS __attribute__((address_space(3)))
#endif
typedef LAS bf16 lbf; typedef LAS float lf32; typedef LAS int li32; typedef LAS unsigned char lu8;

#ifdef EMU
#define WAVE_SYNC() emu::wave_barrier()
#else
#define WAVE_SYNC() do { __builtin_amdgcn_fence(__ATOMIC_RELEASE, "wavefront"); asm volatile("s_waitcnt lgkmcnt(0)" ::: "memory"); __builtin_amdgcn_wave_barrier(); } while (0)
#endif
constexpr int L = SEQ_LEN, D = 1024, NPROJ = 3328, DIN = 3332;
constexpr int C_S5U = 0, C_RQ = 256, C_RK = 512, C_RV = 768, C_RG = 1024, C_MZ = 1280, C_MX = 1536, C_MB = 1792, C_MC = 2048,
              C_GQ = 2304, C_GF = 2560, C_GI = 2816, C_GG = 3072;
constexpr int Y_S5 = 0, Y_RET = 256, Y_M2 = 512, Y_HG = 768;
constexpr int CH = 128, NCH = L / CH;
constexpr int HSC = 64, NHSC = L / HSC;
constexpr int T5 = 32, NCH5 = L / T5;
constexpr int NEXP = 16, FF = 512;
constexpr int NSLOTP = 2 * L + NEXP * 256;
constexpr float EPS = 1e-6f;
constexpr int NTHREADS = 512;
constexpr int LDS_BYTES = 147456;
constexpr int MISC_OFF = 147456 - 512;

constexpr size_t al(size_t x) { return (x + 4095) & ~(size_t)4095; }
constexpr size_t WS_CTL = 0, CTL_ZERO_BYTES = 128u << 10;
constexpr int CW_BAR = 4096;
constexpr int CW_CNT = 65536;
constexpr size_t WS_WIN = 1u << 20;
constexpr size_t WS_WOUT = WS_WIN + al((size_t)2 * NPROJ * 1024 * 2);
constexpr size_t WS_WGLU = WS_WOUT + al((size_t)2 * 1024 * 1024 * 2);
constexpr size_t WS_WGU = WS_WGLU + al((size_t)2 * 256 * 256 * 2);
constexpr size_t WS_WD = WS_WGU + al((size_t)16 * 1024 * 1024 * 2);
constexpr size_t WS_S5MT = WS_WD + al((size_t)16 * 1024 * 512 * 2);
constexpr size_t WS_S5BI = WS_S5MT + al((size_t)16 * 512 * 640 * 2);
constexpr size_t WS_S5AP = WS_S5BI + al((size_t)16 * 128 * 512 * 2);
constexpr size_t WS_S5BB = WS_S5AP + al((size_t)2 * 16 * 64 * 34 * 2 * 4);
constexpr size_t WS_S5KT = WS_S5BB + al((size_t)2 * 16 * 64 * 16 * 2 * 4);
constexpr size_t WS_ROPE = WS_S5KT + al((size_t)16 * 32 * 256 * 4);
constexpr size_t WS_DTW = WS_ROPE + al((size_t)L * 64 * 4);
constexpr size_t WS_HIST = WS_DTW;
constexpr size_t WS_LB = WS_DTW + al((size_t)2 * 1024 * 4 * 4);
constexpr size_t WS_ACT = WS_LB + al(2 * 256 * 4);
constexpr size_t WS_YPRE = WS_ACT + al((size_t)L * 1024 * 2);
constexpr size_t WS_DTRAW = WS_YPRE + al((size_t)L * 256 * 2);
constexpr size_t WS_ROUTE = WS_DTRAW + al((size_t)L * 4 * 4);
constexpr size_t WS_ST_RET = WS_ROUTE + al((size_t)2 * L * 8 * 4);
constexpr size_t WS_ST_M2 = WS_ST_RET + al((size_t)NCH * 4 * 4096 * 4);
constexpr size_t WS_DEC_M2 = WS_ST_M2 + al((size_t)NCH * 4 * 8192 * 4);
constexpr size_t WS_ST_HG = WS_DEC_M2 + al((size_t)NCH * 4 * 4);
constexpr size_t WS_DEC_HG = WS_ST_HG + al((size_t)NHSC * 4 * 4096 * 4);
constexpr size_t WS_ST_S5 = WS_DEC_HG + al((size_t)NHSC * 4 * 64 * 4);
constexpr size_t WS_SP_S5 = WS_ST_S5 + al((size_t)NCH5 * 16 * 128 * 4);
constexpr size_t WS_BIG = WS_SP_S5 + al((size_t)NCH5 * 16 * 128 * 2);
constexpr size_t BIG_BYTES = ((size_t)L * NPROJ * 2 > (size_t)NSLOTP * 1536 * 2) ? (size_t)L * NPROJ * 2 : (size_t)NSLOTP * 1536 * 2;
constexpr size_t WS_XRES = WS_ST_RET;
static_assert(WS_BIG - WS_ST_RET >= (size_t)L * 1024 * 2, "xres overlay");
#define XBC_PTR(F) ((bf16*)(F).out + (size_t)L * 1024)
static_assert((size_t)L * 768 * 2 <= (size_t)16 * 1024 * 1024 * 2, "xbc overlay");
constexpr size_t WS_H2G = WS_BIG, WS_ACTB = WS_BIG + (size_t)NSLOTP * 1024 * 2;
constexpr int NR5 = ((NCH5 + 255) / 256) * 256;
constexpr size_t WS_S5UG = WS_BIG + al(BIG_BYTES);
constexpr size_t WS_SLOTTOK = WS_S5UG + al((size_t)16 * NR5 * 640 * 2);
constexpr size_t WS_RSTD = WS_SLOTTOK + al((size_t)NSLOTP * 4);
constexpr size_t WS_SLOTRS = WS_RSTD + al((size_t)L * 4);
constexpr size_t WS_END = WS_SLOTRS + al((size_t)NSLOTP * 4);

#ifdef EMU
__device__ __forceinline__ unsigned f2bf(float f) { unsigned u = __builtin_bit_cast(unsigned, f); return (u + 0x7fffu + ((u >> 16) & 1u)) >> 16; }
__device__ __forceinline__ unsigned pk2(float lo, float hi) { return f2bf(lo) | (f2bf(hi) << 16); }
#else
typedef __bf16 hw_bf16x2 __attribute__((ext_vector_type(2)));
__device__ __forceinline__ unsigned pk2(float lo, float hi) { return __builtin_bit_cast(unsigned, __builtin_convertvector((f32x2){lo, hi}, hw_bf16x2)); }
__device__ __forceinline__ unsigned f2bf(float f) { return pk2(f, 0.f) & 0xffffu; }
#endif
__device__ __forceinline__ float bf2f(unsigned short b) { return __builtin_bit_cast(float, ((unsigned)b) << 16); }
__device__ __forceinline__ float bflo(unsigned w) { return __builtin_bit_cast(float, w << 16); }
__device__ __forceinline__ float bfhi(unsigned w) { return __builtin_bit_cast(float, w & 0xffff0000u); }
#ifdef EMU
__device__ __forceinline__ float fexp(float x) { return expf(x); }
__device__ __forceinline__ float frcp(float x) { return 1.0f / x; }
__device__ __forceinline__ float frsq(float x) { return 1.0f / sqrtf(x); }
__device__ __forceinline__ float fexp2(float x) { return exp2f(x); }
__device__ __forceinline__ float flog(float x) { return logf(x); }
#else
__device__ __forceinline__ float fexp(float x) { return __builtin_amdgcn_exp2f(x * 1.4426950408889634f); }
__device__ __forceinline__ float frcp(float x) { return __builtin_amdgcn_rcpf(x); }
__device__ __forceinline__ float frsq(float x) { return __builtin_amdgcn_rsqf(x); }
__device__ __forceinline__ float fexp2(float x) { return __builtin_amdgcn_exp2f(x); }
__device__ __forceinline__ float flog(float x) { return __builtin_amdgcn_logf(x) * 0.6931471805599453f; }
#endif
__device__ __forceinline__ float sigmoidf_(float x) { return frcp(1.0f + fexp(-x)); }
__device__ __forceinline__ float siluf_(float x) { return x * frcp(1.0f + fexp(-x)); }
__device__ __forceinline__ float gelu_tanh(float x) { const float u = 0.7978845608028654f * (x + 0.044715f * x * x * x); return x * (1.0f - frcp(1.0f + fexp(2.0f * u))); }
#ifdef EMU
__device__ __forceinline__ float wave_sum(float v) {
#pragma unroll
    for (int o = 1; o < 64; o <<= 1) v += __shfl_xor(v, o);
    return v;
}
#else
__device__ __forceinline__ float wave_sum(float v) {
    v += __builtin_bit_cast(float, __builtin_amdgcn_update_dpp(0, __builtin_bit_cast(int, v), 0xB1, 0xF, 0xF, true));
    v += __builtin_bit_cast(float, __builtin_amdgcn_update_dpp(0, __builtin_bit_cast(int, v), 0x4E, 0xF, 0xF, true));
    v += __builtin_bit_cast(float, __builtin_amdgcn_update_dpp(0, __builtin_bit_cast(int, v), 0x141, 0xF, 0xF, true));
    v += __builtin_bit_cast(float, __builtin_amdgcn_update_dpp(0, __builtin_bit_cast(int, v), 0x140, 0xF, 0xF, true));
    const int iv = __builtin_bit_cast(int, v);
    return (__builtin_bit_cast(float, __builtin_amdgcn_readlane(iv, 0)) + __builtin_bit_cast(float, __builtin_amdgcn_readlane(iv, 16))) +
           (__builtin_bit_cast(float, __builtin_amdgcn_readlane(iv, 32)) + __builtin_bit_cast(float, __builtin_amdgcn_readlane(iv, 48)));
}
#endif
__device__ __forceinline__ void dsincos(double a, double& s, double& c) {
    const double k = __builtin_rint(a * 0.15915494309189535);
    const double r = __builtin_fma(-k, 6.283185307179586, a) - k * 2.4492935982947064e-16;
    const double r2 = r * r;
    double ps = 1.0 / 51090942171709440000.0;
    ps = ps * r2 - 1.0 / 121645100408832000.0; ps = ps * r2 + 1.0 / 355687428096000.0; ps = ps * r2 - 1.0 / 1307674368000.0; ps = ps * r2 + 1.0 / 6227020800.0;
    ps = ps * r2 - 1.0 / 39916800.0; ps = ps * r2 + 1.0 / 362880.0; ps = ps * r2 - 1.0 / 5040.0; ps = ps * r2 + 1.0 / 120.0; ps = ps * r2 - 1.0 / 6.0; ps = ps * r2 + 1.0;
    s = ps * r;
    double pc = -1.0 / 1124000727777607680000.0;
    pc = pc * r2 + 1.0 / 2432902008176640000.0; pc = pc * r2 - 1.0 / 6402373705728000.0; pc = pc * r2 + 1.0 / 20922789888000.0; pc = pc * r2 - 1.0 / 87178291200.0;
    pc = pc * r2 + 1.0 / 479001600.0; pc = pc * r2 - 1.0 / 3628800.0; pc = pc * r2 + 1.0 / 40320.0; pc = pc * r2 - 1.0 / 720.0; pc = pc * r2 + 1.0 / 24.0; pc = pc * r2 - 0.5; pc = pc * r2 + 1.0;
    c = pc;
}

#ifdef EMU
__device__ __forceinline__ unsigned ld_agent(const unsigned* p) { return __atomic_load_n(p, __ATOMIC_RELAXED); }
#else
__device__ __forceinline__ unsigned ld_agent(const unsigned* p) { return __hip_atomic_load(p, __ATOMIC_RELAXED, __HIP_MEMORY_SCOPE_AGENT); }
#endif
struct Args { const void* in[32]; float* out; unsigned char* ws; int ph_lo, ph_hi; };
struct Frame {
    lu8* lds; unsigned char* ws; float* out;
    int tid, lane, wave, G, bid, rep, gpar;
    const float* x; const int* pos;
    const LAS unsigned long long* ptab;
    __device__ __forceinline__ const float* inp(int i) const { const unsigned long long v = ptab[i];
        const unsigned lo = (unsigned)__builtin_amdgcn_readfirstlane((int)(unsigned)v), hi = (unsigned)__builtin_amdgcn_readfirstlane((int)(unsigned)(v >> 32));
#ifdef EMU
        return (const float*)(((unsigned long long)hi << 32) | lo); }
#else
        return (const float*)(const __attribute__((address_space(1))) float*)(((unsigned long long)hi << 32) | lo); }
#endif
};

#define norm1_g inp(2)
#define w_in inp(3)
#define w_out inp(4)
#define s5_a_re inp(5)
#define s5_a_im inp(6)
#define s5_log_dt inp(7)
#define s5_b_re inp(8)
#define s5_b_im inp(9)
#define s5_c_re inp(10)
#define s5_c_im inp(11)
#define s5_d inp(12)
#define s5_w_glu inp(13)
#define s5_b_glu inp(14)
#define m2_conv_w inp(15)
#define m2_conv_b inp(16)
#define m2_dt_bias inp(17)
#define m2_a_log inp(18)
#define m2_d inp(19)
#define m2_norm_g inp(20)
#define hg_lb_logits inp(21)
#define hg_norm_g inp(22)
#define norm2_g inp(23)
#define moe_w_group inp(24)
#define moe_b_group inp(25)
#define moe_w_expert inp(26)
#define moe_b_expert inp(27)
#define moe_w_gate inp(28)
#define moe_w_up inp(29)
#define moe_w_down inp(30)
#define final_norm_g inp(31)
#define WSP(T, off) ((T*)(F.ws + (off)))
#ifdef EMU
#define CFENCE() ((void)0)
#else
#define CFENCE() asm volatile("" ::: "memory")
#endif
#ifdef EMU
#define LAUNDER(F) ((void)0)
#define LAUNDER_I(x) ((void)0)
#else
#define LAUNDER(F) do { size_t z_ = 0; asm volatile("" : "+v"((F).tid), "+v"((F).lane), "+s"((F).wave), "+s"(z_)); (F).ws = (F).ws + z_; } while (0)
#define LAUNDER_I(x) asm volatile("" : "+v"(x))
#endif

#ifndef EMU
#define XB_TMO      128
#define XB_XCNT(j)  (256  + 64 * (j))
#define XB_XSUB(j)  (1280 + 64 * (j))
#define XB_XGEN(j)  (2304 + 64 * (j))
#define XB_TOP      3328
#define XB_TOPGEN   3392
#define XCD_BAR_WORDS 3456
#define XB_SPIN_CAP (1u << 20)
__device__ __forceinline__ unsigned xb_ld(unsigned* p)              { return __hip_atomic_load(p, __ATOMIC_RELAXED, __HIP_MEMORY_SCOPE_AGENT); }
__device__ __forceinline__ unsigned xb_add(unsigned* p, unsigned v) { return __hip_atomic_fetch_add(p, v, __ATOMIC_RELAXED, __HIP_MEMORY_SCOPE_AGENT); }
__device__ __forceinline__ unsigned xb_xcc_id() { return (unsigned)__builtin_amdgcn_s_getreg((3 << 11) | 20) & 0xFu; }
#define XB_SPIN(cond, bar) do { unsigned _sp = 0; while (cond) { __builtin_amdgcn_s_sleep(1); \
    if ((++_sp & 255u) == 0u) { if (xb_ld(&(bar)[XB_TMO])) break; if (_sp > XB_SPIN_CAP) { atomicAdd(&(bar)[XB_TMO], 1u); break; } } } } while (0)
struct XcdBarrier { unsigned* bar; unsigned x; volatile LAS unsigned* st; };
__device__ __forceinline__ XcdBarrier xcd_barrier_post(unsigned* bar, volatile LAS unsigned* st) {
    XcdBarrier b; b.bar = bar; b.x = xb_xcc_id(); b.st = st;
    if (threadIdx.x == 0) (void)xb_add(&bar[XB_XCNT(b.x)], 1u);
    return b;
}
__device__ __forceinline__ void xcd_barrier_complete(unsigned* bar, unsigned x, unsigned& nloc, unsigned& nx) {
    const unsigned G = gridDim.x * gridDim.y * gridDim.z;
    unsigned sum, cnt, mine, sp = 0u;
    for (;;) {
        sum = 0u; cnt = 0u; mine = 0u;
#pragma unroll
        for (unsigned j = 0; j < 16; ++j) { const unsigned c = xb_ld(&bar[XB_XCNT(j)]); sum += c; cnt += (c > 0u) ? 1u : 0u; mine = (j == x) ? c : mine; }
        if (sum == G) break;
        __builtin_amdgcn_s_sleep(1);
        if ((++sp & 255u) == 0u) { if (xb_ld(&bar[XB_TMO])) break; if (sp > XB_SPIN_CAP) { atomicAdd(&bar[XB_TMO], 1u); break; } }
    }
    nloc = mine > 0u ? mine : 1u; nx = cnt > 0u ? cnt : 1u;
}
__device__ __forceinline__ void xcd_barrier(const XcdBarrier& b) {
    asm volatile("s_waitcnt vmcnt(0)" ::: "memory");
    __syncthreads();
    if (threadIdx.x == 0) {
        unsigned* bar = b.bar;
        __builtin_amdgcn_s_waitcnt(0);
        unsigned nloc = b.st[0], nx = b.st[1];
        if (nloc == 0u) { xcd_barrier_complete(bar, b.x, nloc, nx); b.st[0] = nloc; b.st[1] = nx; }
        const unsigned old = xb_add(&bar[XB_XSUB(b.x)], 1u);
        const unsigned gen = old / nloc;
        if (old + 1u == (gen + 1u) * nloc) {
            __builtin_amdgcn_fence(__ATOMIC_RELEASE, "agent");
            asm volatile("s_waitcnt vmcnt(0)" ::: "memory");
            const unsigned og = xb_add(&bar[XB_TOP], 1u);
            const unsigned tg = og / nx;
            if (og + 1u == (tg + 1u) * nx) xb_add(&bar[XB_TOPGEN], 1u);
            else XB_SPIN(xb_ld(&bar[XB_TOPGEN]) == tg, bar);
            __builtin_amdgcn_fence(__ATOMIC_ACQUIRE, "agent");
            xb_add(&bar[XB_XGEN(b.x)], 1u);
            asm volatile("s_waitcnt vmcnt(0)" ::: "memory");
        } else {
            XB_SPIN(xb_ld(&bar[XB_XGEN(b.x)]) == gen, bar);
            __builtin_amdgcn_fence(__ATOMIC_ACQUIRE, "agent");
            asm volatile("s_waitcnt vmcnt(0)" ::: "memory");
        }
    }
    __syncthreads();
}
#endif

constexpr int GT_BK = 128, GT_LD = GT_BK + 8;
constexpr int GT_BYTES = 2 * 128 * GT_LD * 2;
template <class AP, class BP, class EPI>
__device__ __forceinline__ void gemm128(lu8* lds, int K, const AP& ap, const BP& bp, const EPI& epi) {
    int tid = threadIdx.x; LAUNDER_I(tid);
    const int lane = tid & 63, wid = tid >> 6, wr = wid >> 1, wc = wid & 1, fr = lane & 15, fq = lane >> 4;
    lbf* As = (lbf*)lds; lbf* Bs = (lbf*)(lds + 128 * GT_LD * 2);
    f32x4 acc[2][4];
#pragma unroll
    for (int m = 0; m < 2; ++m)
#pragma unroll
        for (int n = 0; n < 4; ++n) acc[m][n] = (f32x4){0.f, 0.f, 0.f, 0.f};
    u32x4 ra[2][4], rb[2][4];
    const int nk = K / GT_BK;
#define GT_LOAD(slot, k0) do { _Pragma("unroll") for (int i = 0; i < 4; ++i) { const int p = tid + 512 * i, r = p >> 4, kc = p & 15; ra[slot][i] = *(const u32x4*)ap(r, (k0) + kc * 8); rb[slot][i] = *(const u32x4*)bp(r, (k0) + kc * 8); } } while (0)
    GT_LOAD(0, 0);
    if (nk > 1) GT_LOAD(1, GT_BK);
    for (int kt = 0; kt < nk; kt += 2) {
#pragma unroll
        for (int half = 0; half < 2; ++half) {
            if (kt + half < nk) {
                __syncthreads();
#pragma unroll
                for (int i = 0; i < 4; ++i) { const int p = tid + 512 * i, r = p >> 4, kc = p & 15; *(LAS u32x4*)(As + r * GT_LD + kc * 8) = ra[half][i]; *(LAS u32x4*)(Bs + r * GT_LD + kc * 8) = rb[half][i]; }
                __syncthreads();
                if (kt + half + 2 < nk) GT_LOAD(half, (kt + half + 2) * GT_BK);
#pragma unroll
                for (int ks = 0; ks < 4; ++ks) {
                    bf16x8 a[2], b[4];
#pragma unroll
                    for (int m = 0; m < 2; ++m) a[m] = *(const LAS bf16x8*)(As + (wr * 32 + m * 16 + fr) * GT_LD + ks * 32 + fq * 8);
#pragma unroll
                    for (int n = 0; n < 4; ++n) b[n] = *(const LAS bf16x8*)(Bs + (wc * 64 + n * 16 + fr) * GT_LD + ks * 32 + fq * 8);
#pragma unroll
                    for (int m = 0; m < 2; ++m)
#pragma unroll
                        for (int n = 0; n < 4; ++n) acc[m][n] = __builtin_amdgcn_mfma_f32_16x16x32_bf16(b[n], a[m], acc[m][n], 0, 0, 0);
                }
            }
        }
    }
#undef GT_LOAD
    if constexpr (EPI::HAS_PRE) {
        typename EPI::Pre pre[2][4];
#pragma unroll
        for (int m = 0; m < 2; ++m)
#pragma unroll
            for (int n = 0; n < 4; ++n) pre[m][n] = epi.load(wr * 32 + m * 16 + fr, wc * 64 + n * 16 + 4 * fq);
#pragma unroll
        for (int m = 0; m < 2; ++m)
#pragma unroll
            for (int n = 0; n < 4; ++n) epi.fin(wr * 32 + m * 16 + fr, wc * 64 + n * 16 + 4 * fq, acc[m][n], pre[m][n]);
    } else {
#pragma unroll
    for (int m = 0; m < 2; ++m)
#pragma unroll
        for (int n = 0; n < 4; ++n) epi(wr * 32 + m * 16 + fr, wc * 64 + n * 16 + 4 * fq, acc[m][n]);
    }
}
struct PtrRM { const bf16* base; size_t ld; int rmax;
    __device__ __forceinline__ const bf16* operator()(int r, int k) const { return base + (size_t)(r < rmax ? r : rmax) * ld + k; } };

template <int NT, int KS>
__device__ __forceinline__ void wave_mma(f32x4 (&acc)[NT], const lbf* A, int lda, const lbf* B, int ldb, int lane) {
    const int fr = lane & 15, fq = lane >> 4;
#pragma unroll
    for (int ks = 0; ks < KS; ++ks) {
        const bf16x8 a = *(const LAS bf16x8*)(A + fr * lda + ks * 32 + fq * 8);
#pragma unroll
        for (int n = 0; n < NT; ++n) { const bf16x8 b = *(const LAS bf16x8*)(B + (n * 16 + fr) * ldb + ks * 32 + fq * 8); acc[n] = __builtin_amdgcn_mfma_f32_16x16x32_bf16(b, a, acc[n], 0, 0, 0); }
    }
}


namespace g8 {
constexpr int BM = 256, BK = 64, HALF = 128, HTB = HALF * BK * 2, STAGE_BYTES = 8 * HTB;
__host__ __device__ __forceinline__ int lds_byte(int r, int c) { const int st = (r >> 4) * 2 + (c >> 5), rr = r & 15, cc = c & 31, ob = rr * 64 + cc * 2; return st * 1024 + (ob ^ (((ob >> 9) & 1) << 5)); }
__host__ __device__ __forceinline__ void stage_rc(int b, int& R, int& C) { const int st = b / 1024, sb = b % 1024, swz = sb ^ (((sb >> 9) & 1) << 5); R = (st >> 1) * 16 + swz / 64; C = (st & 1) * 32 + (swz % 64) / 2; }
__host__ __device__ __forceinline__ int perm32(int rho) { const int n = rho >> 4, i = rho & 15; return 8 * (i >> 2) + 4 * n + (i & 3); }
struct Unit { size_t aoff, boff; int pm, pn; };
#ifdef EMU
#define G8_WAIT_V(n) ((void)0)
#define G8_WAIT_L(n) ((void)0)
#else
#define G8_WAIT_V(n) asm volatile("s_waitcnt vmcnt(" #n ")" ::: "memory")
#define G8_WAIT_L(n) asm volatile("s_waitcnt lgkmcnt(" #n ")" ::: "memory")
#endif
template <class Epi, class Sched, bool ALIGN_EPI = true, bool SP2 = true>
__device__ __forceinline__ void gemm_phase(lu8* lds, const bf16* Abase, const bf16* Bbase, const int K, const Sched& S, const Epi& E) {
    const int tid = threadIdx.x, wid = __builtin_amdgcn_readfirstlane(tid >> 6), lane = tid & 63, wr = wid >> 2, wc = wid & 3, fr = lane & 15, fq = lane >> 4;
    const int nt = K / BK;
    unsigned voffA[2], voffB[2];
#pragma unroll
    for (int i = 0; i < 2; ++i) { int R, C; stage_rc(tid * 16 + i * 8192, R, C); const int Rb = Epi::PERM ? ((R & ~31) + perm32(R & 31)) : R;
        voffA[i] = (unsigned)(R * K + C) * 2u; voffB[i] = (unsigned)(Rb * K + C) * 2u; }
    const size_t kstep = (size_t)(BK * 2), hstep = (size_t)HALF * K * 2;
    const unsigned ldsw = (unsigned)wid * 1024u;
    const int aoff = lds_byte(wr * 64 + fr, fq * 8), boff = lds_byte(wc * 32 + fr, fq * 8);
#define G8_SA(b, h) (((b) * 2 + (h)) * HTB)
#define G8_SB(b, h) ((4 + (b) * 2 + (h)) * HTB)
#define G8_STAGE(bufoff, gbase, voff) do { _Pragma("unroll") for (int _i = 0; _i < 2; ++_i) \
        __builtin_amdgcn_global_load_lds((const unsigned*)((const char*)(gbase) + (voff)[_i]), (LAS unsigned*)(lds + (bufoff) + ldsw + _i * 8192), 16, 0, 0); } while (0)
#define G8_STAGEA(bufoff, gbase, h_, nx_) do { _Pragma("unroll") for (int _i = 0; _i < 2; ++_i) { \
        const char* _p; if constexpr (Sched::GATHER) _p = (const char*)(gbase) + ((nx_) ? ngoff[h_][_i] : goff[h_][_i]); else _p = (const char*)(gbase) + (size_t)(h_) * hstep + voffA[_i]; \
        __builtin_amdgcn_global_load_lds((const unsigned*)_p, (LAS unsigned*)(lds + (bufoff) + ldsw + _i * 8192), 16, 0, Sched::A_AUX); } } while (0)
#define G8_LDA(dst, b, h) do { _Pragma("unroll") for (int m = 0; m < 4; ++m) _Pragma("unroll") for (int k = 0; k < 2; ++k) dst[m][k] = *(const LAS bf16x8*)(lds + G8_SA(b, h) + aoff + m * 2048 + k * 1024); } while (0)
#define G8_LDB(dst, b, h) do { _Pragma("unroll") for (int n = 0; n < 2; ++n) _Pragma("unroll") for (int k = 0; k < 2; ++k) dst[n][k] = *(const LAS bf16x8*)(lds + G8_SB(b, h) + boff + n * 2048 + k * 1024); } while (0)
#define G8_MMA(ai, bj, At, Bt) do { __builtin_amdgcn_s_setprio(1); _Pragma("unroll") for (int m = 0; m < 4; ++m) _Pragma("unroll") for (int n = 0; n < 2; ++n) _Pragma("unroll") for (int k = 0; k < 2; ++k) \
        acc[ai][bj][m][n] = __builtin_amdgcn_mfma_f32_16x16x32_bf16(Bt[n][k], At[m][k], acc[ai][bj][m][n], 0, 0, 0); __builtin_amdgcn_s_setprio(0); } while (0)
#ifdef EMU
#define G8_OPAQUE(x) ((void)0)
#else
#define G8_OPAQUE(x) asm volatile("" : "+v"(x))
#endif
#define G8_BAR __builtin_amdgcn_s_barrier()
#define G8_SCHED __builtin_amdgcn_sched_barrier(0)
    Unit cur, nxt; int ui = 0; int pend = -1;
    if (!S.next(0, cur)) return;
    f32x4 acc[2][2][4][2];
    bool pre = false;
    if constexpr (Epi::INIT_ACC) pre = E.want_pre(cur);
    if (pre) { if constexpr (Epi::INIT_ACC) E.init(acc, cur, wr, wc, fr, fq); }
    else {
#pragma unroll
    for (int a = 0; a < 2; ++a)
#pragma unroll
        for (int b = 0; b < 2; ++b)
#pragma unroll
            for (int m = 0; m < 4; ++m)
#pragma unroll
                for (int n = 0; n < 2; ++n) { acc[a][b][m][n] = (f32x4){0.f, 0.f, 0.f, 0.f}; if constexpr (Epi::DEFER_PUB) G8_OPAQUE(acc[a][b][m][n]); }
    }
    bf16x8 At[4][2], B0[2][2], B1[2][2];
    unsigned goff[2][2], ngoff[2][2];
#define G8_LDOFF(dst, un) do { _Pragma("unroll") for (int _h = 0; _h < 2; ++_h) _Pragma("unroll") for (int _i = 0; _i < 2; ++_i) { int R_, C_; stage_rc(tid * 16 + _i * 8192, R_, C_); \
        dst[_h][_i] = (unsigned)(S.row_of((un).pm * BM + _h * HALF + R_) * K + C_) * 2u; } } while (0)
    if constexpr (Sched::GATHER) { G8_LDOFF(goff, cur); _Pragma("unroll") for (int _h = 0; _h < 2; ++_h) _Pragma("unroll") for (int _i = 0; _i < 2; ++_i) ngoff[_h][_i] = goff[_h][_i]; }
    const char* cA = (const char*)Abase + cur.aoff; const char* cB = (const char*)Bbase + cur.boff;
    if constexpr (SP2) {
        G8_STAGE(G8_SB(0, 0), cB, voffB); G8_STAGE(G8_SB(0, 1), cB + hstep, voffB); G8_STAGEA(G8_SA(0, 0), cA, 0, false); G8_STAGEA(G8_SA(0, 1), cA, 1, false);
        if (wr == 1) G8_BAR;
        G8_WAIT_V(2); G8_BAR;
        G8_STAGE(G8_SB(1, 0), cB + kstep, voffB); G8_STAGEA(G8_SA(1, 0), cA + kstep, 0, false); G8_STAGE(G8_SB(1, 1), cB + hstep + kstep, voffB);
        G8_WAIT_V(6); G8_BAR;
    } else {
        G8_STAGE(G8_SB(0, 0), cB, voffB); G8_STAGEA(G8_SA(0, 0), cA, 0, false); G8_STAGE(G8_SB(0, 1), cB + hstep, voffB); G8_STAGEA(G8_SA(0, 1), cA, 1, false);
        if (wr == 1) G8_BAR;
        G8_WAIT_V(4); G8_BAR;
        G8_STAGE(G8_SB(1, 0), cB + kstep, voffB); G8_STAGEA(G8_SA(1, 0), cA + kstep, 0, false); G8_STAGE(G8_SB(1, 1), cB + hstep + kstep, voffB);
        G8_WAIT_V(6); G8_BAR;
    }
    for (;;) {
        const bool has_next = S.next(ui + 1, nxt);
        const char* nA = has_next ? (const char*)Abase + nxt.aoff : cA; const char* nB = has_next ? (const char*)Bbase + nxt.boff : cB;
        if constexpr (Sched::GATHER) { if (has_next) G8_LDOFF(ngoff, nxt); }
#define G8_KITER(T_) do { const int t = (T_); \
            const bool last = (t == nt - 2); \
            const char* a1 = cA + (size_t)(t + 1) * kstep; \
            const char* a2 = last ? nA : cA + (size_t)(t + 2) * kstep; const char* b2 = last ? nB : cB + (size_t)(t + 2) * kstep; \
            const char* a3 = a2 + kstep; const char* b3 = b2 + kstep; \
            if constexpr (SP2) { \
            G8_LDB(B0, 0, 0); G8_LDB(B1, 0, 1); G8_SCHED; G8_LDA(At, 0, 0); G8_STAGEA(G8_SA(1, 1), a1, 1, false); \
            G8_WAIT_V(8); G8_WAIT_L(0); G8_BAR; G8_MMA(0, 0, At, B0); G8_MMA(0, 1, At, B1); G8_BAR; G8_SCHED; \
            G8_LDA(At, 0, 1); G8_STAGE(G8_SB(0, 0), b2, voffB); G8_STAGE(G8_SB(0, 1), b2 + hstep, voffB); G8_STAGEA(G8_SA(0, 0), a2, 0, last); \
            G8_WAIT_V(8); G8_WAIT_L(0); G8_BAR; G8_MMA(1, 0, At, B0); G8_MMA(1, 1, At, B1); G8_BAR; G8_SCHED; \
            G8_LDB(B0, 1, 0); G8_LDB(B1, 1, 1); G8_SCHED; G8_LDA(At, 1, 0); G8_STAGEA(G8_SA(0, 1), a2, 1, last); \
            G8_WAIT_V(8); G8_WAIT_L(0); G8_BAR; G8_MMA(0, 0, At, B0); G8_MMA(0, 1, At, B1); G8_BAR; G8_SCHED; \
            G8_LDA(At, 1, 1); G8_STAGE(G8_SB(1, 0), b3, voffB); G8_STAGE(G8_SB(1, 1), b3 + hstep, voffB); G8_STAGEA(G8_SA(1, 0), a3, 0, last); \
            G8_WAIT_V(8); G8_WAIT_L(0); G8_BAR; G8_MMA(1, 0, At, B0); G8_MMA(1, 1, At, B1); G8_BAR; G8_SCHED; \
            } else { \
            G8_LDB(B0, 0, 0); G8_SCHED; G8_LDA(At, 0, 0); G8_STAGEA(G8_SA(1, 1), a1, 1, false); \
            G8_WAIT_L(8); G8_BAR; G8_WAIT_L(0); G8_MMA(0, 0, At, B0); G8_BAR; G8_SCHED; \
            G8_LDB(B1, 0, 1); G8_STAGE(G8_SB(0, 0), b2, voffB); \
            G8_BAR; G8_WAIT_L(0); G8_MMA(0, 1, At, B1); G8_BAR; \
            G8_LDA(At, 0, 1); G8_STAGEA(G8_SA(0, 0), a2, 0, last); \
            G8_BAR; G8_WAIT_L(0); G8_MMA(1, 0, At, B0); G8_BAR; G8_SCHED; \
            G8_STAGE(G8_SB(0, 1), b2 + hstep, voffB); \
            G8_WAIT_V(6); G8_BAR; G8_MMA(1, 1, At, B1); G8_BAR; \
            G8_LDB(B0, 1, 0); G8_SCHED; G8_LDA(At, 1, 0); G8_STAGEA(G8_SA(0, 1), a2, 1, last); \
            G8_WAIT_L(8); G8_BAR; G8_WAIT_L(0); G8_MMA(0, 0, At, B0); G8_BAR; G8_SCHED; \
            G8_LDB(B1, 1, 1); G8_STAGE(G8_SB(1, 0), b3, voffB); \
            G8_BAR; G8_WAIT_L(0); G8_MMA(0, 1, At, B1); G8_BAR; \
            G8_LDA(At, 1, 1); G8_STAGEA(G8_SA(1, 0), a3, 0, last); \
            G8_BAR; G8_WAIT_L(0); G8_MMA(1, 0, At, B0); G8_BAR; G8_SCHED; \
            G8_STAGE(G8_SB(1, 1), b3 + hstep, voffB); \
            G8_WAIT_V(6); G8_BAR; G8_MMA(1, 1, At, B1); G8_BAR; \
            } \
        } while (0)
        if constexpr (Epi::DEFER_PUB) {
#pragma unroll 1
            for (int part = 0; part < 2; ++part) { const int hi = part ? nt : 2;
#pragma unroll 1
                for (int tt = part ? 2 : 0; tt < hi; tt += 2) G8_KITER(tt);
                if (part == 0 && pend >= 0) { E.publish(pend, lane == 0); pend = -1; } } }
        else { for (int tt = 0; tt < nt; tt += 2) G8_KITER(tt); }
#undef G8_KITER
        if constexpr (ALIGN_EPI) { if (wr == 0) G8_BAR; }
        if constexpr (Epi::INIT_ACC) { E.ep(acc, cur, wr, wc, fr, fq, pre); pre = false; } else E(acc, cur, wr, wc, fr, fq);
        if constexpr (Epi::DEFER_PUB) pend = cur.pm;
        if (!has_next) break;
#pragma unroll
        for (int a = 0; a < 2; ++a)
#pragma unroll
            for (int b = 0; b < 2; ++b)
#pragma unroll
                for (int m = 0; m < 4; ++m)
#pragma unroll
                    for (int n = 0; n < 2; ++n) { acc[a][b][m][n] = (f32x4){0.f, 0.f, 0.f, 0.f}; if constexpr (Epi::DEFER_PUB) G8_OPAQUE(acc[a][b][m][n]); }
        cur = nxt; cA = nA; cB = nB; ++ui;
        if constexpr (Sched::GATHER) { _Pragma("unroll") for (int _h = 0; _h < 2; ++_h) _Pragma("unroll") for (int _i = 0; _i < 2; ++_i) goff[_h][_i] = ngoff[_h][_i]; }
        if constexpr (ALIGN_EPI) { if (wr == 1) G8_BAR; }
    }
    G8_WAIT_V(0);
    if constexpr (Epi::DEFER_PUB) { if (pend >= 0) E.publish(pend, lane == 0); }
    if constexpr (!ALIGN_EPI) { if (wr == 0) G8_BAR; }
    G8_BAR;
#undef G8_SA
#undef G8_SB
#undef G8_STAGE
#undef G8_STAGEA
#undef G8_LDOFF
#undef G8_LDA
#undef G8_LDB
#undef G8_MMA
#undef G8_BAR
#undef G8_SCHED
}
struct GridOrder { static constexpr int A_AUX = 0; static constexpr bool GATHER = false; int nM, nN, nwg, G, c; size_t astep, bstep;
    __device__ __forceinline__ bool next(int i, Unit& u) const {
        const long Lx = (long)i * G + c; if (Lx >= nwg) return false;
        int wgid = (int)Lx; { const int q = nwg / 8, r = nwg % 8, xcd = wgid % 8, off = wgid / 8; wgid = (xcd < r ? xcd * (q + 1) : r * (q + 1) + (xcd - r) * q) + off; }
        const int nig = 8 * nN, gid = wgid / nig, fm = gid * 8, gsz = (nM - fm) < 8 ? (nM - fm) : 8;
        u.pm = fm + ((wgid % nig) % gsz); u.pn = (wgid % nig) / gsz; u.aoff = (size_t)u.pm * astep; u.boff = (size_t)u.pn * bstep; return true; } };
struct OneUnit { static constexpr int A_AUX = 0; static constexpr bool GATHER = false; int pm, pn; size_t astep, bstep;
    __device__ __forceinline__ bool next(int i, Unit& u) const { if (i != 0) return false; u.pm = pm; u.pn = pn; u.aoff = (size_t)pm * astep; u.boff = (size_t)pn * bstep; return true; } };
struct MoeOrder { static constexpr int A_AUX = 0; static constexpr bool GATHER = false; int np, G, c; const li32* pe; size_t astep, estep, bstep;
    __device__ __forceinline__ bool next(int i, Unit& u) const {
        int Lx = i * G + c; const int nwg = np * 4; if (Lx >= nwg) return false;
        { const int q = nwg / 8, r = nwg % 8, xcd = Lx % 8, off = Lx / 8; Lx = (xcd < r ? xcd * (q + 1) : r * (q + 1) + (xcd - r) * q) + off; }
        u.pm = Lx >> 2; u.pn = Lx & 3; u.aoff = (size_t)u.pm * astep; const int e = __builtin_amdgcn_readfirstlane(pe[u.pm]); u.boff = (size_t)e * estep + (size_t)u.pn * bstep; return true; } };
struct MoeOrderG { static constexpr int A_AUX = 0; static constexpr bool GATHER = true; int np, G, c; const li32* pe; const int* tok; size_t estep, bstep;
    __device__ __forceinline__ int row_of(int slot) const { return tok[slot]; }
    __device__ __forceinline__ bool next(int i, Unit& u) const {
        int Lx = i * G + c; const int nwg = np * 4; if (Lx >= nwg) return false;
        { const int q = nwg / 8, r = nwg % 8, xcd = Lx % 8, off = Lx / 8; Lx = (xcd < r ? xcd * (q + 1) : r * (q + 1) + (xcd - r) * q) + off; }
        u.pm = Lx >> 2; u.pn = Lx & 3; u.aoff = 0; const int e = __builtin_amdgcn_readfirstlane(pe[u.pm]); u.boff = (size_t)e * estep + (size_t)u.pn * bstep; return true; } };
struct EpiStore {
    static constexpr bool PERM = true, DEFER_PUB = false, INIT_ACC = false;
    bf16* O; int ldc; const float* rsc;
    __device__ __forceinline__ void operator()(const f32x4 (&acc)[2][2][4][2], const Unit& u, int wr, int wc, int fr, int fq) const {
        const int row0 = u.pm * BM + wr * 64 + fr, col0 = u.pn * BM + wc * 32 + 8 * fq;
#pragma unroll
        for (int ai = 0; ai < 2; ++ai)
#pragma unroll
            for (int m = 0; m < 4; ++m) { const int t = row0 + ai * HALF + m * 16; bf16* rowp = O + (size_t)t * ldc + col0; const float r = rsc ? rsc[t] : 1.0f;
#pragma unroll
                for (int bj = 0; bj < 2; ++bj) { const f32x4 v0 = acc[ai][bj][m][0] * r, v1 = acc[ai][bj][m][1] * r;
                    u32x4 w; w.x = pk2(v0.x, v0.y); w.y = pk2(v0.z, v0.w); w.z = pk2(v1.x, v1.y); w.w = pk2(v1.z, v1.w); *(u32x4*)(rowp + bj * HALF) = w; } }
    } };
template <bool XBF>
struct EpiResid {
    static constexpr bool PERM = true, DEFER_PUB = false, INIT_ACC = true;
    const void* xin; bf16* out;
    __device__ __forceinline__ bool want_pre(const Unit& u) const { return (u.pm & 1) != 0; }
    __device__ __forceinline__ void init(f32x4 (&acc)[2][2][4][2], const Unit& u, int wr, int wc, int fr, int fq) const {
        const int row0 = u.pm * BM + wr * 64 + fr, col0 = u.pn * BM + wc * 32 + 8 * fq;
#pragma unroll
        for (int ai = 0; ai < 2; ++ai)
#pragma unroll
            for (int m = 0; m < 4; ++m)
#pragma unroll
                for (int bj = 0; bj < 2; ++bj) { const size_t o = (size_t)(row0 + ai * HALF + m * 16) * D + col0 + bj * HALF;
                    if (XBF) { const u32x4 xb = __builtin_nontemporal_load((const u32x4*)((const bf16*)xin + o)); acc[ai][bj][m][0] = (f32x4){bflo(xb.x), bfhi(xb.x), bflo(xb.y), bfhi(xb.y)}; acc[ai][bj][m][1] = (f32x4){bflo(xb.z), bfhi(xb.z), bflo(xb.w), bfhi(xb.w)}; }
                    else { acc[ai][bj][m][0] = __builtin_nontemporal_load((const f32x4*)((const float*)xin + o)); acc[ai][bj][m][1] = __builtin_nontemporal_load((const f32x4*)((const float*)xin + o + 4)); } }
    }
    __device__ __forceinline__ void ep(const f32x4 (&acc)[2][2][4][2], const Unit& u, int wr, int wc, int fr, int fq, bool pre) const {
        const int row0 = u.pm * BM + wr * 64 + fr, col0 = u.pn * BM + wc * 32 + 8 * fq;
        if (pre) {
#pragma unroll
            for (int ai = 0; ai < 2; ++ai)
#pragma unroll
                for (int m = 0; m < 4; ++m)
#pragma unroll
                    for (int bj = 0; bj < 2; ++bj) { const size_t o = (size_t)(row0 + ai * HALF + m * 16) * D + col0 + bj * HALF; const f32x4 v0 = acc[ai][bj][m][0], v1 = acc[ai][bj][m][1];
                        u32x4 w; w.x = pk2(v0.x, v0.y); w.y = pk2(v0.z, v0.w); w.z = pk2(v1.x, v1.y); w.w = pk2(v1.z, v1.w); *(u32x4*)(out + o) = w; }
            return;
        }
#pragma unroll
        for (int ai = 0; ai < 2; ++ai) {
            f32x4 x0[4][2], x1[4][2];
#pragma unroll
            for (int m = 0; m < 4; ++m)
#pragma unroll
                for (int bj = 0; bj < 2; ++bj) { const size_t o = (size_t)(row0 + ai * HALF + m * 16) * D + col0 + bj * HALF;
                    if (XBF) { const u32x4 xb = __builtin_nontemporal_load((const u32x4*)((const bf16*)xin + o)); x0[m][bj] = (f32x4){bflo(xb.x), bfhi(xb.x), bflo(xb.y), bfhi(xb.y)}; x1[m][bj] = (f32x4){bflo(xb.z), bfhi(xb.z), bflo(xb.w), bfhi(xb.w)}; }
                    else { x0[m][bj] = __builtin_nontemporal_load((const f32x4*)((const float*)xin + o)); x1[m][bj] = __builtin_nontemporal_load((const f32x4*)((const float*)xin + o + 4)); } }
#pragma unroll
            for (int m = 0; m < 4; ++m)
#pragma unroll
                for (int bj = 0; bj < 2; ++bj) { const size_t o = (size_t)(row0 + ai * HALF + m * 16) * D + col0 + bj * HALF;
                    const f32x4 v0 = x0[m][bj] + acc[ai][bj][m][0], v1 = x1[m][bj] + acc[ai][bj][m][1];
                    u32x4 w; w.x = pk2(v0.x, v0.y); w.y = pk2(v0.z, v0.w); w.z = pk2(v1.x, v1.y); w.w = pk2(v1.z, v1.w); *(u32x4*)(out + o) = w; }
        }
    } };
struct EpiStoreU {
    static constexpr bool PERM = true, DEFER_PUB = false, INIT_ACC = false;
    bf16* O; int ldc; bf16* ug; const float* rsc;
    __device__ __forceinline__ void operator()(const f32x4 (&acc)[2][2][4][2], const Unit& u, int wr, int wc, int fr, int fq) const {
        const int row0 = u.pm * BM + wr * 64 + fr, col0 = u.pn * BM + wc * 32 + 8 * fq;
        float rr[2][4];
#pragma unroll
        for (int ai = 0; ai < 2; ++ai)
#pragma unroll
            for (int m = 0; m < 4; ++m) rr[ai][m] = rsc ? rsc[row0 + ai * HALF + m * 16] : 1.0f;
#pragma unroll
        for (int ai = 0; ai < 2; ++ai)
#pragma unroll
            for (int m = 0; m < 4; ++m) { const int t = row0 + ai * HALF + m * 16; bf16* rowp = O + (size_t)t * ldc + col0;
#pragma unroll
                for (int bj = 0; bj < 2; ++bj) { const f32x4 v0 = acc[ai][bj][m][0] * rr[ai][m], v1 = acc[ai][bj][m][1] * rr[ai][m];
                    u32x4 w; w.x = pk2(v0.x, v0.y); w.y = pk2(v0.z, v0.w); w.z = pk2(v1.x, v1.y); w.w = pk2(v1.z, v1.w); *(u32x4*)(rowp + bj * HALF) = w;
                    if (u.pn == 0) { const int g = 8 * bj + 2 * wc + (fq >> 1); *(u32x4*)(ug + ((size_t)g * NR5 + (t >> 5)) * 640 + (t & 31) * 16 + 8 * (fq & 1)) = w; } } }
    } };
struct EpiS5OutG {
    static constexpr bool PERM = false, DEFER_PUB = false, INIT_ACC = false;
    const bf16* proj; bf16* ypre; const float* dsk; int g; int nch5, c_s5u, nproj;
    __device__ __forceinline__ void operator()(const f32x4 (&acc)[2][2][4][2], const Unit& u, int wr, int wc, int fr, int fq) const {
        const f32x4 d = *(const f32x4*)(dsk + g * 16 + 4 * fq);
#pragma unroll
        for (int ai = 0; ai < 2; ++ai) {
            u32x2 uu[4][2][2];
#pragma unroll
            for (int m = 0; m < 4; ++m) { const int ch = u.pm * BM + ai * HALF + wr * 64 + m * 16 + fr;
#pragma unroll
                for (int bj = 0; bj < 2; ++bj)
#pragma unroll
                    for (int n = 0; n < 2; ++n) { const int tl = u.pn * 16 + bj * 8 + wc * 2 + n; const size_t t = (size_t)(ch < nch5 ? ch : 0) * 32 + tl;
                        uu[m][bj][n] = *(const u32x2*)(proj + t * nproj + c_s5u + g * 16 + 4 * fq); } }
#pragma unroll
            for (int m = 0; m < 4; ++m) { const int ch = u.pm * BM + ai * HALF + wr * 64 + m * 16 + fr;
#pragma unroll
                for (int bj = 0; bj < 2; ++bj)
#pragma unroll
                    for (int n = 0; n < 2; ++n) { const int tl = u.pn * 16 + bj * 8 + wc * 2 + n; const size_t t = (size_t)ch * 32 + tl; const f32x4 v = acc[ai][bj][m][n]; const u32x2 x = uu[m][bj][n];
                        const float y0 = gelu_tanh(v.x + d.x * bflo(x.x)), y1 = gelu_tanh(v.y + d.y * bfhi(x.x)), y2 = gelu_tanh(v.z + d.z * bflo(x.y)), y3 = gelu_tanh(v.w + d.w * bfhi(x.y));
                        u32x2 o; o.x = pk2(y0, y1); o.y = pk2(y2, y3);
                        if (ch < nch5) {
#ifdef EMU
                            *(u32x2*)(ypre + t * 256 + g * 16 + 4 * fq) = o;
#else
                            __hip_atomic_store((unsigned long long*)(ypre + t * 256 + g * 16 + 4 * fq), (unsigned long long)o.x | ((unsigned long long)o.y << 32), __ATOMIC_RELAXED, __HIP_MEMORY_SCOPE_AGENT);
#endif
                        } } }
        }
    } };
struct EpiGateUp {
    static constexpr bool PERM = true, DEFER_PUB = true, INIT_ACC = false;
    bf16* act; unsigned act_bytes; unsigned* cnt; const float* srs;
    __device__ __forceinline__ void operator()(const f32x4 (&acc)[2][2][4][2], const Unit& u, int wr, int wc, int fr, int fq) const {
        const int row0 = u.pm * BM + wr * 64 + fr, col0 = u.pn * HALF + wc * 32 + 8 * fq;
        float rsd[2][4];
#pragma unroll
        for (int ai = 0; ai < 2; ++ai)
#pragma unroll
            for (int m = 0; m < 4; ++m) rsd[ai][m] = srs[row0 + ai * HALF + m * 16];
#ifndef EMU
        const __amdgpu_buffer_rsrc_t rs = __builtin_amdgcn_make_buffer_rsrc(act, 0, (int)act_bytes, 0x00020000);
#endif
#pragma unroll
        for (int ai = 0; ai < 2; ++ai)
#pragma unroll
            for (int m = 0; m < 4; ++m) { const float r = rsd[ai][m]; const f32x4 g0 = acc[ai][0][m][0] * r, g1 = acc[ai][0][m][1] * r, u0 = acc[ai][1][m][0] * r, u1 = acc[ai][1][m][1] * r;
                u32x4 w; w.x = pk2(siluf_(g0.x) * u0.x, siluf_(g0.y) * u0.y); w.y = pk2(siluf_(g0.z) * u0.z, siluf_(g0.w) * u0.w);
                w.z = pk2(siluf_(g1.x) * u1.x, siluf_(g1.y) * u1.y); w.w = pk2(siluf_(g1.z) * u1.z, siluf_(g1.w) * u1.w);
                const size_t o = (size_t)(row0 + ai * HALF + m * 16) * 512 + col0;
#ifdef EMU
                *(u32x4*)(act + o) = w;
#else
                __builtin_amdgcn_raw_buffer_store_b128(w, rs, (unsigned)(o * 2), 0, 16);
#endif
            }
    }
    __device__ __forceinline__ void publish(int pm, bool leader) const { if (leader) atomicAdd(cnt + pm * 16, 1u); } };
struct MoeOrderDep { static constexpr int A_AUX = 16; static constexpr bool GATHER = false; int np, G, rank, n3; const li32* pe; size_t astep, estep, bstep; const unsigned* cnt; int wid;
    __device__ __forceinline__ bool next(int i, Unit& u) const {
        const int nwg = np * 4; int Lx;
        if (n3 >= 0) { if (i == 0) Lx = rank; else if (i == 1) { if (rank >= G - n3) return false; Lx = G + rank; } else if (i == 2) { if (rank >= 2 * n3) return false; Lx = 2 * G - n3 + rank; } else return false; }
        else Lx = i * G + rank;
        if (Lx >= nwg) return false;
        { const int q = nwg / 8, r = nwg % 8, xcd = Lx % 8, off = Lx / 8; Lx = (xcd < r ? xcd * (q + 1) : r * (q + 1) + (xcd - r) * q) + off; }
        u.pm = Lx >> 2; u.pn = Lx & 3; u.aoff = (size_t)u.pm * astep; const int e = __builtin_amdgcn_readfirstlane(pe[u.pm]); u.boff = (size_t)e * estep + (size_t)u.pn * bstep;
        if (wid == 0) { unsigned spins = 0; while (ld_agent(cnt + u.pm * 16) < 32u && ++spins < (1u << 22)) __builtin_amdgcn_s_sleep(1); }
        if (i == 0) __syncthreads();
        return true; } };
}

constexpr int CW_DEP = 12288;
constexpr int CW_Q = 8192;
static_assert(CW_BAR + 3456 <= CW_Q && CW_Q + 64 * 8 + 64 <= CW_DEP && (size_t)(CW_DEP + 16384 + 1024) * 4 <= CTL_ZERO_BYTES, "control words");
__device__ __forceinline__ int grab_unit(Frame& F, unsigned* ctr) {
    li32* slot = (li32*)(F.lds + MISC_OFF + 128) + (F.gpar & 1); F.gpar ^= 1;
    if (F.tid == 0) *slot = (int)atomicAdd(ctr, 1u);
    __syncthreads();
    return *slot;
}
__device__ __forceinline__ void transpose_item(const float* src, int ldsrc, int scol0, int k0, bf16* dst, int K, int drow0, const float* scale, int lane) {
    const int kq = lane >> 3, n2 = lane & 7;
    const float* sp = src + (size_t)(k0 + 8 * kq) * ldsrc + scol0 + 4 * n2;
    f32x4 v[8];
#pragma unroll
    for (int i = 0; i < 8; ++i) v[i] = __builtin_nontemporal_load((const f32x4*)(sp + (size_t)i * ldsrc));
    if (scale) { const f32x4 s0 = *(const f32x4*)(scale + k0 + 8 * kq), s1 = *(const f32x4*)(scale + k0 + 8 * kq + 4);
        v[0] *= s0.x; v[1] *= s0.y; v[2] *= s0.z; v[3] *= s0.w; v[4] *= s1.x; v[5] *= s1.y; v[6] *= s1.z; v[7] *= s1.w; }
    bf16* dp = dst + (size_t)(drow0 + 4 * n2) * K + k0 + 8 * kq;
#pragma unroll
    for (int j = 0; j < 4; ++j) { u32x4 o; o.x = pk2(v[0][j], v[1][j]); o.y = pk2(v[2][j], v[3][j]); o.z = pk2(v[4][j], v[5][j]); o.w = pk2(v[6][j], v[7][j]);
        *(u32x4*)(dp + (size_t)j * K) = o; }
}
constexpr int CONV_GU_UNITS = 16 * 2 * 256 / 32, CONV_D_UNITS = 16 * 256 / 32;
template <int NI>
__device__ __forceinline__ void transpose_items(const float* src, int ldsrc, int scol0, int k0, bf16* dst, int K, int drow0, int lane, const float* scale = nullptr) {
    const int kq = lane >> 3, n2 = lane & 7;
    const float* sp = src + (size_t)(k0 + 8 * kq) * ldsrc + scol0 + 4 * n2;
    f32x4 v[NI][8];
#pragma unroll
    for (int i = 0; i < 8; ++i)
#pragma unroll
        for (int q = 0; q < NI; ++q) v[q][i] = __builtin_nontemporal_load((const f32x4*)(sp + (size_t)i * ldsrc + 32 * q));
    if (scale) { const f32x4 s0 = *(const f32x4*)(scale + k0 + 8 * kq), s1 = *(const f32x4*)(scale + k0 + 8 * kq + 4); const float sv[8] = {s0.x, s0.y, s0.z, s0.w, s1.x, s1.y, s1.z, s1.w};
#pragma unroll
        for (int i = 0; i < 8; ++i)
#pragma unroll
            for (int q = 0; q < NI; ++q) v[q][i] *= sv[i]; }
    bf16* dp = dst + (size_t)(drow0 + 4 * n2) * K + k0 + 8 * kq;
#pragma unroll
    for (int q = 0; q < NI; ++q)
#pragma unroll
        for (int j = 0; j < 4; ++j) { u32x4 o; o.x = pk2(v[q][0][j], v[q][1][j]); o.y = pk2(v[q][2][j], v[q][3][j]); o.z = pk2(v[q][4][j], v[q][5][j]); o.w = pk2(v[q][6][j], v[q][7][j]);
            *(u32x4*)(dp + (size_t)(32 * q + j) * K) = o; }
}
__device__ __forceinline__ void conv_gu_unit(Frame& F0, int l, int cu) {
    Frame F = F0; LAUNDER(F);
    const int it0 = cu * 32 + F.wave * 4, e = it0 >> 9, up = (it0 >> 8) & 1, r = it0 & 255, kb = r >> 4, nb0 = r & 15;
    const float* src = (up ? F.moe_w_up : F.moe_w_gate) + ((size_t)l * 16 + e) * 1024 * 512;
    const int ff0 = 32 * nb0, drow0 = (ff0 >> 7) * 256 + up * 128;
    transpose_items<2>(src, 512, ff0, 64 * kb, WSP(bf16, WS_WGU) + (size_t)e * 1024 * 1024, 1024, drow0, F.lane, F.norm2_g + l * 1024);
    transpose_items<2>(src, 512, ff0 + 64, 64 * kb, WSP(bf16, WS_WGU) + (size_t)e * 1024 * 1024, 1024, drow0 + 64, F.lane, F.norm2_g + l * 1024);
}
__device__ __forceinline__ void conv_d_unit(Frame& F0, int l, int cu) {
    Frame F = F0; LAUNDER(F);
    const int it0 = cu * 32 + F.wave * 4, e = it0 >> 8, r = it0 & 255, kb = r >> 5, nb0 = r & 31;
    transpose_items<4>(F.moe_w_down + ((size_t)l * 16 + e) * 512 * 1024, 1024, 32 * nb0, 64 * kb, WSP(bf16, WS_WD) + (size_t)e * 1024 * 512, 512, 32 * nb0, F.lane);
}
__device__ __forceinline__ void r1_row(Frame& F, int t, int mode, const LAS f32x4* dw) {
    const int lane = F.lane;
    f32x4 v[4];
    if (mode == 0) { const f32x4* xr = (const f32x4*)(F.x + (size_t)t * D) + lane;
#pragma unroll
        for (int j = 0; j < 4; ++j) v[j] = __builtin_nontemporal_load(xr + 64 * j); }
    else { const u32x2* xr = (const u32x2*)(WSP(bf16, WS_XRES) + (size_t)t * D) + lane;
#pragma unroll
        for (int j = 0; j < 4; ++j) { const u32x2 xb = __builtin_nontemporal_load(xr + 64 * j); v[j] = (f32x4){bflo(xb.x), bfhi(xb.x), bflo(xb.y), bfhi(xb.y)}; } }
    if (mode != 0) {
        const int* rt = WSP(int, WS_ROUTE) + ((size_t)(mode == 2 ? L : 0) + t) * 8; const float* rtf = (const float*)rt;
        const bf16* ym = WSP(bf16, WS_H2G);
#pragma unroll
        for (int k = 0; k < 2; ++k) { const int slot = rt[6 + k]; const float w = rtf[4 + k];
            const u32x2* yr = (const u32x2*)(ym + (size_t)slot * 1024) + lane;
#pragma unroll
            for (int j = 0; j < 4; ++j) { const u32x2 y = __builtin_nontemporal_load(yr + 64 * j); v[j].x += w * bflo(y.x); v[j].y += w * bfhi(y.x); v[j].z += w * bflo(y.y); v[j].w += w * bfhi(y.y); } }
    }
    float ss = 0.f;
#pragma unroll
    for (int j = 0; j < 4; ++j) ss += (v[j].x * v[j].x + v[j].y * v[j].y) + (v[j].z * v[j].z + v[j].w * v[j].w);
    const float rstd = frsq(wave_sum(ss) * (1.0f / D) + EPS);
    if (mode == 2) {
        f32x4* o = (f32x4*)(F.out + (size_t)t * D) + lane; const f32x4* g = (const f32x4*)F.final_norm_g + lane;
#pragma unroll
        for (int j = 0; j < 4; ++j) o[64 * j] = v[j] * rstd * g[64 * j];
        return;
    }
    if (mode == 1) { u32x2* o = (u32x2*)((bf16*)F.out + (size_t)t * D) + lane;
#pragma unroll
        for (int j = 0; j < 4; ++j) { u32x2 w; w.x = pk2(v[j].x, v[j].y); w.y = pk2(v[j].z, v[j].w); o[64 * j] = w; } }
    u32x2* hb = (u32x2*)(WSP(bf16, WS_ACT) + (size_t)t * D) + lane;
    if (mode == 1 && lane == 0) WSP(float, WS_RSTD)[t] = rstd;
    f32x4 da = (f32x4){0.f, 0.f, 0.f, 0.f};
#pragma unroll
    for (int j = 0; j < 4; ++j) { const f32x4 h = v[j] * rstd; if (mode == 0) { u32x2 w; w.x = pk2(h.x, h.y); w.y = pk2(h.z, h.w); hb[64 * j] = w; }
        const int k = 4 * lane + 256 * j; da += h.x * dw[k] + h.y * dw[k + 1] + h.z * dw[k + 2] + h.w * dw[k + 3]; }
    da.x = wave_sum(da.x); da.y = wave_sum(da.y); da.z = wave_sum(da.z); da.w = wave_sum(da.w);
    if (lane == 0) *(f32x4*)(WSP(float, WS_DTRAW) + (size_t)t * 4) = da;
}

__device__ __forceinline__ void r1_phase(Frame& F, int mode, int l) {
    LAS f32x4* dw = (LAS f32x4*)F.lds;
    if (mode != 2) { for (int k = F.tid; k < 1024; k += NTHREADS) { const float g = F.norm1_g[l * 1024 + k]; dw[k] = g * *(const f32x4*)(F.w_in + ((size_t)l * 1024 + k) * DIN + 2304); } }
    __syncthreads();
    const int gw = F.bid * 8 + F.wave, ngw = F.G * 8;
    for (int t = gw; t < L; t += ngw) r1_row(F, t, mode, dw);
}

constexpr int WCONV_I_IN = (1024 / 64) * (NPROJ / 32), WCONV_I_OUT = (1024 / 64) * (1024 / 32), WCONV_I_GLU = (256 / 64) * (256 / 32), WCONV_ITEMS = WCONV_I_IN + WCONV_I_OUT + WCONV_I_GLU;
__device__ __forceinline__ void wconv_item(Frame& F, int l, int r) {
    if (r < WCONV_I_IN) { const int kb = r / (NPROJ / 32), nb = r % (NPROJ / 32); const int n0 = 32 * nb, sc0 = n0 < 2304 ? n0 : n0 + 4;
        transpose_item(F.w_in + (size_t)l * 1024 * DIN, DIN, sc0, 64 * kb, WSP(bf16, WS_WIN) + (size_t)l * NPROJ * 1024, 1024, n0, F.norm1_g + l * 1024, F.lane); }
    else if (r < WCONV_I_IN + WCONV_I_OUT) { r -= WCONV_I_IN; const int kb = r / 32, nb = r % 32;
        transpose_item(F.w_out + (size_t)l * 1024 * 1024, 1024, 32 * nb, 64 * kb, WSP(bf16, WS_WOUT) + (size_t)l * 1024 * 1024, 1024, 32 * nb, nullptr, F.lane); }
    else { r -= WCONV_I_IN + WCONV_I_OUT; const int kb = r / 8, nb = r % 8;
        transpose_item(F.s5_w_glu + (size_t)l * 65536, 256, 32 * nb, 64 * kb, WSP(bf16, WS_WGLU) + (size_t)l * 65536, 256, 32 * nb, nullptr, F.lane); }
}
__device__ __forceinline__ void phase_p0(Frame& F) {
    const int gw = F.bid * 8 + F.wave, ngw = F.G * 8, gt = F.bid * NTHREADS + F.tid, ngt = F.G * NTHREADS;
    for (int k = 0; k * ngw < WCONV_ITEMS; ++k) { const int it = k * ngw + ((k & 1) ? ngw - 1 - gw : gw); if (it < WCONV_ITEMS) wconv_item(F, 0, it); }
    for (int i = gt; i < 256; i += ngt) {
        const float a = F.hg_lb_logits[i], b = F.hg_lb_logits[256 + i], m = fmaxf(a, b), ea = fexp(a - m), eb = fexp(b - m);
        WSP(float, WS_LB)[i] = 0.f; WSP(float, WS_LB)[256 + i] = eb / (ea + eb); }
    for (int i0 = gt; i0 < L * 32; i0 += 4 * ngt) { int pz[4];
#pragma unroll
        for (int k = 0; k < 4; ++k) { const int i = i0 + k * ngt; pz[k] = i < L * 32 ? F.pos[i >> 5] : 0; }
#pragma unroll
        for (int k = 0; k < 4; ++k) { const int i = i0 + k * ngt; if (i < L * 32) { const int j = i & 31;
            const float inv = powf(10000.0f, -(float)j / 32.0f); const float ang = (float)pz[k] * inv; double s, c; dsincos((double)ang, s, c);
            *(f32x2*)(WSP(float, WS_ROPE) + (size_t)i * 2) = (f32x2){(float)c, (float)s}; } } }
    for (int i = gt; i < 2 * 16 * 64 * 34; i += ngt) { const int e = i / 34, d = i % 34, l = e >> 10, g = (e >> 6) & 15;
        const double dt = exp((double)F.s5_log_dt[l * 16 + g]); const double are = fmin((double)F.s5_a_re[e], -1e-4), aim = (double)F.s5_a_im[e];
        const double mag = exp(are * dt * d); double sn, cs; dsincos(aim * dt * d, sn, cs);
        *(f32x2*)(WSP(float, WS_S5AP) + (size_t)e * 68 + 2 * d) = (f32x2){(float)(mag * cs), (float)(mag * sn)}; }
    for (int iq = ngt - 1 - gt; iq < 2 * 16 * 64 * 16; iq += ngt) { const int i = iq >> 4, q = iq & 15;
        const int l = i >> 10, g = (i >> 6) & 15;
        const double dt = exp((double)F.s5_log_dt[l * 16 + g]); const double are = fmin((double)F.s5_a_re[i], -1e-4), aim = (double)F.s5_a_im[i];
        const double mag = exp(are * dt); double sn, cs; dsincos(aim * dt, sn, cs); const double abr = mag * cs, abi = mag * sn;
        const double den = are * are + aim * aim;
        const double kre = ((abr - 1.0) * are + abi * aim) / den, kim = (abi * are - (abr - 1.0) * aim) / den;
        float* bb = WSP(float, WS_S5BB) + (size_t)i * 32;
        { const double br = F.s5_b_re[(size_t)i * 16 + q], bi = F.s5_b_im[(size_t)i * 16 + q]; *(f32x2*)(bb + 2 * q) = (f32x2){(float)(kre * br - kim * bi), (float)(kre * bi + kim * br)}; }
    }
    __syncthreads();
    r1_phase(F, 0, 0);
}

__device__ __forceinline__ void s5_prep_a(Frame& F, int l, int chunk, int nchunk) {
    const float* AP = WSP(float, WS_S5AP) + (size_t)l * 16 * 64 * 68; const float* BB = WSP(float, WS_S5BB) + (size_t)l * 16 * 64 * 32;
    constexpr int N1 = 16 * 32 * 256, N2 = 16 * 128 * 512;
    if (nchunk == 256 && NTHREADS == 512) {
        const int lo = chunk * 512, g = lo >> 13, d0 = (lo >> 8) & 31;
        LAS f32x2* Cs = (LAS f32x2*)F.lds; LAS f32x2* Bs = Cs + 16 * 65; LAS f32x2* As = Bs + 1024;
        __syncthreads();
#pragma unroll
        for (int k = 0; k < 2; ++k) { const int idx = F.tid + 512 * k; const size_t ci = ((size_t)l * 16 + g) * 1024 + idx;
            Cs[(idx >> 6) * 65 + (idx & 63)] = (f32x2){F.s5_c_re[ci], F.s5_c_im[ci]}; Bs[idx] = *(const f32x2*)(BB + (size_t)g * 64 * 32 + 2 * idx); }
        if (F.tid < 128) As[F.tid] = *(const f32x2*)(AP + ((size_t)g * 64 + (F.tid & 63)) * 68 + 2 * (d0 + (F.tid >> 6)));
        __syncthreads();
        { const int i = lo + F.tid, dd = (F.tid >> 8) & 1, p = (F.tid >> 4) & 15, q = F.tid & 15; float s = 0.f;
#pragma unroll 8
          for (int n = 0; n < 64; ++n) { const f32x2 a = As[dd * 64 + n], b = Bs[n * 16 + q], c = Cs[p * 65 + n];
              const float tr = a.x * b.x - a.y * b.y, ti = a.x * b.y + a.y * b.x; s += c.x * tr - c.y * ti; }
          WSP(float, WS_S5KT)[i] = s; }
        __syncthreads();
    } else
    { const int per = (N1 + nchunk - 1) / nchunk, lo = chunk * per, hi = lo + per < N1 ? lo + per : N1;
      for (int i = lo + F.tid; i < hi; i += NTHREADS) { const int g = i >> 13, d = (i >> 8) & 31, p = (i >> 4) & 15, q = i & 15;
        float s = 0.f;
        for (int n = 0; n < 64; ++n) { const size_t gn = (size_t)g * 64 + n; const float cr = F.s5_c_re[((size_t)l * 16 + g) * 1024 + p * 64 + n], ci = F.s5_c_im[((size_t)l * 16 + g) * 1024 + p * 64 + n];
            const float ar = AP[gn * 68 + 2 * d], ai = AP[gn * 68 + 2 * d + 1], br = BB[gn * 32 + 2 * q], bi = BB[gn * 32 + 2 * q + 1];
            const float tr = ar * br - ai * bi, ti = ar * bi + ai * br; s += cr * tr - ci * ti; }
        WSP(float, WS_S5KT)[i] = s; } }
    if (nchunk == 256 && NTHREADS == 512) {
        const int i0 = chunk * 4096 + 8 * F.tid, g = i0 >> 16, m = (i0 >> 9) & 127, k0 = i0 & 511, n = m >> 1, j = k0 >> 4, q0 = k0 & 15; const size_t gn = (size_t)g * 64 + n;
        const f32x2 a = *(const f32x2*)(AP + gn * 68 + 2 * (31 - j)); const f32x4* bp = (const f32x4*)(BB + gn * 32 + 2 * q0);
        const f32x4 b0 = bp[0], b1 = bp[1], b2 = bp[2], b3 = bp[3]; const bool im = m & 1;
#define BINC_V(br, bi) (im ? (a.x * (bi) + a.y * (br)) : (a.x * (br) - a.y * (bi)))
        u32x4 o; o.x = pk2(BINC_V(b0.x, b0.y), BINC_V(b0.z, b0.w)); o.y = pk2(BINC_V(b1.x, b1.y), BINC_V(b1.z, b1.w)); o.z = pk2(BINC_V(b2.x, b2.y), BINC_V(b2.z, b2.w)); o.w = pk2(BINC_V(b3.x, b3.y), BINC_V(b3.z, b3.w));
#undef BINC_V
        *(u32x4*)(WSP(bf16, WS_S5BI) + i0) = o;
    } else
    { const int per = (N2 + nchunk - 1) / nchunk, lo = chunk * per, hi = lo + per < N2 ? lo + per : N2;
      for (int i = lo + F.tid; i < hi; i += NTHREADS) { const int g = i >> 16, m = (i >> 9) & 127, k = i & 511, n = m >> 1, j = k >> 4, q = k & 15; const size_t gn = (size_t)g * 64 + n;
        const float ar = AP[gn * 68 + 2 * (31 - j)], ai = AP[gn * 68 + 2 * (31 - j) + 1], br = BB[gn * 32 + 2 * q], bi = BB[gn * 32 + 2 * q + 1];
        WSP(bf16, WS_S5BI)[i] = (bf16)f2bf((m & 1) ? (ar * bi + ai * br) : (ar * br - ai * bi)); } }
}
__device__ __forceinline__ void s5_prep_b(Frame& F, int l, int chunk, int nchunk) {
    const float* AP = WSP(float, WS_S5AP) + (size_t)l * 16 * 64 * 68; const float* KT = WSP(float, WS_S5KT);
    constexpr int N = 16 * 512 * 640; const int per = (N + nchunk - 1) / nchunk, lo = chunk * per, hi = lo + per < N ? lo + per : N;
    if (nchunk == 256 && NTHREADS == 512) {
#pragma unroll 1
        for (int it = 0; it < 5; ++it) { const int i0 = chunk * 20480 + 8 * (F.tid + 512 * it);
            const int g = i0 / (512 * 640), r = i0 % (512 * 640), np = r / 640, k0 = r % 640, tl = np >> 4, p = np & 15;
            u32x4 o = (u32x4){0u, 0u, 0u, 0u};
            if (k0 < 512) { const int j = k0 >> 4, q0 = k0 & 15;
                if (tl >= j) { const f32x4* kp = (const f32x4*)(KT + (((size_t)g * 32 + (tl - j)) * 16 + p) * 16 + q0); const f32x4 x0 = kp[0], x1 = kp[1];
                    o.x = pk2(x0.x, x0.y); o.y = pk2(x0.z, x0.w); o.z = pk2(x1.x, x1.y); o.w = pk2(x1.z, x1.w); } }
            else { const int n0 = (k0 - 512) >> 1; const size_t cb = ((size_t)l * 16 + g) * 1024 + p * 64 + n0;
                const f32x4 cr = *(const f32x4*)(F.s5_c_re + cb), ci = *(const f32x4*)(F.s5_c_im + cb); const float* ap = AP + ((size_t)g * 64 + n0) * 68 + 2 * (tl + 1);
                const f32x2 a0 = *(const f32x2*)ap, a1 = *(const f32x2*)(ap + 68), a2 = *(const f32x2*)(ap + 136), a3 = *(const f32x2*)(ap + 204);
                o.x = pk2(cr.x * a0.x - ci.x * a0.y, -(cr.x * a0.y + ci.x * a0.x)); o.y = pk2(cr.y * a1.x - ci.y * a1.y, -(cr.y * a1.y + ci.y * a1.x));
                o.z = pk2(cr.z * a2.x - ci.z * a2.y, -(cr.z * a2.y + ci.z * a2.x)); o.w = pk2(cr.w * a3.x - ci.w * a3.y, -(cr.w * a3.y + ci.w * a3.x)); }
            *(u32x4*)(WSP(bf16, WS_S5MT) + i0) = o; }
        return;
    }
    for (int i = lo + F.tid; i < hi; i += NTHREADS) { const int g = i / (512 * 640), r = i % (512 * 640), np = r / 640, k = r % 640, tl = np >> 4, p = np & 15;
        float v;
        if (k < 512) { const int j = k >> 4, q = k & 15; v = tl >= j ? KT[(((size_t)g * 32 + (tl - j)) * 16 + p) * 16 + q] : 0.f; }
        else { const int n = (k - 512) >> 1; const size_t gn = (size_t)g * 64 + n; const float cr = F.s5_c_re[((size_t)l * 16 + g) * 1024 + p * 64 + n], ci = F.s5_c_im[((size_t)l * 16 + g) * 1024 + p * 64 + n];
            const float ar = AP[gn * 68 + 2 * (tl + 1)], ai = AP[gn * 68 + 2 * (tl + 1) + 1]; v = (k & 1) ? -(cr * ai + ci * ar) : (cr * ar - ci * ai); }
        WSP(bf16, WS_S5MT)[i] = (bf16)f2bf(v); }
}

struct EpiBf16Store { static constexpr bool HAS_PRE = false; bf16* O; size_t ld; int r0, c0;
    __device__ __forceinline__ void operator()(int r, int c, f32x4 v) const { u32x2 w; w.x = pk2(v.x, v.y); w.y = pk2(v.z, v.w); *(u32x2*)(O + (size_t)(r0 + r) * ld + c0 + c) = w; } };
__device__ __forceinline__ void phase_g1(Frame& F, int l) {
    g8::GridOrder S{L / 256, NPROJ / 256 - 1, (L / 256) * (NPROJ / 256 - 1), F.G, F.bid, (size_t)256 * 1024 * 2, (size_t)256 * 1024 * 2};
    g8::EpiStoreU E{WSP(bf16, WS_BIG), NPROJ, WSP(bf16, WS_S5UG), l == 0 ? nullptr : WSP(float, WS_RSTD)};
    g8::gemm_phase(F.lds, l == 0 ? WSP(bf16, WS_ACT) : (const bf16*)F.out, WSP(bf16, WS_WIN) + (size_t)l * NPROJ * 1024, 1024, S, E);
    if (l == 0) { unsigned* ctr = WSP(unsigned, WS_CTL) + CW_Q + 64 * 4 + 32 * F.rep;
      for (int u = grab_unit(F, ctr); u < 256; u = grab_unit(F, ctr)) s5_prep_a(F, 0, u, 256); }
}

constexpr int LD64 = 72, LD128 = 136;
template <bool HAS_DST, bool HAS_DSTT>
__device__ __forceinline__ void stage_rot(Frame& F, const bf16* proj, int t0, int col0, float scale, lbf* dst  , lbf* dstT  , const lf32* tscale  ) {
    const int t = F.tid >> 2, ib = (F.tid & 3) * 8;
    const bf16* row = proj + (size_t)(t0 + t) * NPROJ + col0;
    const u32x4 a = *(const u32x4*)(row + ib), b = *(const u32x4*)(row + 32 + ib);
    const f32x4* cs4 = (const f32x4*)(WSP(float, WS_ROPE) + ((size_t)(t0 + t) * 32 + ib) * 2);
    const f32x4 r0 = cs4[0], r1 = cs4[1], r2 = cs4[2], r3 = cs4[3];
    const float cs[16] = {r0.x, r0.y, r0.z, r0.w, r1.x, r1.y, r1.z, r1.w, r2.x, r2.y, r2.z, r2.w, r3.x, r3.y, r3.z, r3.w};
    float o1[8], o2[8];
    const unsigned aw[4] = {a.x, a.y, a.z, a.w}, bw[4] = {b.x, b.y, b.z, b.w};
#pragma unroll
    for (int j = 0; j < 8; ++j) { const float q1 = (j & 1) ? bfhi(aw[j >> 1]) : bflo(aw[j >> 1]), q2 = (j & 1) ? bfhi(bw[j >> 1]) : bflo(bw[j >> 1]); const float c = cs[2 * j], s = cs[2 * j + 1];
        o1[j] = (q1 * c - q2 * s) * scale; o2[j] = (q2 * c + q1 * s) * scale;
        }
    if (HAS_DST) { u32x4 w1, w2; w1.x = pk2(o1[0], o1[1]); w1.y = pk2(o1[2], o1[3]); w1.z = pk2(o1[4], o1[5]); w1.w = pk2(o1[6], o1[7]); w2.x = pk2(o2[0], o2[1]); w2.y = pk2(o2[2], o2[3]); w2.z = pk2(o2[4], o2[5]); w2.w = pk2(o2[6], o2[7]);
        *(LAS u32x4*)(dst + t * LD64 + ib) = w1; *(LAS u32x4*)(dst + t * LD64 + 32 + ib) = w2; }
    if (HAS_DSTT) { const float ts = tscale[t];
#pragma unroll
        for (int j = 0; j < 8; ++j) { dstT[(ib + j) * LD128 + t] = (bf16)f2bf(o1[j] * ts); dstT[(32 + ib + j) * LD128 + t] = (bf16)f2bf(o2[j] * ts); } }
}
__device__ __forceinline__ void hg_logf_cumsum_r(Frame& F, const u32x4 (&rf)[2], const float (&lb)[16], lf32* bL, lf32* tot) {
    { const int t = F.tid >> 2, dq = (F.tid & 3) * 16;
#pragma unroll
      for (int hh = 0; hh < 2; ++hh) { const unsigned aw[4] = {rf[hh].x, rf[hh].y, rf[hh].z, rf[hh].w}; float lf[8];
#pragma unroll
          for (int j = 0; j < 8; ++j) { const float x = (j & 1) ? bfhi(aw[j >> 1]) : bflo(aw[j >> 1]); const float b = lb[8 * hh + j]; lf[j] = flog(b + (1.0f - b) * sigmoidf_(x)); }
          *(LAS f32x4*)(bL + t * 64 + dq + 8 * hh) = (f32x4){lf[0], lf[1], lf[2], lf[3]}; *(LAS f32x4*)(bL + t * 64 + dq + 8 * hh + 4) = (f32x4){lf[4], lf[5], lf[6], lf[7]}; } }
    __syncthreads();
    const int d = F.tid & 63, sg = F.tid >> 6;
    { float run = 0.f;
#pragma unroll
      for (int j = 0; j < 16; ++j) { run += bL[(sg * 16 + j) * 64 + d]; bL[(sg * 16 + j) * 64 + d] = run; }
      tot[sg * 64 + d] = run; }
    __syncthreads();
    { float off = 0.f; for (int g = 0; g < sg; ++g) off += tot[g * 64 + d];
#pragma unroll
      for (int j = 0; j < 16; ++j) bL[(sg * 16 + j) * 64 + d] += off; }
    __syncthreads();
}
__device__ __forceinline__ void stage_T64(Frame& F, const bf16* proj, int t0, int col0, lbf* dstT) {
#pragma unroll
    for (int i = 0; i < 2; ++i) { const int p = F.tid + 512 * i, s = p >> 3, eb = (p & 7) * 8;
        const u32x4 a = *(const u32x4*)(proj + (size_t)(t0 + s) * NPROJ + col0 + eb); const unsigned aw[4] = {a.x, a.y, a.z, a.w};
#pragma unroll
        for (int j = 0; j < 8; ++j) dstT[(eb + j) * LD128 + s] = (bf16)((j & 1) ? (aw[j >> 1] >> 16) : (aw[j >> 1] & 0xffffu)); }
}

__device__ __forceinline__ float ret_log2gamma(int h) { return log2f(1.0f - exp2f(-5.0f - (float)h)); }
__device__ __forceinline__ void ret_state_unit(Frame& F0, int c, int h) {
    Frame F = F0; LAUNDER(F);
    lbf* VT = (lbf*)F.lds; lbf* KT = VT + 64 * LD128; lf32* zeta = (lf32*)(KT + 64 * LD128);
    const bf16* proj = WSP(bf16, WS_BIG); const int t0 = c * CH; const float lg = ret_log2gamma(h);
    if (F.tid < 128) zeta[F.tid] = fexp2((float)(CH - 1 - F.tid) * lg);
    __syncthreads();
    stage_T64(F, proj, t0, C_RV + h * 64, VT);
    stage_rot<false, true>(F, proj, t0, C_RK + h * 64, 0.125f, KT, KT, zeta);
    __syncthreads();
    f32x4 acc[2] = {(f32x4){0, 0, 0, 0}, (f32x4){0, 0, 0, 0}};
    const int w = F.wave;
    wave_mma<2, 4>(acc, VT + 16 * (w >> 1) * LD128, LD128, KT + 32 * (w & 1) * LD128, LD128, F.lane);
    float* st = WSP(float, WS_ST_RET) + ((size_t)c * 4 + h) * 4096;
    const int e = 16 * (w >> 1) + (F.lane & 15);
#pragma unroll
    for (int n = 0; n < 2; ++n) *(f32x4*)(st + e * 64 + 32 * (w & 1) + 16 * n + 4 * (F.lane >> 4)) = acc[n];
}
__device__ __forceinline__ void ret_out_unit(Frame& F0, int c, int h) {
    Frame F = F0; LAUNDER(F);
    lbf* Q = (lbf*)F.lds; lbf* K = Q + 128 * LD64; lbf* VT = K + 128 * LD64; lbf* RT = VT + 64 * LD128; lbf* P = RT + 64 * LD64;
    const bf16* proj = WSP(bf16, WS_BIG); const int t0 = c * CH; const float lg = ret_log2gamma(h);
    const int w = F.wave, lane = F.lane, fr = lane & 15, fq = lane >> 4;
    stage_rot<true, false>(F, proj, t0, C_RQ + h * 64, 1.0f, Q, Q, (const lf32*)Q);
    stage_rot<true, false>(F, proj, t0, C_RK + h * 64, 0.125f, K, K, (const lf32*)K);
    stage_T64(F, proj, t0, C_RV + h * 64, VT);
    { const float* st = WSP(float, WS_ST_RET) + ((size_t)c * 4 + h) * 4096 + F.tid * 8; const f32x4 a = __builtin_nontemporal_load((const f32x4*)st), b = __builtin_nontemporal_load((const f32x4*)(st + 4));
      u32x4 o; o.x = pk2(a.x, a.y); o.y = pk2(a.z, a.w); o.z = pk2(b.x, b.y); o.w = pk2(b.z, b.w); *(LAS u32x4*)(RT + (F.tid >> 3) * LD64 + (F.tid & 7) * 8) = o; }
    __syncthreads();
    f32x4 sc[8];
#pragma unroll
    for (int n = 0; n < 8; ++n) sc[n] = (f32x4){0, 0, 0, 0};
    wave_mma<8, 2>(sc, Q + 16 * w * LD64, LD64, K, LD64, lane);
    lbf* Pw = P + w * 16 * LD128;
    const int tl = 16 * w + fr;
#pragma unroll
    for (int n = 0; n < 8; ++n) { float pv[4];
#pragma unroll
        for (int j = 0; j < 4; ++j) { const int s = 16 * n + 4 * fq + j; pv[j] = (s <= tl) ? sc[n][j] * fexp2((float)(tl - s) * lg) : 0.f; }
        u32x2 o; o.x = pk2(pv[0], pv[1]); o.y = pk2(pv[2], pv[3]); *(LAS u32x2*)(Pw + fr * LD128 + 16 * n + 4 * fq) = o; }
    __syncthreads();
    f32x4 oi[4], ox[4];
#pragma unroll
    for (int n = 0; n < 4; ++n) { oi[n] = (f32x4){0, 0, 0, 0}; ox[n] = (f32x4){0, 0, 0, 0}; }
    wave_mma<4, 4>(oi, Pw, LD128, VT, LD128, lane);
    wave_mma<4, 2>(ox, Q + 16 * w * LD64, LD64, RT, LD64, lane);
    const float xi = fexp2((float)(tl + 1) * lg);
    float s1 = 0.f;
#pragma unroll
    for (int n = 0; n < 4; ++n) {
        oi[n] = oi[n] + xi * ox[n];
        s1 += (oi[n].x + oi[n].y) + (oi[n].z + oi[n].w); }
    s1 += __shfl_xor(s1, 16); s1 += __shfl_xor(s1, 32);
    const float mean = s1 * (1.0f / 64.0f); float s2 = 0.f;
#pragma unroll
    for (int n = 0; n < 4; ++n) { oi[n] = oi[n] - mean; s2 += (oi[n].x * oi[n].x + oi[n].y * oi[n].y) + (oi[n].z * oi[n].z + oi[n].w * oi[n].w); }
    s2 += __shfl_xor(s2, 16); s2 += __shfl_xor(s2, 32);
    const float rstd = frsq(s2 * (1.0f / 64.0f) + EPS);
    const int t = t0 + tl; bf16* y = WSP(bf16, WS_ACT) + (size_t)t * 1024 + Y_RET + h * 64;
    const bf16* gp = proj + (size_t)t * NPROJ + C_RG + h * 64;
#pragma unroll
    for (int n = 0; n < 4; ++n) { const int e = 16 * n + 4 * fq; const u32x2 g = *(const u32x2*)(gp + e);
        const f32x4 v = oi[n] * rstd; u32x2 o; o.x = pk2(v.x * siluf_(bflo(g.x)), v.y * siluf_(bfhi(g.x))); o.y = pk2(v.z * siluf_(bflo(g.y)), v.w * siluf_(bfhi(g.y))); *(u32x2*)(y + e) = o; }
}

__device__ __forceinline__ void m2_conv8(Frame& F, int l, const bf16* proj, int t, int cc  , float (&o)[8]) {
    const float* cw = F.m2_conv_w + (size_t)l * 4 * 768 + cc; const float* cb = F.m2_conv_b + (size_t)l * 768 + cc;
#pragma unroll
    for (int j = 0; j < 8; ++j) o[j] = cb[j];
#pragma unroll
    for (int q = 0; q < 4; ++q) { const int ts = t - 3 + q; if (ts >= 0) { const u32x4 a = *(const u32x4*)(proj + (size_t)ts * NPROJ + C_MX + cc); const unsigned aw[4] = {a.x, a.y, a.z, a.w};
#pragma unroll
        for (int j = 0; j < 8; ++j) o[j] += cw[q * 768 + j] * ((j & 1) ? bfhi(aw[j >> 1]) : bflo(aw[j >> 1])); } }
#pragma unroll
    for (int j = 0; j < 8; ++j) o[j] = siluf_(o[j]);
}
__device__ __forceinline__ void m2_dt_acum(Frame& F, int l, int c, lf32* dts, lf32* acs) {
    const int h = F.tid >> 7, t = F.tid & 127, lane = F.lane; const float x = WSP(float, WS_DTRAW)[(size_t)(c * CH + t) * 4 + h] + F.m2_dt_bias[l * 4 + h];
    const float dt = x > 20.f ? x : log1pf(fexp(x)); dts[h * 128 + t] = dt;
    float a = -fexp(F.m2_a_log[l * 4 + h]) * dt;
#pragma unroll
    for (int off = 1; off < 64; off <<= 1) { const float o = __shfl(a, lane - off); if (lane >= off) a += o; }
    acs[h * 128 + t] = a;
    __syncthreads();
    if (t >= 64) acs[h * 128 + t] = a + acs[h * 128 + 63];
    __syncthreads();
}
__device__ __forceinline__ void m2_conv8_r(const u32x4 (&raw)[4], const f32x4 (&w)[4][2], const f32x4 (&bs)[2], int t, float (&o)[8]) {
    o[0] = bs[0].x; o[1] = bs[0].y; o[2] = bs[0].z; o[3] = bs[0].w; o[4] = bs[1].x; o[5] = bs[1].y; o[6] = bs[1].z; o[7] = bs[1].w;
#pragma unroll
    for (int q = 0; q < 4; ++q) { if (t - 3 + q >= 0) { const unsigned aw[4] = {raw[q].x, raw[q].y, raw[q].z, raw[q].w}; const float wq[8] = {w[q][0].x, w[q][0].y, w[q][0].z, w[q][0].w, w[q][1].x, w[q][1].y, w[q][1].z, w[q][1].w};
#pragma unroll
        for (int j = 0; j < 8; ++j) o[j] += wq[j] * ((j & 1) ? bfhi(aw[j >> 1]) : bflo(aw[j >> 1])); } }
#pragma unroll
    for (int j = 0; j < 8; ++j) o[j] = siluf_(o[j]);
}
#define M2S_LDW(w_, b_, cc_) do { const float* cw_ = F.m2_conv_w + (size_t)l * 4 * 768 + (cc_); const float* cb_ = F.m2_conv_b + (size_t)l * 768 + (cc_); \
        _Pragma("unroll") for (int q = 0; q < 4; ++q) { w_[q][0] = *(const f32x4*)(cw_ + q * 768); w_[q][1] = *(const f32x4*)(cw_ + q * 768 + 4); } b_[0] = *(const f32x4*)cb_; b_[1] = *(const f32x4*)(cb_ + 4); } while (0)
#define M2S_LDR(raw_, t_, cc_) do { _Pragma("unroll") for (int q = 0; q < 4; ++q) { const int ts_ = (t_) - 3 + q; raw_[q] = *(const u32x4*)(proj + (size_t)(ts_ < 0 ? 0 : ts_) * NPROJ + C_MX + (cc_)); } } while (0)
__device__ __forceinline__ void m2_state_unit(Frame& F0, int l, int c, int g) {
    Frame F = F0; LAUNDER(F);
    lbf* XT = (lbf*)F.lds; lbf* BT = XT + 64 * LD128; lf32* dts = (lf32*)(BT + 128 * LD128); lf32* acs = dts + 512;
    const bf16* proj = WSP(bf16, WS_BIG); bf16* xbc = XBC_PTR(F); const int t0 = c * CH;
    const int nb = (F.tid & 15) * 8, sb = F.tid >> 4;
    f32x4 wB[4][2], bB[2], wC[4][2], bC[2]; u32x4 rB[4], rC[4], nB[4];
    M2S_LDW(wB, bB, 256 + g * 128 + nb); M2S_LDW(wC, bC, 512 + g * 128 + nb);
    M2S_LDR(rB, t0 + sb, 256 + g * 128 + nb);
    m2_dt_acum(F, l, c, dts, acs);
#pragma unroll 1
    for (int i = 0; i < 4; ++i) { const int s = sb + 32 * i; float o[8], o2[8];
        M2S_LDR(rC, t0 + s, 512 + g * 128 + nb);
        if (i < 3) { M2S_LDR(nB, t0 + s + 32, 256 + g * 128 + nb); }
        { const float* cbp = F.m2_conv_b + (size_t)l * 768 + g * 128 + nb; bB[0] = *(const f32x4*)(cbp + 256); bB[1] = *(const f32x4*)(cbp + 260); bC[0] = *(const f32x4*)(cbp + 512); bC[1] = *(const f32x4*)(cbp + 516); }
        m2_conv8_r(rB, wB, bB, t0 + s, o); m2_conv8_r(rC, wC, bC, t0 + s, o2);
        u32x4 wv; wv.x = pk2(o[0], o[1]); wv.y = pk2(o[2], o[3]); wv.z = pk2(o[4], o[5]); wv.w = pk2(o[6], o[7]); *(u32x4*)(xbc + (size_t)(t0 + s) * 768 + 256 + g * 128 + nb) = wv;
#pragma unroll
        for (int j = 0; j < 8; ++j) BT[(nb + j) * LD128 + s] = (bf16)f2bf(o[j]);
        wv.x = pk2(o2[0], o2[1]); wv.y = pk2(o2[2], o2[3]); wv.z = pk2(o2[4], o2[5]); wv.w = pk2(o2[6], o2[7]); *(u32x4*)(xbc + (size_t)(t0 + s) * 768 + 512 + g * 128 + nb) = wv;
#pragma unroll
        for (int q = 0; q < 4; ++q) rB[q] = nB[q]; }
#pragma unroll 1
    for (int hh = 0; hh < 2; ++hh) { const int h = 2 * g + hh;
        const float alast = acs[h * 128 + 127];
        { const int s0 = F.tid >> 3, eb = (F.tid & 7) * 8, s1 = s0 + 64; float o[8], o2[8];
          M2S_LDW(wB, bB, h * 64 + eb); M2S_LDR(rB, t0 + s0, h * 64 + eb); M2S_LDR(rC, t0 + s1, h * 64 + eb);
          m2_conv8_r(rB, wB, bB, t0 + s0, o); m2_conv8_r(rC, wB, bB, t0 + s1, o2);
          u32x4 wv; wv.x = pk2(o[0], o[1]); wv.y = pk2(o[2], o[3]); wv.z = pk2(o[4], o[5]); wv.w = pk2(o[6], o[7]); *(u32x4*)(xbc + (size_t)(t0 + s0) * 768 + h * 64 + eb) = wv;
          wv.x = pk2(o2[0], o2[1]); wv.y = pk2(o2[2], o2[3]); wv.z = pk2(o2[4], o2[5]); wv.w = pk2(o2[6], o2[7]); *(u32x4*)(xbc + (size_t)(t0 + s1) * 768 + h * 64 + eb) = wv;
          const float sc0 = dts[h * 128 + s0] * fexp(alast - acs[h * 128 + s0]), sc1 = dts[h * 128 + s1] * fexp(alast - acs[h * 128 + s1]);
#pragma unroll
          for (int j = 0; j < 8; ++j) { XT[(eb + j) * LD128 + s0] = (bf16)f2bf(o[j] * sc0); XT[(eb + j) * LD128 + s1] = (bf16)f2bf(o2[j] * sc1); } }
        __syncthreads();
        f32x4 acc[4];
#pragma unroll
        for (int n = 0; n < 4; ++n) acc[n] = (f32x4){0, 0, 0, 0};
        const int w = F.wave;
        wave_mma<4, 4>(acc, XT + 16 * (w >> 1) * LD128, LD128, BT + 64 * (w & 1) * LD128, LD128, F.lane);
        float* st = WSP(float, WS_ST_M2) + ((size_t)c * 4 + h) * 8192; const int pr = 16 * (w >> 1) + (F.lane & 15);
#pragma unroll
        for (int n = 0; n < 4; ++n) *(f32x4*)(st + pr * 128 + 64 * (w & 1) + 16 * n + 4 * (F.lane >> 4)) = acc[n];
        if (F.tid == 0) WSP(float, WS_DEC_M2)[c * 4 + h] = fexp(alast);
        __syncthreads();
    }
}
#undef M2S_LDW
#undef M2S_LDR
__device__ __forceinline__ void m2_out_unit(Frame& F0, int l, int c) {
    Frame F = F0; LAUNDER(F);
    lbf* Cm = (lbf*)F.lds; lbf* Bm = Cm + 128 * LD128; lbf* XT = Bm + 128 * LD128; lbf* ST = XT + 64 * LD128; lf32* dts = (lf32*)(ST + 64 * LD128); lf32* acs = dts + 512;
    lbf* P = Bm;
    const bf16* proj = WSP(bf16, WS_BIG); const bf16* xbc = XBC_PTR(F); const int t0 = c * CH;
    const int w = F.wave, lane = F.lane, fr = lane & 15, fq = lane >> 4, tl = 16 * w + fr;
    u32x4 rC[4], rB[4], rX[2]; f32x4 rSa[2], rSb[2];
#define M2O_LD_CB(g_) do { _Pragma("unroll") for (int i = 0; i < 4; ++i) { const int p = F.tid + 512 * i, s = p >> 4, nb = (p & 15) * 8; const bf16* xr = xbc + (size_t)(t0 + s) * 768 + (g_) * 128 + nb; \
        rC[i] = *(const u32x4*)(xr + 512); rB[i] = *(const u32x4*)(xr + 256); } } while (0)
#define M2O_LD_XS(h_) do { const float* st_ = WSP(float, WS_ST_M2) + ((size_t)c * 4 + (h_)) * 8192; _Pragma("unroll") for (int i = 0; i < 2; ++i) { const int p = F.tid + 512 * i, s = p >> 3, eb = (p & 7) * 8; \
        rX[i] = *(const u32x4*)(xbc + (size_t)(t0 + s) * 768 + (h_) * 64 + eb); rSa[i] = __builtin_nontemporal_load((const f32x4*)(st_ + p * 8)); rSb[i] = __builtin_nontemporal_load((const f32x4*)(st_ + p * 8 + 4)); } } while (0)
    M2O_LD_CB(0);
    m2_dt_acum(F, l, c, dts, acs);
    float ss = 0.f;
    bf16* yrow = WSP(bf16, WS_ACT) + (size_t)(t0 + tl) * 1024 + Y_M2;
#pragma unroll 1
    for (int g = 0; g < 2; ++g) {
        __syncthreads();
#pragma unroll
        for (int i = 0; i < 4; ++i) { const int p = F.tid + 512 * i, s = p >> 4, nb = (p & 15) * 8; *(LAS u32x4*)(Cm + s * LD128 + nb) = rC[i]; *(LAS u32x4*)(Bm + s * LD128 + nb) = rB[i]; }
        M2O_LD_XS(2 * g);
        __syncthreads();
        f32x4 sc[8];
#pragma unroll
        for (int n = 0; n < 8; ++n) sc[n] = (f32x4){0, 0, 0, 0};
        wave_mma<8, 4>(sc, Cm + 16 * w * LD128, LD128, Bm, LD128, lane);
#pragma unroll 1
        for (int hh = 0; hh < 2; ++hh) { const int h = 2 * g + hh;
            __syncthreads();
#pragma unroll
            for (int i = 0; i < 2; ++i) { const int p = F.tid + 512 * i, s = p >> 3, eb = (p & 7) * 8; const unsigned aw[4] = {rX[i].x, rX[i].y, rX[i].z, rX[i].w};
#pragma unroll
                for (int j = 0; j < 8; ++j) XT[(eb + j) * LD128 + s] = (bf16)((j & 1) ? (aw[j >> 1] >> 16) : (aw[j >> 1] & 0xffffu));
                u32x4 o; o.x = pk2(rSa[i].x, rSa[i].y); o.y = pk2(rSa[i].z, rSa[i].w); o.z = pk2(rSb[i].x, rSb[i].y); o.w = pk2(rSb[i].z, rSb[i].w); *(LAS u32x4*)(ST + (p >> 4) * LD128 + (p & 15) * 8) = o; }
            const bf16* zp = proj + (size_t)(t0 + tl) * NPROJ + C_MZ + h * 64;
            u32x2 zr[4];
#pragma unroll
            for (int n = 0; n < 4; ++n) zr[n] = *(const u32x2*)(zp + 16 * n + 4 * fq);
            if (hh == 0) M2O_LD_XS(h + 1); else if (g == 0) M2O_LD_CB(1);
            const float at = acs[h * 128 + tl];
            lbf* Pw = P + w * 16 * LD128;
#pragma unroll
            for (int n = 0; n < 8; ++n) { float pv[4];
#pragma unroll
                for (int j = 0; j < 4; ++j) { const int s = 16 * n + 4 * fq + j; pv[j] = (s <= tl) ? sc[n][j] * fexp(at - acs[h * 128 + s]) * dts[h * 128 + s] : 0.f; }
                u32x2 o; o.x = pk2(pv[0], pv[1]); o.y = pk2(pv[2], pv[3]); *(LAS u32x2*)(Pw + fr * LD128 + 16 * n + 4 * fq) = o; CFENCE(); }
            __syncthreads();
            f32x4 yi[4], yx[4];
#pragma unroll
            for (int n = 0; n < 4; ++n) { yi[n] = (f32x4){0, 0, 0, 0}; yx[n] = (f32x4){0, 0, 0, 0}; }
            wave_mma<4, 4>(yi, Pw, LD128, XT, LD128, lane);
            wave_mma<4, 4>(yx, Cm + 16 * w * LD128, LD128, ST, LD128, lane);
            const float ea = fexp(at), dsk = F.m2_d[l * 4 + h];
#pragma unroll
            for (int n = 0; n < 4; ++n) { const int p0 = 16 * n + 4 * fq; const u32x2 z = zr[n];
                f32x4 v = yi[n] + ea * yx[n];
                v.x += dsk * bf2f(XT[(p0 + 0) * LD128 + tl]); v.y += dsk * bf2f(XT[(p0 + 1) * LD128 + tl]); v.z += dsk * bf2f(XT[(p0 + 2) * LD128 + tl]); v.w += dsk * bf2f(XT[(p0 + 3) * LD128 + tl]);
                v.x *= siluf_(bflo(z.x)); v.y *= siluf_(bfhi(z.x)); v.z *= siluf_(bflo(z.y)); v.w *= siluf_(bfhi(z.y));
                ss += (v.x * v.x + v.y * v.y) + (v.z * v.z + v.w * v.w);
                u32x2 o; o.x = pk2(v.x, v.y); o.y = pk2(v.z, v.w); *(u32x2*)(yrow + h * 64 + p0) = o; CFENCE(); }
        }
    }
#undef M2O_LD_CB
#undef M2O_LD_XS
    ss += __shfl_xor(ss, 16); ss += __shfl_xor(ss, 32);
    const float rstd = frsq(ss * (1.0f / 256.0f) + EPS);
    const float* ng = F.m2_norm_g + l * 256;
#ifndef EMU
    asm volatile("s_waitcnt vmcnt(0)" ::: "memory");
#endif
#pragma unroll
    for (int qh = 0; qh < 2; ++qh) {
        f32x4 gv[8]; u32x2 yv[8];
#pragma unroll
        for (int q = 0; q < 8; ++q) { const int cc = (2 * qh + (q >> 2)) * 64 + 16 * (q & 3) + 4 * fq; gv[q] = *(const f32x4*)(ng + cc); yv[q] = *(const u32x2*)(yrow + cc); }
#pragma unroll
        for (int q = 0; q < 8; ++q) { const int cc = (2 * qh + (q >> 2)) * 64 + 16 * (q & 3) + 4 * fq;
            u32x2 o; o.x = pk2(bflo(yv[q].x) * rstd * gv[q].x, bfhi(yv[q].x) * rstd * gv[q].y); o.y = pk2(bflo(yv[q].y) * rstd * gv[q].z, bfhi(yv[q].y) * rstd * gv[q].w); *(u32x2*)(yrow + cc) = o; } }
}

template <bool OUT>
__device__ __forceinline__ void hg_wave_unit(Frame& F0, int l, int sc, int h) {
    Frame F = F0; LAUNDER(F);
    constexpr int TB = 16;
    lf32* Fb = (lf32*)(F.lds + F.wave * 16384); lf32* Vb = Fb + 1024; lf32* Qb = Vb + 1024; lf32* Gb = Qb + 1024;
    const bf16* proj = WSP(bf16, WS_BIG); const int lane = F.lane, t0 = sc * HSC;
    const float lb = WSP(float, WS_LB)[l * 256 + h * 64 + lane];
    float S[64];
    if (OUT) { const float* sp = WSP(float, WS_ST_HG) + ((size_t)sc * 4 + h) * 4096 + lane;
#pragma unroll
        for (int d = 0; d < 64; ++d) S[d] = sp[d * 64]; }
    else {
#pragma unroll
        for (int d = 0; d < 64; ++d) S[d] = 0.f; }
    float lam = 1.0f;
    const float ng = OUT ? F.hg_norm_g[l * 256 + h * 64 + lane] : 0.f;
    bf16 rf[TB], rq[TB], rv[TB], rg[TB];
    const bf16* pb = proj + (size_t)t0 * NPROJ + h * 64 + lane;
#pragma unroll
    for (int tt = 0; tt < TB; ++tt) { const bf16* pr = pb + (size_t)tt * NPROJ; rf[tt] = pr[C_GF]; rv[tt] = pr[C_GI]; if (OUT) { rq[tt] = pr[C_GQ]; rg[tt] = pr[C_GG]; } }
#pragma unroll 1
    for (int tb = 0; tb < HSC; tb += TB) {
#pragma unroll
        for (int tt = 0; tt < TB; ++tt) {
            const float f = lb + (1.0f - lb) * sigmoidf_(bf2f(rf[tt])); Fb[tt * 64 + lane] = f; lam *= f; Vb[tt * 64 + lane] = bf2f(rv[tt]);
            if (OUT) { Qb[tt * 64 + lane] = siluf_(bf2f(rq[tt])); Gb[tt * 64 + lane] = siluf_(bf2f(rg[tt])) * ng; } }
        WAVE_SYNC();
        if (tb + TB < HSC) { const bf16* pn = pb + (size_t)(tb + TB) * NPROJ;
#pragma unroll
            for (int tt = 0; tt < TB; ++tt) { const bf16* pr = pn + (size_t)tt * NPROJ; rf[tt] = pr[C_GF]; rv[tt] = pr[C_GI]; if (OUT) { rq[tt] = pr[C_GQ]; rg[tt] = pr[C_GG]; } } }
#pragma unroll 2
        for (int tt = 0; tt < TB; ++tt) {
            const float v = Vb[tt * 64 + lane];
            float o0 = 0.f, o1 = 0.f, o2 = 0.f, o3 = 0.f;
#pragma unroll
            for (int d4 = 0; d4 < 16; ++d4) { const f32x4 f4 = *(const LAS f32x4*)(Fb + tt * 64 + 4 * d4);
                S[4 * d4 + 0] = f4.x * (S[4 * d4 + 0] - v) + v; S[4 * d4 + 1] = f4.y * (S[4 * d4 + 1] - v) + v; S[4 * d4 + 2] = f4.z * (S[4 * d4 + 2] - v) + v; S[4 * d4 + 3] = f4.w * (S[4 * d4 + 3] - v) + v;
                if (OUT) { const f32x4 q4 = *(const LAS f32x4*)(Qb + tt * 64 + 4 * d4); o0 += q4.x * S[4 * d4 + 0]; o1 += q4.y * S[4 * d4 + 1]; o2 += q4.z * S[4 * d4 + 2]; o3 += q4.w * S[4 * d4 + 3]; } }
            if (OUT) { const float o = (o0 + o1) + (o2 + o3); const float ssq = wave_sum(o * o); const float rstd = frsq(ssq * (1.0f / 64.0f) + EPS);
                WSP(bf16, WS_ACT)[(size_t)(t0 + tb + tt) * 1024 + Y_HG + h * 64 + lane] = (bf16)f2bf(o * rstd * Gb[tt * 64 + lane]); } }
        WAVE_SYNC();
    }
    if (!OUT) { float* sp = WSP(float, WS_ST_HG) + ((size_t)sc * 4 + h) * 4096 + lane;
#pragma unroll
        for (int d = 0; d < 64; ++d) sp[d * 64] = S[d];
        WSP(float, WS_DEC_HG)[((size_t)sc * 4 + h) * 64 + lane] = lam; }
}


__device__ __forceinline__ bf16x8 pack8(const float (&x)[8]) {
    u32x4 w; w.x = pk2(x[0], x[1]); w.y = pk2(x[2], x[3]); w.z = pk2(x[4], x[5]); w.w = pk2(x[6], x[7]); return __builtin_bit_cast(bf16x8, w); }
__device__ __forceinline__ void ld8f(const lf32* p, float (&x)[8]) { const f32x4 a = *(const LAS f32x4*)p, b = *(const LAS f32x4*)(p + 4); x[0] = a.x; x[1] = a.y; x[2] = a.z; x[3] = a.w; x[4] = b.x; x[5] = b.y; x[6] = b.z; x[7] = b.w; }
__device__ __forceinline__ void ld8b(const lbf* p, float (&x)[8]) { const u32x4 a = *(const LAS u32x4*)p; x[0] = bflo(a.x); x[1] = bfhi(a.x); x[2] = bflo(a.y); x[3] = bfhi(a.y); x[4] = bflo(a.z); x[5] = bfhi(a.z); x[6] = bflo(a.w); x[7] = bfhi(a.w); }
__device__ __forceinline__ void hg_logf_cumsum(Frame& F, int l, const bf16* proj, int t0, int h, lf32* bL, lf32* tot) {
    { const int t = F.tid >> 2, dq = (F.tid & 3) * 16; const bf16* pr = proj + (size_t)(t0 + t) * NPROJ + C_GF + h * 64 + dq; const float* lbp = WSP(float, WS_LB) + l * 256 + h * 64 + dq;
#pragma unroll
      for (int hh = 0; hh < 2; ++hh) { const u32x4 a = *(const u32x4*)(pr + 8 * hh); const unsigned aw[4] = {a.x, a.y, a.z, a.w}; float lf[8];
#pragma unroll
          for (int j = 0; j < 8; ++j) { const float x = (j & 1) ? bfhi(aw[j >> 1]) : bflo(aw[j >> 1]); const float lb = lbp[8 * hh + j]; lf[j] = flog(lb + (1.0f - lb) * sigmoidf_(x)); }
          *(LAS f32x4*)(bL + t * 64 + dq + 8 * hh) = (f32x4){lf[0], lf[1], lf[2], lf[3]}; *(LAS f32x4*)(bL + t * 64 + dq + 8 * hh + 4) = (f32x4){lf[4], lf[5], lf[6], lf[7]}; } }
    __syncthreads();
    const int d = F.tid & 63, sg = F.tid >> 6;
    { float run = 0.f;
#pragma unroll
      for (int j = 0; j < 16; ++j) { run += bL[(sg * 16 + j) * 64 + d]; bL[(sg * 16 + j) * 64 + d] = run; }
      tot[sg * 64 + d] = run; }
    __syncthreads();
    { float off = 0.f; for (int g = 0; g < sg; ++g) off += tot[g * 64 + d];
#pragma unroll
      for (int j = 0; j < 16; ++j) bL[(sg * 16 + j) * 64 + d] += off; }
    __syncthreads();
}
__device__ __forceinline__ void hg_state_unit(Frame& F0, int l, int c, int h) {
    Frame F = F0; LAUNDER(F);
    lf32* bL = (lf32*)F.lds; lf32* tot = bL + 128 * 64; lbf* VT = (lbf*)(tot + 512); lbf* KT = VT + 64 * LD128;
    const bf16* proj = WSP(bf16, WS_BIG); const int t0 = c * CH;
    hg_logf_cumsum(F, l, proj, t0, h, bL, tot);
    stage_T64(F, proj, t0, C_GI + h * 64, VT);
    { const int s = F.tid >> 2, dq = (F.tid & 3) * 16; const bf16* pr = proj + (size_t)(t0 + s) * NPROJ + C_GF + h * 64 + dq; const float* lbp = WSP(float, WS_LB) + l * 256 + h * 64 + dq;
#pragma unroll
      for (int hh = 0; hh < 2; ++hh) { const u32x4 a = *(const u32x4*)(pr + 8 * hh); const unsigned aw[4] = {a.x, a.y, a.z, a.w};
#pragma unroll
          for (int j = 0; j < 8; ++j) { const int d = dq + 8 * hh + j; const float x = (j & 1) ? bfhi(aw[j >> 1]) : bflo(aw[j >> 1]); const float lb = lbp[8 * hh + j];
              const float k = 1.0f - (lb + (1.0f - lb) * sigmoidf_(x)); KT[d * LD128 + s] = (bf16)f2bf(k * fexp(bL[127 * 64 + d] - bL[s * 64 + d])); } } }
    __syncthreads();
    f32x4 acc[2] = {(f32x4){0, 0, 0, 0}, (f32x4){0, 0, 0, 0}};
    const int w = F.wave;
    wave_mma<2, 4>(acc, VT + 16 * (w >> 1) * LD128, LD128, KT + 32 * (w & 1) * LD128, LD128, F.lane);
    float* st = WSP(float, WS_ST_HG) + ((size_t)c * 4 + h) * 4096; const int e = 16 * (w >> 1) + (F.lane & 15);
#pragma unroll
    for (int n = 0; n < 2; ++n) *(f32x4*)(st + e * 64 + 32 * (w & 1) + 16 * n + 4 * (F.lane >> 4)) = acc[n];
    if (F.tid < 64) WSP(float, WS_DEC_HG)[((size_t)c * 4 + h) * 64 + F.tid] = fexp(bL[127 * 64 + F.tid]);
}
__device__ __forceinline__ void hg_out_unit(Frame& F0, int l, int c, int h) {
    Frame F = F0; LAUNDER(F);
    lf32* bL = (lf32*)F.lds; lf32* tot = bL + 128 * 64; lbf* Qr = (lbf*)(tot + 512); lbf* Kh = Qr + 128 * LD64; lbf* VT = Kh + 128 * LD64; lbf* ST = VT + 64 * LD128; lbf* P = ST + 64 * LD64;
    const bf16* proj = WSP(bf16, WS_BIG); const int t0 = c * CH;
    const int w = F.wave, lane = F.lane, fr = lane & 15, fq = lane >> 4, tl = 16 * w + fr;
    u32x4 rq[2], rf[2], rv[2]; f32x4 rsa, rsb; u32x2 rg[4]; f32x4 rn[4]; float lb[16];
    { const int t = F.tid >> 2, dq = (F.tid & 3) * 16; const bf16* pq = proj + (size_t)(t0 + t) * NPROJ + C_GQ + h * 64 + dq; const bf16* pf = proj + (size_t)(t0 + t) * NPROJ + C_GF + h * 64 + dq;
      const f32x4* lbp = (const f32x4*)(WSP(float, WS_LB) + l * 256 + h * 64 + dq);
#pragma unroll
      for (int hh = 0; hh < 2; ++hh) { rq[hh] = *(const u32x4*)(pq + 8 * hh); rf[hh] = *(const u32x4*)(pf + 8 * hh); }
#pragma unroll
      for (int i = 0; i < 4; ++i) { const f32x4 x = lbp[i]; lb[4 * i] = x.x; lb[4 * i + 1] = x.y; lb[4 * i + 2] = x.z; lb[4 * i + 3] = x.w; }
#pragma unroll
      for (int i = 0; i < 2; ++i) { const int p = F.tid + 512 * i, s = p >> 3, eb = (p & 7) * 8; rv[i] = *(const u32x4*)(proj + (size_t)(t0 + s) * NPROJ + C_GI + h * 64 + eb); }
      const float* st = WSP(float, WS_ST_HG) + ((size_t)c * 4 + h) * 4096 + F.tid * 8; rsa = __builtin_nontemporal_load((const f32x4*)st); rsb = __builtin_nontemporal_load((const f32x4*)(st + 4));
      const bf16* gp0 = proj + (size_t)(t0 + tl) * NPROJ + C_GG + h * 64; const float* ng0 = F.hg_norm_g + l * 256 + h * 64;
#pragma unroll
      for (int n = 0; n < 4; ++n) { rg[n] = *(const u32x2*)(gp0 + 16 * n + 4 * fq); rn[n] = *(const f32x4*)(ng0 + 16 * n + 4 * fq); } }
    hg_logf_cumsum_r(F, rf, lb, bL, tot);
    { const int t = F.tid >> 2, dq = (F.tid & 3) * 16, te = (t | 15);
#pragma unroll
      for (int hh = 0; hh < 2; ++hh) { const unsigned aw[4] = {rq[hh].x, rq[hh].y, rq[hh].z, rq[hh].w}, bw[4] = {rf[hh].x, rf[hh].y, rf[hh].z, rf[hh].w}; float qo[8], ko[8];
#pragma unroll
          for (int j = 0; j < 8; ++j) { const int d = dq + 8 * hh + j; const float xq = (j & 1) ? bfhi(aw[j >> 1]) : bflo(aw[j >> 1]), xf = (j & 1) ? bfhi(bw[j >> 1]) : bflo(bw[j >> 1]); const float lbv = lb[8 * hh + j];
              qo[j] = siluf_(xq); ko[j] = (1.0f - (lbv + (1.0f - lbv) * sigmoidf_(xf))) * fexp(bL[te * 64 + d] - bL[t * 64 + d]); }
          *(LAS bf16x8*)(Qr + t * LD64 + dq + 8 * hh) = pack8(qo); *(LAS bf16x8*)(Kh + t * LD64 + dq + 8 * hh) = pack8(ko); } }
#pragma unroll
    for (int i = 0; i < 2; ++i) { const int p = F.tid + 512 * i, s = p >> 3, eb = (p & 7) * 8; const unsigned aw[4] = {rv[i].x, rv[i].y, rv[i].z, rv[i].w};
#pragma unroll
        for (int j = 0; j < 8; ++j) VT[(eb + j) * LD128 + s] = (bf16)((j & 1) ? (aw[j >> 1] >> 16) : (aw[j >> 1] & 0xffffu)); }
    { u32x4 o; o.x = pk2(rsa.x, rsa.y); o.y = pk2(rsa.z, rsa.w); o.z = pk2(rsb.x, rsb.y); o.w = pk2(rsb.z, rsb.w); *(LAS u32x4*)(ST + (F.tid >> 3) * LD64 + (F.tid & 7) * 8) = o; }
    __syncthreads();
    float qv[2][8], bt[2][8];
#pragma unroll
    for (int ks = 0; ks < 2; ++ks) { ld8b(Qr + tl * LD64 + ks * 32 + fq * 8, qv[ks]); ld8f(bL + tl * 64 + ks * 32 + fq * 8, bt[ks]); }
    lbf* Pw = P + w * 16 * LD128;
    f32x4 ox[4];
#pragma unroll
    for (int n = 0; n < 4; ++n) ox[n] = (f32x4){0, 0, 0, 0};
#pragma unroll
    for (int ks = 0; ks < 2; ++ks) { float x[8];
#pragma unroll
        for (int j = 0; j < 8; ++j) x[j] = qv[ks][j] * fexp(bt[ks][j]);
        const bf16x8 a = pack8(x);
#pragma unroll
        for (int n = 0; n < 4; ++n) { const bf16x8 b = *(const LAS bf16x8*)(ST + (n * 16 + fr) * LD64 + ks * 32 + fq * 8); ox[n] = __builtin_amdgcn_mfma_f32_16x16x32_bf16(b, a, ox[n], 0, 0, 0); } }
    for (int j = 0; j < w; ++j) { f32x4 sc = (f32x4){0, 0, 0, 0};
#pragma unroll
        for (int ks = 0; ks < 2; ++ks) { float be[8], x[8]; ld8f(bL + (16 * j + 15) * 64 + ks * 32 + fq * 8, be);
#pragma unroll
            for (int q = 0; q < 8; ++q) x[q] = qv[ks][q] * fexp(bt[ks][q] - be[q]);
            const bf16x8 a = pack8(x); const bf16x8 b = *(const LAS bf16x8*)(Kh + (16 * j + fr) * LD64 + ks * 32 + fq * 8);
            sc = __builtin_amdgcn_mfma_f32_16x16x32_bf16(b, a, sc, 0, 0, 0); }
        u32x2 o; o.x = pk2(sc.x, sc.y); o.y = pk2(sc.z, sc.w); *(LAS u32x2*)(Pw + fr * LD128 + 16 * j + 4 * fq) = o; }
    { f32x4 sc = (f32x4){0, 0, 0, 0};
#pragma unroll
      for (int ks = 0; ks < 2; ++ks) { float br[8], bee[8], kk[8], x[8], y[8]; ld8f(bL + (16 * w + 7) * 64 + ks * 32 + fq * 8, br); ld8f(bL + (16 * w + 15) * 64 + ks * 32 + fq * 8, bee); ld8b(Kh + tl * LD64 + ks * 32 + fq * 8, kk);
#pragma unroll
          for (int q = 0; q < 8; ++q) { x[q] = qv[ks][q] * fexp(bt[ks][q] - br[q]); y[q] = kk[q] * fexp(br[q] - bee[q]); }
          sc = __builtin_amdgcn_mfma_f32_16x16x32_bf16(pack8(y), pack8(x), sc, 0, 0, 0); }
      float pv[4];
#pragma unroll
      for (int q = 0; q < 4; ++q) pv[q] = (4 * fq + q <= fr) ? sc[q] : 0.f;
      u32x2 o; o.x = pk2(pv[0], pv[1]); o.y = pk2(pv[2], pv[3]); *(LAS u32x2*)(Pw + fr * LD128 + 16 * w + 4 * fq) = o; }
    for (int j = w + 1; j < 8; ++j) *(LAS u32x2*)(Pw + fr * LD128 + 16 * j + 4 * fq) = (u32x2){0u, 0u};
    WAVE_SYNC();
    f32x4 oi[4];
#pragma unroll
    for (int n = 0; n < 4; ++n) oi[n] = (f32x4){0, 0, 0, 0};
    wave_mma<4, 4>(oi, Pw, LD128, VT, LD128, lane);
    float ss = 0.f;
#pragma unroll
    for (int n = 0; n < 4; ++n) { oi[n] = oi[n] + ox[n]; ss += (oi[n].x * oi[n].x + oi[n].y * oi[n].y) + (oi[n].z * oi[n].z + oi[n].w * oi[n].w); }
    ss += __shfl_xor(ss, 16); ss += __shfl_xor(ss, 32);
    const float rstd = frsq(ss * (1.0f / 64.0f) + EPS);
    const int t = t0 + tl; bf16* y = WSP(bf16, WS_ACT) + (size_t)t * 1024 + Y_HG + h * 64;
#pragma unroll
    for (int n = 0; n < 4; ++n) { const int e = 16 * n + 4 * fq; const u32x2 g = rg[n]; const f32x4 gn = rn[n]; const f32x4 v = oi[n] * rstd * gn;
        u32x2 o; o.x = pk2(v.x * siluf_(bflo(g.x)), v.y * siluf_(bfhi(g.x))); o.y = pk2(v.z * siluf_(bflo(g.y)), v.w * siluf_(bfhi(g.y))); *(u32x2*)(y + e) = o; }
}

struct PtrS5A { const bf16* proj; const bf16* sp; int g, c0;
    __device__ __forceinline__ const bf16* operator()(int r, int k) const { int c = c0 + r; if (c >= NCH5) c = NCH5 - 1;
        return k < 512 ? proj + (size_t)(c * 32 + (k >> 4)) * NPROJ + C_S5U + g * 16 + (k & 15) : sp + ((size_t)c * 16 + g) * 128 + (k - 512); } };
struct EpiS5Inc { static constexpr bool HAS_PRE = false; float* st; int g, c0;
    __device__ __forceinline__ void operator()(int r, int c, f32x4 v) const { const int ch = c0 + r; if (ch < NCH5) *(f32x4*)(st + ((size_t)ch * 16 + g) * 128 + c) = v; } };
struct EpiS5Out { static constexpr bool HAS_PRE = false; const bf16* proj; bf16* ypre; const float* dsk; int g, c0, n0;
    __device__ __forceinline__ void operator()(int r, int c, f32x4 v) const { const int ch = c0 + r; if (ch >= NCH5) return; const int np = n0 + c, tl = np >> 4, p = np & 15, t = ch * 32 + tl;
        const u32x2 u = *(const u32x2*)(proj + (size_t)t * NPROJ + C_S5U + g * 16 + p); const float* d = dsk + g * 16 + p;
        const float y0 = gelu_tanh(v.x + d[0] * bflo(u.x)), y1 = gelu_tanh(v.y + d[1] * bfhi(u.x)), y2 = gelu_tanh(v.z + d[2] * bflo(u.y)), y3 = gelu_tanh(v.w + d[3] * bfhi(u.y));
        u32x2 o; o.x = pk2(y0, y1); o.y = pk2(y2, y3); *(u32x2*)(ypre + (size_t)t * 256 + g * 16 + p) = o; } };

constexpr int S5_CB = (NCH5 + 127) / 128;
__device__ __forceinline__ void phase_m1(Frame& F, int l) {
    constexpr int U_HG = NCH * 4, U_M2 = NCH * 2, U_RET = NCH * 4, U_S5 = 16 * S5_CB;
    unsigned* ctr = WSP(unsigned, WS_CTL) + CW_Q + 64 * (2 * l) + 32 * F.rep;
    constexpr int U_GG = L / 256;
    constexpr int NC = U_GG + U_HG + U_M2 + U_RET + U_S5 + 256;
    for (int u0 = grab_unit(F, ctr); u0 < NC + CONV_D_UNITS; u0 = grab_unit(F, ctr)) {
        if (u0 >= NC) { conv_d_unit(F, l, u0 - NC); continue; }
        if (u0 < U_GG) { g8::OneUnit S1{u0, NPROJ / 256 - 1, (size_t)256 * 1024 * 2, (size_t)256 * 1024 * 2}; g8::EpiStore E1{WSP(bf16, WS_BIG), NPROJ, l == 0 ? nullptr : WSP(float, WS_RSTD)};
            g8::gemm_phase(F.lds, l == 0 ? WSP(bf16, WS_ACT) : (const bf16*)F.out, WSP(bf16, WS_WIN) + (size_t)l * NPROJ * 1024, 1024, S1, E1); continue; }
        const int u = u0 - U_GG;
        if (u >= U_HG + U_M2 + U_RET + U_S5) { s5_prep_b(F, l, u - (U_HG + U_M2 + U_RET + U_S5), 256); continue; }
        if (u < U_HG) { hg_state_unit(F, l, u >> 2, u & 3); continue; }
        int r = u - U_HG;
        if (r < U_M2) { m2_state_unit(F, l, r >> 1, r & 1); continue; } r -= U_M2;
        if (r < U_RET) { ret_state_unit(F, r >> 2, r & 3); continue; } r -= U_RET;
        { const int g = r / S5_CB, cb = r % S5_CB; PtrS5A ap{WSP(bf16, WS_BIG), nullptr, g, cb * 128}; PtrRM bp{WSP(bf16, WS_S5BI) + (size_t)g * 128 * 512, 512, 127};
          EpiS5Inc e{WSP(float, WS_ST_S5), g, cb * 128}; gemm128(F.lds, 512, ap, bp, e); }
    }
}
constexpr int SL = 32;
template <int LEN, class DEC>
__device__ __forceinline__ void seg_scan_real(Frame& F0, float* base, size_t cstride, int chain0, int nchain_total, const DEC& dec) {
    Frame F = F0; LAUNDER(F);
    constexpr int NSEG = (LEN + SL - 1) / SL, CHB = NTHREADS / NSEG;
    lf32* Ts = (lf32*)F.lds; lf32* Qs = Ts + NTHREADS;
    const int ch = chain0 + (F.tid % CHB), sg = F.tid / CHB; const bool act = (F.tid < CHB * NSEG) && ch < nchain_total;
    float v[SL], d[SL]; float s = 0.f, q = 1.f;
    float* p = base + ch;
    if (act) {
#pragma unroll
        for (int j = 0; j < SL; ++j) { const int c = sg * SL + j; const bool ok = c < LEN; v[j] = ok ? __builtin_nontemporal_load(p + (size_t)c * cstride) : 0.f; d[j] = ok ? dec(ch, c) : 1.f; }
#pragma unroll
        for (int j = 0; j < SL; ++j) { s = d[j] * s + v[j]; q *= d[j]; }
        Ts[sg * CHB + (F.tid % CHB)] = s; Qs[sg * CHB + (F.tid % CHB)] = q;
    }
    __syncthreads();
    if (act) {
        float c0 = 0.f;
        for (int g = 0; g < sg; ++g) c0 = Qs[g * CHB + (F.tid % CHB)] * c0 + Ts[g * CHB + (F.tid % CHB)];
        s = c0;
#pragma unroll
        for (int j = 0; j < SL; ++j) { const int c = sg * SL + j; if (c < LEN) { p[(size_t)c * cstride] = s; s = d[j] * s + v[j]; } }
    }
}
struct DecConst { float d; __device__ __forceinline__ float operator()(int, int) const { return d; } };
struct DecM2 { const float* dc; __device__ __forceinline__ float operator()(int ch, int c) const { return dc[c * 4 + (ch >> 13)]; } };
struct DecHG { const float* dc; __device__ __forceinline__ float operator()(int ch, int c) const { return dc[(size_t)c * 256 + (ch >> 12) * 64 + (ch & 63)]; } };
template <int LEN>
__device__ __forceinline__ void seg_scan_s5(Frame& F0, int l, int chain0) {
    Frame F = F0; LAUNDER(F);
    constexpr int NSEG = (LEN + SL - 1) / SL, CHB = NTHREADS / NSEG;
    LAS f32x2* Ts = (LAS f32x2*)F.lds; LAS f32x2* Qs = Ts + NTHREADS;
    const int r = chain0 + (F.tid % CHB), sg = F.tid / CHB; const bool act = (F.tid < CHB * NSEG) && r < 1024;
    const float* ap = WSP(float, WS_S5AP) + ((size_t)l * 1024 + (act ? r : 0)) * 68 + 64; const float ar = ap[0], ai = ap[1];
    const f32x2* p = (const f32x2*)(WSP(float, WS_ST_S5) + 2 * r); bf16* qo = WSP(bf16, WS_S5UG) + (size_t)(r >> 6) * NR5 * 640 + 512 + 2 * (r & 63);
    f32x2 v[SL]; float sr = 0.f, si = 0.f, qr = 1.f, qi = 0.f;
    if (act) {
#pragma unroll
        for (int j = 0; j < SL; ++j) { const int c = sg * SL + j; v[j] = (c < LEN) ? __builtin_nontemporal_load(p + (size_t)c * 1024) : (f32x2){0.f, 0.f}; }
#pragma unroll
        for (int j = 0; j < SL; ++j) { const int c = sg * SL + j; if (c < LEN) { const float nr = ar * sr - ai * si + v[j].x, ni = ar * si + ai * sr + v[j].y; sr = nr; si = ni; const float tr = ar * qr - ai * qi, ti = ar * qi + ai * qr; qr = tr; qi = ti; } }
        Ts[sg * CHB + (F.tid % CHB)] = (f32x2){sr, si}; Qs[sg * CHB + (F.tid % CHB)] = (f32x2){qr, qi};
    }
    __syncthreads();
    if (act) {
        float cr = 0.f, ci = 0.f;
        for (int g = 0; g < sg; ++g) { const f32x2 Q = Qs[g * CHB + (F.tid % CHB)], T = Ts[g * CHB + (F.tid % CHB)]; const float nr = Q.x * cr - Q.y * ci + T.x, ni = Q.x * ci + Q.y * cr + T.y; cr = nr; ci = ni; }
        sr = cr; si = ci;
#pragma unroll
        for (int j = 0; j < SL; ++j) { const int c = sg * SL + j; if (c < LEN) { *(unsigned*)(qo + (size_t)c * 640) = pk2(sr, si); const float nr = ar * sr - ai * si + v[j].x, ni = ar * si + ai * sr + v[j].y; sr = nr; si = ni; } }
    }
}
__device__ __forceinline__ void phase_m2(Frame& F, int l) {
    constexpr int N_RET = 4 * 4096, N_M2 = 4 * 8192, N_HG = 4 * 4096, N_S5 = 16 * 64;
    constexpr int CB_R = NTHREADS / ((NCH + SL - 1) / SL), CB_H = NTHREADS / ((NCH + SL - 1) / SL), CB_S = NTHREADS / ((NCH5 + SL - 1) / SL);
    constexpr int U_S5 = (N_S5 + CB_S - 1) / CB_S, U_HG = (N_HG + CB_H - 1) / CB_H, U_M2 = (N_M2 + CB_R - 1) / CB_R, U_RET = (N_RET + CB_R - 1) / CB_R;
    unsigned* ctr = WSP(unsigned, WS_CTL) + CW_Q + 64 * (6 + l) + 32 * F.rep;
    for (int u = grab_unit(F, ctr); u < U_S5 + U_HG + U_M2 + U_RET; u = grab_unit(F, ctr)) {
        if (u < U_S5) { seg_scan_s5<NCH5>(F, l, u * CB_S); continue; }
        int r = u - U_S5;
        if (r < U_HG) { DecHG dh{WSP(float, WS_DEC_HG)}; seg_scan_real<NCH>(F, WSP(float, WS_ST_HG), 16384, r * CB_H, N_HG, dh); continue; }
        r -= U_HG;
        if (r < U_M2) { DecM2 dm{WSP(float, WS_DEC_M2)}; seg_scan_real<NCH>(F, WSP(float, WS_ST_M2), 32768, r * CB_R, N_M2, dm); continue; }
        r -= U_M2;
        { const int ch0 = r * CB_R; DecConst dcst{exp2f(128.0f * ret_log2gamma(ch0 >> 12))};
          seg_scan_real<NCH>(F, WSP(float, WS_ST_RET), 16384, ch0, N_RET, dcst); }
    }
}
struct EpiGlu { static constexpr bool HAS_PRE = true; const bf16* ypre; bf16* y; const float* bias; int r0, c0;
    struct Pre { u32x2 u; f32x4 b; };
    __device__ __forceinline__ Pre load(int r, int c) const { const int t = r0 + r, j = c0 + c; Pre p; p.u = *(const u32x2*)(ypre + (size_t)t * 256 + j); p.b = *(const f32x4*)(bias + j); return p; }
    __device__ __forceinline__ void fin(int r, int c, f32x4 v, const Pre& p) const { const int t = r0 + r, j = c0 + c; const u32x2 u = p.u; const f32x4 b = p.b;
        u32x2 o; o.x = pk2(bflo(u.x) * sigmoidf_(v.x + b.x), bfhi(u.x) * sigmoidf_(v.y + b.y)); o.y = pk2(bflo(u.y) * sigmoidf_(v.z + b.z), bfhi(u.y) * sigmoidf_(v.w + b.w));
        *(u32x2*)(y + (size_t)t * 1024 + Y_S5 + j) = o; } };
__device__ __forceinline__ void phase_m3(Frame& F, int l) {
    constexpr int U_HG = NCH * 4, U_M2 = NCH, U_RET = NCH * 4, U_S5 = 16 * (NR5 / 256) * 2;
    unsigned* ctr = WSP(unsigned, WS_CTL) + CW_Q + 64 * (2 * l + 1) + 32 * F.rep;
    constexpr int NC = U_HG + U_M2 + U_RET + U_S5, U_GLU = (L / 128) * 2;
    unsigned* dep = WSP(unsigned, WS_CTL) + CW_DEP + 16384 + l * 256 + F.rep * 128;
    for (int u0 = grab_unit(F, ctr); u0 < NC + CONV_GU_UNITS + U_GLU; u0 = grab_unit(F, ctr)) {
        if (u0 >= NC + CONV_GU_UNITS) { const int ug = u0 - (NC + CONV_GU_UNITS), pm = ug >> 1, pn = ug & 1;
            if (F.wave == 0) { const unsigned* cw = dep + ((pm * 4) / 256) * 16; unsigned spins = 0; while (ld_agent(cw) < 32u && ++spins < (1u << 22)) __builtin_amdgcn_s_sleep(1);
                __builtin_amdgcn_fence(__ATOMIC_ACQUIRE, "agent");
#ifndef EMU
                asm volatile("s_waitcnt vmcnt(0)" ::: "memory");
#endif
            }
            __syncthreads();
            PtrRM ap{WSP(bf16, WS_YPRE) + (size_t)pm * 128 * 256, 256, 127}, bp{WSP(bf16, WS_WGLU) + (size_t)l * 65536 + (size_t)pn * 128 * 256, 256, 127};
            EpiGlu e{WSP(bf16, WS_YPRE), WSP(bf16, WS_ACT), F.s5_b_glu + l * 256, pm * 128, pn * 128}; gemm128(F.lds, 256, ap, bp, e); continue; }
        if (u0 >= U_M2 + U_S5 && u0 < U_M2 + U_S5 + CONV_GU_UNITS) { conv_gu_unit(F, l, u0 - (U_M2 + U_S5)); continue; }
        const int u = u0 < U_M2 + U_S5 ? u0 : u0 - CONV_GU_UNITS;
#ifndef M3SKIP
#define M3SKIP 0
#endif
        if (u < U_M2) { if (!(M3SKIP & 2)) m2_out_unit(F, l, u); continue; }
        int r = u - U_M2;
        if (r >= U_S5) { r -= U_S5;
            if (r < U_HG) { if (!(M3SKIP & 1)) hg_out_unit(F, l, r >> 2, r & 3); continue; } r -= U_HG;
            if (!(M3SKIP & 4)) ret_out_unit(F, r >> 2, r & 3); continue; }
        if (M3SKIP & 8) continue;
        { const int g = r / (2 * (NR5 / 256)), pm = (r >> 1) % (NR5 / 256), pn = r & 1;
          g8::OneUnit S1{pm, pn, (size_t)256 * 640 * 2, (size_t)256 * 640 * 2};
          g8::EpiS5OutG E1{WSP(bf16, WS_BIG), WSP(bf16, WS_YPRE), F.s5_d + l * 256, g, NCH5, C_S5U, NPROJ};
          g8::gemm_phase(F.lds, WSP(bf16, WS_S5UG) + (size_t)g * NR5 * 640, WSP(bf16, WS_S5MT) + (size_t)g * 512 * 640, 640, S1, E1);
          if (F.tid == 0) atomicAdd(dep + pm * 16, 1u); }
    }
}

__device__ __forceinline__ void phase_g2(Frame& F, int l) {
    g8::GridOrder S{L / 256, 4, (L / 256) * 4, F.G, F.bid, (size_t)256 * 1024 * 2, (size_t)256 * 1024 * 2};
    if (l == 0) { g8::EpiResid<false> E{F.x, WSP(bf16, WS_XRES)}; g8::gemm_phase(F.lds, WSP(bf16, WS_ACT), WSP(bf16, WS_WOUT), 1024, S, E); }
    else { g8::EpiResid<true> E{F.out, WSP(bf16, WS_XRES)}; g8::gemm_phase(F.lds, WSP(bf16, WS_ACT), WSP(bf16, WS_WOUT) + (size_t)1048576, 1024, S, E); }
}

__device__ __forceinline__ void phase_r2(Frame& F, int l) {
    const int RPB = L / F.G;
    LAS f32x4* T = (LAS f32x4*)F.lds;
    li32* e_s = (li32*)(F.lds + 81920); li32* base_s = e_s + 128;
    int* hist = WSP(int, WS_HIST) + l * 256 * 16;
    const float* g2 = F.norm2_g + l * 1024; const float* wg = F.moe_w_group + (size_t)l * 4096; const float* we = F.moe_w_expert + (size_t)l * 16384;
    __syncthreads();
    for (int k = F.tid; k < 1024; k += NTHREADS) { const float g = g2[k]; const int ln = (k >> 2) & 63, a = k & 3, j = k >> 8; const int idx = (j * 4 + a) * 64 + ln;
        T[idx] = g * *(const f32x4*)(wg + (size_t)k * 4);
#pragma unroll
        for (int b = 0; b < 4; ++b) T[(b + 1) * 1024 + idx] = g * *(const f32x4*)(we + (size_t)k * 16 + 4 * b); }
    for (int rb = 0; rb < RPB; rb += 64) {
        __syncthreads();
        u32x2 xq[4];
        if (rb + F.wave * 8 < RPB) { const u32x2* x0 = (const u32x2*)(WSP(bf16, WS_XRES) + (size_t)(F.bid * RPB + rb + F.wave * 8) * D) + F.lane;
#pragma unroll
            for (int j = 0; j < 4; ++j) xq[j] = x0[64 * j]; }
        for (int rr = 0; rr < 8; ++rr) { const int ri = F.wave * 8 + rr; if (rb + ri >= RPB) break; const int t = F.bid * RPB + rb + ri; const int lane = F.lane;
            const u32x2* xr = (const u32x2*)(WSP(bf16, WS_XRES) + (size_t)t * D) + lane; float ss = 0.f; f32x4 v[4];
#pragma unroll
            for (int j = 0; j < 4; ++j) { const u32x2 xb = xq[j]; v[j] = (f32x4){bflo(xb.x), bfhi(xb.x), bflo(xb.y), bfhi(xb.y)}; ss += (v[j].x * v[j].x + v[j].y * v[j].y) + (v[j].z * v[j].z + v[j].w * v[j].w); }
            if (rr + 1 < 8 && rb + ri + 1 < RPB) {
#pragma unroll
                for (int j = 0; j < 4; ++j) xq[j] = xr[256 + 64 * j]; }
            const float rstd = frsq(wave_sum(ss) * (1.0f / D) + EPS);
            float lgg[4] = {0.f, 0.f, 0.f, 0.f};
            if (lane == 0) WSP(float, WS_RSTD)[t] = rstd;
#pragma unroll
            for (int j = 0; j < 4; ++j) {
                const float xv[4] = {v[j].x, v[j].y, v[j].z, v[j].w};
#pragma unroll
                for (int a = 0; a < 4; ++a) { const f32x4 w4 = T[(j * 4 + a) * 64 + lane]; lgg[0] += xv[a] * w4.x; lgg[1] += xv[a] * w4.y; lgg[2] += xv[a] * w4.z; lgg[3] += xv[a] * w4.w; } }
            float gl[4]; float gm = -1e30f; int gi = 0;
#pragma unroll
            for (int q = 0; q < 4; ++q) { gl[q] = wave_sum(lgg[q]) * rstd + F.moe_b_group[l * 4 + q]; if (gl[q] > gm) { gm = gl[q]; gi = q; } }
            gi = __builtin_amdgcn_readfirstlane(gi);
            float lge[4] = {0.f, 0.f, 0.f, 0.f};
            { const LAS f32x4* Te = T + (1 + gi) * 1024;
#pragma unroll
              for (int j = 0; j < 4; ++j) { const float xv[4] = {v[j].x, v[j].y, v[j].z, v[j].w};
#pragma unroll
                for (int a = 0; a < 4; ++a) { const f32x4 w4 = Te[(j * 4 + a) * 64 + lane]; lge[0] += xv[a] * w4.x; lge[1] += xv[a] * w4.y; lge[2] += xv[a] * w4.z; lge[3] += xv[a] * w4.w; } } }
            float el[4];
#pragma unroll
            for (int q = 0; q < 4; ++q) el[q] = wave_sum(lge[q]) * rstd + F.moe_b_expert[l * 16 + gi * 4 + q];
            if (lane == 0) {
                float gs = 0.f;
#pragma unroll
                for (int q = 0; q < 4; ++q) gs += fexp(gl[q] - gm);
                const float pg = 1.0f / gs;
                int i0 = 0; float m0 = el[0];
#pragma unroll
                for (int q = 1; q < 4; ++q) if (el[q] > m0) { m0 = el[q]; i0 = q; }
                int i1 = -1; float m1 = -1e30f;
#pragma unroll
                for (int q = 0; q < 4; ++q) if (q != i0 && el[q] > m1) { m1 = el[q]; i1 = q; }
                if (i1 < 0) { i1 = (i0 + 1) & 3; m1 = m0; }
                const float p1 = fexp(m1 - m0);
                const float w0 = pg / (1.0f + p1), w1 = pg * p1 / (1.0f + p1);
                int* rt = WSP(int, WS_ROUTE) + ((size_t)l * L + t) * 8; float* rtf = (float*)rt;
                rt[0] = gi * 4 + i0; rt[1] = gi * 4 + i1; rtf[4] = w0; rtf[5] = w1;
                e_s[2 * ri] = gi * 4 + i0; e_s[2 * ri + 1] = gi * 4 + i1;
            } }
        __syncthreads();
        const int nrow = (RPB - rb) < 64 ? (RPB - rb) : 64;
        li32* cnt_s = base_s;
        int my_e = -1, my_rank = 0;
        if (F.wave < 2) { const int idx = F.wave * 64 + F.lane; my_e = idx < 2 * nrow ? e_s[idx] : -1;
#pragma unroll
            for (int q = 0; q < 16; ++q) { const unsigned long long m = __ballot(my_e == q); if (my_e == q) my_rank = __builtin_popcountll(m & ((1ull << F.lane) - 1ull)); if (F.lane == 0) cnt_s[F.wave * 16 + q] = __builtin_popcountll(m); } }
        __syncthreads();
        if (F.tid < 16) hist[F.bid * 16 + F.tid] = cnt_s[F.tid] + cnt_s[16 + F.tid];
        if (F.wave < 2 && my_e >= 0) { const int idx = F.wave * 64 + F.lane; const int pos = my_rank + (F.wave == 1 ? cnt_s[my_e] : 0);
            const int t = F.bid * RPB + rb + (idx >> 1); WSP(int, WS_ROUTE)[((size_t)l * L + t) * 8 + 2 + (idx & 1)] = pos; }
    }
}
__device__ __forceinline__ int moe_tables(Frame& F, int l, li32* base_s, li32* pe_s, li32* pref_s) {
    const int* hist = WSP(int, WS_HIST) + l * 256 * 16; const int G = F.G; li32* seg_s = pref_s + 256 * 16;
    const int e = F.tid & 15, sg = F.tid >> 4, per = (G + 31) / 32;
    __syncthreads();
    for (int i = F.tid; i < G * 16; i += NTHREADS) pref_s[i] = hist[i];
    __syncthreads();
    { int run = 0; for (int b = sg * per; b < (sg + 1) * per && b < G; ++b) { const int v = pref_s[b * 16 + e]; pref_s[b * 16 + e] = run; run += v; } seg_s[sg * 16 + e] = run; }
    __syncthreads();
    if (F.tid < 16) { int run = 0; for (int g = 0; g < 32; ++g) { const int v = seg_s[g * 16 + F.tid]; seg_s[g * 16 + F.tid] = run; run += v; } base_s[16 + F.tid] = run; }
    __syncthreads();
    { const int off = seg_s[sg * 16 + e]; for (int b = sg * per; b < (sg + 1) * per && b < G; ++b) pref_s[b * 16 + e] += off; }
    if (F.tid == 0) { int tot[16];
#pragma unroll
        for (int q = 0; q < 16; ++q) tot[q] = base_s[16 + q];
        int b = 0, np = 0;
#pragma unroll
        for (int q = 0; q < 16; ++q) { base_s[q] = b; const int pp = (tot[q] + 255) >> 8; for (int i = 0; i < pp; ++i) pe_s[np++] = q; b += pp * 256; }
        base_s[16] = np; pe_s[159] = tot[0]; }
    __syncthreads();
    return base_s[16];
}
constexpr size_t WS_MOETAB = WS_LB + 2048;
__device__ __forceinline__ int moe_tables_small(Frame& F, int l, li32* base_s, li32* pe_s) {
    const int* tab = WSP(int, WS_MOETAB) + l * 256;
    __syncthreads();
    if (F.tid < 32) base_s[F.tid] = tab[F.tid];
    if (F.tid >= 32 && F.tid < 32 + 160) pe_s[F.tid - 32] = tab[F.tid];
    __syncthreads();
    return base_s[16];
}
__device__ __forceinline__ void phase_ga(Frame& F, int l) {
    li32* base_s = (li32*)F.lds; li32* pe_s = base_s + 32; li32* pref_s = pe_s + 160;
    moe_tables(F, l, base_s, pe_s, pref_s);
    if (F.bid == 0) { int* tab = WSP(int, WS_MOETAB) + l * 256; if (F.tid < 32) tab[F.tid] = base_s[F.tid]; if (F.tid >= 32 && F.tid < 32 + 160) tab[F.tid] = pe_s[F.tid - 32]; }
    const int RPB = L / F.G; int* stok = WSP(int, WS_SLOTTOK); float* srs = WSP(float, WS_SLOTRS);
    for (int t = F.bid * NTHREADS + F.tid; t < L; t += F.G * NTHREADS) { int* rt = WSP(int, WS_ROUTE) + ((size_t)l * L + t) * 8;
        typedef int i32x4_ __attribute__((ext_vector_type(4))); const i32x4_ r4 = *(const i32x4_*)rt;
        const int ob = (t / RPB) * 16; const int s0 = base_s[r4.x] + pref_s[ob + r4.x] + r4.z, s1 = base_s[r4.y] + pref_s[ob + r4.y] + r4.w;
        rt[6] = s0; rt[7] = s1; stok[s0] = t; stok[s1] = t; const float r = WSP(float, WS_RSTD)[t]; srs[s0] = r; srs[s1] = r; }
    if (F.bid == 0) {
        for (int q = F.wave; q < 16; q += 8) { const int tq = q == 0 ? pe_s[159] : base_s[16 + q]; const int lo = base_s[q] + tq, hi = base_s[q] + ((tq + 255) & ~255); for (int sl = lo + F.lane; sl < hi; sl += 64) { stok[sl] = 0; srs[sl] = 0.f; } } }
}
__device__ __forceinline__ void phase_g3(Frame& F, int l) {
    li32* base_s = (li32*)(F.lds + g8::STAGE_BYTES); li32* pe_s = base_s + 32;
    const int np = moe_tables_small(F, l, base_s, pe_s);
    g8::MoeOrderG S{np, F.G, F.bid, pe_s, WSP(int, WS_SLOTTOK), (size_t)1024 * 1024 * 2, (size_t)256 * 1024 * 2};
    g8::EpiGateUp E{WSP(bf16, WS_ACTB), (unsigned)((size_t)NSLOTP * 512 * 2), WSP(unsigned, WS_CTL) + CW_DEP + l * 4096, WSP(float, WS_SLOTRS)};
    g8::gemm_phase(F.lds, WSP(bf16, WS_XRES), WSP(bf16, WS_WGU), 1024, S, E);
}
__device__ __forceinline__ void phase_g4(Frame& F, int l) {
    li32* base_s = (li32*)(F.lds + g8::STAGE_BYTES); li32* pe_s = base_s + 32;
#ifdef EMU
    const int np = moe_tables_small(F, l, base_s, pe_s);
#else
    const int np = base_s[16];
#endif
    const int n3raw = np * 4 - 2 * F.G, n3 = (n3raw >= 0 && n3raw <= F.G / 4) ? n3raw : -1;
    const int rank = n3 < 0 ? (F.bid + F.G / 2) % F.G : (F.bid >= n3 ? F.bid - n3 : F.G - n3 + F.bid);
    g8::MoeOrderDep S{np, F.G, rank, n3, pe_s, (size_t)256 * 512 * 2, (size_t)1024 * 512 * 2, (size_t)256 * 512 * 2, WSP(unsigned, WS_CTL) + CW_DEP + l * 4096, F.wave};
    g8::EpiStore E{WSP(bf16, WS_H2G), 1024, nullptr};
    g8::gemm_phase(F.lds, WSP(bf16, WS_ACTB), WSP(bf16, WS_WD), 512, S, E);
    if (l == 0) { unsigned* ctr = WSP(unsigned, WS_CTL) + CW_Q + 64 * 5 + 32 * F.rep;
      constexpr int WU = (WCONV_ITEMS + 7) / 8;
      for (int u = grab_unit(F, ctr); u < 256 + WU; u = grab_unit(F, ctr)) { if (u < 256) s5_prep_a(F, 1, u, 256); else { const int it = (u - 256) * 8 + F.wave; if (it < WCONV_ITEMS) wconv_item(F, 1, it); } } }
}
#ifndef ONLY
#define ONLY -1
#endif
#define EN(k) (ONLY < 0 || ONLY == (k))
constexpr int NPHASE = 23;
__global__ void __launch_bounds__(NTHREADS, 2) fwd_kernel(Args a) {
#ifdef EMU
    lu8* lds = emu::ctx->lds;
#else
    __shared__ __attribute__((aligned(16))) unsigned char lds_raw[LDS_BYTES];
    lu8* lds = (lu8*)lds_raw;
#endif
    Frame F;
    F.lds = lds; F.ws = a.ws; F.out = a.out; F.tid = threadIdx.x; F.lane = F.tid & 63; F.wave = __builtin_amdgcn_readfirstlane(F.tid >> 6); F.G = gridDim.x; F.bid = blockIdx.x; F.rep = 0; F.gpar = 0;
    F.x = (const float*)a.in[0]; F.pos = (const int*)a.in[1];
    { LAS unsigned long long* tab = (LAS unsigned long long*)(lds + MISC_OFF + 256); if (F.tid < 32) tab[F.tid] = (unsigned long long)a.in[F.tid]; F.ptab = tab; }
#ifndef EMU
    volatile LAS unsigned* misc = (volatile LAS unsigned*)(lds + MISC_OFF);
    for (int u = F.tid; u < 64; u += NTHREADS) misc[u] = 0u;
#endif
    __syncthreads();
#ifndef EMU
    XcdBarrier bar = xcd_barrier_post(WSP(unsigned, WS_CTL) + CW_BAR, misc + 8);
#endif
    const Frame F00 = F;
    const int lo = a.ph_lo, hi = a.ph_hi;
#ifdef EMU
#define GRID_BAR() ((void)0)
#else
#define GRID_BAR() xcd_barrier(bar)
#endif
#ifndef REPEAT_PH
#define REPEAT_PH -1
#endif
#define PH(k, en, stmt) if (lo <= (k) && (k) < hi) { Frame F = F00; LAUNDER(F); if (EN(en)) { stmt; } if ((k) + 1 < hi && (k) != 9 && (k) != 20 && (k) != 5 && (k) != 16) GRID_BAR(); \
        if ((k) == REPEAT_PH) { Frame F = F00; LAUNDER(F); F.rep = 1; stmt; GRID_BAR(); } }
    PH(0, 10, phase_p0(F))
    PH(1, 0, phase_g1(F, 0)) PH(2, 1, phase_m1(F, 0)) PH(3, 2, phase_m2(F, 0)) PH(4, 3, phase_m3(F, 0)) PH(5, 4, (void)0)
    PH(6, 5, phase_g2(F, 0)) PH(7, 6, phase_r2(F, 0)) PH(8, 7, phase_ga(F, 0)) PH(9, 8, phase_g3(F, 0)) PH(10, 9, phase_g4(F, 0))
    PH(11, 12, r1_phase(F, 1, 1))
    PH(12, 0, phase_g1(F, 1)) PH(13, 1, phase_m1(F, 1)) PH(14, 2, phase_m2(F, 1)) PH(15, 3, phase_m3(F, 1)) PH(16, 4, (void)0)
    PH(17, 5, phase_g2(F, 1)) PH(18, 6, phase_r2(F, 1)) PH(19, 7, phase_ga(F, 1)) PH(20, 8, phase_g3(F, 1)) PH(21, 9, phase_g4(F, 1))
    PH(22, 11, r1_phase(F, 2, 0))
#undef PH
}


#ifdef STOP_AFTER
__global__ void __launch_bounds__(512) diag0(unsigned char* ws) { unsigned* flag = (unsigned*)(ws + WS_CTL) + 70000; if (threadIdx.x < 8 && blockIdx.x == 0) flag[threadIdx.x] = threadIdx.x == 1 ? 0x7fffffffu : 0u; }
__global__ void __launch_bounds__(512) diag1(const float* out, unsigned char* ws) {
    const size_t N = (size_t)L * D; const unsigned short* act = (const unsigned short*)(ws + WS_ACT); unsigned* flag = (unsigned*)(ws + WS_CTL) + 70000;
    for (size_t i = (size_t)blockIdx.x * 512 + threadIdx.x; i < N; i += (size_t)gridDim.x * 512) { if ((act[i] & 0x7F80u) == 0x7F80u) { atomicAdd(flag, 1u); atomicMin(flag + 1, (unsigned)(i >> 10)); if (((i >> 8) & 3) == 1) atomicOr(flag + 2, 1u << ((i >> 4) & 3)); } }
}
__global__ void __launch_bounds__(512) diag2(float* out, const unsigned char* ws) {
    const size_t N = (size_t)L * D; const unsigned* flag = (const unsigned*)(ws + WS_CTL) + 70000;
    const float c = DIAG_SEL == 0 ? (float)flag[0] : DIAG_SEL == 1 ? (float)flag[1] + 1.f : DIAG_SEL == 2 ? (float)flag[2] * 10.f : DIAG_SEL == 4 ? (float)flag[16] * 10.f : (float)flag[3];
    for (size_t i = (size_t)blockIdx.x * 512 + threadIdx.x; i < N; i += (size_t)gridDim.x * 512) out[i] = c;
}
#endif
#ifdef EMU
extern "C" int emu_seq() { return L; }
extern "C" size_t emu_ws_bytes() { return WS_END; }
extern "C" void emu_dump_layout(FILE* f) {
#define LO(n) fprintf(f, #n " %zu\n", (size_t)n)
    LO(WS_WIN); LO(WS_WOUT); LO(WS_WGLU); LO(WS_WGU); LO(WS_WD); LO(WS_S5MT); LO(WS_S5BI); LO(WS_S5AP); LO(WS_S5BB); LO(WS_S5KT); LO(WS_ROPE); LO(WS_DTW); LO(WS_LB); LO(WS_ACT); LO(WS_YPRE);
    LO(WS_DTRAW); LO(WS_ROUTE); LO(WS_ST_RET); LO(WS_ST_M2); LO(WS_DEC_M2); LO(WS_ST_HG); LO(WS_DEC_HG); LO(WS_ST_S5); LO(WS_SP_S5); LO(WS_BIG); LO(WS_H2G); LO(WS_ACTB); LO(WS_S5UG); LO(WS_SLOTTOK); LO(WS_END);
    fprintf(f, "CNT %zu\n", (size_t)CW_CNT * 4);
}
#endif

extern "C" void kernel_launch(void* const* d_in, const int* in_sizes, int n_in, void* d_out, int out_size, void* d_ws, size_t ws_size, hipStream_t stream) {
    static int grid = 0;
    if (grid == 0) {
        if (n_in != 32 || out_size != L * D || ws_size < WS_END) { fprintf(stderr, "kernel_launch: unexpected shapes: n_in %d out %d ws %zu (need %zu)\n", n_in, out_size, ws_size, (size_t)WS_END); grid = -1; return; }
#ifdef EMU
        grid = getenv("EMU_GRID") ? atoi(getenv("EMU_GRID")) : L / 64;
#else
        int dev = 0, cus = 0, per_cu = 0;
        (void)hipGetDevice(&dev);
        (void)hipDeviceGetAttribute(&cus, hipDeviceAttributeMultiprocessorCount, dev);
        (void)hipOccupancyMaxActiveBlocksPerMultiprocessor(&per_cu, (const void*)fwd_kernel, NTHREADS, 0);
        (void)hipGetLastError();
        grid = cus > 0 ? cus : 256;
        if (per_cu < 1) { fprintf(stderr, "kernel_launch: occupancy query says 0 blocks/CU\n"); grid = -1; return; }
        if (L % grid != 0 || L / grid > 64 || grid > 256) { fprintf(stderr, "kernel_launch: grid %d unsupported (need L %% grid == 0, L / grid <= 64, grid <= 256)\n", grid); grid = -1; return; }
#endif
    }
    if (grid < 0) return;
    (void)hipMemsetAsync((char*)d_ws + WS_CTL, 0, CTL_ZERO_BYTES, stream);
    Args a{};
    for (int i = 0; i < 32; ++i) a.in[i] = d_in[i];
    a.out = (float*)d_out; a.ws = (unsigned char*)d_ws;
#ifdef EMU
    const int nph = getenv("EMU_PHASES") ? atoi(getenv("EMU_PHASES")) : NPHASE;
    for (int ph = 0; ph < nph; ++ph) { a.ph_lo = ph; a.ph_hi = ph + 1; Args b = a; fprintf(stderr, "emu: phase %d\n", ph);
        emu::launch(dim3(grid), dim3(NTHREADS), LDS_BYTES, [b]() { fwd_kernel(b); }); }
#else
#if defined(STOP_AFTER)
    for (int ph = 0; ph < STOP_AFTER; ++ph) { a.ph_lo = ph; a.ph_hi = ph + 1; hipLaunchKernelGGL(fwd_kernel, dim3(grid), dim3(NTHREADS), 0, stream, a); }
    hipLaunchKernelGGL(diag0, dim3(1), dim3(512), 0, stream, (unsigned char*)d_ws);
    hipLaunchKernelGGL(diag1, dim3(1024), dim3(512), 0, stream, (const float*)d_out, (unsigned char*)d_ws);
    hipLaunchKernelGGL(diag2, dim3(1024), dim3(512), 0, stream, (float*)d_out, (const unsigned char*)d_ws);
#elif defined(MULTI_LAUNCH)
    for (int ph = 0; ph < NPHASE; ++ph) { a.ph_lo = ph; a.ph_hi = ph + 1; hipLaunchKernelGGL(fwd_kernel, dim3(grid), dim3(NTHREADS), 0, stream, a); }
#else
    a.ph_lo = 0; a.ph_hi = NPHASE;
    void* args[] = {&a};
    hipError_t e = hipLaunchCooperativeKernel((const void*)fwd_kernel, dim3(grid), dim3(NTHREADS), args, 0, stream);
    if (e != hipSuccess) fprintf(stderr, "cooperative launch failed: %s (grid %d)\n", hipGetErrorString(e), grid);
#endif
#endif
}
```
